# Optimizing an MI355X kernel written in HIP

```python
import jax, jax.numpy as jnp
from jax import lax
import numpy as np

D_MODEL = 1024
BATCH = 8
SEQ = 4096
DEPTH = 1

HEAD_DIM = 64
RWKV_HEADS = 8
RWKV_WIDTH = RWKV_HEADS * HEAD_DIM
ATT_Q_HEADS = 8
ATT_KV_HEADS = 2
ATT_GROUP = ATT_Q_HEADS // ATT_KV_HEADS
ATT_WIDTH = ATT_Q_HEADS * HEAD_DIM
KV_WIDTH = ATT_KV_HEADS * HEAD_DIM
WINDOW = 128
BLOCK = 128
DECAY_LORA = 32
ICLR_LORA = 32
GATE_LORA = 96
D_FF = 2816
N_BRANCH = 2
RMS_EPS = 1e-6
GN_EPS = 64e-5

RWKV_COLS = 3 * RWKV_WIDTH + DECAY_LORA + ICLR_LORA + GATE_LORA
ATT_COLS = ATT_WIDTH + 2 * KV_WIDTH
GATE_COLS = N_BRANCH * D_MODEL
IN_COLS = RWKV_COLS + ATT_COLS + GATE_COLS

kernel_name = "rwkv7_swa_sink_macaron_hybrid"


def rms_norm(x, g, eps=RMS_EPS):
    xf = x.astype(jnp.float32)
    y = xf * lax.rsqrt(jnp.mean(xf * xf, axis=-1, keepdims=True) + eps)
    return (y * g.astype(jnp.float32)).astype(x.dtype)


def swiglu(h, w_gate, w_up, w_down):
    return (jax.nn.silu(h @ w_gate) * (h @ w_up)) @ w_down


def token_shift(p):
    return jnp.pad(p, ((0, 0), (1, 0), (0, 0)))[:, :-1]


def wkv7_scan(r, w, k, v, a, b):
    Bsz, T, H, N = r.shape
    xs = tuple(jnp.moveaxis(t, 1, 0) for t in (r, w, k, v, a, b))

    def step(S, inp):
        r_t, w_t, k_t, v_t, a_t, b_t = inp
        sa = jnp.einsum('bhij,bhj->bhi', S, a_t)
        S = S * w_t[:, :, None, :] + sa[..., None] * b_t[:, :, None, :] + v_t[..., None] * k_t[:, :, None, :]
        y_t = jnp.einsum('bhij,bhj->bhi', S, r_t)
        return S, y_t

    S0 = jnp.zeros((Bsz, H, N, N), jnp.float32)
    _, ys = lax.scan(step, S0, xs)
    return jnp.moveaxis(ys, 0, 1)


def rwkv7_branch(p, mu, w0, w_lora_up, a0, a_lora_up, g_lora_up, k_k, k_a, r_k, ln_w, ln_b):
    Bsz, T, _ = p.shape
    f32 = jnp.float32
    p = p + (token_shift(p) - p) * mu
    r, k, v, xw, xa, xg = jnp.split(
        p, [RWKV_WIDTH, 2 * RWKV_WIDTH, 3 * RWKV_WIDTH,
            3 * RWKV_WIDTH + DECAY_LORA, 3 * RWKV_WIDTH + DECAY_LORA + ICLR_LORA], axis=-1)
    w_log = -jax.nn.softplus(-(w0 + jnp.tanh(xw) @ w_lora_up)) - 0.5
    decay = jnp.exp(-jnp.exp(w_log.astype(f32)))
    a = jax.nn.sigmoid(a0 + xa @ a_lora_up)
    g = jax.nn.sigmoid(xg) @ g_lora_up

    def heads(t):
        return t.reshape(Bsz, T, RWKV_HEADS, HEAD_DIM).astype(f32)

    r, k, v, decay, a = heads(r), heads(k), heads(v), heads(decay), heads(a)
    k_k = k_k.reshape(RWKV_HEADS, HEAD_DIM).astype(f32)
    k_a = k_a.reshape(RWKV_HEADS, HEAD_DIM).astype(f32)
    kk = k * k_k
    kk = kk / jnp.maximum(jnp.sqrt(jnp.sum(kk * kk, axis=-1, keepdims=True)), 1e-12)
    k = k * (1.0 + (a - 1.0) * k_a)
    y = wkv7_scan(r, decay, k, v, -kk, kk * a)
    mean = jnp.mean(y, axis=-1, keepdims=True)
    var = jnp.mean(jnp.square(y - mean), axis=-1, keepdims=True)
    y = (y - mean) * lax.rsqrt(var + GN_EPS)
    y = y * ln_w.reshape(RWKV_HEADS, HEAD_DIM).astype(f32) + ln_b.reshape(RWKV_HEADS, HEAD_DIM).astype(f32)
    bonus = jnp.sum(r * k * r_k.astype(f32), axis=-1, keepdims=True) * v
    y = (y + bonus).reshape(Bsz, T, RWKV_WIDTH) * g.astype(f32)
    return y.astype(p.dtype)


def sliding_window_attention(q, k, v, sinks):
    Bsz, T = q.shape[:2]
    nb = T // BLOCK
    f32 = jnp.float32
    qb = q.reshape(Bsz, nb, BLOCK, ATT_KV_HEADS, ATT_GROUP, HEAD_DIM)

    def with_prev(t):
        tb = t.reshape(Bsz, nb, BLOCK, ATT_KV_HEADS, HEAD_DIM)
        prev = jnp.pad(tb, ((0, 0), (1, 0), (0, 0), (0, 0), (0, 0)))[:, :-1]
        return jnp.concatenate([prev, tb], axis=2)

    kc, vc = with_prev(k), with_prev(v)
    scale = HEAD_DIM ** -0.5
    s = jnp.einsum('bnqhgd,bnkhd->bnhgqk', qb, kc).astype(f32) * scale
    qi = jnp.arange(BLOCK)[:, None]
    kj = jnp.arange(2 * BLOCK)[None, :]
    band = (kj <= qi + BLOCK) & (kj > qi + BLOCK - WINDOW)
    valid = (jnp.arange(nb)[:, None, None] > 0) | (kj >= BLOCK)[None]
    mask = (band[None] & valid)[None, :, None, None]
    s = jnp.where(mask, s, -jnp.inf)
    sink = sinks.astype(f32).reshape(1, 1, ATT_KV_HEADS, ATT_GROUP, 1, 1)
    m = jnp.maximum(jnp.max(s, axis=-1, keepdims=True), sink)
    pexp = jnp.exp(s - m)
    denom = jnp.sum(pexp, axis=-1, keepdims=True) + jnp.exp(sink - m)
    probs = (pexp / denom).astype(v.dtype)
    o = jnp.einsum('bnhgqk,bnkhd->bnqhgd', probs, vc)
    return o.reshape(Bsz, T, ATT_WIDTH)


def attention_branch(p, q_norm, k_norm, sinks):
    Bsz, T, _ = p.shape
    q, k, v = jnp.split(p, [ATT_WIDTH, ATT_WIDTH + KV_WIDTH], axis=-1)
    q = rms_norm(q.reshape(Bsz, T, ATT_Q_HEADS, HEAD_DIM), q_norm)
    k = rms_norm(k.reshape(Bsz, T, ATT_KV_HEADS, HEAD_DIM), k_norm)
    v = v.reshape(Bsz, T, ATT_KV_HEADS, HEAD_DIM)
    return sliding_window_attention(q, k, v, sinks)


def setup_inputs(seed: int = 0) -> dict:
    key = jax.random.key(seed)
    ks = iter(jax.random.split(key, 40))
    L = DEPTH

    def nrm(shape, scale):
        return jax.random.normal(next(ks), shape, jnp.float32) * scale

    def gain(shape):
        return 1.0 + nrm(shape, 0.02)

    return {
        "x": jax.random.normal(next(ks), (BATCH, SEQ, D_MODEL), jnp.float32),
        "ffn1_norm": gain((L, D_MODEL)),
        "ffn1_w_gate": nrm((L, D_MODEL, D_FF), D_MODEL ** -0.5),
        "ffn1_w_up": nrm((L, D_MODEL, D_FF), D_MODEL ** -0.5),
        "ffn1_w_down": nrm((L, D_FF, D_MODEL), D_FF ** -0.5),
        "mix_norm": gain((L, D_MODEL)),
        "w_in": nrm((L, D_MODEL, IN_COLS), D_MODEL ** -0.5),
        "rwkv_mu": jax.random.uniform(next(ks), (L, RWKV_COLS), jnp.float32),
        "rwkv_w0": jax.random.uniform(next(ks), (L, RWKV_WIDTH), jnp.float32, -6.5, -1.5),
        "rwkv_w_lora_up": nrm((L, DECAY_LORA, RWKV_WIDTH), 0.1),
        "rwkv_a0": nrm((L, RWKV_WIDTH), 0.1),
        "rwkv_a_lora_up": nrm((L, ICLR_LORA, RWKV_WIDTH), 0.1),
        "rwkv_g_lora_up": nrm((L, GATE_LORA, RWKV_WIDTH), GATE_LORA ** -0.5),
        "rwkv_k_k": 0.85 + nrm((L, RWKV_WIDTH), 0.02),
        "rwkv_k_a": gain((L, RWKV_WIDTH)),
        "rwkv_r_k": nrm((L, RWKV_HEADS, HEAD_DIM), 0.1),
        "rwkv_ln_w": gain((L, RWKV_WIDTH)),
        "rwkv_ln_b": nrm((L, RWKV_WIDTH), 0.02),
        "attn_q_norm": gain((L, HEAD_DIM)),
        "attn_k_norm": gain((L, HEAD_DIM)),
        "attn_sinks": nrm((L, ATT_Q_HEADS), 0.5),
        "w_branch_rwkv": nrm((L, RWKV_WIDTH, D_MODEL), RWKV_WIDTH ** -0.5),
        "w_branch_attn": nrm((L, ATT_WIDTH, D_MODEL), ATT_WIDTH ** -0.5),
        "w_out": nrm((L, D_MODEL, D_MODEL), D_MODEL ** -0.5),
        "ffn2_norm": gain((L, D_MODEL)),
        "ffn2_w_gate": nrm((L, D_MODEL, D_FF), D_MODEL ** -0.5),
        "ffn2_w_up": nrm((L, D_MODEL, D_FF), D_MODEL ** -0.5),
        "ffn2_w_down": nrm((L, D_FF, D_MODEL), D_FF ** -0.5),
        "final_norm": gain((L, D_MODEL)),
    }


def reference(x, ffn1_norm, ffn1_w_gate, ffn1_w_up, ffn1_w_down, mix_norm, w_in,
              rwkv_mu, rwkv_w0, rwkv_w_lora_up, rwkv_a0, rwkv_a_lora_up, rwkv_g_lora_up,
              rwkv_k_k, rwkv_k_a, rwkv_r_k, rwkv_ln_w, rwkv_ln_b,
              attn_q_norm, attn_k_norm, attn_sinks,
              w_branch_rwkv, w_branch_attn, w_out,
              ffn2_norm, ffn2_w_gate, ffn2_w_up, ffn2_w_down, final_norm):
    for l in range(DEPTH):
        x = x + 0.5 * swiglu(rms_norm(x, ffn1_norm[l]), ffn1_w_gate[l], ffn1_w_up[l], ffn1_w_down[l])
        h = rms_norm(x, mix_norm[l])
        proj = h @ w_in[l]
        p_rwkv, p_att, p_gate = jnp.split(proj, [RWKV_COLS, RWKV_COLS + ATT_COLS], axis=-1)
        y_rwkv = rwkv7_branch(p_rwkv, rwkv_mu[l], rwkv_w0[l], rwkv_w_lora_up[l], rwkv_a0[l],
                              rwkv_a_lora_up[l], rwkv_g_lora_up[l], rwkv_k_k[l], rwkv_k_a[l],
                              rwkv_r_k[l], rwkv_ln_w[l], rwkv_ln_b[l])
        y_att = attention_branch(p_att, attn_q_norm[l], attn_k_norm[l], attn_sinks[l])
        gate_rwkv, gate_att = jnp.split(jax.nn.sigmoid(p_gate), N_BRANCH, axis=-1)
        merged = gate_rwkv * (y_rwkv @ w_branch_rwkv[l]) + gate_att * (y_att @ w_branch_attn[l])
        x = x + merged @ w_out[l]
        x = x + 0.5 * swiglu(rms_norm(x, ffn2_norm[l]), ffn2_w_gate[l], ffn2_w_up[l], ffn2_w_down[l])
        x = rms_norm(x, final_norm[l])
    return x
```

```cpp
#include <hip/hip_runtime.h>
#include <hip/hip_cooperative_groups.h>
#include <cstdio>
#include <cstdint>
namespace cg = cooperative_groups;
namespace pg8 {
#define PG8_LAS __attribute__((address_space(3)))
typedef unsigned short bf16_t;
typedef short bf16x8 __attribute__((ext_vector_type(8)));
typedef float f32x4 __attribute__((ext_vector_type(4)));
typedef unsigned u32x4 __attribute__((ext_vector_type(4)));
constexpr int BM = 256, BK = 64, HALF = 128, HTB = HALF * BK * 2  , STAGE_BYTES = 8 * HTB, NXCD = 8, WGM = 8;

__host__ __device__ __forceinline__ int lds_byte(int r, int c) { const int st = (r >> 4) * 2 + (c >> 5), rr = r & 15, cc = c & 31, ob = rr * 64 + cc * 2; return st * 1024 + (ob ^ (((ob >> 9) & 1) << 5)); }
__host__ __device__ __forceinline__ void stage_rc(int b, int& R, int& C) { const int st = b / 1024, sb = b % 1024, swz = sb ^ (((sb >> 9) & 1) << 5); R = (st >> 1) * 16 + swz / 64; C = (st & 1) * 32 + (swz % 64) / 2; }
__host__ __device__ __forceinline__ int perm32(int rho) { const int n = rho >> 4, i = rho & 15; return 8 * (i >> 2) + 4 * n + (i & 3); }

struct Unit { int pm, pn; };
struct Gemm { const bf16_t* A; const bf16_t* Bt; int M, N, K; };

struct StaticOrder {
    int nM, nN, nwg, G, c;
    __host__ __device__ void init(int M, int N, int G_, int c_) { nM = M / BM; nN = N / BM; nwg = nM * nN; G = G_; c = c_; }
    __host__ __device__ bool next(int i, Unit& u) const {
        const long L = (long)i * G + c; if (L >= nwg) return false;
        int wgid = (int)L; { const int q = nwg / NXCD, r = nwg % NXCD, xcd = wgid % NXCD, off = wgid / NXCD; wgid = (xcd < r ? xcd * (q + 1) : r * (q + 1) + (xcd - r) * q) + off; }
        const int nig = WGM * nN, gid = wgid / nig, fm = gid * WGM, gsz = (nM - fm) < WGM ? (nM - fm) : WGM;
        u.pm = fm + ((wgid % nig) % gsz); u.pn = (wgid % nig) / gsz; return true;
    }
    __device__ __forceinline__ void a_ready(const Unit&) const {}
    __device__ __forceinline__ void done(const Unit&) const {}
};

__device__ __forceinline__ unsigned cvt_pk_bf16(float lo, float hi) { unsigned r; asm volatile("v_cvt_pk_bf16_f32 %0, %1, %2" : "=v"(r) : "v"(lo), "v"(hi)); return r; }
__device__ __forceinline__ u32x4 pack8(f32x4 v0, f32x4 v1) { u32x4 w; w.x = cvt_pk_bf16(v0[0], v0[1]); w.y = cvt_pk_bf16(v0[2], v0[3]); w.z = cvt_pk_bf16(v1[0], v1[1]); w.w = cvt_pk_bf16(v1[2], v1[3]); return w; }
__device__ __forceinline__ float bf_lo(unsigned u) { return __uint_as_float(u << 16); }
__device__ __forceinline__ float bf_hi(unsigned u) { return __uint_as_float(u & 0xffff0000u); }
__device__ __forceinline__ void rows_rstd(const float* part, int row0, int fq, float (&rs)[2][4]) {
#pragma unroll
    for (int ai = 0; ai < 2; ++ai)
#pragma unroll
        for (int m = 0; m < 4; ++m) { const f32x4 a = *(const f32x4*)(part + (size_t)(row0 + ai * HALF + m * 16) * 16 + 4 * fq);
            float s = (a[0] + a[1]) + (a[2] + a[3]); s += __shfl_xor(s, 16); s += __shfl_xor(s, 32);
            rs[ai][m] = 1.0f / sqrtf(s * (1.0f / 1024.0f) + 1e-6f); }
    asm volatile("" ::: "memory");
}
__device__ __forceinline__ float sigmoidf_(float x) { return 1.0f / (1.0f + __expf(-x)); }

struct EpiGU {
    static constexpr bool PERM = true, AFTER_DRAIN = false;
    bf16_t* H; const float* part;
    __device__ __forceinline__ void operator()(const f32x4 (&acc)[2][2][4][2], const Unit& u, int wr, int wc, int fr, int fq) const {
        const int row0 = u.pm * BM + wr * 64 + fr, col0 = u.pn * 128 + wc * 32 + 8 * fq;
        float rsv[2][4]; rows_rstd(part, row0, fq, rsv);
#pragma unroll
        for (int ai = 0; ai < 2; ++ai)
#pragma unroll
            for (int m = 0; m < 4; ++m) { const int row = row0 + ai * HALF + m * 16; const float rs = rsv[ai][m];
                f32x4 h0, h1;
#pragma unroll
                for (int j = 0; j < 4; ++j) { const float g0 = acc[ai][0][m][0][j] * rs, u0 = acc[ai][1][m][0][j] * rs, g1 = acc[ai][0][m][1][j] * rs, u1 = acc[ai][1][m][1][j] * rs;
                    h0[j] = g0 * u0 / (1.0f + __expf(-g0)); h1[j] = g1 * u1 / (1.0f + __expf(-g1)); }
                *(u32x4*)(H + (size_t)row * 2816 + col0) = pack8(h0, h1); asm volatile("" ::: "memory"); }
    }
};
struct EpiRes {
    static constexpr bool PERM = true, AFTER_DRAIN = false;
    const float* xin; float* xout; bf16_t* xb; float* part; float alpha;
    __device__ __forceinline__ void operator()(const f32x4 (&acc)[2][2][4][2], const Unit& u, int wr, int wc, int fr, int fq) const {
        const int row0 = u.pm * BM + wr * 64 + fr, col0 = u.pn * BM + wc * 32 + 8 * fq;
#pragma unroll
        for (int ai = 0; ai < 2; ++ai)
#pragma unroll
            for (int m = 0; m < 4; ++m) { const int row = row0 + ai * HALF + m * 16; float ss = 0.f;
#pragma unroll
                for (int bj = 0; bj < 2; ++bj) { const size_t off = (size_t)row * 1024 + col0 + bj * HALF;
                    const f32x4 r0 = *(const f32x4*)(xin + off), r1 = *(const f32x4*)(xin + off + 4);
                    const f32x4 v0 = r0 + acc[ai][bj][m][0] * alpha, v1 = r1 + acc[ai][bj][m][1] * alpha;
                    *(f32x4*)(xout + off) = v0; *(f32x4*)(xout + off + 4) = v1;
                    if (xb) *(u32x4*)(xb + off) = pack8(v0, v1);
                    ss += (v0[0] * v0[0] + v0[1] * v0[1]) + (v0[2] * v0[2] + v0[3] * v0[3]) + (v1[0] * v1[0] + v1[1] * v1[1]) + (v1[2] * v1[2] + v1[3] * v1[3]); }
                ss += __shfl_xor(ss, 16); ss += __shfl_xor(ss, 32);
                if (fq == 0) part[(size_t)row * 16 + u.pn * 4 + wc] = ss; asm volatile("" ::: "memory"); }
    }
};
struct EpiProj {
    static constexpr bool PERM = true, AFTER_DRAIN = false;
    bf16_t* rkvl; bf16_t* attq; bf16_t* attkv; const float* part;
    __device__ __forceinline__ void operator()(const f32x4 (&acc)[2][2][4][2], const Unit& u, int wr, int wc, int fr, int fq) const {
        bf16_t* base; int ldc, colt;
        if (u.pn < 7) { base = rkvl; ldc = 1792; colt = u.pn * BM; } else if (u.pn < 9) { base = attq; ldc = 512; colt = (u.pn - 7) * BM; } else { base = attkv; ldc = 256; colt = 0; }
        const int row0 = u.pm * BM + wr * 64 + fr, col0 = colt + wc * 32 + 8 * fq;
        float rsv[2][4]; rows_rstd(part, row0, fq, rsv);
#pragma unroll
        for (int ai = 0; ai < 2; ++ai)
#pragma unroll
            for (int m = 0; m < 4; ++m) { const int row = row0 + ai * HALF + m * 16; const float rs = rsv[ai][m];
#pragma unroll
                for (int bj = 0; bj < 2; ++bj) *(u32x4*)(base + (size_t)row * ldc + col0 + bj * HALF) = pack8(acc[ai][bj][m][0] * rs, acc[ai][bj][m][1] * rs); }
    }
};
struct EpiGate {
    static constexpr bool PERM = true, AFTER_DRAIN = false;
    bf16_t* gates; const float* part;
    __device__ __forceinline__ void operator()(const f32x4 (&acc)[2][2][4][2], const Unit& u, int wr, int wc, int fr, int fq) const {
        const int row0 = u.pm * BM + wr * 64 + fr, col0 = u.pn * BM + wc * 32 + 8 * fq;
        float rsv[2][4]; rows_rstd(part, row0, fq, rsv);
#pragma unroll
        for (int ai = 0; ai < 2; ++ai)
#pragma unroll
            for (int m = 0; m < 4; ++m) { const int row = row0 + ai * HALF + m * 16; const float rs = rsv[ai][m];
#pragma unroll
                for (int bj = 0; bj < 2; ++bj) { f32x4 v0, v1;
#pragma unroll
                    for (int j = 0; j < 4; ++j) { v0[j] = sigmoidf_(acc[ai][bj][m][0][j] * rs); v1[j] = sigmoidf_(acc[ai][bj][m][1][j] * rs); }
                    *(u32x4*)(gates + (size_t)row * 2048 + col0 + bj * HALF) = pack8(v0, v1); } }
    }
};
struct EpiLora {
    static constexpr bool PERM = true, AFTER_DRAIN = false;
    bf16_t* rec_lw; bf16_t* rec_a; bf16_t* g; const float* w0; const float* a0;
    template <int KIND> __device__ __forceinline__ void body(const f32x4 (&acc)[2][2][4][2], const Unit& u, int wr, int wc, int fr, int fq) const {
        const int row0 = u.pm * BM + wr * 64 + fr, col0 = (u.pn & 1) * BM + wc * 32 + 8 * fq;
#pragma unroll
        for (int ai = 0; ai < 2; ++ai)
#pragma unroll
            for (int m = 0; m < 4; ++m) { const int row = row0 + ai * HALF + m * 16; const int b = row >> 12, t = row & 4095;
#pragma unroll
                for (int bj = 0; bj < 2; ++bj) { const int c = col0 + bj * HALF; f32x4 v0 = acc[ai][bj][m][0], v1 = acc[ai][bj][m][1];
                    if (KIND != 2) { const float* bias = (KIND == 0 ? w0 : a0) + c; v0 = v0 + *(const f32x4*)bias; v1 = v1 + *(const f32x4*)(bias + 4); }
                    if (KIND == 2) { *(u32x4*)(g + (size_t)row * 512 + c) = pack8(v0, v1); }
                    else {
#pragma unroll
                        for (int j = 0; j < 4; ++j) {
                            if (KIND == 0) { const float y0 = -v0[j], y1 = -v1[j];
                                const float sp0 = fmaxf(y0, 0.f) + __logf(1.0f + __expf(-fabsf(y0))), sp1 = fmaxf(y1, 0.f) + __logf(1.0f + __expf(-fabsf(y1)));
                                v0[j] = -__expf(-sp0 - 0.5f); v1[j] = -__expf(-sp1 - 0.5f); }
                            else { v0[j] = sigmoidf_(v0[j]); v1[j] = sigmoidf_(v1[j]); } }
                        bf16_t* dst = (KIND == 0 ? rec_lw : rec_a) + ((size_t)((b * 8 + (c >> 6)) * 4096 + t)) * 64 + (c & 63);
                        *(u32x4*)dst = pack8(v0, v1); } }
                asm volatile("" ::: "memory"); }
    }
    __device__ __forceinline__ void operator()(const f32x4 (&acc)[2][2][4][2], const Unit& u, int wr, int wc, int fr, int fq) const {
        const int kind = u.pn >> 1;
        if (kind == 0) body<0>(acc, u, wr, wc, fr, fq); else if (kind == 1) body<1>(acc, u, wr, wc, fr, fq); else body<2>(acc, u, wr, wc, fr, fq);
    }
};
struct EpiBranch {
    static constexpr bool PERM = true, AFTER_DRAIN = false;
    const bf16_t* gates; bf16_t* merged; int goff;
    __device__ __forceinline__ void operator()(const f32x4 (&acc)[2][2][4][2], const Unit& u, int wr, int wc, int fr, int fq) const {
        const int row0 = u.pm * BM + wr * 64 + fr, col0 = goff + u.pn * BM + wc * 32 + 8 * fq;
#pragma unroll
        for (int ai = 0; ai < 2; ++ai)
#pragma unroll
            for (int m = 0; m < 4; ++m) { const int row = row0 + ai * HALF + m * 16;
#pragma unroll
                for (int bj = 0; bj < 2; ++bj) { const size_t off = (size_t)row * 2048 + col0 + bj * HALF; const u32x4 gq = *(const u32x4*)(gates + off);
                    f32x4 v0 = acc[ai][bj][m][0], v1 = acc[ai][bj][m][1];
                    v0[0] *= bf_lo(gq.x); v0[1] *= bf_hi(gq.x); v0[2] *= bf_lo(gq.y); v0[3] *= bf_hi(gq.y);
                    v1[0] *= bf_lo(gq.z); v1[1] *= bf_hi(gq.z); v1[2] *= bf_lo(gq.w); v1[3] *= bf_hi(gq.w);
                    *(u32x4*)(merged + off) = pack8(v0, v1); } asm volatile("" ::: "memory"); }
    }
};

template <class Epi, class Sched, bool ALIGN_EPI = false, bool SP2 = false>
__device__ __forceinline__ void gemm_phase(PG8_LAS unsigned char* lds, const Gemm g, const Sched& S, const Epi& E) {
    int tid_ = threadIdx.x; asm volatile("" : "+v"(tid_));
    const int tid = tid_, wid = __builtin_amdgcn_readfirstlane(tid >> 6), lane = tid & 63, wr = wid >> 2, wc = wid & 3, fr = lane & 15, fq = lane >> 4;
    const int K = g.K, nt = K / BK;
    unsigned voffA[2], voffB[2];
#pragma unroll
    for (int i = 0; i < 2; ++i) { int R, C; stage_rc(tid * 16 + i * 8192, R, C); const int Rb = Epi::PERM ? ((R & ~31) + perm32(R & 31)) : R;
        voffA[i] = (unsigned)(R * K + C) * 2u; voffB[i] = (unsigned)(Rb * K + C) * 2u; }
    const size_t kstep = (size_t)(BK * 2);
    const size_t hstep = (size_t)HALF * K * 2;
    const size_t tstep = 2 * hstep;
    const unsigned ldsw = (unsigned)wid * 1024u;
    const int aoff = lds_byte(wr * 64 + fr, fq * 8), boff = lds_byte(wc * 32 + fr, fq * 8);
#define PG8_SA(b, h) (((b) * 2 + (h)) * HTB)
#define PG8_SB(b, h) ((4 + (b) * 2 + (h)) * HTB)
#define PG8_STAGE(bufoff, gbase, voff) do { _Pragma("unroll") for (int _i = 0; _i < 2; ++_i) \
        __builtin_amdgcn_global_load_lds((const unsigned*)((const char*)(gbase) + (voff)[_i]), (PG8_LAS unsigned*)(lds + (bufoff) + ldsw + _i * 8192), 16, 0, 0); } while (0)
#define PG8_LDA(dst, b, h) do { _Pragma("unroll") for (int m = 0; m < 4; ++m) _Pragma("unroll") for (int k = 0; k < 2; ++k) dst[m][k] = *(const PG8_LAS bf16x8*)(lds + PG8_SA(b, h) + aoff + m * 2048 + k * 1024); } while (0)
#define PG8_LDB(dst, b, h) do { _Pragma("unroll") for (int n = 0; n < 2; ++n) _Pragma("unroll") for (int k = 0; k < 2; ++k) dst[n][k] = *(const PG8_LAS bf16x8*)(lds + PG8_SB(b, h) + boff + n * 2048 + k * 1024); } while (0)
#define PG8_MMA(ai, bj, At, Bt) do { __builtin_amdgcn_s_setprio(1); _Pragma("unroll") for (int m = 0; m < 4; ++m) _Pragma("unroll") for (int n = 0; n < 2; ++n) _Pragma("unroll") for (int k = 0; k < 2; ++k) \
        acc[ai][bj][m][n] = __builtin_amdgcn_mfma_f32_16x16x32_bf16(Bt[n][k], At[m][k], acc[ai][bj][m][n], 0, 0, 0); __builtin_amdgcn_s_setprio(0); } while (0)
#define PG8_WAIT_V(n) asm volatile("s_waitcnt vmcnt(" #n ")" ::: "memory")
#define PG8_WAIT_L(n) asm volatile("s_waitcnt lgkmcnt(" #n ")" ::: "memory")
#define PG8_BAR __builtin_amdgcn_s_barrier()
#define PG8_SCHED __builtin_amdgcn_sched_barrier(0)
    Unit cur, nxt; int ui = 0;
    if (!S.next(0, cur)) return;
    f32x4 acc[2][2][4][2];
#pragma unroll
    for (int a = 0; a < 2; ++a)
#pragma unroll
        for (int b = 0; b < 2; ++b)
#pragma unroll
            for (int m = 0; m < 4; ++m)
#pragma unroll
                for (int n = 0; n < 2; ++n) acc[a][b][m][n] = (f32x4){0.f, 0.f, 0.f, 0.f};
    bf16x8 At[4][2], B0[2][2], B1[2][2];
    const char* cA = (const char*)g.A + (size_t)cur.pm * tstep; const char* cB = (const char*)g.Bt + (size_t)cur.pn * tstep;
    S.a_ready(cur);
    if constexpr (SP2) {
        PG8_STAGE(PG8_SB(0, 0), cB, voffB); PG8_STAGE(PG8_SB(0, 1), cB + hstep, voffB); PG8_STAGE(PG8_SA(0, 0), cA, voffA); PG8_STAGE(PG8_SA(0, 1), cA + hstep, voffA);
        if (wr == 1) PG8_BAR;
        PG8_WAIT_V(2); PG8_BAR;
        PG8_STAGE(PG8_SB(1, 0), cB + kstep, voffB); PG8_STAGE(PG8_SA(1, 0), cA + kstep, voffA); PG8_STAGE(PG8_SB(1, 1), cB + hstep + kstep, voffB);
        PG8_WAIT_V(6); PG8_BAR;
    } else {
        PG8_STAGE(PG8_SB(0, 0), cB, voffB); PG8_STAGE(PG8_SA(0, 0), cA, voffA); PG8_STAGE(PG8_SB(0, 1), cB + hstep, voffB); PG8_STAGE(PG8_SA(0, 1), cA + hstep, voffA);
        if (wr == 1) PG8_BAR;
        PG8_WAIT_V(4); PG8_BAR;
        PG8_STAGE(PG8_SB(1, 0), cB + kstep, voffB); PG8_STAGE(PG8_SA(1, 0), cA + kstep, voffA); PG8_STAGE(PG8_SB(1, 1), cB + hstep + kstep, voffB);
        PG8_WAIT_V(6); PG8_BAR;
    }
    for (;;) {
        const bool has_next = S.next(ui + 1, nxt);
        const char* nA = has_next ? (const char*)g.A + (size_t)nxt.pm * tstep : cA; const char* nB = has_next ? (const char*)g.Bt + (size_t)nxt.pn * tstep : cB;
        for (int t = 0; t < nt; t += 2) {
            const bool last = (t == nt - 2);
            const char* a1 = cA + (size_t)(t + 1) * kstep;
            const char* a2 = last ? nA : cA + (size_t)(t + 2) * kstep; const char* b2 = last ? nB : cB + (size_t)(t + 2) * kstep;
            const char* a3 = a2 + kstep; const char* b3 = b2 + kstep;
            if (last && has_next) S.a_ready(nxt);
            if constexpr (SP2) {
            PG8_LDB(B0, 0, 0); PG8_LDB(B1, 0, 1); PG8_SCHED; PG8_LDA(At, 0, 0); PG8_STAGE(PG8_SA(1, 1), a1 + hstep, voffA);
            PG8_WAIT_V(8); PG8_WAIT_L(0); PG8_BAR; PG8_MMA(0, 0, At, B0); PG8_MMA(0, 1, At, B1); PG8_BAR; PG8_SCHED;
            PG8_LDA(At, 0, 1); PG8_STAGE(PG8_SB(0, 0), b2, voffB); PG8_STAGE(PG8_SB(0, 1), b2 + hstep, voffB); PG8_STAGE(PG8_SA(0, 0), a2, voffA);
            PG8_WAIT_V(8); PG8_WAIT_L(0); PG8_BAR; PG8_MMA(1, 0, At, B0); PG8_MMA(1, 1, At, B1); PG8_BAR; PG8_SCHED;
            PG8_LDB(B0, 1, 0); PG8_LDB(B1, 1, 1); PG8_SCHED; PG8_LDA(At, 1, 0); PG8_STAGE(PG8_SA(0, 1), a2 + hstep, voffA);
            PG8_WAIT_V(8); PG8_WAIT_L(0); PG8_BAR; PG8_MMA(0, 0, At, B0); PG8_MMA(0, 1, At, B1); PG8_BAR; PG8_SCHED;
            PG8_LDA(At, 1, 1); PG8_STAGE(PG8_SB(1, 0), b3, voffB); PG8_STAGE(PG8_SB(1, 1), b3 + hstep, voffB); PG8_STAGE(PG8_SA(1, 0), a3, voffA);
            PG8_WAIT_V(8); PG8_WAIT_L(0); PG8_BAR; PG8_MMA(1, 0, At, B0); PG8_MMA(1, 1, At, B1); PG8_BAR; PG8_SCHED;
            } else {
            PG8_LDB(B0, 0, 0); PG8_SCHED; PG8_LDA(At, 0, 0); PG8_STAGE(PG8_SA(1, 1), a1 + hstep, voffA);
            PG8_WAIT_L(8); PG8_BAR; PG8_WAIT_L(0); PG8_MMA(0, 0, At, B0); PG8_BAR; PG8_SCHED;
            PG8_LDB(B1, 0, 1); PG8_STAGE(PG8_SB(0, 0), b2, voffB);
            PG8_BAR; PG8_WAIT_L(0); PG8_MMA(0, 1, At, B1); PG8_BAR;
            PG8_LDA(At, 0, 1); PG8_STAGE(PG8_SA(0, 0), a2, voffA);
            PG8_BAR; PG8_WAIT_L(0); PG8_MMA(1, 0, At, B0); PG8_BAR; PG8_SCHED;
            PG8_STAGE(PG8_SB(0, 1), b2 + hstep, voffB);
            PG8_WAIT_V(6); PG8_BAR; PG8_MMA(1, 1, At, B1); PG8_BAR;
            PG8_LDB(B0, 1, 0); PG8_SCHED; PG8_LDA(At, 1, 0); PG8_STAGE(PG8_SA(0, 1), a2 + hstep, voffA);
            PG8_WAIT_L(8); PG8_BAR; PG8_WAIT_L(0); PG8_MMA(0, 0, At, B0); PG8_BAR; PG8_SCHED;
            PG8_LDB(B1, 1, 1); PG8_STAGE(PG8_SB(1, 0), b3, voffB);
            PG8_BAR; PG8_WAIT_L(0); PG8_MMA(0, 1, At, B1); PG8_BAR;
            PG8_LDA(At, 1, 1); PG8_STAGE(PG8_SA(1, 0), a3, voffA);
            PG8_BAR; PG8_WAIT_L(0); PG8_MMA(1, 0, At, B0); PG8_BAR; PG8_SCHED;
            PG8_STAGE(PG8_SB(1, 1), b3 + hstep, voffB);
            PG8_WAIT_V(6); PG8_BAR; PG8_MMA(1, 1, At, B1); PG8_BAR;
            }
        }
        if constexpr (ALIGN_EPI) { if (wr == 0) PG8_BAR; }
        if constexpr (!Epi::AFTER_DRAIN) { E(acc, cur, wr, wc, fr, fq); S.done(cur); }
        if (!has_next) break;
#pragma unroll
        for (int a = 0; a < 2; ++a)
#pragma unroll
            for (int b = 0; b < 2; ++b)
#pragma unroll
                for (int m = 0; m < 4; ++m)
#pragma unroll
                    for (int n = 0; n < 2; ++n) acc[a][b][m][n] = (f32x4){0.f, 0.f, 0.f, 0.f};
        cur = nxt; cA = nA; cB = nB; ++ui;
        if constexpr (ALIGN_EPI) { if (wr == 1) PG8_BAR; }
    }
    PG8_WAIT_V(0);
    if constexpr (!ALIGN_EPI) { if (wr == 0) PG8_BAR; }
    PG8_BAR;
    if constexpr (Epi::AFTER_DRAIN) { E.fused(acc, cur, wr, wc, fr, fq, lds, wid, lane); S.done(cur); }
#undef PG8_SA
#undef PG8_SB
#undef PG8_STAGE
#undef PG8_LDA
#undef PG8_LDB
#undef PG8_MMA
#undef PG8_WAIT_V
#undef PG8_WAIT_L
#undef PG8_BAR
#undef PG8_SCHED
}
}
constexpr int NWAVES = 8;
constexpr int BATCH = 8, T = 4096, D = 1024, M = BATCH * T, FF = 2816, NH = 8, HD = 64, INC = 4512;
constexpr float RMS_EPS = 1e-6f, GN_EPS = 64e-5f;
constexpr size_t MiB = 1u << 20;
constexpr size_t WS_PART = 1 * MiB;
constexpr size_t WS_SC = 9 * MiB;
constexpr size_t WS_WGU1 = 13 * MiB, WS_WDN1 = WS_WGU1 + 11 * MiB, WS_WGU2 = WS_WDN1 + 5632 * 1024, WS_WDN2 = WS_WGU2 + 11 * MiB;
constexpr size_t WS_WIN = WS_WDN2 + 5632 * 1024, WS_WGT = WS_WIN + 5 * MiB, WS_WLO = WS_WGT + 4 * MiB, WS_WBR = WS_WLO + 768 * 1024, WS_WBA = WS_WBR + 1 * MiB, WS_WOUT = WS_WBA + 1 * MiB;
constexpr size_t WS_XB = 62 * MiB;
constexpr size_t WS_ATTQ = 126 * MiB;
constexpr size_t WS_ATTKV = 158 * MiB;
constexpr size_t WS_RKVL = 174 * MiB;
constexpr size_t WS_G = 286 * MiB;
constexpr size_t WS_REC = 318 * MiB, REC_SLOT = 32 * MiB;
constexpr size_t WS_H = 126 * MiB;
constexpr size_t WS_YRAW = WS_RKVL;
constexpr size_t WS_MERGED = WS_RKVL;
constexpr size_t WS_GATES = WS_REC;
constexpr size_t WS_YR = WS_REC + 4 * REC_SLOT;
constexpr size_t WS_LA = WS_REC + 5 * REC_SLOT;
constexpr size_t WS_END = WS_REC + 6 * REC_SLOT;
static_assert(WS_WOUT + 4 * MiB <= WS_XB && WS_H + (size_t)M * FF * 2 <= WS_REC && WS_MERGED + (size_t)M * 2048 * 2 <= WS_REC, "ws map");
constexpr int RING_BYTES = 131072, LDS_BYTES = 147456;

#define GAS __attribute__((address_space(1)))
#define LAS __attribute__((address_space(3)))
typedef unsigned short bf16;
typedef unsigned v4u __attribute__((ext_vector_type(4)));
typedef unsigned v2u __attribute__((ext_vector_type(2)));
typedef float f32x4 __attribute__((ext_vector_type(4)));
typedef float f32x2 __attribute__((ext_vector_type(2)));
typedef short bf16x8 __attribute__((ext_vector_type(8)));
#define LDS_WAIT() asm volatile("s_waitcnt lgkmcnt(0)" ::: "memory")
__device__ __forceinline__ unsigned f2bf(float f) { unsigned u = __builtin_bit_cast(unsigned, f); return (u + 0x7fffu + ((u >> 16) & 1u)) >> 16; }
__device__ __forceinline__ unsigned pk2(float lo, float hi) { return f2bf(lo) | (f2bf(hi) << 16); }
__device__ __forceinline__ float bflo(unsigned u) { return __uint_as_float(u << 16); }
__device__ __forceinline__ float bfhi(unsigned u) { return __uint_as_float(u & 0xffff0000u); }
__device__ __forceinline__ float bf1(bf16 h) { return __uint_as_float((unsigned)h << 16); }
__device__ __forceinline__ float wave_sum(float v) {
#pragma unroll
    for (int o = 1; o < 64; o <<= 1) v += __shfl_xor(v, o);
    return v;
}
template <int CTRL> __device__ __forceinline__ float dppf(float x) { return __builtin_bit_cast(float, __builtin_amdgcn_update_dpp(0, __builtin_bit_cast(int, x), CTRL, 0xf, 0xf, false)); }
__device__ __forceinline__ float row16_sum(float x) { x += dppf<0xB1>(x); x += dppf<0x4E>(x); x += dppf<0x141>(x); x += dppf<0x140>(x); return x; }

#define RLX_AGENT __ATOMIC_RELAXED, __HIP_MEMORY_SCOPE_AGENT
#define XB_TMO      128
#define XB_XCNT(j)  (256  + 64 * (j))
#define XB_XSUB(j)  (1280 + 64 * (j))
#define XB_XGEN(j)  (2304 + 64 * (j))
#define XB_TOP      3328
#define XB_TOPGEN   3392
#define XCD_BAR_WORDS 3456
#define XB_SPIN_CAP (1u << 18)

__device__ __forceinline__ unsigned xb_ld(unsigned* p)              { return __hip_atomic_load(p, __ATOMIC_RELAXED, __HIP_MEMORY_SCOPE_AGENT); }
__device__ __forceinline__ unsigned xb_add(unsigned* p, unsigned v) { return __hip_atomic_fetch_add(p, v, __ATOMIC_RELAXED, __HIP_MEMORY_SCOPE_AGENT); }
__device__ __forceinline__ unsigned xb_xcc_id() { return (unsigned)__builtin_amdgcn_s_getreg((3 << 11) | 20) & 0xFu; }
#define XB_SPIN(cond, bar) do { unsigned _sp = 0; while (cond) { __builtin_amdgcn_s_sleep(1); \
    if ((++_sp & 255u) == 0u) { if (xb_ld(&(bar)[XB_TMO])) break; if (_sp > XB_SPIN_CAP) { atomicAdd(&(bar)[XB_TMO], 1u); break; } } } } while (0)

struct XcdBarrier {
    unsigned* bar; unsigned x;
    volatile LAS unsigned* st;
};

__device__ __forceinline__ XcdBarrier xcd_barrier_post(unsigned* bar, volatile LAS unsigned* st) {
    XcdBarrier b; b.bar = bar; b.x = xb_xcc_id(); b.st = st;
    if (threadIdx.x == 0) (void)xb_add(&bar[XB_XCNT(b.x)], 1u);
    return b;
}
__device__ __forceinline__ void xcd_barrier_complete(unsigned* bar, unsigned x, unsigned& nloc, unsigned& nx) {
    const unsigned G = gridDim.x * gridDim.y * gridDim.z;
    unsigned sum, cnt, mine, sp = 0u;
    for (;;) {
        sum = 0u; cnt = 0u; mine = 0u;
#pragma unroll
        for (unsigned j = 0; j < 16; ++j) { const unsigned c = xb_ld(&bar[XB_XCNT(j)]); sum += c; cnt += (c > 0u) ? 1u : 0u; mine = (j == x) ? c : mine; }
        if (sum == G) break;
        __builtin_amdgcn_s_sleep(1);
        if ((++sp & 255u) == 0u) { if (xb_ld(&bar[XB_TMO])) break; if (sp > XB_SPIN_CAP) { atomicAdd(&bar[XB_TMO], 1u); break; } }
    }
    nloc = mine > 0u ? mine : 1u; nx = cnt > 0u ? cnt : 1u;
}

__device__ __forceinline__ void xcd_barrier(const XcdBarrier& b) {
    asm volatile("s_waitcnt vmcnt(0)" ::: "memory");
    __syncthreads();
    if (threadIdx.x == 0) {
        unsigned* bar = b.bar;
        __builtin_amdgcn_s_waitcnt(0);
        unsigned nloc = b.st[0], nx = b.st[1];
        if (nloc == 0u) { xcd_barrier_complete(bar, b.x, nloc, nx); b.st[0] = nloc; b.st[1] = nx; }
        const unsigned old = xb_add(&bar[XB_XSUB(b.x)], 1u);
        const unsigned gen = old / nloc;
        if (old + 1u == (gen + 1u) * nloc) {
            __builtin_amdgcn_fence(__ATOMIC_RELEASE, "agent");
            asm volatile("s_waitcnt vmcnt(0)" ::: "memory");
            const unsigned og = xb_add(&bar[XB_TOP], 1u);
            const unsigned tg = og / nx;
            if (og + 1u == (tg + 1u) * nx) xb_add(&bar[XB_TOPGEN], 1u);
            else XB_SPIN(xb_ld(&bar[XB_TOPGEN]) == tg, bar);
            __builtin_amdgcn_fence(__ATOMIC_ACQUIRE, "agent");
            xb_add(&bar[XB_XGEN(b.x)], 1u);
            asm volatile("s_waitcnt vmcnt(0)" ::: "memory");
        } else {
            XB_SPIN(xb_ld(&bar[XB_XGEN(b.x)]) == gen, bar);
            __builtin_amdgcn_fence(__ATOMIC_ACQUIRE, "agent");
            asm volatile("s_waitcnt vmcnt(0)" ::: "memory");
        }
    }
    __syncthreads();
}

__device__ __forceinline__ int fresh_tid() { int t = threadIdx.x; asm volatile("" : "+v"(t)); return t; }
struct Frame {
    LAS unsigned char* lds;
    int tid, lane, wave, vcu, G;
    const float *in0, *in1, *in2, *in3, *in4, *in5, *in6, *in7, *in8, *in9, *in10, *in11, *in12, *in13, *in14, *in15, *in16, *in17, *in18, *in19, *in20, *in21, *in22, *in23, *in24, *in25, *in26, *in27, *in28; float* out; unsigned char* ws;
};

__device__ __forceinline__ void tr_item(const float* W, int ldn, int k0, int n0, bf16* WT, int ldk, int drow0, int dk0, const float* scale, int dup, LAS float* scr, int lane) {
#pragma unroll 8
    for (int i = 0; i < 32; ++i) { const int kk = 2 * i + (lane >> 5); float v = W[(size_t)(k0 + kk) * ldn + n0 + (lane & 31)]; if (scale) v *= scale[k0 + kk]; scr[kk * 33 + (lane & 31)] = v; }
    LDS_WAIT(); asm volatile("" ::: "memory");
    const int c = lane & 7;
#pragma unroll
    for (int j = 0; j < 4; ++j) { const int n = (lane >> 3) + 8 * j; const LAS float* s = scr + (8 * c) * 33 + n;
        v4u o; o.x = pk2(s[0 * 33], s[1 * 33]); o.y = pk2(s[2 * 33], s[3 * 33]); o.z = pk2(s[4 * 33], s[5 * 33]); o.w = pk2(s[6 * 33], s[7 * 33]);
        bf16* dp = WT + (size_t)(drow0 + n0 + n) * ldk + dk0 + k0 + 8 * c;
        *(GAS v4u*)dp = o; if (dup) *(GAS v4u*)(dp + dup) = o; }
    LDS_WAIT(); asm volatile("" ::: "memory");
}
__device__ __forceinline__ void p0_prologue(Frame& F) {
    LAS float* scr = (LAS float*)(F.lds + F.wave * 16384);
    unsigned char* ws = F.ws;
    const int gw = F.vcu * NWAVES + F.wave, NGW = F.G * NWAVES, lane = fresh_tid() & 63;
    constexpr int I_GU = 16 * 88, I_DN = 44 * 32, I_IN = 16 * 77, I_GT = 16 * 64, I_BR = 8 * 32, I_OUT = 16 * 32;
    constexpr int NITEMS = 4 * I_GU + 2 * I_DN + I_IN + I_GT + 2 * I_BR + I_OUT;
    for (int it = gw; it < NITEMS; it += NGW) {
        int r = it;
        if (r < 4 * I_GU) {
            const int which = r / I_GU; r -= which * I_GU; const int kb = r / 88, nb = r % 88, n0 = nb * 32;
            const float* W = which == 0 ? F.in2 : which == 1 ? F.in3 : which == 2 ? F.in25 : F.in26;
            tr_item(W, FF, kb * 64, n0, (bf16*)(ws + (which < 2 ? WS_WGU1 : WS_WGU2)), D, (n0 >> 7) * 256 + (which & 1) * 128 + (n0 & 127) - n0, 0, which < 2 ? F.in1 : F.in24, 0, scr, lane);
            continue; }
        r -= 4 * I_GU;
        if (r < 2 * I_DN) { const int which = r / I_DN; r -= which * I_DN; const int kb = r / 32, nb = r % 32;
            tr_item(which ? F.in27 : F.in4, D, kb * 64, nb * 32, (bf16*)(ws + (which ? WS_WDN2 : WS_WDN1)), FF, 0, 0, nullptr, 0, scr, lane); continue; }
        r -= 2 * I_DN;
        if (r < I_IN) { const int kb = r / 77, nb = r % 77, n0 = nb * 32;
            tr_item(F.in6, INC, kb * 64, n0, (bf16*)(ws + WS_WIN), D, n0 < 1696 ? 0 : 96, 0, F.in5, 0, scr, lane); continue; }
        r -= I_IN;
        if (r < I_GT) { const int kb = r / 64, nb = r % 64;
            tr_item(F.in6, INC, kb * 64, 2464 + nb * 32, (bf16*)(ws + WS_WGT), D, -2464, 0, F.in5, 0, scr, lane); continue; }
        r -= I_GT;
        if (r < 2 * I_BR) { const int which = r / I_BR; r -= which * I_BR; const int kb = r / 32, nb = r % 32;
            tr_item(which ? F.in22 : F.in21, D, kb * 64, nb * 32, (bf16*)(ws + (which ? WS_WBA : WS_WBR)), 512, 0, 0, nullptr, 0, scr, lane); continue; }
        r -= 2 * I_BR;
        { const int kb = r / 32, nb = r % 32; tr_item(F.in23, D, kb * 64, nb * 32, (bf16*)(ws + WS_WOUT), 2048, 0, 0, nullptr, 1024, scr, lane); }
    }
    { GAS v4u* z = (GAS v4u*)(ws + WS_WIN + (size_t)1696 * D * 2); for (int i = gw * 64 + lane; i < 12288; i += NGW * 64) z[i] = (v4u){0u, 0u, 0u, 0u}; }
    { bf16* WL = (bf16*)(ws + WS_WLO);
      for (int i = gw * 64 + lane; i < 1536 * 256; i += NGW * 64) { const int n = i >> 8, k = i & 255, grp = n >> 9, nn = n & 511; float v = 0.f;
          if (grp == 0) { if (k < 32) v = F.in9[k * 512 + nn]; } else if (grp == 1) { if (k >= 32 && k < 64) v = F.in11[(k - 32) * 512 + nn]; } else { if (k >= 64 && k < 160) v = F.in12[(k - 64) * 512 + nn]; }
          WL[i] = (bf16)f2bf(v); } }
    { const float* x = F.in0; bf16* XB = (bf16*)(ws + WS_XB); float* part = (float*)(ws + WS_PART);
      for (int m = gw; m < M; m += NGW) { const GAS f32x4* xr = (const GAS f32x4*)(x + (size_t)m * D) + lane; f32x4 v[4]; float s = 0.f;
#pragma unroll
          for (int j = 0; j < 4; ++j) { v[j] = xr[64 * j]; s += (v[j].x * v[j].x + v[j].y * v[j].y) + (v[j].z * v[j].z + v[j].w * v[j].w); }
          s = wave_sum(s);
          GAS unsigned long long* o8 = (GAS unsigned long long*)(XB + (size_t)m * D) + lane;
#pragma unroll
          for (int j = 0; j < 4; ++j) o8[64 * j] = (unsigned long long)pk2(v[j].x, v[j].y) | ((unsigned long long)pk2(v[j].z, v[j].w) << 32);
          if (lane < 16) part[(size_t)m * 16 + lane] = lane == 0 ? s : 0.f; } }
}
__device__ __forceinline__ void p4_lora_in(Frame& F) {
    const bf16* RKVL = (const bf16*)(F.ws + WS_RKVL); bf16* LA = (bf16*)(F.ws + WS_LA); const float* mu = F.in7 + 1536;
    const int gw = F.vcu * NWAVES + F.wave, NGW = F.G * NWAVES, lane = fresh_tid() & 63, c0 = 4 * lane;
    for (int m = gw; m < M; m += NGW) {
        float o[4] = {0.f, 0.f, 0.f, 0.f};
        if (c0 < 160) {
            const v2u cu = *(const GAS v2u*)(RKVL + (size_t)m * 1792 + 1536 + c0);
            v2u pu = (v2u){0u, 0u}; if ((m & (T - 1)) != 0) pu = *(const GAS v2u*)(RKVL + (size_t)(m - 1) * 1792 + 1536 + c0);
            const float cur[4] = {bflo(cu.x), bfhi(cu.x), bflo(cu.y), bfhi(cu.y)}, prv[4] = {bflo(pu.x), bfhi(pu.x), bflo(pu.y), bfhi(pu.y)};
            const f32x4 mv = *(const GAS f32x4*)(mu + c0);
#pragma unroll
            for (int j = 0; j < 4; ++j) { const float p = cur[j] + (prv[j] - cur[j]) * mv[j]; const int c = c0 + j;
                o[j] = c < 32 ? tanhf(p) : (c < 64 ? p : 1.0f / (1.0f + __expf(-p))); }
        }
        *(GAS v2u*)(LA + (size_t)m * 256 + c0) = (v2u){pk2(o[0], o[1]), pk2(o[2], o[3])};
    }
}
__device__ __forceinline__ void p6_prep(Frame& F) {
    const bf16* RKVL = (const bf16*)(F.ws + WS_RKVL); bf16* REC = (bf16*)(F.ws + WS_REC); f32x4* SC = (f32x4*)(F.ws + WS_SC);
    const float* mu = F.in7; const float* k_k = F.in13; const float* k_a = F.in14; const float* r_k = F.in15;
    constexpr size_t SL = REC_SLOT / 2;
    const int gw = F.vcu * NWAVES + F.wave, NGW = F.G * NWAVES, lane = fresh_tid() & 63;
    for (int task = gw; task < M * NH; task += NGW) {
        const int m = task >> 3, h = task & 7, b = m >> 12, t = m & (T - 1), col = h * 64 + lane;
        const bf16* cr = RKVL + (size_t)m * 1792 + col; const bool hp = t != 0;
        float r = bf1(cr[0]), k = bf1(cr[512]), v = bf1(cr[1024]);
        const float rp = hp ? bf1(cr[-1792]) : 0.f, kp = hp ? bf1(cr[512 - 1792]) : 0.f, vp = hp ? bf1(cr[1024 - 1792]) : 0.f;
        r += (rp - r) * mu[col]; k += (kp - k) * mu[512 + col]; v += (vp - v) * mu[1024 + col];
        const size_t ri = ((size_t)(b * 8 + h) * T + t) * 64 + lane;
        const float a = bf1(REC[4 * SL + ri]);
        float kk = k * k_k[col]; const float nrm = sqrtf(wave_sum(kk * kk)); kk = kk / fmaxf(nrm, 1e-12f);
        const float kn = k * (1.0f + (a - 1.0f) * k_a[col]);
        const unsigned ua = f2bf(-kk), ur = f2bf(r), uk = f2bf(kn), ub = f2bf(kk * a), uv = f2bf(v);
        const float rq = __uint_as_float(ur << 16), kq = __uint_as_float(uk << 16), bq = __uint_as_float(ub << 16);
        const float beta = wave_sum(bq * rq), kappa = wave_sum(kq * rq), bonus = wave_sum(rq * kq * r_k[col]);
        REC[1 * SL + ri] = (bf16)ua; REC[2 * SL + ri] = (bf16)ur; REC[3 * SL + ri] = (bf16)uk; REC[4 * SL + ri] = (bf16)ub; REC[5 * SL + ri] = (bf16)uv;
        if (lane == 0) SC[(size_t)(b * 8 + h) * T + t] = (f32x4){beta, kappa, bonus, 0.f};
    }
}
constexpr int KS_STRIDE = 144, VT_STRIDE = 528, ATT_KS_OFF = 0, ATT_VT_OFF = 256 * KS_STRIDE;
__device__ __forceinline__ void p6_attention(Frame& F) {
    bf16* ATTQ = (bf16*)(F.ws + WS_ATTQ); const bf16* ATTKV = (const bf16*)(F.ws + WS_ATTKV);
    const float* qn = F.in18; const float* kn = F.in19; const float* sinks = F.in20;
    LAS unsigned char* Ks = F.lds + ATT_KS_OFF; LAS unsigned char* Vt = F.lds + ATT_VT_OFF;
    const int tid = fresh_tid(), lane = tid & 63, w = F.wave, g = lane >> 4, n16 = lane & 15;
    for (int unit = F.vcu; unit < BATCH * 2 * 32; unit += F.G) {
        const int nb = unit & 31, kvh = (unit >> 5) & 1, b = unit >> 6; const int m0 = b * T + nb * 128;
#pragma unroll
        for (int i = 0; i < 4; ++i) { const int e = tid + 512 * i, key = e >> 3, dg = e & 7; const bool valid = nb > 0 || key >= 128;
            v4u ku = (v4u){0u, 0u, 0u, 0u}, vu = (v4u){0u, 0u, 0u, 0u};
            if (valid) { const bf16* src = ATTKV + (size_t)(m0 - 128 + key) * 256 + kvh * 64 + dg * 8; ku = *(const GAS v4u*)src; vu = *(const GAS v4u*)(src + 128); }
            float kf[8] = {bflo(ku.x), bfhi(ku.x), bflo(ku.y), bfhi(ku.y), bflo(ku.z), bfhi(ku.z), bflo(ku.w), bfhi(ku.w)};
            float ss = 0.f;
#pragma unroll
            for (int j = 0; j < 8; ++j) ss += kf[j] * kf[j];
            ss += __shfl_xor(ss, 1); ss += __shfl_xor(ss, 2); ss += __shfl_xor(ss, 4);
            const float rs = 1.0f / sqrtf(ss * (1.0f / 64.0f) + RMS_EPS);
#pragma unroll
            for (int j = 0; j < 8; ++j) kf[j] *= rs * kn[dg * 8 + j];
            *(LAS v4u*)(Ks + key * KS_STRIDE + dg * 16) = (v4u){pk2(kf[0], kf[1]), pk2(kf[2], kf[3]), pk2(kf[4], kf[5]), pk2(kf[6], kf[7])};
            const unsigned vv[4] = {vu.x, vu.y, vu.z, vu.w};
#pragma unroll
            for (int j = 0; j < 8; ++j) *(LAS bf16*)(Vt + (dg * 8 + j) * VT_STRIDE + key * 2) = (bf16)((vv[j >> 1] >> ((j & 1) * 16)) & 0xffffu);
        }
        __syncthreads();
        const int hq = kvh * 4 + (w >> 1), qbase = (w & 1) * 64; const float sink = sinks[hq];
        for (int qt = 0; qt < 4; ++qt) {
            const int q0 = qbase + 16 * qt, qi = q0 + n16, kt0 = q0 >> 4;
            bf16* qp = ATTQ + (size_t)(m0 + qi) * 512 + hq * 64 + 8 * g;
            const v4u qa = *(const GAS v4u*)qp, qb = *(const GAS v4u*)(qp + 32);
            float q[16] = {bflo(qa.x), bfhi(qa.x), bflo(qa.y), bfhi(qa.y), bflo(qa.z), bfhi(qa.z), bflo(qa.w), bfhi(qa.w),
                           bflo(qb.x), bfhi(qb.x), bflo(qb.y), bfhi(qb.y), bflo(qb.z), bfhi(qb.z), bflo(qb.w), bfhi(qb.w)};
            float ss = 0.f;
#pragma unroll
            for (int j = 0; j < 16; ++j) ss += q[j] * q[j];
            ss += __shfl_xor(ss, 16); ss += __shfl_xor(ss, 32);
            const float rs = 0.125f / sqrtf(ss * (1.0f / 64.0f) + RMS_EPS);
#pragma unroll
            for (int j = 0; j < 16; ++j) q[j] *= rs * qn[(j >> 3) * 32 + 8 * g + (j & 7)];
            const v4u qf0 = (v4u){pk2(q[0], q[1]), pk2(q[2], q[3]), pk2(q[4], q[5]), pk2(q[6], q[7])}, qf1 = (v4u){pk2(q[8], q[9]), pk2(q[10], q[11]), pk2(q[12], q[13]), pk2(q[14], q[15])};
            const bf16x8 bq0 = __builtin_bit_cast(bf16x8, qf0), bq1 = __builtin_bit_cast(bf16x8, qf1);
            f32x4 st[10]; float mx = -INFINITY;
#pragma unroll
            for (int i = 0; i < 10; ++i) { const int kt = kt0 + i, ktc = kt < 16 ? kt : 15;
                const LAS unsigned char* kp = Ks + (16 * ktc + n16) * KS_STRIDE + 16 * g;
                const bf16x8 a0 = *(const LAS bf16x8*)kp, a1 = *(const LAS bf16x8*)(kp + 64);
                f32x4 acc = (f32x4){0.f, 0.f, 0.f, 0.f};
                acc = __builtin_amdgcn_mfma_f32_16x16x32_bf16(a0, bq0, acc, 0, 0, 0);
                acc = __builtin_amdgcn_mfma_f32_16x16x32_bf16(a1, bq1, acc, 0, 0, 0);
#pragma unroll
                for (int r = 0; r < 4; ++r) { const int kj = 16 * kt + 4 * g + r; const bool ok = (kj > qi) && (kj <= qi + 128) && (nb > 0 || kj >= 128);
                    acc[r] = ok ? acc[r] : -INFINITY; mx = fmaxf(mx, acc[r]); }
                st[i] = acc; }
            mx = fmaxf(mx, __shfl_xor(mx, 16)); mx = fmaxf(mx, __shfl_xor(mx, 32)); mx = fmaxf(mx, sink);
            float den = 0.f;
#pragma unroll
            for (int i = 0; i < 10; ++i)
#pragma unroll
                for (int r = 0; r < 4; ++r) { const float p = __expf(st[i][r] - mx); st[i][r] = p; den += p; }
            den += __shfl_xor(den, 16); den += __shfl_xor(den, 32); den += __expf(sink - mx);
            const float inv = 1.0f / den;
            f32x4 o[4];
#pragma unroll
            for (int dt = 0; dt < 4; ++dt) o[dt] = (f32x4){0.f, 0.f, 0.f, 0.f};
#pragma unroll
            for (int j = 0; j < 5; ++j) { const int ka = kt0 + 2 * j, kb2 = ka + 1, kac = ka < 16 ? ka : 15, kbc = kb2 < 16 ? kb2 : 15;
                const v4u pu = (v4u){pk2(st[2 * j][0], st[2 * j][1]), pk2(st[2 * j][2], st[2 * j][3]), pk2(st[2 * j + 1][0], st[2 * j + 1][1]), pk2(st[2 * j + 1][2], st[2 * j + 1][3])};
                const bf16x8 pf = __builtin_bit_cast(bf16x8, pu);
#pragma unroll
                for (int dt = 0; dt < 4; ++dt) { const LAS unsigned char* vp = Vt + (16 * dt + n16) * VT_STRIDE;
                    const v2u va = *(const LAS v2u*)(vp + (16 * kac + 4 * g) * 2), vb = *(const LAS v2u*)(vp + (16 * kbc + 4 * g) * 2);
                    const bf16x8 af = __builtin_bit_cast(bf16x8, (v4u){va.x, va.y, vb.x, vb.y});
                    o[dt] = __builtin_amdgcn_mfma_f32_16x16x32_bf16(af, pf, o[dt], 0, 0, 0); } }
            bf16* op = ATTQ + (size_t)(m0 + qi) * 512 + hq * 64 + 4 * g;
#pragma unroll
            for (int dt = 0; dt < 4; ++dt) *(GAS v2u*)(op + 16 * dt) = (v2u){pk2(o[dt][0] * inv, o[dt][1] * inv), pk2(o[dt][2] * inv, o[dt][3] * inv)};
        }
        __syncthreads();
    }
}
constexpr int SC_NS = 32, SC_AW = 0, SC_WV = 16384, SC_KV = 24576, SC_BV = 32768, SC_VS = 40960, SC_YB = 49152, SC_BUF = 51200;
__device__ __forceinline__ void scan_load(Frame& F, int bh, int quarter, int t0, LAS unsigned char* buf, int lt) {
    const unsigned char* REC = F.ws + WS_REC; const f32x4* SC = (const f32x4*)(F.ws + WS_SC);
    const size_t eoff = ((size_t)bh * T + t0) * 128 + (size_t)lt * 16;
    const v4u ulw = *(const GAS v4u*)(REC + 0 * REC_SLOT + eoff), ua = *(const GAS v4u*)(REC + 1 * REC_SLOT + eoff), ur = *(const GAS v4u*)(REC + 2 * REC_SLOT + eoff),
              uk = *(const GAS v4u*)(REC + 3 * REC_SLOT + eoff), ub = *(const GAS v4u*)(REC + 4 * REC_SLOT + eoff);
    const int s = lt >> 3, e0 = 8 * (lt & 7), rp = 2 * (lt & 7);
    const unsigned uv = *(const GAS unsigned*)(REC + 5 * REC_SLOT + (((size_t)bh * T + t0 + s) * 64 + 16 * quarter + rp) * 2);
    const f32x4 sc = SC[(size_t)bh * T + t0 + s];
    const unsigned lw4[4] = {ulw.x, ulw.y, ulw.z, ulw.w}, a4[4] = {ua.x, ua.y, ua.z, ua.w}, r4[4] = {ur.x, ur.y, ur.z, ur.w}, k4[4] = {uk.x, uk.y, uk.z, uk.w}, b4[4] = {ub.x, ub.y, ub.z, ub.w};
    float w[8], av[8], wr[8], kv[8], bv[8];
#pragma unroll
    for (int i = 0; i < 4; ++i) {
        w[2 * i] = __expf(bflo(lw4[i])); w[2 * i + 1] = __expf(bfhi(lw4[i]));
        av[2 * i] = bflo(a4[i]); av[2 * i + 1] = bfhi(a4[i]);
        wr[2 * i] = w[2 * i] * bflo(r4[i]); wr[2 * i + 1] = w[2 * i + 1] * bfhi(r4[i]);
        kv[2 * i] = bflo(k4[i]); kv[2 * i + 1] = bfhi(k4[i]);
        bv[2 * i] = bflo(b4[i]); bv[2 * i + 1] = bfhi(b4[i]); }
    LAS f32x4* AW = (LAS f32x4*)(buf + SC_AW); const int q0 = e0 >> 2;
#pragma unroll
    for (int qq = 0; qq < 2; ++qq)
#pragma unroll
        for (int hh = 0; hh < 2; ++hh) { const int e = 4 * qq + 2 * hh; AW[(s * 2 + hh) * 16 + q0 + qq] = (f32x4){av[e], wr[e], av[e + 1], wr[e + 1]}; }
    LAS f32x4* WV = (LAS f32x4*)(buf + SC_WV); LAS f32x4* KV = (LAS f32x4*)(buf + SC_KV); LAS f32x4* BV = (LAS f32x4*)(buf + SC_BV);
#pragma unroll
    for (int qq = 0; qq < 2; ++qq) { const int e = 4 * qq;
        WV[s * 16 + q0 + qq] = (f32x4){w[e], w[e + 1], w[e + 2], w[e + 3]}; KV[s * 16 + q0 + qq] = (f32x4){kv[e], kv[e + 1], kv[e + 2], kv[e + 3]}; BV[s * 16 + q0 + qq] = (f32x4){bv[e], bv[e + 1], bv[e + 2], bv[e + 3]}; }
    LAS f32x4* VS = (LAS f32x4*)(buf + SC_VS); const float v0 = bflo(uv), v1 = bfhi(uv);
    VS[s * 16 + rp] = (f32x4){v0, v0 * sc.y, sc.x, 0.f}; VS[s * 16 + rp + 1] = (f32x4){v1, v1 * sc.y, sc.x, 0.f};
}
__device__ __forceinline__ void scan_flush(Frame& F, int bh, int quarter, int t0, const LAS unsigned char* buf, int lt) {
    if (lt < 128) { const int s = lt >> 2, c4 = lt & 3; const int b = bh >> 3, h = bh & 7;
        float* yraw = (float*)(F.ws + WS_YRAW);
        const f32x4 y = *(const LAS f32x4*)(buf + SC_YB + (s * 16 + 4 * c4) * 4);
        *(GAS f32x4*)(yraw + (size_t)(b * T + t0 + s) * 512 + h * 64 + 16 * quarter + 4 * c4) = y; }
}
__device__ __forceinline__ void p7_scan(Frame& F) {
    const int w = F.wave, tid = fresh_tid(), lane = tid & 63, rl = lane >> 4, q = lane & 15;
    for (int unit = F.vcu; unit < 256; unit += F.G) {
        const int bh = unit >> 2, quarter = unit & 3;
        if (w >= 4) scan_load(F, bh, quarter, 0, F.lds, tid - 256);
        __syncthreads();
        float S0 = 0.f, S1 = 0.f, S2 = 0.f, S3 = 0.f;
        for (int nb = 0; nb < T / SC_NS; ++nb) {
            LAS unsigned char* cur = F.lds + (nb & 1) * SC_BUF; LAS unsigned char* oth = F.lds + ((nb + 1) & 1) * SC_BUF;
            if (w >= 4) {
                if (nb > 0) scan_flush(F, bh, quarter, (nb - 1) * SC_NS, oth, tid - 256);
                if (nb + 1 < T / SC_NS) scan_load(F, bh, quarter, (nb + 1) * SC_NS, oth, tid - 256);
            } else {
                const LAS f32x4* AW = (const LAS f32x4*)(cur + SC_AW); const LAS f32x4* WV = (const LAS f32x4*)(cur + SC_WV); const LAS f32x4* KV = (const LAS f32x4*)(cur + SC_KV);
                const LAS f32x4* BV = (const LAS f32x4*)(cur + SC_BV); const LAS f32x4* VS = (const LAS f32x4*)(cur + SC_VS); LAS float* YB = (LAS float*)(cur + SC_YB);
                const int rowl = 4 * w + rl;
                f32x4 aw0 = AW[q], aw1 = AW[16 + q], wv = WV[q], kv = KV[q], bv = BV[q], vs = VS[rowl];
#pragma unroll 8
                for (int s = 0; s < SC_NS; ++s) {
                    const int sn = s + 1;
                    const f32x4 n_aw0 = AW[(sn * 2) * 16 + q], n_aw1 = AW[(sn * 2 + 1) * 16 + q], n_wv = WV[sn * 16 + q], n_kv = KV[sn * 16 + q], n_bv = BV[sn * 16 + q], n_vs = VS[sn * 16 + rowl];
                    __builtin_amdgcn_sched_barrier(0);
                    float sa = S0 * aw0.x; sa = fmaf(S1, aw0.z, sa); sa = fmaf(S2, aw1.x, sa); sa = fmaf(S3, aw1.z, sa);
                    float z = S0 * aw0.y; z = fmaf(S1, aw0.w, z); z = fmaf(S2, aw1.y, z); z = fmaf(S3, aw1.w, z);
                    float t0_ = fmaf(vs.x, kv.x, S0 * wv.x), t1_ = fmaf(vs.x, kv.y, S1 * wv.y), t2_ = fmaf(vs.x, kv.z, S2 * wv.z), t3_ = fmaf(vs.x, kv.w, S3 * wv.w);
                    asm volatile("" : "+v"(t0_), "+v"(t1_), "+v"(t2_), "+v"(t3_));
                    sa = row16_sum(sa); z = row16_sum(z);
                    S0 = fmaf(sa, bv.x, t0_); S1 = fmaf(sa, bv.y, t1_); S2 = fmaf(sa, bv.z, t2_); S3 = fmaf(sa, bv.w, t3_);
                    asm volatile("" : "+v"(S0), "+v"(S1), "+v"(S2), "+v"(S3));
                    YB[s * 16 + rowl] = fmaf(sa, vs.z, z) + (vs.y + vs.w);
                    aw0 = n_aw0; aw1 = n_aw1; wv = n_wv; kv = n_kv; bv = n_bv; vs = n_vs;
                }
            }
            __syncthreads();
        }
        if (w >= 4) scan_flush(F, bh, quarter, T - SC_NS, F.lds + ((T / SC_NS - 1) & 1) * SC_BUF, tid - 256);
        __syncthreads();
    }
}
__device__ __forceinline__ void p8_post(Frame& F) {
    const float* yraw = (const float*)(F.ws + WS_YRAW); const bf16* RV = (const bf16*)(F.ws + WS_REC + 5 * REC_SLOT); const f32x4* SC = (const f32x4*)(F.ws + WS_SC);
    const bf16* Gt = (const bf16*)(F.ws + WS_G); bf16* YR = (bf16*)(F.ws + WS_YR); const float* lnw = F.in16; const float* lnb = F.in17;
    const int gw = F.vcu * NWAVES + F.wave, NGW = F.G * NWAVES, lane = fresh_tid() & 63;
    for (int task = gw; task < M * NH; task += NGW) {
        const int m = task >> 3, h = task & 7, b = m >> 12, t = m & (T - 1), col = h * 64 + lane;
        const float y = yraw[(size_t)m * 512 + col];
        const float mean = wave_sum(y) * (1.0f / 64.0f), d = y - mean, var = wave_sum(d * d) * (1.0f / 64.0f);
        const float yn = d * (1.0f / sqrtf(var + GN_EPS)) * lnw[col] + lnb[col];
        const size_t ri = ((size_t)(b * 8 + h) * T + t);
        const float bonus = SC[ri].z, v = bf1(RV[ri * 64 + lane]), gt = bf1(Gt[(size_t)m * 512 + col]);
        YR[(size_t)m * 512 + col] = (bf16)f2bf((yn + bonus * v) * gt);
    }
}
__device__ __forceinline__ void p13_final(Frame& F) {
    const float* part = (const float*)(F.ws + WS_PART + 3 * 2 * MiB); const float* gn = F.in28;
    const int gw = F.vcu * NWAVES + F.wave, NGW = F.G * NWAVES, lane = fresh_tid() & 63;
    for (int m = gw; m < M; m += NGW) {
        float s = lane < 16 ? part[(size_t)m * 16 + lane] : 0.f; s = wave_sum(s);
        const float rs = 1.0f / sqrtf(s * (1.0f / 1024.0f) + RMS_EPS);
        GAS f32x4* xr = (GAS f32x4*)(F.out + (size_t)m * D) + lane; const GAS f32x4* gr = (const GAS f32x4*)gn + lane;
#pragma unroll
        for (int j = 0; j < 4; ++j) { const f32x4 v = xr[64 * j], g4 = gr[64 * j]; xr[64 * j] = v * rs * g4; }
    }
}
struct Args { const float* in[29]; float* out; unsigned char* ws; };
__global__ void __launch_bounds__(NWAVES * 64, 2) fwd_megakernel(Args args) {
    extern __shared__ __attribute__((aligned(16))) unsigned char lds[];
    cg::grid_group grid = cg::this_grid();
    Frame F;
    F.lds = (LAS unsigned char*)lds;
    F.tid = threadIdx.x; F.lane = F.tid & 63; F.wave = __builtin_amdgcn_readfirstlane(F.tid >> 6);
    F.G = gridDim.x; { const int bx = blockIdx.x; F.vcu = (F.G % 8 == 0) ? (bx % 8) * (F.G / 8) + bx / 8 : bx; }
F.in0 = args.in[0]; F.in1 = args.in[1]; F.in2 = args.in[2]; F.in3 = args.in[3]; F.in4 = args.in[4]; F.in5 = args.in[5]; F.in6 = args.in[6]; F.in7 = args.in[7]; F.in8 = args.in[8]; F.in9 = args.in[9]; F.in10 = args.in[10]; F.in11 = args.in[11]; F.in12 = args.in[12]; F.in13 = args.in[13]; F.in14 = args.in[14]; F.in15 = args.in[15]; F.in16 = args.in[16]; F.in17 = args.in[17]; F.in18 = args.in[18]; F.in19 = args.in[19]; F.in20 = args.in[20]; F.in21 = args.in[21]; F.in22 = args.in[22]; F.in23 = args.in[23]; F.in24 = args.in[24]; F.in25 = args.in[25]; F.in26 = args.in[26]; F.in27 = args.in[27]; F.in28 = args.in[28];
    F.out = args.out; F.ws = args.ws;
    unsigned char* ws = args.ws;
    bf16* XB = (bf16*)(ws + WS_XB); bf16* HB = (bf16*)(ws + WS_H);
    float* PA = (float*)(ws + WS_PART); float* PB = PA + (size_t)M * 16; float* PC = PB + (size_t)M * 16; float* PD = PC + (size_t)M * 16;
    using pg8::gemm_phase; using pg8::StaticOrder; using pg8::Gemm;
    volatile LAS unsigned* bst = (volatile LAS unsigned*)(F.lds + RING_BYTES);
    if (F.tid == 0) { bst[0] = 0u; bst[1] = 0u; }
    __syncthreads();
    XcdBarrier bar = xcd_barrier_post((unsigned*)ws, bst);
#define SYNC() xcd_barrier(bar)
#define RUN_GEMM(EPI, Aptr, Bptr, NN, KK, ...) do { Gemm g_{(const pg8::bf16_t*)(Aptr), (const pg8::bf16_t*)(Bptr), M, (NN), (KK)}; StaticOrder S_; S_.init(M, (NN), F.G, (int)blockIdx.x); \
        pg8::EPI E_{__VA_ARGS__}; gemm_phase<pg8::EPI, StaticOrder, true, true>(F.lds, g_, S_, E_); } while (0)

    p0_prologue(F); grid.sync();
    RUN_GEMM(EpiGU, XB, ws + WS_WGU1, 2 * FF, D, HB, PA); SYNC();
    RUN_GEMM(EpiRes, HB, ws + WS_WDN1, D, FF, F.in0, F.out, XB, PB, 0.5f); SYNC();
    RUN_GEMM(EpiProj, XB, ws + WS_WIN, 2560, D, (bf16*)(ws + WS_RKVL), (bf16*)(ws + WS_ATTQ), (bf16*)(ws + WS_ATTKV), PB); SYNC();
    p4_lora_in(F); SYNC();
    RUN_GEMM(EpiLora, ws + WS_LA, ws + WS_WLO, 1536, 256, (bf16*)(ws + WS_REC), (bf16*)(ws + WS_REC + 4 * REC_SLOT), (bf16*)(ws + WS_G), F.in8, F.in10); SYNC();
    p6_prep(F); p6_attention(F); SYNC();
    p7_scan(F); SYNC();
    p8_post(F); SYNC();
    RUN_GEMM(EpiGate, XB, ws + WS_WGT, 2048, D, (bf16*)(ws + WS_GATES), PB); SYNC();
    RUN_GEMM(EpiBranch, ws + WS_YR, ws + WS_WBR, D, 512, (const bf16*)(ws + WS_GATES), (bf16*)(ws + WS_MERGED), 0);
    RUN_GEMM(EpiBranch, ws + WS_ATTQ, ws + WS_WBA, D, 512, (const bf16*)(ws + WS_GATES), (bf16*)(ws + WS_MERGED), 1024); SYNC();
    RUN_GEMM(EpiRes, ws + WS_MERGED, ws + WS_WOUT, D, 2048, F.out, F.out, XB, PC, 1.0f); SYNC();
    RUN_GEMM(EpiGU, XB, ws + WS_WGU2, 2 * FF, D, HB, PC); SYNC();
    RUN_GEMM(EpiRes, HB, ws + WS_WDN2, D, FF, F.out, F.out, (bf16*)nullptr, PD, 0.5f); SYNC();
    p13_final(F);
}

extern "C" void kernel_launch(void* const* d_in, const int* in_sizes, int n_in, void* d_out, int out_size, void* d_ws, size_t ws_size, hipStream_t stream) {
    static int grid = 0;
    if (grid == 0) {
        if (n_in != 29 || in_sizes[0] != M * D || out_size != M * D || ws_size < WS_END) { fprintf(stderr, "kernel_launch: unexpected shapes (n_in %d, ws %zu)\n", n_in, ws_size); grid = -1; return; }
        int dev = 0, cus = 0, per_cu = 0;
        hipGetDevice(&dev); hipDeviceGetAttribute(&cus, hipDeviceAttributeMultiprocessorCount, dev);
        if (hipFuncSetAttribute((const void*)fwd_megakernel, hipFuncAttributeMaxDynamicSharedMemorySize, LDS_BYTES) != hipSuccess) { fprintf(stderr, "kernel_launch: hipFuncSetAttribute failed\n"); grid = -1; return; }
        hipOccupancyMaxActiveBlocksPerMultiprocessor(&per_cu, (const void*)fwd_megakernel, NWAVES * 64, LDS_BYTES);
        (void)hipGetLastError();
        if (per_cu < 1) fprintf(stderr, "kernel_launch: occupancy query says %d blocks/CU\n", per_cu);
        grid = cus;
    }
    if (grid < 0) return;
    if (hipMemsetAsync(d_ws, 0, 16384, stream) != hipSuccess) { fprintf(stderr, "kernel_launch: memset failed\n"); return; }
    Args a{};
    for (int i = 0; i < 29; ++i) a.in[i] = (const float*)d_in[i];
    a.out = (float*)d_out; a.ws = (unsigned char*)d_ws;
    void* kargs[] = {&a};
    hipError_t e = hipLaunchCooperativeKernel((const void*)fwd_megakernel, dim3(grid), dim3(NWAVES * 64), kargs, LDS_BYTES, stream);
    if (e != hipSuccess) fprintf(stderr, "kernel_launch: cooperative launch failed: %s (grid %d)\n", hipGetErrorString(e), grid);
}
```

```cpp
#include <hip/hip_runtime.h>
#include <hip/hip_cooperative_groups.h>
#include <cstdio>
#include <cstdint>
namespace cg = cooperative_groups;
namespace pg8 {
#define PG8_LAS __attribute__((address_space(3)))
typedef unsigned short bf16_t;
typedef short bf16x8 __attribute__((ext_vector_type(8)));
typedef float f32x4 __attribute__((ext_vector_type(4)));
typedef unsigned u32x4 __attribute__((ext_vector_type(4)));
constexpr int BM = 256, BK = 64, HALF = 128, HTB = HALF * BK * 2  , STAGE_BYTES = 8 * HTB, NXCD = 8, WGM = 8;

__host__ __device__ __forceinline__ int lds_byte(int r, int c) { const int st = (r >> 4) * 2 + (c >> 5), rr = r & 15, cc = c & 31, ob = rr * 64 + cc * 2; return st * 1024 + (ob ^ (((ob >> 9) & 1) << 5)); }
__host__ __device__ __forceinline__ void stage_rc(int b, int& R, int& C) { const int st = b / 1024, sb = b % 1024, swz = sb ^ (((sb >> 9) & 1) << 5); R = (st >> 1) * 16 + swz / 64; C = (st & 1) * 32 + (swz % 64) / 2; }
__host__ __device__ __forceinline__ int perm32(int rho) { const int n = rho >> 4, i = rho & 15; return 8 * (i >> 2) + 4 * n + (i & 3); }

struct Unit { int pm, pn; };
struct Gemm { const bf16_t* A; const bf16_t* Bt; int M, N, K; };

struct StaticOrder {
    int nM, nN, nwg, G, c;
    __host__ __device__ void init(int M, int N, int G_, int c_) { nM = M / BM; nN = N / BM; nwg = nM * nN; G = G_; c = c_; }
    __host__ __device__ bool next(int i, Unit& u) const {
        const long L = (long)i * G + c; if (L >= nwg) return false;
        int wgid = (int)L; { const int q = nwg / NXCD, r = nwg % NXCD, xcd = wgid % NXCD, off = wgid / NXCD; wgid = (xcd < r ? xcd * (q + 1) : r * (q + 1) + (xcd - r) * q) + off; }
        const int nig = WGM * nN, gid = wgid / nig, fm = gid * WGM, gsz = (nM - fm) < WGM ? (nM - fm) : WGM;
        u.pm = fm + ((wgid % nig) % gsz); u.pn = (wgid % nig) / gsz; return true;
    }
    __device__ __forceinline__ void a_ready(const Unit&) const {}
    __device__ __forceinline__ void done(const Unit&) const {}
};

__device__ __forceinline__ unsigned cvt_pk_bf16(float lo, float hi) { unsigned r; asm volatile("v_cvt_pk_bf16_f32 %0, %1, %2" : "=v"(r) : "v"(lo), "v"(hi)); return r; }
__device__ __forceinline__ u32x4 pack8(f32x4 v0, f32x4 v1) { u32x4 w; w.x = cvt_pk_bf16(v0[0], v0[1]); w.y = cvt_pk_bf16(v0[2], v0[3]); w.z = cvt_pk_bf16(v1[0], v1[1]); w.w = cvt_pk_bf16(v1[2], v1[3]); return w; }
__device__ __forceinline__ float bf_lo(unsigned u) { return __uint_as_float(u << 16); }
__device__ __forceinline__ float bf_hi(unsigned u) { return __uint_as_float(u & 0xffff0000u); }
__device__ __forceinline__ void rows_rstd(const float* part, int row0, int fq, float (&rs)[2][4]) {
#pragma unroll
    for (int ai = 0; ai < 2; ++ai)
#pragma unroll
        for (int m = 0; m < 4; ++m) { const f32x4 a = *(const f32x4*)(part + (size_t)(row0 + ai * HALF + m * 16) * 16 + 4 * fq);
            float s = (a[0] + a[1]) + (a[2] + a[3]); s += __shfl_xor(s, 16); s += __shfl_xor(s, 32);
            rs[ai][m] = 1.0f / sqrtf(s * (1.0f / 1024.0f) + 1e-6f); }
    asm volatile("" ::: "memory");
}
__device__ __forceinline__ float sigmoidf_(float x) { return 1.0f / (1.0f + __expf(-x)); }

struct EpiGU {
    static constexpr bool PERM = true, AFTER_DRAIN = false;
    bf16_t* H; const float* part;
    __device__ __forceinline__ void operator()(const f32x4 (&acc)[2][2][4][2], const Unit& u, int wr, int wc, int fr, int fq) const {
        const int row0 = u.pm * BM + wr * 64 + fr, col0 = u.pn * 128 + wc * 32 + 8 * fq;
        float rsv[2][4]; rows_rstd(part, row0, fq, rsv);
#pragma unroll
        for (int ai = 0; ai < 2; ++ai)
#pragma unroll
            for (int m = 0; m < 4; ++m) { const int row = row0 + ai * HALF + m * 16; const float rs = rsv[ai][m];
                f32x4 h0, h1;
#pragma unroll
                for (int j = 0; j < 4; ++j) { const float g0 = acc[ai][0][m][0][j] * rs, u0 = acc[ai][1][m][0][j] * rs, g1 = acc[ai][0][m][1][j] * rs, u1 = acc[ai][1][m][1][j] * rs;
                    h0[j] = g0 * u0 / (1.0f + __expf(-g0)); h1[j] = g1 * u1 / (1.0f + __expf(-g1)); }
                *(u32x4*)(H + (size_t)row * 2816 + col0) = pack8(h0, h1); asm volatile("" ::: "memory"); }
    }
};
struct EpiRes {
    static constexpr bool PERM = true, AFTER_DRAIN = false;
    const float* xin; float* xout; bf16_t* xb; float* part; float alpha;
    __device__ __forceinline__ void operator()(const f32x4 (&acc)[2][2][4][2], const Unit& u, int wr, int wc, int fr, int fq) const {
        const int row0 = u.pm * BM + wr * 64 + fr, col0 = u.pn * BM + wc * 32 + 8 * fq;
#pragma unroll
        for (int ai = 0; ai < 2; ++ai)
#pragma unroll
            for (int m = 0; m < 4; ++m) { const int row = row0 + ai * HALF + m * 16; float ss = 0.f;
#pragma unroll
                for (int bj = 0; bj < 2; ++bj) { const size_t off = (size_t)row * 1024 + col0 + bj * HALF;
                    const f32x4 r0 = *(const f32x4*)(xin + off), r1 = *(const f32x4*)(xin + off + 4);
                    const f32x4 v0 = r0 + acc[ai][bj][m][0] * alpha, v1 = r1 + acc[ai][bj][m][1] * alpha;
                    *(f32x4*)(xout + off) = v0; *(f32x4*)(xout + off + 4) = v1;
                    if (xb) *(u32x4*)(xb + off) = pack8(v0, v1);
                    ss += (v0[0] * v0[0] + v0[1] * v0[1]) + (v0[2] * v0[2] + v0[3] * v0[3]) + (v1[0] * v1[0] + v1[1] * v1[1]) + (v1[2] * v1[2] + v1[3] * v1[3]); }
                ss += __shfl_xor(ss, 16); ss += __shfl_xor(ss, 32);
                if (fq == 0) part[(size_t)row * 16 + u.pn * 4 + wc] = ss; asm volatile("" ::: "memory"); }
    }
};
struct EpiProj {
    static constexpr bool PERM = true, AFTER_DRAIN = false;
    bf16_t* rkvl; bf16_t* attq; bf16_t* attkv; const float* part;
    __device__ __forceinline__ void operator()(const f32x4 (&acc)[2][2][4][2], const Unit& u, int wr, int wc, int fr, int fq) const {
        bf16_t* base; int ldc, colt;
        if (u.pn < 7) { base = rkvl; ldc = 1792; colt = u.pn * BM; } else if (u.pn < 9) { base = attq; ldc = 512; colt = (u.pn - 7) * BM; } else { base = attkv; ldc = 256; colt = 0; }
        const int row0 = u.pm * BM + wr * 64 + fr, col0 = colt + wc * 32 + 8 * fq;
        float rsv[2][4]; rows_rstd(part, row0, fq, rsv);
#pragma unroll
        for (int ai = 0; ai < 2; ++ai)
#pragma unroll
            for (int m = 0; m < 4; ++m) { const int row = row0 + ai * HALF + m * 16; const float rs = rsv[ai][m];
#pragma unroll
                for (int bj = 0; bj < 2; ++bj) *(u32x4*)(base + (size_t)row * ldc + col0 + bj * HALF) = pack8(acc[ai][bj][m][0] * rs, acc[ai][bj][m][1] * rs); }
    }
};
struct EpiGate {
    static constexpr bool PERM = true, AFTER_DRAIN = false;
    bf16_t* gates; const float* part;
    __device__ __forceinline__ void operator()(const f32x4 (&acc)[2][2][4][2], const Unit& u, int wr, int wc, int fr, int fq) const {
        const int row0 = u.pm * BM + wr * 64 + fr, col0 = u.pn * BM + wc * 32 + 8 * fq;
        float rsv[2][4]; rows_rstd(part, row0, fq, rsv);
#pragma unroll
        for (int ai = 0; ai < 2; ++ai)
#pragma unroll
            for (int m = 0; m < 4; ++m) { const int row = row0 + ai * HALF + m * 16; const float rs = rsv[ai][m];
#pragma unroll
                for (int bj = 0; bj < 2; ++bj) { f32x4 v0, v1;
#pragma unroll
                    for (int j = 0; j < 4; ++j) { v0[j] = sigmoidf_(acc[ai][bj][m][0][j] * rs); v1[j] = sigmoidf_(acc[ai][bj][m][1][j] * rs); }
                    *(u32x4*)(gates + (size_t)row * 2048 + col0 + bj * HALF) = pack8(v0, v1); } }
    }
};
struct EpiLora {
    static constexpr bool PERM = true, AFTER_DRAIN = false;
    bf16_t* rec_lw; bf16_t* rec_a; bf16_t* g; const float* w0; const float* a0;
    template <int KIND> __device__ __forceinline__ void body(const f32x4 (&acc)[2][2][4][2], const Unit& u, int wr, int wc, int fr, int fq) const {
        const int row0 = u.pm * BM + wr * 64 + fr, col0 = (u.pn & 1) * BM + wc * 32 + 8 * fq;
#pragma unroll
        for (int ai = 0; ai < 2; ++ai)
#pragma unroll
            for (int m = 0; m < 4; ++m) { const int row = row0 + ai * HALF + m * 16; const int b = row >> 12, t = row & 4095;
#pragma unroll
                for (int bj = 0; bj < 2; ++bj) { const int c = col0 + bj * HALF; f32x4 v0 = acc[ai][bj][m][0], v1 = acc[ai][bj][m][1];
                    if (KIND != 2) { const float* bias = (KIND == 0 ? w0 : a0) + c; v0 = v0 + *(const f32x4*)bias; v1 = v1 + *(const f32x4*)(bias + 4); }
                    if (KIND == 2) { *(u32x4*)(g + (size_t)row * 512 + c) = pack8(v0, v1); }
                    else {
#pragma unroll
                        for (int j = 0; j < 4; ++j) {
                            if (KIND == 0) { const float y0 = -v0[j], y1 = -v1[j];
                                const float sp0 = fmaxf(y0, 0.f) + __logf(1.0f + __expf(-fabsf(y0))), sp1 = fmaxf(y1, 0.f) + __logf(1.0f + __expf(-fabsf(y1)));
                                v0[j] = -__expf(-sp0 - 0.5f); v1[j] = -__expf(-sp1 - 0.5f); }
                            else { v0[j] = sigmoidf_(v0[j]); v1[j] = sigmoidf_(v1[j]); } }
                        bf16_t* dst = (KIND == 0 ? rec_lw : rec_a) + ((size_t)((b * 8 + (c >> 6)) * 4096 + t)) * 64 + (c & 63);
                        *(u32x4*)dst = pack8(v0, v1); } }
                asm volatile("" ::: "memory"); }
    }
    __device__ __forceinline__ void operator()(const f32x4 (&acc)[2][2][4][2], const Unit& u, int wr, int wc, int fr, int fq) const {
        const int kind = u.pn >> 1;
        if (kind == 0) body<0>(acc, u, wr, wc, fr, fq); else if (kind == 1) body<1>(acc, u, wr, wc, fr, fq); else body<2>(acc, u, wr, wc, fr, fq);
    }
};
struct EpiBranch {
    static constexpr bool PERM = true, AFTER_DRAIN = false;
    const bf16_t* gates; bf16_t* merged; int goff;
    __device__ __forceinline__ void operator()(const f32x4 (&acc)[2][2][4][2], const Unit& u, int wr, int wc, int fr, int fq) const {
        const int row0 = u.pm * BM + wr * 64 + fr, col0 = goff + u.pn * BM + wc * 32 + 8 * fq;
#pragma unroll
        for (int ai = 0; ai < 2; ++ai)
#pragma unroll
            for (int m = 0; m < 4; ++m) { const int row = row0 + ai * HALF + m * 16;
#pragma unroll
                for (int bj = 0; bj < 2; ++bj) { const size_t off = (size_t)row * 2048 + col0 + bj * HALF; const u32x4 gq = *(const u32x4*)(gates + off);
                    f32x4 v0 = acc[ai][bj][m][0], v1 = acc[ai][bj][m][1];
                    v0[0] *= bf_lo(gq.x); v0[1] *= bf_hi(gq.x); v0[2] *= bf_lo(gq.y); v0[3] *= bf_hi(gq.y);
                    v1[0] *= bf_lo(gq.z); v1[1] *= bf_hi(gq.z); v1[2] *= bf_lo(gq.w); v1[3] *= bf_hi(gq.w);
                    *(u32x4*)(merged + off) = pack8(v0, v1); } asm volatile("" ::: "memory"); }
    }
};

template <class Epi, class Sched, bool ALIGN_EPI = false, bool SP2 = false>
__device__ __forceinline__ void gemm_phase(PG8_LAS unsigned char* lds, const Gemm g, const Sched& S, const Epi& E) {
    int tid_ = threadIdx.x; asm volatile("" : "+v"(tid_));
    const int tid = tid_, wid = __builtin_amdgcn_readfirstlane(tid >> 6), lane = tid & 63, wr = wid >> 2, wc = wid & 3, fr = lane & 15, fq = lane >> 4;
    const int K = g.K, nt = K / BK;
    unsigned voffA[2], voffB[2];
#pragma unroll
    for (int i = 0; i < 2; ++i) { int R, C; stage_rc(tid * 16 + i * 8192, R, C); const int Rb = Epi::PERM ? ((R & ~31) + perm32(R & 31)) : R;
        voffA[i] = (unsigned)(R * K + C) * 2u; voffB[i] = (unsigned)(Rb * K + C) * 2u; }
    const size_t kstep = (size_t)(BK * 2);
    const size_t hstep = (size_t)HALF * K * 2;
    const size_t tstep = 2 * hstep;
    const unsigned ldsw = (unsigned)wid * 1024u;
    const int aoff = lds_byte(wr * 64 + fr, fq * 8), boff = lds_byte(wc * 32 + fr, fq * 8);
#define PG8_SA(b, h) (((b) * 2 + (h)) * HTB)
#define PG8_SB(b, h) ((4 + (b) * 2 + (h)) * HTB)
#define PG8_STAGE(bufoff, gbase, voff) do { _Pragma("unroll") for (int _i = 0; _i < 2; ++_i) \
        __builtin_amdgcn_global_load_lds((const unsigned*)((const char*)(gbase) + (voff)[_i]), (PG8_LAS unsigned*)(lds + (bufoff) + ldsw + _i * 8192), 16, 0, 0); } while (0)
#define PG8_LDA(dst, b, h) do { _Pragma("unroll") for (int m = 0; m < 4; ++m) _Pragma("unroll") for (int k = 0; k < 2; ++k) dst[m][k] = *(const PG8_LAS bf16x8*)(lds + PG8_SA(b, h) + aoff + m * 2048 + k * 1024); } while (0)
#define PG8_LDB(dst, b, h) do { _Pragma("unroll") for (int n = 0; n < 2; ++n) _Pragma("unroll") for (int k = 0; k < 2; ++k) dst[n][k] = *(const PG8_LAS bf16x8*)(lds + PG8_SB(b, h) + boff + n * 2048 + k * 1024); } while (0)
#define PG8_MMA(ai, bj, At, Bt) do { __builtin_amdgcn_s_setprio(1); _Pragma("unroll") for (int m = 0; m < 4; ++m) _Pragma("unroll") for (int n = 0; n < 2; ++n) _Pragma("unroll") for (int k = 0; k < 2; ++k) \
        acc[ai][bj][m][n] = __builtin_amdgcn_mfma_f32_16x16x32_bf16(Bt[n][k], At[m][k], acc[ai][bj][m][n], 0, 0, 0); __builtin_amdgcn_s_setprio(0); } while (0)
#define PG8_WAIT_V(n) asm volatile("s_waitcnt vmcnt(" #n ")" ::: "memory")
#define PG8_WAIT_L(n) asm volatile("s_waitcnt lgkmcnt(" #n ")" ::: "memory")
#define PG8_BAR __builtin_amdgcn_s_barrier()
#define PG8_SCHED __builtin_amdgcn_sched_barrier(0)
    Unit cur, nxt; int ui = 0;
    if (!S.next(0, cur)) return;
    f32x4 acc[2][2][4][2];
#pragma unroll
    for (int a = 0; a < 2; ++a)
#pragma unroll
        for (int b = 0; b < 2; ++b)
#pragma unroll
            for (int m = 0; m < 4; ++m)
#pragma unroll
                for (int n = 0; n < 2; ++n) acc[a][b][m][n] = (f32x4){0.f, 0.f, 0.f, 0.f};
    bf16x8 At[4][2], B0[2][2], B1[2][2];
    const char* cA = (const char*)g.A + (size_t)cur.pm * tstep; const char* cB = (const char*)g.Bt + (size_t)cur.pn * tstep;
    S.a_ready(cur);
    if constexpr (SP2) {
        PG8_STAGE(PG8_SB(0, 0), cB, voffB); PG8_STAGE(PG8_SB(0, 1), cB + hstep, voffB); PG8_STAGE(PG8_SA(0, 0), cA, voffA); PG8_STAGE(PG8_SA(0, 1), cA + hstep, voffA);
        if (wr == 1) PG8_BAR;
        PG8_WAIT_V(2); PG8_BAR;
        PG8_STAGE(PG8_SB(1, 0), cB + kstep, voffB); PG8_STAGE(PG8_SA(1, 0), cA + kstep, voffA); PG8_STAGE(PG8_SB(1, 1), cB + hstep + kstep, voffB);
        PG8_WAIT_V(6); PG8_BAR;
    } else {
        PG8_STAGE(PG8_SB(0, 0), cB, voffB); PG8_STAGE(PG8_SA(0, 0), cA, voffA); PG8_STAGE(PG8_SB(0, 1), cB + hstep, voffB); PG8_STAGE(PG8_SA(0, 1), cA + hstep, voffA);
        if (wr == 1) PG8_BAR;
        PG8_WAIT_V(4); PG8_BAR;
        PG8_STAGE(PG8_SB(1, 0), cB + kstep, voffB); PG8_STAGE(PG8_SA(1, 0), cA + kstep, voffA); PG8_STAGE(PG8_SB(1, 1), cB + hstep + kstep, voffB);
        PG8_WAIT_V(6); PG8_BAR;
    }
    for (;;) {
        const bool has_next = S.next(ui + 1, nxt);
        const char* nA = has_next ? (const char*)g.A + (size_t)nxt.pm * tstep : cA; const char* nB = has_next ? (const char*)g.Bt + (size_t)nxt.pn * tstep : cB;
        for (int t = 0; t < nt; t += 2) {
            const bool last = (t == nt - 2);
            const char* a1 = cA + (size_t)(t + 1) * kstep;
            const char* a2 = last ? nA : cA + (size_t)(t + 2) * kstep; const char* b2 = last ? nB : cB + (size_t)(t + 2) * kstep;
            const char* a3 = a2 + kstep; const char* b3 = b2 + kstep;
            if (last && has_next) S.a_ready(nxt);
            if constexpr (SP2) {
            PG8_LDB(B0, 0, 0); PG8_LDB(B1, 0, 1); PG8_SCHED; PG8_LDA(At, 0, 0); PG8_STAGE(PG8_SA(1, 1), a1 + hstep, voffA);
            PG8_WAIT_V(8); PG8_WAIT_L(0); PG8_BAR; PG8_MMA(0, 0, At, B0); PG8_MMA(0, 1, At, B1); PG8_BAR; PG8_SCHED;
            PG8_LDA(At, 0, 1); PG8_STAGE(PG8_SB(0, 0), b2, voffB); PG8_STAGE(PG8_SB(0, 1), b2 + hstep, voffB); PG8_STAGE(PG8_SA(0, 0), a2, voffA);
            PG8_WAIT_V(8); PG8_WAIT_L(0); PG8_BAR; PG8_MMA(1, 0, At, B0); PG8_MMA(1, 1, At, B1); PG8_BAR; PG8_SCHED;
            PG8_LDB(B0, 1, 0); PG8_LDB(B1, 1, 1); PG8_SCHED; PG8_LDA(At, 1, 0); PG8_STAGE(PG8_SA(0, 1), a2 + hstep, voffA);
            PG8_WAIT_V(8); PG8_WAIT_L(0); PG8_BAR; PG8_MMA(0, 0, At, B0); PG8_MMA(0, 1, At, B1); PG8_BAR; PG8_SCHED;
            PG8_LDA(At, 1, 1); PG8_STAGE(PG8_SB(1, 0), b3, voffB); PG8_STAGE(PG8_SB(1, 1), b3 + hstep, voffB); PG8_STAGE(PG8_SA(1, 0), a3, voffA);
            PG8_WAIT_V(8); PG8_WAIT_L(0); PG8_BAR; PG8_MMA(1, 0, At, B0); PG8_MMA(1, 1, At, B1); PG8_BAR; PG8_SCHED;
            } else {
            PG8_LDB(B0, 0, 0); PG8_SCHED; PG8_LDA(At, 0, 0); PG8_STAGE(PG8_SA(1, 1), a1 + hstep, voffA);
            PG8_WAIT_L(8); PG8_BAR; PG8_WAIT_L(0); PG8_MMA(0, 0, At, B0); PG8_BAR; PG8_SCHED;
            PG8_LDB(B1, 0, 1); PG8_STAGE(PG8_SB(0, 0), b2, voffB);
            PG8_BAR; PG8_WAIT_L(0); PG8_MMA(0, 1, At, B1); PG8_BAR;
            PG8_LDA(At, 0, 1); PG8_STAGE(PG8_SA(0, 0), a2, voffA);
            PG8_BAR; PG8_WAIT_L(0); PG8_MMA(1, 0, At, B0); PG8_BAR; PG8_SCHED;
            PG8_STAGE(PG8_SB(0, 1), b2 + hstep, voffB);
            PG8_WAIT_V(6); PG8_BAR; PG8_MMA(1, 1, At, B1); PG8_BAR;
            PG8_LDB(B0, 1, 0); PG8_SCHED; PG8_LDA(At, 1, 0); PG8_STAGE(PG8_SA(0, 1), a2 + hstep, voffA);
            PG8_WAIT_L(8); PG8_BAR; PG8_WAIT_L(0); PG8_MMA(0, 0, At, B0); PG8_BAR; PG8_SCHED;
            PG8_LDB(B1, 1, 1); PG8_STAGE(PG8_SB(1, 0), b3, voffB);
            PG8_BAR; PG8_WAIT_L(0); PG8_MMA(0, 1, At, B1); PG8_BAR;
            PG8_LDA(At, 1, 1); PG8_STAGE(PG8_SA(1, 0), a3, voffA);
            PG8_BAR; PG8_WAIT_L(0); PG8_MMA(1, 0, At, B0); PG8_BAR; PG8_SCHED;
            PG8_STAGE(PG8_SB(1, 1), b3 + hstep, voffB);
            PG8_WAIT_V(6); PG8_BAR; PG8_MMA(1, 1, At, B1); PG8_BAR;
            }
        }
        if constexpr (ALIGN_EPI) { if (wr == 0) PG8_BAR; }
        if constexpr (!Epi::AFTER_DRAIN) { E(acc, cur, wr, wc, fr, fq); S.done(cur); }
        if (!has_next) break;
#pragma unroll
        for (int a = 0; a < 2; ++a)
#pragma unroll
            for (int b = 0; b < 2; ++b)
#pragma unroll
                for (int m = 0; m < 4; ++m)
#pragma unroll
                    for (int n = 0; n < 2; ++n) acc[a][b][m][n] = (f32x4){0.f, 0.f, 0.f, 0.f};
        cur = nxt; cA = nA; cB = nB; ++ui;
        if constexpr (ALIGN_EPI) { if (wr == 1) PG8_BAR; }
    }
    PG8_WAIT_V(0);
    if constexpr (!ALIGN_EPI) { if (wr == 0) PG8_BAR; }
    PG8_BAR;
    if constexpr (Epi::AFTER_DRAIN) { E.fused(acc, cur, wr, wc, fr, fq, lds, wid, lane); S.done(cur); }
#undef PG8_SA
#undef PG8_SB
#undef PG8_STAGE
#undef PG8_LDA
#undef PG8_LDB
#undef PG8_MMA
#undef PG8_WAIT_V
#undef PG8_WAIT_L
#undef PG8_BAR
#undef PG8_SCHED
}
}
constexpr int NWAVES = 8;
constexpr int BATCH = 8, T = 4096, D = 1024, M = BATCH * T, FF = 2816, NH = 8, HD = 64, INC = 4512;
constexpr float RMS_EPS = 1e-6f, GN_EPS = 64e-5f;
constexpr size_t MiB = 1u << 20;
constexpr size_t WS_PART = 1 * MiB;
constexpr size_t WS_SC = 9 * MiB;
constexpr size_t WS_WGU1 = 13 * MiB, WS_WDN1 = WS_WGU1 + 11 * MiB, WS_WGU2 = WS_WDN1 + 5632 * 1024, WS_WDN2 = WS_WGU2 + 11 * MiB;
constexpr size_t WS_WIN = WS_WDN2 + 5632 * 1024, WS_WGT = WS_WIN + 5 * MiB, WS_WLO = WS_WGT + 4 * MiB, WS_WBR = WS_WLO + 768 * 1024, WS_WBA = WS_WBR + 1 * MiB, WS_WOUT = WS_WBA + 1 * MiB;
constexpr size_t WS_XB = 62 * MiB;
constexpr size_t WS_ATTQ = 126 * MiB;
constexpr size_t WS_ATTKV = 158 * MiB;
constexpr size_t WS_RKVL = 174 * MiB;
constexpr size_t WS_G = 286 * MiB;
constexpr size_t WS_REC = 318 * MiB, REC_SLOT = 32 * MiB;
constexpr size_t WS_H = 126 * MiB;
constexpr size_t WS_YRAW = WS_RKVL;
constexpr size_t WS_MERGED = WS_RKVL;
constexpr size_t WS_GATES = WS_REC;
constexpr size_t WS_YR = WS_REC + 4 * REC_SLOT;
constexpr size_t WS_LA = WS_REC + 5 * REC_SLOT;
constexpr size_t WS_END = WS_REC + 6 * REC_SLOT;
static_assert(WS_WOUT + 4 * MiB <= WS_XB && WS_H + (size_t)M * FF * 2 <= WS_REC && WS_MERGED + (size_t)M * 2048 * 2 <= WS_REC, "ws map");
constexpr int RING_BYTES = 131072, LDS_BYTES = 147456;

#define GAS __attribute__((address_space(1)))
#define LAS __attribute__((address_space(3)))
typedef unsigned short bf16;
typedef unsigned v4u __attribute__((ext_vector_type(4)));
typedef unsigned v2u __attribute__((ext_vector_type(2)));
typedef float f32x4 __attribute__((ext_vector_type(4)));
typedef float f32x2 __attribute__((ext_vector_type(2)));
typedef short bf16x8 __attribute__((ext_vector_type(8)));
#define LDS_WAIT() asm volatile("s_waitcnt lgkmcnt(0)" ::: "memory")
__device__ __forceinline__ unsigned f2bf(float f) { unsigned u = __builtin_bit_cast(unsigned, f); return (u + 0x7fffu + ((u >> 16) & 1u)) >> 16; }
__device__ __forceinline__ unsigned pk2(float lo, float hi) { return f2bf(lo) | (f2bf(hi) << 16); }
__device__ __forceinline__ float bflo(unsigned u) { return __uint_as_float(u << 16); }
__device__ __forceinline__ float bfhi(unsigned u) { return __uint_as_float(u & 0xffff0000u); }
__device__ __forceinline__ float bf1(bf16 h) { return __uint_as_float((unsigned)h << 16); }
__device__ __forceinline__ float wave_sum(float v) {
#pragma unroll
    for (int o = 1; o < 64; o <<= 1) v += __shfl_xor(v, o);
    return v;
}
template <int CTRL> __device__ __forceinline__ float dppf(float x) { return __builtin_bit_cast(float, __builtin_amdgcn_update_dpp(0, __builtin_bit_cast(int, x), CTRL, 0xf, 0xf, false)); }
__device__ __forceinline__ float row16_sum(float x) { x += dppf<0xB1>(x); x += dppf<0x4E>(x); x += dppf<0x141>(x); x += dppf<0x140>(x); return x; }

#define RLX_AGENT __ATOMIC_RELAXED, __HIP_MEMORY_SCOPE_AGENT
#define XB_TMO      128
#define XB_XCNT(j)  (256  + 64 * (j))
#define XB_XSUB(j)  (1280 + 64 * (j))
#define XB_XGEN(j)  (2304 + 64 * (j))
#define XB_TOP      3328
#define XB_TOPGEN   3392
#define XCD_BAR_WORDS 3456
#define XB_SPIN_CAP (1u << 18)

__device__ __forceinline__ unsigned xb_ld(unsigned* p)              { return __hip_atomic_load(p, __ATOMIC_RELAXED, __HIP_MEMORY_SCOPE_AGENT); }
__device__ __forceinline__ unsigned xb_add(unsigned* p, unsigned v) { return __hip_atomic_fetch_add(p, v, __ATOMIC_RELAXED, __HIP_MEMORY_SCOPE_AGENT); }
__device__ __forceinline__ unsigned xb_xcc_id() { return (unsigned)__builtin_amdgcn_s_getreg((3 << 11) | 20) & 0xFu; }
#define XB_SPIN(cond, bar) do { unsigned _sp = 0; while (cond) { __builtin_amdgcn_s_sleep(1); \
    if ((++_sp & 255u) == 0u) { if (xb_ld(&(bar)[XB_TMO])) break; if (_sp > XB_SPIN_CAP) { atomicAdd(&(bar)[XB_TMO], 1u); break; } } } } while (0)

struct XcdBarrier {
    unsigned* bar; unsigned x;
    volatile LAS unsigned* st;
};

__device__ __forceinline__ XcdBarrier xcd_barrier_post(unsigned* bar, volatile LAS unsigned* st) {
    XcdBarrier b; b.bar = bar; b.x = xb_xcc_id(); b.st = st;
    if (threadIdx.x == 0) (void)xb_add(&bar[XB_XCNT(b.x)], 1u);
    return b;
}
__device__ __forceinline__ void xcd_barrier_complete(unsigned* bar, unsigned x, unsigned& nloc, unsigned& nx) {
    const unsigned G = gridDim.x * gridDim.y * gridDim.z;
    unsigned sum, cnt, mine, sp = 0u;
    for (;;) {
        sum = 0u; cnt = 0u; mine = 0u;
#pragma unroll
        for (unsigned j = 0; j < 16; ++j) { const unsigned c = xb_ld(&bar[XB_XCNT(j)]); sum += c; cnt += (c > 0u) ? 1u : 0u; mine = (j == x) ? c : mine; }
        if (sum == G) break;
        __builtin_amdgcn_s_sleep(1);
        if ((++sp & 255u) == 0u) { if (xb_ld(&bar[XB_TMO])) break; if (sp > XB_SPIN_CAP) { atomicAdd(&bar[XB_TMO], 1u); break; } }
    }
    nloc = mine > 0u ? mine : 1u; nx = cnt > 0u ? cnt : 1u;
}

__device__ __forceinline__ void xcd_barrier(const XcdBarrier& b) {
    asm volatile("s_waitcnt vmcnt(0)" ::: "memory");
    __syncthreads();
    if (threadIdx.x == 0) {
        unsigned* bar = b.bar;
        __builtin_amdgcn_s_waitcnt(0);
        unsigned nloc = b.st[0], nx = b.st[1];
        if (nloc == 0u) { xcd_barrier_complete(bar, b.x, nloc, nx); b.st[0] = nloc; b.st[1] = nx; }
        const unsigned old = xb_add(&bar[XB_XSUB(b.x)], 1u);
        const unsigned gen = old / nloc;
        if (old + 1u == (gen + 1u) * nloc) {
            __builtin_amdgcn_fence(__ATOMIC_RELEASE, "agent");
            asm volatile("s_waitcnt vmcnt(0)" ::: "memory");
            const unsigned og = xb_add(&bar[XB_TOP], 1u);
            const unsigned tg = og / nx;
            if (og + 1u == (tg + 1u) * nx) xb_add(&bar[XB_TOPGEN], 1u);
            else XB_SPIN(xb_ld(&bar[XB_TOPGEN]) == tg, bar);
            __builtin_amdgcn_fence(__ATOMIC_ACQUIRE, "agent");
            xb_add(&bar[XB_XGEN(b.x)], 1u);
            asm volatile("s_waitcnt vmcnt(0)" ::: "memory");
        } else {
            XB_SPIN(xb_ld(&bar[XB_XGEN(b.x)]) == gen, bar);
            __builtin_amdgcn_fence(__ATOMIC_ACQUIRE, "agent");
            asm volatile("s_waitcnt vmcnt(0)" ::: "memory");
        }
    }
    __syncthreads();
}

__device__ __forceinline__ int fresh_tid() { int t = threadIdx.x; asm volatile("" : "+v"(t)); return t; }
struct Frame {
    LAS unsigned char* lds;
    int tid, lane, wave, vcu, G;
    const float *in0, *in1, *in2, *in3, *in4, *in5, *in6, *in7, *in8, *in9, *in10, *in11, *in12, *in13, *in14, *in15, *in16, *in17, *in18, *in19, *in20, *in21, *in22, *in23, *in24, *in25, *in26, *in27, *in28; float* out; unsigned char* ws;
};

__device__ __forceinline__ void tr_item(const float* W, int ldn, int k0, int n0, bf16* WT, int ldk, int drow0, int dk0, const float* scale, int dup, LAS float* scr, int lane) {
#pragma unroll 8
    for (int i = 0; i < 32; ++i) { const int kk = 2 * i + (lane >> 5); float v = W[(size_t)(k0 + kk) * ldn + n0 + (lane & 31)]; if (scale) v *= scale[k0 + kk]; scr[kk * 33 + (lane & 31)] = v; }
    LDS_WAIT(); asm volatile("" ::: "memory");
    const int c = lane & 7;
#pragma unroll
    for (int j = 0; j < 4; ++j) { const int n = (lane >> 3) + 8 * j; const LAS float* s = scr + (8 * c) * 33 + n;
        v4u o; o.x = pk2(s[0 * 33], s[1 * 33]); o.y = pk2(s[2 * 33], s[3 * 33]); o.z = pk2(s[4 * 33], s[5 * 33]); o.w = pk2(s[6 * 33], s[7 * 33]);
        bf16* dp = WT + (size_t)(drow0 + n0 + n) * ldk + dk0 + k0 + 8 * c;
        *(GAS v4u*)dp = o; if (dup) *(GAS v4u*)(dp + dup) = o; }
    LDS_WAIT(); asm volatile("" ::: "memory");
}
__device__ __forceinline__ void p0_prologue(Frame& F) {
    LAS float* scr = (LAS float*)(F.lds + F.wave * 16384);
    unsigned char* ws = F.ws;
    const int gw = F.vcu * NWAVES + F.wave, NGW = F.G * NWAVES, lane = fresh_tid() & 63;
    constexpr int I_GU = 16 * 88, I_DN = 44 * 32, I_IN = 16 * 77, I_GT = 16 * 64, I_BR = 8 * 32, I_OUT = 16 * 32;
    constexpr int NITEMS = 4 * I_GU + 2 * I_DN + I_IN + I_GT + 2 * I_BR + I_OUT;
    for (int it = gw; it < NITEMS; it += NGW) {
        int r = it;
        if (r < 4 * I_GU) {
            const int which = r / I_GU; r -= which * I_GU; const int kb = r / 88, nb = r % 88, n0 = nb * 32;
            const float* W = which == 0 ? F.in2 : which == 1 ? F.in3 : which == 2 ? F.in25 : F.in26;
            tr_item(W, FF, kb * 64, n0, (bf16*)(ws + (which < 2 ? WS_WGU1 : WS_WGU2)), D, (n0 >> 7) * 256 + (which & 1) * 128 + (n0 & 127) - n0, 0, which < 2 ? F.in1 : F.in24, 0, scr, lane);
            continue; }
        r -= 4 * I_GU;
        if (r < 2 * I_DN) { const int which = r / I_DN; r -= which * I_DN; const int kb = r / 32, nb = r % 32;
            tr_item(which ? F.in27 : F.in4, D, kb * 64, nb * 32, (bf16*)(ws + (which ? WS_WDN2 : WS_WDN1)), FF, 0, 0, nullptr, 0, scr, lane); continue; }
        r -= 2 * I_DN;
        if (r < I_IN) { const int kb = r / 77, nb = r % 77, n0 = nb * 32;
            tr_item(F.in6, INC, kb * 64, n0, (bf16*)(ws + WS_WIN), D, n0 < 1696 ? 0 : 96, 0, F.in5, 0, scr, lane); continue; }
        r -= I_IN;
        if (r < I_GT) { const int kb = r / 64, nb = r % 64;
            tr_item(F.in6, INC, kb * 64, 2464 + nb * 32, (bf16*)(ws + WS_WGT), D, -2464, 0, F.in5, 0, scr, lane); continue; }
        r -= I_GT;
        if (r < 2 * I_BR) { const int which = r / I_BR; r -= which * I_BR; const int kb = r / 32, nb = r % 32;
            tr_item(which ? F.in22 : F.in21, D, kb * 64, nb * 32, (bf16*)(ws + (which ? WS_WBA : WS_WBR)), 512, 0, 0, nullptr, 0, scr, lane); continue; }
        r -= 2 * I_BR;
        { const int kb = r / 32, nb = r % 32; tr_item(F.in23, D, kb * 64, nb * 32, (bf16*)(ws + WS_WOUT), 2048, 0, 0, nullptr, 1024, scr, lane); }
    }
    { GAS v4u* z = (GAS v4u*)(ws + WS_WIN + (size_t)1696 * D * 2); for (int i = gw * 64 + lane; i < 12288; i += NGW * 64) z[i] = (v4u){0u, 0u, 0u, 0u}; }
    { bf16* WL = (bf16*)(ws + WS_WLO);
      for (int i = gw * 64 + lane; i < 1536 * 256; i += NGW * 64) { const int n = i >> 8, k = i & 255, grp = n >> 9, nn = n & 511; float v = 0.f;
          if (grp == 0) { if (k < 32) v = F.in9[k * 512 + nn]; } else if (grp == 1) { if (k >= 32 && k < 64) v = F.in11[(k - 32) * 512 + nn]; } else { if (k >= 64 && k < 160) v = F.in12[(k - 64) * 512 + nn]; }
          WL[i] = (bf16)f2bf(v); } }
    { const float* x = F.in0; bf16* XB = (bf16*)(ws + WS_XB); float* part = (float*)(ws + WS_PART);
      for (int m = gw; m < M; m += NGW) { const GAS f32x4* xr = (const GAS f32x4*)(x + (size_t)m * D) + lane; f32x4 v[4]; float s = 0.f;
#pragma unroll
          for (int j = 0; j < 4; ++j) { v[j] = xr[64 * j]; s += (v[j].x * v[j].x + v[j].y * v[j].y) + (v[j].z * v[j].z + v[j].w * v[j].w); }
          s = wave_sum(s);
          GAS unsigned long long* o8 = (GAS unsigned long long*)(XB + (size_t)m * D) + lane;
#pragma unroll
          for (int j = 0; j < 4; ++j) o8[64 * j] = (unsigned long long)pk2(v[j].x, v[j].y) | ((unsigned long long)pk2(v[j].z, v[j].w) << 32);
          if (lane < 16) part[(size_t)m * 16 + lane] = lane == 0 ? s : 0.f; } }
}
__device__ __forceinline__ void p4_lora_in(Frame& F) {
    const bf16* RKVL = (const bf16*)(F.ws + WS_RKVL); bf16* LA = (bf16*)(F.ws + WS_LA); const float* mu = F.in7 + 1536;
    const int gw = F.vcu * NWAVES + F.wave, NGW = F.G * NWAVES, lane = fresh_tid() & 63, c0 = 4 * lane;
    for (int m = gw; m < M; m += NGW) {
        float o[4] = {0.f, 0.f, 0.f, 0.f};
        if (c0 < 160) {
            const v2u cu = *(const GAS v2u*)(RKVL + (size_t)m * 1792 + 1536 + c0);
            v2u pu = (v2u){0u, 0u}; if ((m & (T - 1)) != 0) pu = *(const GAS v2u*)(RKVL + (size_t)(m - 1) * 1792 + 1536 + c0);
            const float cur[4] = {bflo(cu.x), bfhi(cu.x), bflo(cu.y), bfhi(cu.y)}, prv[4] = {bflo(pu.x), bfhi(pu.x), bflo(pu.y), bfhi(pu.y)};
            const f32x4 mv = *(const GAS f32x4*)(mu + c0);
#pragma unroll
            for (int j = 0; j < 4; ++j) { const float p = cur[j] + (prv[j] - cur[j]) * mv[j]; const int c = c0 + j;
                o[j] = c < 32 ? tanhf(p) : (c < 64 ? p : 1.0f / (1.0f + __expf(-p))); }
        }
        *(GAS v2u*)(LA + (size_t)m * 256 + c0) = (v2u){pk2(o[0], o[1]), pk2(o[2], o[3])};
    }
}
__device__ __forceinline__ void p6_prep(Frame& F) {
    const bf16* RKVL = (const bf16*)(F.ws + WS_RKVL); bf16* REC = (bf16*)(F.ws + WS_REC); f32x4* SC = (f32x4*)(F.ws + WS_SC);
    const float* mu = F.in7; const float* k_k = F.in13; const float* k_a = F.in14; const float* r_k = F.in15;
    constexpr size_t SL = REC_SLOT / 2;
    const int gw = F.vcu * NWAVES + F.wave, NGW = F.G * NWAVES, lane = fresh_tid() & 63;
    for (int task = gw; task < M * NH; task += NGW) {
        const int m = task >> 3, h = task & 7, b = m >> 12, t = m & (T - 1), col = h * 64 + lane;
        const bf16* cr = RKVL + (size_t)m * 1792 + col; const bool hp = t != 0;
        float r = bf1(cr[0]), k = bf1(cr[512]), v = bf1(cr[1024]);
        const float rp = hp ? bf1(cr[-1792]) : 0.f, kp = hp ? bf1(cr[512 - 1792]) : 0.f, vp = hp ? bf1(cr[1024 - 1792]) : 0.f;
        r += (rp - r) * mu[col]; k += (kp - k) * mu[512 + col]; v += (vp - v) * mu[1024 + col];
        const size_t ri = ((size_t)(b * 8 + h) * T + t) * 64 + lane;
        const float a = bf1(REC[4 * SL + ri]);
        float kk = k * k_k[col]; const float nrm = sqrtf(wave_sum(kk * kk)); kk = kk / fmaxf(nrm, 1e-12f);
        const float kn = k * (1.0f + (a - 1.0f) * k_a[col]);
        const unsigned ua = f2bf(-kk), ur = f2bf(r), uk = f2bf(kn), ub = f2bf(kk * a), uv = f2bf(v);
        const float rq = __uint_as_float(ur << 16), kq = __uint_as_float(uk << 16), bq = __uint_as_float(ub << 16);
        const float beta = wave_sum(bq * rq), kappa = wave_sum(kq * rq), bonus = wave_sum(rq * kq * r_k[col]);
        REC[1 * SL + ri] = (bf16)ua; REC[2 * SL + ri] = (bf16)ur; REC[3 * SL + ri] = (bf16)uk; REC[4 * SL + ri] = (bf16)ub; REC[5 * SL + ri] = (bf16)uv;
        if (lane == 0) SC[(size_t)(b * 8 + h) * T + t] = (f32x4){beta, kappa, bonus, 0.f};
    }
}
constexpr int KS_STRIDE = 144, VT_STRIDE = 528, ATT_KS_OFF = 0, ATT_VT_OFF = 256 * KS_STRIDE;
__device__ __forceinline__ void p6_attention(Frame& F) {
    bf16* ATTQ = (bf16*)(F.ws + WS_ATTQ); const bf16* ATTKV = (const bf16*)(F.ws + WS_ATTKV);
    const float* qn = F.in18; const float* kn = F.in19; const float* sinks = F.in20;
    LAS unsigned char* Ks = F.lds + ATT_KS_OFF; LAS unsigned char* Vt = F.lds + ATT_VT_OFF;
    const int tid = fresh_tid(), lane = tid & 63, w = F.wave, g = lane >> 4, n16 = lane & 15;
    for (int unit = F.vcu; unit < BATCH * 2 * 32; unit += F.G) {
        const int nb = unit & 31, kvh = (unit >> 5) & 1, b = unit >> 6; const int m0 = b * T + nb * 128;
#pragma unroll
        for (int i = 0; i < 4; ++i) { const int e = tid + 512 * i, key = e >> 3, dg = e & 7; const bool valid = nb > 0 || key >= 128;
            v4u ku = (v4u){0u, 0u, 0u, 0u}, vu = (v4u){0u, 0u, 0u, 0u};
            if (valid) { const bf16* src = ATTKV + (size_t)(m0 - 128 + key) * 256 + kvh * 64 + dg * 8; ku = *(const GAS v4u*)src; vu = *(const GAS v4u*)(src + 128); }
            float kf[8] = {bflo(ku.x), bfhi(ku.x), bflo(ku.y), bfhi(ku.y), bflo(ku.z), bfhi(ku.z), bflo(ku.w), bfhi(ku.w)};
            float ss = 0.f;
#pragma unroll
            for (int j = 0; j < 8; ++j) ss += kf[j] * kf[j];
            ss += __shfl_xor(ss, 1); ss += __shfl_xor(ss, 2); ss += __shfl_xor(ss, 4);
            const float rs = 1.0f / sqrtf(ss * (1.0f / 64.0f) + RMS_EPS);
#pragma unroll
            for (int j = 0; j < 8; ++j) kf[j] *= rs * kn[dg * 8 + j];
            *(LAS v4u*)(Ks + key * KS_STRIDE + dg * 16) = (v4u){pk2(kf[0], kf[1]), pk2(kf[2], kf[3]), pk2(kf[4], kf[5]), pk2(kf[6], kf[7])};
            const unsigned vv[4] = {vu.x, vu.y, vu.z, vu.w};
#pragma unroll
            for (int j = 0; j < 8; ++j) *(LAS bf16*)(Vt + (dg * 8 + j) * VT_STRIDE + key * 2) = (bf16)((vv[j >> 1] >> ((j & 1) * 16)) & 0xffffu);
        }
        __syncthreads();
        const int hq = kvh * 4 + (w >> 1), qbase = (w & 1) * 64; const float sink = sinks[hq];
        for (int qt = 0; qt < 4; ++qt) {
            const int q0 = qbase + 16 * qt, qi = q0 + n16, kt0 = q0 >> 4;
            bf16* qp = ATTQ + (size_t)(m0 + qi) * 512 + hq * 64 + 8 * g;
            const v4u qa = *(const GAS v4u*)qp, qb = *(const GAS v4u*)(qp + 32);
            float q[16] = {bflo(qa.x), bfhi(qa.x), bflo(qa.y), bfhi(qa.y), bflo(qa.z), bfhi(qa.z), bflo(qa.w), bfhi(qa.w),
                           bflo(qb.x), bfhi(qb.x), bflo(qb.y), bfhi(qb.y), bflo(qb.z), bfhi(qb.z), bflo(qb.w), bfhi(qb.w)};
            float ss = 0.f;
#pragma unroll
            for (int j = 0; j < 16; ++j) ss += q[j] * q[j];
            ss += __shfl_xor(ss, 16); ss += __shfl_xor(ss, 32);
            const float rs = 0.125f / sqrtf(ss * (1.0f / 64.0f) + RMS_EPS);
#pragma unroll
            for (int j = 0; j < 16; ++j) q[j] *= rs * qn[(j >> 3) * 32 + 8 * g + (j & 7)];
            const v4u qf0 = (v4u){pk2(q[0], q[1]), pk2(q[2], q[3]), pk2(q[4], q[5]), pk2(q[6], q[7])}, qf1 = (v4u){pk2(q[8], q[9]), pk2(q[10], q[11]), pk2(q[12], q[13]), pk2(q[14], q[15])};
            const bf16x8 bq0 = __builtin_bit_cast(bf16x8, qf0), bq1 = __builtin_bit_cast(bf16x8, qf1);
            f32x4 st[10]; float mx = -INFINITY;
#pragma unroll
            for (int i = 0; i < 10; ++i) { const int kt = kt0 + i, ktc = kt < 16 ? kt : 15;
                const LAS unsigned char* kp = Ks + (16 * ktc + n16) * KS_STRIDE + 16 * g;
                const bf16x8 a0 = *(const LAS bf16x8*)kp, a1 = *(const LAS bf16x8*)(kp + 64);
                f32x4 acc = (f32x4){0.f, 0.f, 0.f, 0.f};
                acc = __builtin_amdgcn_mfma_f32_16x16x32_bf16(a0, bq0, acc, 0, 0, 0);
                acc = __builtin_amdgcn_mfma_f32_16x16x32_bf16(a1, bq1, acc, 0, 0, 0);
#pragma unroll
                for (int r = 0; r < 4; ++r) { const int kj = 16 * kt + 4 * g + r; const bool ok = (kj > qi) && (kj <= qi + 128) && (nb > 0 || kj >= 128);
                    acc[r] = ok ? acc[r] : -INFINITY; mx = fmaxf(mx, acc[r]); }
                st[i] = acc; }
            mx = fmaxf(mx, __shfl_xor(mx, 16)); mx = fmaxf(mx, __shfl_xor(mx, 32)); mx = fmaxf(mx, sink);
            float den = 0.f;
#pragma unroll
            for (int i = 0; i < 10; ++i)
#pragma unroll
                for (int r = 0; r < 4; ++r) { const float p = __expf(st[i][r] - mx); st[i][r] = p; den += p; }
            den += __shfl_xor(den, 16); den += __shfl_xor(den, 32); den += __expf(sink - mx);
            const float inv = 1.0f / den;
            f32x4 o[4];
#pragma unroll
            for (int dt = 0; dt < 4; ++dt) o[dt] = (f32x4){0.f, 0.f, 0.f, 0.f};
#pragma unroll
            for (int j = 0; j < 5; ++j) { const int ka = kt0 + 2 * j, kb2 = ka + 1, kac = ka < 16 ? ka : 15, kbc = kb2 < 16 ? kb2 : 15;
                const v4u pu = (v4u){pk2(st[2 * j][0], st[2 * j][1]), pk2(st[2 * j][2], st[2 * j][3]), pk2(st[2 * j + 1][0], st[2 * j + 1][1]), pk2(st[2 * j + 1][2], st[2 * j + 1][3])};
                const bf16x8 pf = __builtin_bit_cast(bf16x8, pu);
#pragma unroll
                for (int dt = 0; dt < 4; ++dt) { const LAS unsigned char* vp = Vt + (16 * dt + n16) * VT_STRIDE;
                    const v2u va = *(const LAS v2u*)(vp + (16 * kac + 4 * g) * 2), vb = *(const LAS v2u*)(vp + (16 * kbc + 4 * g) * 2);
                    const bf16x8 af = __builtin_bit_cast(bf16x8, (v4u){va.x, va.y, vb.x, vb.y});
                    o[dt] = __builtin_amdgcn_mfma_f32_16x16x32_bf16(af, pf, o[dt], 0, 0, 0); } }
            bf16* op = ATTQ + (size_t)(m0 + qi) * 512 + hq * 64 + 4 * g;
#pragma unroll
            for (int dt = 0; dt < 4; ++dt) *(GAS v2u*)(op + 16 * dt) = (v2u){pk2(o[dt][0] * inv, o[dt][1] * inv), pk2(o[dt][2] * inv, o[dt][3] * inv)};
        }
        __syncthreads();
    }
}
constexpr int SC_NS = 32, SC_AW = 0, SC_WV = 16384, SC_KV = 24576, SC_BV = 32768, SC_VS = 40960, SC_YB = 49152, SC_BUF = 51200;
struct ScanPre { v4u ulw, ua, ur, uk, ub; unsigned uv; f32x4 sc; };
__device__ __forceinline__ ScanPre scan_issue(Frame& F, int bh, int quarter, int t0, int lt) {
    const unsigned char* REC = F.ws + WS_REC; const f32x4* SC = (const f32x4*)(F.ws + WS_SC);
    const size_t eoff = ((size_t)bh * T + t0) * 128 + (size_t)lt * 16;
    ScanPre p;
    p.ulw = *(const GAS v4u*)(REC + 0 * REC_SLOT + eoff); p.ua = *(const GAS v4u*)(REC + 1 * REC_SLOT + eoff); p.ur = *(const GAS v4u*)(REC + 2 * REC_SLOT + eoff);
    p.uk = *(const GAS v4u*)(REC + 3 * REC_SLOT + eoff); p.ub = *(const GAS v4u*)(REC + 4 * REC_SLOT + eoff);
    const int s = lt >> 3, rp = 2 * (lt & 7);
    p.uv = *(const GAS unsigned*)(REC + 5 * REC_SLOT + (((size_t)bh * T + t0 + s) * 64 + 16 * quarter + rp) * 2);
    p.sc = *(const GAS f32x4*)(SC + (size_t)bh * T + t0 + s);
    return p;
}
__device__ __forceinline__ void scan_commit(const ScanPre& p, LAS unsigned char* buf, int lt) {
    const v4u ulw = p.ulw, ua = p.ua, ur = p.ur, uk = p.uk, ub = p.ub; const unsigned uv = p.uv; const f32x4 sc = p.sc;
    const int s = lt >> 3, e0 = 8 * (lt & 7), rp = 2 * (lt & 7);
    const unsigned lw4[4] = {ulw.x, ulw.y, ulw.z, ulw.w}, a4[4] = {ua.x, ua.y, ua.z, ua.w}, r4[4] = {ur.x, ur.y, ur.z, ur.w}, k4[4] = {uk.x, uk.y, uk.z, uk.w}, b4[4] = {ub.x, ub.y, ub.z, ub.w};
    float w[8], av[8], wr[8], kv[8], bv[8];
#pragma unroll
    for (int i = 0; i < 4; ++i) {
        w[2 * i] = __expf(bflo(lw4[i])); w[2 * i + 1] = __expf(bfhi(lw4[i]));
        av[2 * i] = bflo(a4[i]); av[2 * i + 1] = bfhi(a4[i]);
        wr[2 * i] = w[2 * i] * bflo(r4[i]); wr[2 * i + 1] = w[2 * i + 1] * bfhi(r4[i]);
        kv[2 * i] = bflo(k4[i]); kv[2 * i + 1] = bfhi(k4[i]);
        bv[2 * i] = bflo(b4[i]); bv[2 * i + 1] = bfhi(b4[i]); }
    LAS f32x4* AW = (LAS f32x4*)(buf + SC_AW); const int q0 = e0 >> 2;
#pragma unroll
    for (int qq = 0; qq < 2; ++qq)
#pragma unroll
        for (int hh = 0; hh < 2; ++hh) { const int e = 4 * qq + 2 * hh; AW[(s * 2 + hh) * 16 + q0 + qq] = (f32x4){av[e], wr[e], av[e + 1], wr[e + 1]}; }
    LAS f32x4* WV = (LAS f32x4*)(buf + SC_WV); LAS f32x4* KV = (LAS f32x4*)(buf + SC_KV); LAS f32x4* BV = (LAS f32x4*)(buf + SC_BV);
#pragma unroll
    for (int qq = 0; qq < 2; ++qq) { const int e = 4 * qq;
        WV[s * 16 + q0 + qq] = (f32x4){w[e], w[e + 1], w[e + 2], w[e + 3]}; KV[s * 16 + q0 + qq] = (f32x4){kv[e], kv[e + 1], kv[e + 2], kv[e + 3]}; BV[s * 16 + q0 + qq] = (f32x4){bv[e], bv[e + 1], bv[e + 2], bv[e + 3]}; }
    LAS f32x4* VS = (LAS f32x4*)(buf + SC_VS); const float v0 = bflo(uv), v1 = bfhi(uv);
    VS[s * 16 + rp] = (f32x4){v0, v0 * sc.y, sc.x, 0.f}; VS[s * 16 + rp + 1] = (f32x4){v1, v1 * sc.y, sc.x, 0.f};
}
__device__ __forceinline__ void scan_flush(Frame& F, int bh, int quarter, int t0, const LAS unsigned char* buf, int lt) {
    if (lt < 128) { const int s = lt >> 2, c4 = lt & 3; const int b = bh >> 3, h = bh & 7;
        float* yraw = (float*)(F.ws + WS_YRAW);
        const f32x4 y = *(const LAS f32x4*)(buf + SC_YB + (s * 16 + 4 * c4) * 4);
        *(GAS f32x4*)(yraw + (size_t)(b * T + t0 + s) * 512 + h * 64 + 16 * quarter + 4 * c4) = y; }
}
__device__ __forceinline__ void p7_scan(Frame& F) {
    const int w = F.wave, tid = fresh_tid(), lane = tid & 63, rl = lane >> 4, q = lane & 15, lt = tid - 256;
    constexpr int NBLK = T / SC_NS;
#define SCAN_BAR() do { asm volatile("s_waitcnt lgkmcnt(0)" ::: "memory"); __builtin_amdgcn_s_barrier(); asm volatile("" ::: "memory"); } while (0)
    for (int unit = F.vcu; unit < 256; unit += F.G) {
        const int bh = unit >> 2, quarter = unit & 3;
        ScanPre pre;
        if (w >= 4) { pre = scan_issue(F, bh, quarter, 0, lt); scan_commit(pre, F.lds, lt); pre = scan_issue(F, bh, quarter, SC_NS, lt); }
        SCAN_BAR();
        float S0 = 0.f, S1 = 0.f, S2 = 0.f, S3 = 0.f;
        for (int nb = 0; nb < NBLK; ++nb) {
            LAS unsigned char* cur = F.lds + (nb & 1) * SC_BUF; LAS unsigned char* oth = F.lds + ((nb + 1) & 1) * SC_BUF;
            if (w >= 4) {
                if (nb > 0) scan_flush(F, bh, quarter, (nb - 1) * SC_NS, oth, lt);
                if (nb + 1 < NBLK) scan_commit(pre, oth, lt);
                if (nb + 2 < NBLK) pre = scan_issue(F, bh, quarter, (nb + 2) * SC_NS, lt);
            } else {
                const LAS f32x4* AW = (const LAS f32x4*)(cur + SC_AW); const LAS f32x4* WV = (const LAS f32x4*)(cur + SC_WV); const LAS f32x4* KV = (const LAS f32x4*)(cur + SC_KV);
                const LAS f32x4* BV = (const LAS f32x4*)(cur + SC_BV); const LAS f32x4* VS = (const LAS f32x4*)(cur + SC_VS); LAS float* YB = (LAS float*)(cur + SC_YB);
                const int rowl = 4 * w + rl;
                f32x4 aw0 = AW[q], aw1 = AW[16 + q], wv = WV[q], kv = KV[q], bv = BV[q], vs = VS[rowl];
#pragma unroll 8
                for (int s = 0; s < SC_NS; ++s) {
                    const int sn = s + 1;
                    const f32x4 n_aw0 = AW[(sn * 2) * 16 + q], n_aw1 = AW[(sn * 2 + 1) * 16 + q], n_wv = WV[sn * 16 + q], n_kv = KV[sn * 16 + q], n_bv = BV[sn * 16 + q], n_vs = VS[sn * 16 + rowl];
                    __builtin_amdgcn_sched_barrier(0);
                    float sa = S0 * aw0.x; sa = fmaf(S1, aw0.z, sa); sa = fmaf(S2, aw1.x, sa); sa = fmaf(S3, aw1.z, sa);
                    float z = S0 * aw0.y; z = fmaf(S1, aw0.w, z); z = fmaf(S2, aw1.y, z); z = fmaf(S3, aw1.w, z);
                    const float t0_ = fmaf(vs.x, kv.x, S0 * wv.x), t1_ = fmaf(vs.x, kv.y, S1 * wv.y), t2_ = fmaf(vs.x, kv.z, S2 * wv.z), t3_ = fmaf(vs.x, kv.w, S3 * wv.w);
                    sa = row16_sum(sa); z = row16_sum(z);
                    S0 = fmaf(sa, bv.x, t0_); S1 = fmaf(sa, bv.y, t1_); S2 = fmaf(sa, bv.z, t2_); S3 = fmaf(sa, bv.w, t3_);
                    YB[s * 16 + rowl] = fmaf(sa, vs.z, z) + vs.y;
                    aw0 = n_aw0; aw1 = n_aw1; wv = n_wv; kv = n_kv; bv = n_bv; vs = n_vs;
                }
            }
            SCAN_BAR();
        }
        if (w >= 4) scan_flush(F, bh, quarter, T - SC_NS, F.lds + ((NBLK - 1) & 1) * SC_BUF, lt);
        asm volatile("s_waitcnt vmcnt(0)" ::: "memory"); SCAN_BAR();
    }
#undef SCAN_BAR
}
__device__ __forceinline__ void p8_post(Frame& F) {
    const float* yraw = (const float*)(F.ws + WS_YRAW); const bf16* RV = (const bf16*)(F.ws + WS_REC + 5 * REC_SLOT); const f32x4* SC = (const f32x4*)(F.ws + WS_SC);
    const bf16* Gt = (const bf16*)(F.ws + WS_G); bf16* YR = (bf16*)(F.ws + WS_YR); const float* lnw = F.in16; const float* lnb = F.in17;
    const int gw = F.vcu * NWAVES + F.wave, NGW = F.G * NWAVES, lane = fresh_tid() & 63;
    for (int task = gw; task < M * NH; task += NGW) {
        const int m = task >> 3, h = task & 7, b = m >> 12, t = m & (T - 1), col = h * 64 + lane;
        const float y = yraw[(size_t)m * 512 + col];
        const float mean = wave_sum(y) * (1.0f / 64.0f), d = y - mean, var = wave_sum(d * d) * (1.0f / 64.0f);
        const float yn = d * (1.0f / sqrtf(var + GN_EPS)) * lnw[col] + lnb[col];
        const size_t ri = ((size_t)(b * 8 + h) * T + t);
        const float bonus = SC[ri].z, v = bf1(RV[ri * 64 + lane]), gt = bf1(Gt[(size_t)m * 512 + col]);
        YR[(size_t)m * 512 + col] = (bf16)f2bf((yn + bonus * v) * gt);
    }
}
__device__ __forceinline__ void p13_final(Frame& F) {
    const float* part = (const float*)(F.ws + WS_PART + 3 * 2 * MiB); const float* gn = F.in28;
    const int gw = F.vcu * NWAVES + F.wave, NGW = F.G * NWAVES, lane = fresh_tid() & 63;
    for (int m = gw; m < M; m += NGW) {
        float s = lane < 16 ? part[(size_t)m * 16 + lane] : 0.f; s = wave_sum(s);
        const float rs = 1.0f / sqrtf(s * (1.0f / 1024.0f) + RMS_EPS);
        GAS f32x4* xr = (GAS f32x4*)(F.out + (size_t)m * D) + lane; const GAS f32x4* gr = (const GAS f32x4*)gn + lane;
#pragma unroll
        for (int j = 0; j < 4; ++j) { const f32x4 v = xr[64 * j], g4 = gr[64 * j]; xr[64 * j] = v * rs * g4; }
    }
}
struct Args { const float* in[29]; float* out; unsigned char* ws; };
__global__ void __launch_bounds__(NWAVES * 64, 2) fwd_megakernel(Args args) {
    extern __shared__ __attribute__((aligned(16))) unsigned char lds[];
    cg::grid_group grid = cg::this_grid();
    Frame F;
    F.lds = (LAS unsigned char*)lds;
    F.tid = threadIdx.x; F.lane = F.tid & 63; F.wave = __builtin_amdgcn_readfirstlane(F.tid >> 6);
    F.G = gridDim.x; { const int bx = blockIdx.x; F.vcu = (F.G % 8 == 0) ? (bx % 8) * (F.G / 8) + bx / 8 : bx; }
F.in0 = args.in[0]; F.in1 = args.in[1]; F.in2 = args.in[2]; F.in3 = args.in[3]; F.in4 = args.in[4]; F.in5 = args.in[5]; F.in6 = args.in[6]; F.in7 = args.in[7]; F.in8 = args.in[8]; F.in9 = args.in[9]; F.in10 = args.in[10]; F.in11 = args.in[11]; F.in12 = args.in[12]; F.in13 = args.in[13]; F.in14 = args.in[14]; F.in15 = args.in[15]; F.in16 = args.in[16]; F.in17 = args.in[17]; F.in18 = args.in[18]; F.in19 = args.in[19]; F.in20 = args.in[20]; F.in21 = args.in[21]; F.in22 = args.in[22]; F.in23 = args.in[23]; F.in24 = args.in[24]; F.in25 = args.in[25]; F.in26 = args.in[26]; F.in27 = args.in[27]; F.in28 = args.in[28];
    F.out = args.out; F.ws = args.ws;
    unsigned char* ws = args.ws;
    bf16* XB = (bf16*)(ws + WS_XB); bf16* HB = (bf16*)(ws + WS_H);
    float* PA = (float*)(ws + WS_PART); float* PB = PA + (size_t)M * 16; float* PC = PB + (size_t)M * 16; float* PD = PC + (size_t)M * 16;
    using pg8::gemm_phase; using pg8::StaticOrder; using pg8::Gemm;
    volatile LAS unsigned* bst = (volatile LAS unsigned*)(F.lds + RING_BYTES);
    if (F.tid == 0) { bst[0] = 0u; bst[1] = 0u; }
    __syncthreads();
    XcdBarrier bar = xcd_barrier_post((unsigned*)ws, bst);
#define SYNC() xcd_barrier(bar)
#define RUN_GEMM(EPI, Aptr, Bptr, NN, KK, ...) do { Gemm g_{(const pg8::bf16_t*)(Aptr), (const pg8::bf16_t*)(Bptr), M, (NN), (KK)}; StaticOrder S_; S_.init(M, (NN), F.G, (int)blockIdx.x); \
        pg8::EPI E_{__VA_ARGS__}; gemm_phase<pg8::EPI, StaticOrder, true, true>(F.lds, g_, S_, E_); } while (0)

    p0_prologue(F); grid.sync();
    RUN_GEMM(EpiGU, XB, ws + WS_WGU1, 2 * FF, D, HB, PA); SYNC();
    RUN_GEMM(EpiRes, HB, ws + WS_WDN1, D, FF, F.in0, F.out, XB, PB, 0.5f); SYNC();
    RUN_GEMM(EpiProj, XB, ws + WS_WIN, 2560, D, (bf16*)(ws + WS_RKVL), (bf16*)(ws + WS_ATTQ), (bf16*)(ws + WS_ATTKV), PB); SYNC();
    p4_lora_in(F); SYNC();
    RUN_GEMM(EpiLora, ws + WS_LA, ws + WS_WLO, 1536, 256, (bf16*)(ws + WS_REC), (bf16*)(ws + WS_REC + 4 * REC_SLOT), (bf16*)(ws + WS_G), F.in8, F.in10); SYNC();
    p6_prep(F); p6_attention(F); SYNC();
    p7_scan(F); SYNC();
    p8_post(F); SYNC();
    RUN_GEMM(EpiGate, XB, ws + WS_WGT, 2048, D, (bf16*)(ws + WS_GATES), PB); SYNC();
    RUN_GEMM(EpiBranch, ws + WS_YR, ws + WS_WBR, D, 512, (const bf16*)(ws + WS_GATES), (bf16*)(ws + WS_MERGED), 0);
    RUN_GEMM(EpiBranch, ws + WS_ATTQ, ws + WS_WBA, D, 512, (const bf16*)(ws + WS_GATES), (bf16*)(ws + WS_MERGED), 1024); SYNC();
    RUN_GEMM(EpiRes, ws + WS_MERGED, ws + WS_WOUT, D, 2048, F.out, F.out, XB, PC, 1.0f); SYNC();
    RUN_GEMM(EpiGU, XB, ws + WS_WGU2, 2 * FF, D, HB, PC); SYNC();
    RUN_GEMM(EpiRes, HB, ws + WS_WDN2, D, FF, F.out, F.out, (bf16*)nullptr, PD, 0.5f); SYNC();
    p13_final(F);
}

extern "C" void kernel_launch(void* const* d_in, const int* in_sizes, int n_in, void* d_out, int out_size, void* d_ws, size_t ws_size, hipStream_t stream) {
    static int grid = 0;
    if (grid == 0) {
        if (n_in != 29 || in_sizes[0] != M * D || out_size != M * D || ws_size < WS_END) { fprintf(stderr, "kernel_launch: unexpected shapes (n_in %d, ws %zu)\n", n_in, ws_size); grid = -1; return; }
        int dev = 0, cus = 0, per_cu = 0;
        hipGetDevice(&dev); hipDeviceGetAttribute(&cus, hipDeviceAttributeMultiprocessorCount, dev);
        if (hipFuncSetAttribute((const void*)fwd_megakernel, hipFuncAttributeMaxDynamicSharedMemorySize, LDS_BYTES) != hipSuccess) { fprintf(stderr, "kernel_launch: hipFuncSetAttribute failed\n"); grid = -1; return; }
        hipOccupancyMaxActiveBlocksPerMultiprocessor(&per_cu, (const void*)fwd_megakernel, NWAVES * 64, LDS_BYTES);
        (void)hipGetLastError();
        if (per_cu < 1) fprintf(stderr, "kernel_launch: occupancy query says %d blocks/CU\n", per_cu);
        grid = cus;
    }
    if (grid < 0) return;
    if (hipMemsetAsync(d_ws, 0, 16384, stream) != hipSuccess) { fprintf(stderr, "kernel_launch: memset failed\n"); return; }
    Args a{};
    for (int i = 0; i < 29; ++i) a.in[i] = (const float*)d_in[i];
    a.out = (float*)d_out; a.ws = (unsigned char*)d_ws;
    void* kargs[] = {&a};
    hipError_t e = hipLaunchCooperativeKernel((const void*)fwd_megakernel, dim3(grid), dim3(NWAVES * 64), kargs, LDS_BYTES, stream);
    if (e != hipSuccess) fprintf(stderr, "kernel_launch: cooperative launch failed: %s (grid %d)\n", hipGetErrorString(e), grid);
}
```

```cpp
#include <hip/hip_runtime.h>
#include <hip/hip_cooperative_groups.h>
#include <cstdio>
#include <cstdint>
namespace cg = cooperative_groups;
namespace pg8 {
#define PG8_LAS __attribute__((address_space(3)))
typedef unsigned short bf16_t;
typedef short bf16x8 __attribute__((ext_vector_type(8)));
typedef float f32x4 __attribute__((ext_vector_type(4)));
typedef unsigned u32x4 __attribute__((ext_vector_type(4)));
constexpr int BM = 256, BK = 64, HALF = 128, HTB = HALF * BK * 2  , STAGE_BYTES = 8 * HTB, NXCD = 8, WGM = 8;

__host__ __device__ __forceinline__ int lds_byte(int r, int c) { const int st = (r >> 4) * 2 + (c >> 5), rr = r & 15, cc = c & 31, ob = rr * 64 + cc * 2; return st * 1024 + (ob ^ (((ob >> 9) & 1) << 5)); }
__host__ __device__ __forceinline__ void stage_rc(int b, int& R, int& C) { const int st = b / 1024, sb = b % 1024, swz = sb ^ (((sb >> 9) & 1) << 5); R = (st >> 1) * 16 + swz / 64; C = (st & 1) * 32 + (swz % 64) / 2; }
__host__ __device__ __forceinline__ int perm32(int rho) { const int n = rho >> 4, i = rho & 15; return 8 * (i >> 2) + 4 * n + (i & 3); }

struct Unit { int pm, pn; };
struct Gemm { const bf16_t* A; const bf16_t* Bt; int M, N, K; };

struct StaticOrder {
    int nM, nN, nwg, G, c;
    __host__ __device__ void init(int M, int N, int G_, int c_) { nM = M / BM; nN = N / BM; nwg = nM * nN; G = G_; c = c_; }
    __host__ __device__ bool next(int i, Unit& u) const {
        const long L = (long)i * G + c; if (L >= nwg) return false;
        int wgid = (int)L; { const int q = nwg / NXCD, r = nwg % NXCD, xcd = wgid % NXCD, off = wgid / NXCD; wgid = (xcd < r ? xcd * (q + 1) : r * (q + 1) + (xcd - r) * q) + off; }
        const int nig = WGM * nN, gid = wgid / nig, fm = gid * WGM, gsz = (nM - fm) < WGM ? (nM - fm) : WGM;
        u.pm = fm + ((wgid % nig) % gsz); u.pn = (wgid % nig) / gsz; return true;
    }
    __device__ __forceinline__ void a_ready(const Unit&) const {}
    __device__ __forceinline__ void done(const Unit&) const {}
};

__device__ __forceinline__ unsigned cvt_pk_bf16(float lo, float hi) { unsigned r; asm volatile("v_cvt_pk_bf16_f32 %0, %1, %2" : "=v"(r) : "v"(lo), "v"(hi)); return r; }
__device__ __forceinline__ u32x4 pack8(f32x4 v0, f32x4 v1) { u32x4 w; w.x = cvt_pk_bf16(v0[0], v0[1]); w.y = cvt_pk_bf16(v0[2], v0[3]); w.z = cvt_pk_bf16(v1[0], v1[1]); w.w = cvt_pk_bf16(v1[2], v1[3]); return w; }
__device__ __forceinline__ float bf_lo(unsigned u) { return __uint_as_float(u << 16); }
__device__ __forceinline__ float bf_hi(unsigned u) { return __uint_as_float(u & 0xffff0000u); }
__device__ __forceinline__ void rows_rstd(const float* part, int row0, int fq, float (&rs)[2][4]) {
#pragma unroll
    for (int ai = 0; ai < 2; ++ai)
#pragma unroll
        for (int m = 0; m < 4; ++m) { const f32x4 a = *(const f32x4*)(part + (size_t)(row0 + ai * HALF + m * 16) * 16 + 4 * fq);
            float s = (a[0] + a[1]) + (a[2] + a[3]); s += __shfl_xor(s, 16); s += __shfl_xor(s, 32);
            rs[ai][m] = 1.0f / sqrtf(s * (1.0f / 1024.0f) + 1e-6f); }
    asm volatile("" ::: "memory");
}
__device__ __forceinline__ float sigmoidf_(float x) { return 1.0f / (1.0f + __expf(-x)); }

struct EpiGU {
    static constexpr bool PERM = true, AFTER_DRAIN = false;
    bf16_t* H; const float* part;
    __device__ __forceinline__ void operator()(const f32x4 (&acc)[2][2][4][2], const Unit& u, int wr, int wc, int fr, int fq) const {
        const int row0 = u.pm * BM + wr * 64 + fr, col0 = u.pn * 128 + wc * 32 + 8 * fq;
        float rsv[2][4]; rows_rstd(part, row0, fq, rsv);
#pragma unroll
        for (int ai = 0; ai < 2; ++ai)
#pragma unroll
            for (int m = 0; m < 4; ++m) { const int row = row0 + ai * HALF + m * 16; const float rs = rsv[ai][m];
                f32x4 h0, h1;
#pragma unroll
                for (int j = 0; j < 4; ++j) { const float g0 = acc[ai][0][m][0][j] * rs, u0 = acc[ai][1][m][0][j] * rs, g1 = acc[ai][0][m][1][j] * rs, u1 = acc[ai][1][m][1][j] * rs;
                    h0[j] = g0 * u0 / (1.0f + __expf(-g0)); h1[j] = g1 * u1 / (1.0f + __expf(-g1)); }
                *(u32x4*)(H + (size_t)row * 2816 + col0) = pack8(h0, h1); asm volatile("" ::: "memory"); }
    }
};
struct EpiRes {
    static constexpr bool PERM = true, AFTER_DRAIN = false;
    const float* xin; float* xout; bf16_t* xb; float* part; float alpha;
    __device__ __forceinline__ void operator()(const f32x4 (&acc)[2][2][4][2], const Unit& u, int wr, int wc, int fr, int fq) const {
        const int row0 = u.pm * BM + wr * 64 + fr, col0 = u.pn * BM + wc * 32 + 8 * fq;
#pragma unroll
        for (int ai = 0; ai < 2; ++ai)
#pragma unroll
            for (int m = 0; m < 4; ++m) { const int row = row0 + ai * HALF + m * 16; float ss = 0.f;
#pragma unroll
                for (int bj = 0; bj < 2; ++bj) { const size_t off = (size_t)row * 1024 + col0 + bj * HALF;
                    const f32x4 r0 = *(const f32x4*)(xin + off), r1 = *(const f32x4*)(xin + off + 4);
                    const f32x4 v0 = r0 + acc[ai][bj][m][0] * alpha, v1 = r1 + acc[ai][bj][m][1] * alpha;
                    *(f32x4*)(xout + off) = v0; *(f32x4*)(xout + off + 4) = v1;
                    if (xb) *(u32x4*)(xb + off) = pack8(v0, v1);
                    ss += (v0[0] * v0[0] + v0[1] * v0[1]) + (v0[2] * v0[2] + v0[3] * v0[3]) + (v1[0] * v1[0] + v1[1] * v1[1]) + (v1[2] * v1[2] + v1[3] * v1[3]); }
                ss += __shfl_xor(ss, 16); ss += __shfl_xor(ss, 32);
                if (fq == 0) part[(size_t)row * 16 + u.pn * 4 + wc] = ss; asm volatile("" ::: "memory"); }
    }
};
struct EpiProj {
    static constexpr bool PERM = true, AFTER_DRAIN = false;
    bf16_t* rkvl; bf16_t* attq; bf16_t* attkv; const float* part;
    __device__ __forceinline__ void operator()(const f32x4 (&acc)[2][2][4][2], const Unit& u, int wr, int wc, int fr, int fq) const {
        bf16_t* base; int ldc, colt;
        if (u.pn < 7) { base = rkvl; ldc = 1792; colt = u.pn * BM; } else if (u.pn < 9) { base = attq; ldc = 512; colt = (u.pn - 7) * BM; } else { base = attkv; ldc = 256; colt = 0; }
        const int row0 = u.pm * BM + wr * 64 + fr, col0 = colt + wc * 32 + 8 * fq;
        float rsv[2][4]; rows_rstd(part, row0, fq, rsv);
#pragma unroll
        for (int ai = 0; ai < 2; ++ai)
#pragma unroll
            for (int m = 0; m < 4; ++m) { const int row = row0 + ai * HALF + m * 16; const float rs = rsv[ai][m];
#pragma unroll
                for (int bj = 0; bj < 2; ++bj) *(u32x4*)(base + (size_t)row * ldc + col0 + bj * HALF) = pack8(acc[ai][bj][m][0] * rs, acc[ai][bj][m][1] * rs); }
    }
};
struct EpiGate {
    static constexpr bool PERM = true, AFTER_DRAIN = false;
    bf16_t* gates; const float* part;
    __device__ __forceinline__ void operator()(const f32x4 (&acc)[2][2][4][2], const Unit& u, int wr, int wc, int fr, int fq) const {
        const int row0 = u.pm * BM + wr * 64 + fr, col0 = u.pn * BM + wc * 32 + 8 * fq;
        float rsv[2][4]; rows_rstd(part, row0, fq, rsv);
#pragma unroll
        for (int ai = 0; ai < 2; ++ai)
#pragma unroll
            for (int m = 0; m < 4; ++m) { const int row = row0 + ai * HALF + m * 16; const float rs = rsv[ai][m];
#pragma unroll
                for (int bj = 0; bj < 2; ++bj) { f32x4 v0, v1;
#pragma unroll
                    for (int j = 0; j < 4; ++j) { v0[j] = sigmoidf_(acc[ai][bj][m][0][j] * rs); v1[j] = sigmoidf_(acc[ai][bj][m][1][j] * rs); }
                    *(u32x4*)(gates + (size_t)row * 2048 + col0 + bj * HALF) = pack8(v0, v1); } }
    }
};
struct EpiLora {
    static constexpr bool PERM = true, AFTER_DRAIN = false;
    bf16_t* rec_lw; bf16_t* rec_a; bf16_t* g; const float* w0; const float* a0;
    template <int KIND> __device__ __forceinline__ void body(const f32x4 (&acc)[2][2][4][2], const Unit& u, int wr, int wc, int fr, int fq) const {
        const int row0 = u.pm * BM + wr * 64 + fr, col0 = (u.pn & 1) * BM + wc * 32 + 8 * fq;
#pragma unroll
        for (int ai = 0; ai < 2; ++ai)
#pragma unroll
            for (int m = 0; m < 4; ++m) { const int row = row0 + ai * HALF + m * 16; const int b = row >> 12, t = row & 4095;
#pragma unroll
                for (int bj = 0; bj < 2; ++bj) { const int c = col0 + bj * HALF; f32x4 v0 = acc[ai][bj][m][0], v1 = acc[ai][bj][m][1];
                    if (KIND != 2) { const float* bias = (KIND == 0 ? w0 : a0) + c; v0 = v0 + *(const f32x4*)bias; v1 = v1 + *(const f32x4*)(bias + 4); }
                    if (KIND == 2) { *(u32x4*)(g + (size_t)row * 512 + c) = pack8(v0, v1); }
                    else {
#pragma unroll
                        for (int j = 0; j < 4; ++j) {
                            if (KIND == 0) { const float y0 = -v0[j], y1 = -v1[j];
                                const float sp0 = fmaxf(y0, 0.f) + __logf(1.0f + __expf(-fabsf(y0))), sp1 = fmaxf(y1, 0.f) + __logf(1.0f + __expf(-fabsf(y1)));
                                v0[j] = -__expf(-sp0 - 0.5f); v1[j] = -__expf(-sp1 - 0.5f); }
                            else { v0[j] = sigmoidf_(v0[j]); v1[j] = sigmoidf_(v1[j]); } }
                        bf16_t* dst = (KIND == 0 ? rec_lw : rec_a) + ((size_t)((b * 8 + (c >> 6)) * 4096 + t)) * 64 + (c & 63);
                        *(u32x4*)dst = pack8(v0, v1); } }
                asm volatile("" ::: "memory"); }
    }
    __device__ __forceinline__ void operator()(const f32x4 (&acc)[2][2][4][2], const Unit& u, int wr, int wc, int fr, int fq) const {
        const int kind = u.pn >> 1;
        if (kind == 0) body<0>(acc, u, wr, wc, fr, fq); else if (kind == 1) body<1>(acc, u, wr, wc, fr, fq); else body<2>(acc, u, wr, wc, fr, fq);
    }
};
struct EpiBranch {
    static constexpr bool PERM = true, AFTER_DRAIN = false;
    const bf16_t* gates; bf16_t* merged; int goff;
    __device__ __forceinline__ void operator()(const f32x4 (&acc)[2][2][4][2], const Unit& u, int wr, int wc, int fr, int fq) const {
        const int row0 = u.pm * BM + wr * 64 + fr, col0 = goff + u.pn * BM + wc * 32 + 8 * fq;
#pragma unroll
        for (int ai = 0; ai < 2; ++ai)
#pragma unroll
            for (int m = 0; m < 4; ++m) { const int row = row0 + ai * HALF + m * 16;
#pragma unroll
                for (int bj = 0; bj < 2; ++bj) { const size_t off = (size_t)row * 2048 + col0 + bj * HALF; const u32x4 gq = *(const u32x4*)(gates + off);
                    f32x4 v0 = acc[ai][bj][m][0], v1 = acc[ai][bj][m][1];
                    v0[0] *= bf_lo(gq.x); v0[1] *= bf_hi(gq.x); v0[2] *= bf_lo(gq.y); v0[3] *= bf_hi(gq.y);
                    v1[0] *= bf_lo(gq.z); v1[1] *= bf_hi(gq.z); v1[2] *= bf_lo(gq.w); v1[3] *= bf_hi(gq.w);
                    *(u32x4*)(merged + off) = pack8(v0, v1); } asm volatile("" ::: "memory"); }
    }
};

template <class Epi, class Sched, bool ALIGN_EPI = false, bool SP2 = false>
__device__ __forceinline__ void gemm_phase(PG8_LAS unsigned char* lds, const Gemm g, const Sched& S, const Epi& E) {
    int tid_ = threadIdx.x; asm volatile("" : "+v"(tid_));
    const int tid = tid_, wid = __builtin_amdgcn_readfirstlane(tid >> 6), lane = tid & 63, wr = wid >> 2, wc = wid & 3, fr = lane & 15, fq = lane >> 4;
    const int K = g.K, nt = K / BK;
    unsigned voffA[2], voffB[2];
#pragma unroll
    for (int i = 0; i < 2; ++i) { int R, C; stage_rc(tid * 16 + i * 8192, R, C); const int Rb = Epi::PERM ? ((R & ~31) + perm32(R & 31)) : R;
        voffA[i] = (unsigned)(R * K + C) * 2u; voffB[i] = (unsigned)(Rb * K + C) * 2u; }
    const size_t kstep = (size_t)(BK * 2);
    const size_t hstep = (size_t)HALF * K * 2;
    const size_t tstep = 2 * hstep;
    const unsigned ldsw = (unsigned)wid * 1024u;
    const int aoff = lds_byte(wr * 64 + fr, fq * 8), boff = lds_byte(wc * 32 + fr, fq * 8);
#define PG8_SA(b, h) (((b) * 2 + (h)) * HTB)
#define PG8_SB(b, h) ((4 + (b) * 2 + (h)) * HTB)
#define PG8_STAGE(bufoff, gbase, voff) do { _Pragma("unroll") for (int _i = 0; _i < 2; ++_i) \
        __builtin_amdgcn_global_load_lds((const unsigned*)((const char*)(gbase) + (voff)[_i]), (PG8_LAS unsigned*)(lds + (bufoff) + ldsw + _i * 8192), 16, 0, 0); } while (0)
#define PG8_LDA(dst, b, h) do { _Pragma("unroll") for (int m = 0; m < 4; ++m) _Pragma("unroll") for (int k = 0; k < 2; ++k) dst[m][k] = *(const PG8_LAS bf16x8*)(lds + PG8_SA(b, h) + aoff + m * 2048 + k * 1024); } while (0)
#define PG8_LDB(dst, b, h) do { _Pragma("unroll") for (int n = 0; n < 2; ++n) _Pragma("unroll") for (int k = 0; k < 2; ++k) dst[n][k] = *(const PG8_LAS bf16x8*)(lds + PG8_SB(b, h) + boff + n * 2048 + k * 1024); } while (0)
#define PG8_MMA(ai, bj, At, Bt) do { __builtin_amdgcn_s_setprio(1); _Pragma("unroll") for (int m = 0; m < 4; ++m) _Pragma("unroll") for (int n = 0; n < 2; ++n) _Pragma("unroll") for (int k = 0; k < 2; ++k) \
        acc[ai][bj][m][n] = __builtin_amdgcn_mfma_f32_16x16x32_bf16(Bt[n][k], At[m][k], acc[ai][bj][m][n], 0, 0, 0); __builtin_amdgcn_s_setprio(0); } while (0)
#define PG8_WAIT_V(n) asm volatile("s_waitcnt vmcnt(" #n ")" ::: "memory")
#define PG8_WAIT_L(n) asm volatile("s_waitcnt lgkmcnt(" #n ")" ::: "memory")
#define PG8_BAR __builtin_amdgcn_s_barrier()
#define PG8_SCHED __builtin_amdgcn_sched_barrier(0)
    Unit cur, nxt; int ui = 0;
    if (!S.next(0, cur)) return;
    f32x4 acc[2][2][4][2];
#pragma unroll
    for (int a = 0; a < 2; ++a)
#pragma unroll
        for (int b = 0; b < 2; ++b)
#pragma unroll
            for (int m = 0; m < 4; ++m)
#pragma unroll
                for (int n = 0; n < 2; ++n) acc[a][b][m][n] = (f32x4){0.f, 0.f, 0.f, 0.f};
    bf16x8 At[4][2], B0[2][2], B1[2][2];
    const char* cA = (const char*)g.A + (size_t)cur.pm * tstep; const char* cB = (const char*)g.Bt + (size_t)cur.pn * tstep;
    S.a_ready(cur);
    if constexpr (SP2) {
        PG8_STAGE(PG8_SB(0, 0), cB, voffB); PG8_STAGE(PG8_SB(0, 1), cB + hstep, voffB); PG8_STAGE(PG8_SA(0, 0), cA, voffA); PG8_STAGE(PG8_SA(0, 1), cA + hstep, voffA);
        if (wr == 1) PG8_BAR;
        PG8_WAIT_V(2); PG8_BAR;
        PG8_STAGE(PG8_SB(1, 0), cB + kstep, voffB); PG8_STAGE(PG8_SA(1, 0), cA + kstep, voffA); PG8_STAGE(PG8_SB(1, 1), cB + hstep + kstep, voffB);
        PG8_WAIT_V(6); PG8_BAR;
    } else {
        PG8_STAGE(PG8_SB(0, 0), cB, voffB); PG8_STAGE(PG8_SA(0, 0), cA, voffA); PG8_STAGE(PG8_SB(0, 1), cB + hstep, voffB); PG8_STAGE(PG8_SA(0, 1), cA + hstep, voffA);
        if (wr == 1) PG8_BAR;
        PG8_WAIT_V(4); PG8_BAR;
        PG8_STAGE(PG8_SB(1, 0), cB + kstep, voffB); PG8_STAGE(PG8_SA(1, 0), cA + kstep, voffA); PG8_STAGE(PG8_SB(1, 1), cB + hstep + kstep, voffB);
        PG8_WAIT_V(6); PG8_BAR;
    }
    for (;;) {
        const bool has_next = S.next(ui + 1, nxt);
        const char* nA = has_next ? (const char*)g.A + (size_t)nxt.pm * tstep : cA; const char* nB = has_next ? (const char*)g.Bt + (size_t)nxt.pn * tstep : cB;
        for (int t = 0; t < nt; t += 2) {
            const bool last = (t == nt - 2);
            const char* a1 = cA + (size_t)(t + 1) * kstep;
            const char* a2 = last ? nA : cA + (size_t)(t + 2) * kstep; const char* b2 = last ? nB : cB + (size_t)(t + 2) * kstep;
            const char* a3 = a2 + kstep; const char* b3 = b2 + kstep;
            if (last && has_next) S.a_ready(nxt);
            if constexpr (SP2) {
            PG8_LDB(B0, 0, 0); PG8_LDB(B1, 0, 1); PG8_SCHED; PG8_LDA(At, 0, 0); PG8_STAGE(PG8_SA(1, 1), a1 + hstep, voffA);
            PG8_WAIT_V(8); PG8_WAIT_L(0); PG8_BAR; PG8_MMA(0, 0, At, B0); PG8_MMA(0, 1, At, B1); PG8_BAR; PG8_SCHED;
            PG8_LDA(At, 0, 1); PG8_STAGE(PG8_SB(0, 0), b2, voffB); PG8_STAGE(PG8_SB(0, 1), b2 + hstep, voffB); PG8_STAGE(PG8_SA(0, 0), a2, voffA);
            PG8_WAIT_V(8); PG8_WAIT_L(0); PG8_BAR; PG8_MMA(1, 0, At, B0); PG8_MMA(1, 1, At, B1); PG8_BAR; PG8_SCHED;
            PG8_LDB(B0, 1, 0); PG8_LDB(B1, 1, 1); PG8_SCHED; PG8_LDA(At, 1, 0); PG8_STAGE(PG8_SA(0, 1), a2 + hstep, voffA);
            PG8_WAIT_V(8); PG8_WAIT_L(0); PG8_BAR; PG8_MMA(0, 0, At, B0); PG8_MMA(0, 1, At, B1); PG8_BAR; PG8_SCHED;
            PG8_LDA(At, 1, 1); PG8_STAGE(PG8_SB(1, 0), b3, voffB); PG8_STAGE(PG8_SB(1, 1), b3 + hstep, voffB); PG8_STAGE(PG8_SA(1, 0), a3, voffA);
            PG8_WAIT_V(8); PG8_WAIT_L(0); PG8_BAR; PG8_MMA(1, 0, At, B0); PG8_MMA(1, 1, At, B1); PG8_BAR; PG8_SCHED;
            } else {
            PG8_LDB(B0, 0, 0); PG8_SCHED; PG8_LDA(At, 0, 0); PG8_STAGE(PG8_SA(1, 1), a1 + hstep, voffA);
            PG8_WAIT_L(8); PG8_BAR; PG8_WAIT_L(0); PG8_MMA(0, 0, At, B0); PG8_BAR; PG8_SCHED;
            PG8_LDB(B1, 0, 1); PG8_STAGE(PG8_SB(0, 0), b2, voffB);
            PG8_BAR; PG8_WAIT_L(0); PG8_MMA(0, 1, At, B1); PG8_BAR;
            PG8_LDA(At, 0, 1); PG8_STAGE(PG8_SA(0, 0), a2, voffA);
            PG8_BAR; PG8_WAIT_L(0); PG8_MMA(1, 0, At, B0); PG8_BAR; PG8_SCHED;
            PG8_STAGE(PG8_SB(0, 1), b2 + hstep, voffB);
            PG8_WAIT_V(6); PG8_BAR; PG8_MMA(1, 1, At, B1); PG8_BAR;
            PG8_LDB(B0, 1, 0); PG8_SCHED; PG8_LDA(At, 1, 0); PG8_STAGE(PG8_SA(0, 1), a2 + hstep, voffA);
            PG8_WAIT_L(8); PG8_BAR; PG8_WAIT_L(0); PG8_MMA(0, 0, At, B0); PG8_BAR; PG8_SCHED;
            PG8_LDB(B1, 1, 1); PG8_STAGE(PG8_SB(1, 0), b3, voffB);
            PG8_BAR; PG8_WAIT_L(0); PG8_MMA(0, 1, At, B1); PG8_BAR;
            PG8_LDA(At, 1, 1); PG8_STAGE(PG8_SA(1, 0), a3, voffA);
            PG8_BAR; PG8_WAIT_L(0); PG8_MMA(1, 0, At, B0); PG8_BAR; PG8_SCHED;
            PG8_STAGE(PG8_SB(1, 1), b3 + hstep, voffB);
            PG8_WAIT_V(6); PG8_BAR; PG8_MMA(1, 1, At, B1); PG8_BAR;
            }
        }
        if constexpr (ALIGN_EPI) { if (wr == 0) PG8_BAR; }
        if constexpr (!Epi::AFTER_DRAIN) { E(acc, cur, wr, wc, fr, fq); S.done(cur); }
        if (!has_next) break;
#pragma unroll
        for (int a = 0; a < 2; ++a)
#pragma unroll
            for (int b = 0; b < 2; ++b)
#pragma unroll
                for (int m = 0; m < 4; ++m)
#pragma unroll
                    for (int n = 0; n < 2; ++n) acc[a][b][m][n] = (f32x4){0.f, 0.f, 0.f, 0.f};
        cur = nxt; cA = nA; cB = nB; ++ui;
        if constexpr (ALIGN_EPI) { if (wr == 1) PG8_BAR; }
    }
    PG8_WAIT_V(0);
    if constexpr (!ALIGN_EPI) { if (wr == 0) PG8_BAR; }
    PG8_BAR;
    if constexpr (Epi::AFTER_DRAIN) { E.fused(acc, cur, wr, wc, fr, fq, lds, wid, lane); S.done(cur); }
#undef PG8_SA
#undef PG8_SB
#undef PG8_STAGE
#undef PG8_LDA
#undef PG8_LDB
#undef PG8_MMA
#undef PG8_WAIT_V
#undef PG8_WAIT_L
#undef PG8_BAR
#undef PG8_SCHED
}
}
constexpr int NWAVES = 8;
constexpr int BATCH = 8, T = 4096, D = 1024, M = BATCH * T, FF = 2816, NH = 8, HD = 64, INC = 4512;
constexpr float RMS_EPS = 1e-6f, GN_EPS = 64e-5f;
constexpr size_t MiB = 1u << 20;
constexpr size_t WS_PART = 1 * MiB;
constexpr size_t WS_SC = 9 * MiB;
constexpr size_t WS_WGU1 = 13 * MiB, WS_WDN1 = WS_WGU1 + 11 * MiB, WS_WGU2 = WS_WDN1 + 5632 * 1024, WS_WDN2 = WS_WGU2 + 11 * MiB;
constexpr size_t WS_WIN = WS_WDN2 + 5632 * 1024, WS_WGT = WS_WIN + 5 * MiB, WS_WLO = WS_WGT + 4 * MiB, WS_WBR = WS_WLO + 768 * 1024, WS_WBA = WS_WBR + 1 * MiB, WS_WOUT = WS_WBA + 1 * MiB;
constexpr size_t WS_XB = 62 * MiB;
constexpr size_t WS_ATTQ = 126 * MiB;
constexpr size_t WS_ATTKV = 158 * MiB;
constexpr size_t WS_RKVL = 174 * MiB;
constexpr size_t WS_G = 286 * MiB;
constexpr size_t WS_REC = 318 * MiB, REC_SLOT = 32 * MiB;
constexpr size_t WS_H = 126 * MiB;
constexpr size_t WS_YRAW = WS_RKVL;
constexpr size_t WS_MERGED = WS_RKVL;
constexpr size_t WS_GATES = WS_REC;
constexpr size_t WS_YR = WS_REC + 4 * REC_SLOT;
constexpr size_t WS_LA = WS_REC + 5 * REC_SLOT;
constexpr size_t WS_END = WS_REC + 6 * REC_SLOT;
static_assert(WS_WOUT + 4 * MiB <= WS_XB && WS_H + (size_t)M * FF * 2 <= WS_REC && WS_MERGED + (size_t)M * 2048 * 2 <= WS_REC, "ws map");
constexpr int RING_BYTES = 131072, LDS_BYTES = 147456;

#define GAS __attribute__((address_space(1)))
#define LAS __attribute__((address_space(3)))
typedef unsigned short bf16;
typedef unsigned v4u __attribute__((ext_vector_type(4)));
typedef unsigned v2u __attribute__((ext_vector_type(2)));
typedef float f32x4 __attribute__((ext_vector_type(4)));
typedef float f32x2 __attribute__((ext_vector_type(2)));
typedef short bf16x8 __attribute__((ext_vector_type(8)));
#define LDS_WAIT() asm volatile("s_waitcnt lgkmcnt(0)" ::: "memory")
__device__ __forceinline__ unsigned f2bf(float f) { unsigned u = __builtin_bit_cast(unsigned, f); return (u + 0x7fffu + ((u >> 16) & 1u)) >> 16; }
__device__ __forceinline__ unsigned pk2(float lo, float hi) { return f2bf(lo) | (f2bf(hi) << 16); }
__device__ __forceinline__ float bflo(unsigned u) { return __uint_as_float(u << 16); }
__device__ __forceinline__ float bfhi(unsigned u) { return __uint_as_float(u & 0xffff0000u); }
__device__ __forceinline__ float bf1(bf16 h) { return __uint_as_float((unsigned)h << 16); }
__device__ __forceinline__ float wave_sum(float v) {
#pragma unroll
    for (int o = 1; o < 64; o <<= 1) v += __shfl_xor(v, o);
    return v;
}
template <int CTRL> __device__ __forceinline__ float dppf(float x) { return __builtin_bit_cast(float, __builtin_amdgcn_update_dpp(0, __builtin_bit_cast(int, x), CTRL, 0xf, 0xf, false)); }
__device__ __forceinline__ float row16_sum(float x) { x += dppf<0xB1>(x); x += dppf<0x4E>(x); x += dppf<0x141>(x); x += dppf<0x140>(x); return x; }

#define RLX_AGENT __ATOMIC_RELAXED, __HIP_MEMORY_SCOPE_AGENT
#define XB_TMO      128
#define XB_XCNT(j)  (256  + 64 * (j))
#define XB_XSUB(j)  (1280 + 64 * (j))
#define XB_XGEN(j)  (2304 + 64 * (j))
#define XB_TOP      3328
#define XB_TOPGEN   3392
#define XCD_BAR_WORDS 3456
#define XB_SPIN_CAP (1u << 18)

__device__ __forceinline__ unsigned xb_ld(unsigned* p)              { return __hip_atomic_load(p, __ATOMIC_RELAXED, __HIP_MEMORY_SCOPE_AGENT); }
__device__ __forceinline__ unsigned xb_add(unsigned* p, unsigned v) { return __hip_atomic_fetch_add(p, v, __ATOMIC_RELAXED, __HIP_MEMORY_SCOPE_AGENT); }
__device__ __forceinline__ unsigned xb_xcc_id() { return (unsigned)__builtin_amdgcn_s_getreg((3 << 11) | 20) & 0xFu; }
#define XB_SPIN(cond, bar) do { unsigned _sp = 0; while (cond) { __builtin_amdgcn_s_sleep(1); \
    if ((++_sp & 255u) == 0u) { if (xb_ld(&(bar)[XB_TMO])) break; if (_sp > XB_SPIN_CAP) { atomicAdd(&(bar)[XB_TMO], 1u); break; } } } } while (0)

struct XcdBarrier {
    unsigned* bar; unsigned x;
    volatile LAS unsigned* st;
};

__device__ __forceinline__ XcdBarrier xcd_barrier_post(unsigned* bar, volatile LAS unsigned* st) {
    XcdBarrier b; b.bar = bar; b.x = xb_xcc_id(); b.st = st;
    if (threadIdx.x == 0) (void)xb_add(&bar[XB_XCNT(b.x)], 1u);
    return b;
}
__device__ __forceinline__ void xcd_barrier_complete(unsigned* bar, unsigned x, unsigned& nloc, unsigned& nx) {
    const unsigned G = gridDim.x * gridDim.y * gridDim.z;
    unsigned sum, cnt, mine, sp = 0u;
    for (;;) {
        sum = 0u; cnt = 0u; mine = 0u;
#pragma unroll
        for (unsigned j = 0; j < 16; ++j) { const unsigned c = xb_ld(&bar[XB_XCNT(j)]); sum += c; cnt += (c > 0u) ? 1u : 0u; mine = (j == x) ? c : mine; }
        if (sum == G) break;
        __builtin_amdgcn_s_sleep(1);
        if ((++sp & 255u) == 0u) { if (xb_ld(&bar[XB_TMO])) break; if (sp > XB_SPIN_CAP) { atomicAdd(&bar[XB_TMO], 1u); break; } }
    }
    nloc = mine > 0u ? mine : 1u; nx = cnt > 0u ? cnt : 1u;
}

__device__ __forceinline__ void xcd_barrier(const XcdBarrier& b) {
    asm volatile("s_waitcnt vmcnt(0)" ::: "memory");
    __syncthreads();
    if (threadIdx.x == 0) {
        unsigned* bar = b.bar;
        __builtin_amdgcn_s_waitcnt(0);
        unsigned nloc = b.st[0], nx = b.st[1];
        if (nloc == 0u) { xcd_barrier_complete(bar, b.x, nloc, nx); b.st[0] = nloc; b.st[1] = nx; }
        const unsigned old = xb_add(&bar[XB_XSUB(b.x)], 1u);
        const unsigned gen = old / nloc;
        if (old + 1u == (gen + 1u) * nloc) {
            __builtin_amdgcn_fence(__ATOMIC_RELEASE, "agent");
            asm volatile("s_waitcnt vmcnt(0)" ::: "memory");
            const unsigned og = xb_add(&bar[XB_TOP], 1u);
            const unsigned tg = og / nx;
            if (og + 1u == (tg + 1u) * nx) xb_add(&bar[XB_TOPGEN], 1u);
            else XB_SPIN(xb_ld(&bar[XB_TOPGEN]) == tg, bar);
            __builtin_amdgcn_fence(__ATOMIC_ACQUIRE, "agent");
            xb_add(&bar[XB_XGEN(b.x)], 1u);
            asm volatile("s_waitcnt vmcnt(0)" ::: "memory");
        } else {
            XB_SPIN(xb_ld(&bar[XB_XGEN(b.x)]) == gen, bar);
            __builtin_amdgcn_fence(__ATOMIC_ACQUIRE, "agent");
            asm volatile("s_waitcnt vmcnt(0)" ::: "memory");
        }
    }
    __syncthreads();
}

__device__ __forceinline__ int fresh_tid() { int t = threadIdx.x; asm volatile("" : "+v"(t)); return t; }
struct Frame {
    LAS unsigned char* lds;
    int tid, lane, wave, vcu, G;
    const float *in0, *in1, *in2, *in3, *in4, *in5, *in6, *in7, *in8, *in9, *in10, *in11, *in12, *in13, *in14, *in15, *in16, *in17, *in18, *in19, *in20, *in21, *in22, *in23, *in24, *in25, *in26, *in27, *in28; float* out; unsigned char* ws;
};

__device__ __forceinline__ void tr_item(const float* W, int ldn, int k0, int n0, bf16* WT, int ldk, int drow0, int dk0, const float* scale, int dup, LAS float* scr, int lane) {
#pragma unroll 8
    for (int i = 0; i < 32; ++i) { const int kk = 2 * i + (lane >> 5); float v = W[(size_t)(k0 + kk) * ldn + n0 + (lane & 31)]; if (scale) v *= scale[k0 + kk]; scr[kk * 33 + (lane & 31)] = v; }
    LDS_WAIT(); asm volatile("" ::: "memory");
    const int c = lane & 7;
#pragma unroll
    for (int j = 0; j < 4; ++j) { const int n = (lane >> 3) + 8 * j; const LAS float* s = scr + (8 * c) * 33 + n;
        v4u o; o.x = pk2(s[0 * 33], s[1 * 33]); o.y = pk2(s[2 * 33], s[3 * 33]); o.z = pk2(s[4 * 33], s[5 * 33]); o.w = pk2(s[6 * 33], s[7 * 33]);
        bf16* dp = WT + (size_t)(drow0 + n0 + n) * ldk + dk0 + k0 + 8 * c;
        *(GAS v4u*)dp = o; if (dup) *(GAS v4u*)(dp + dup) = o; }
    LDS_WAIT(); asm volatile("" ::: "memory");
}
__device__ __forceinline__ void p0_prologue(Frame& F) {
    LAS float* scr = (LAS float*)(F.lds + F.wave * 16384);
    unsigned char* ws = F.ws;
    const int gw = F.vcu * NWAVES + F.wave, NGW = F.G * NWAVES, lane = fresh_tid() & 63;
    constexpr int I_GU = 16 * 88, I_DN = 44 * 32, I_IN = 16 * 77, I_GT = 16 * 64, I_BR = 8 * 32, I_OUT = 16 * 32;
    constexpr int NITEMS = 4 * I_GU + 2 * I_DN + I_IN + I_GT + 2 * I_BR + I_OUT;
    for (int it = gw; it < NITEMS; it += NGW) {
        int r = it;
        if (r < 4 * I_GU) {
            const int which = r / I_GU; r -= which * I_GU; const int kb = r / 88, nb = r % 88, n0 = nb * 32;
            const float* W = which == 0 ? F.in2 : which == 1 ? F.in3 : which == 2 ? F.in25 : F.in26;
            tr_item(W, FF, kb * 64, n0, (bf16*)(ws + (which < 2 ? WS_WGU1 : WS_WGU2)), D, (n0 >> 7) * 256 + (which & 1) * 128 + (n0 & 127) - n0, 0, which < 2 ? F.in1 : F.in24, 0, scr, lane);
            continue; }
        r -= 4 * I_GU;
        if (r < 2 * I_DN) { const int which = r / I_DN; r -= which * I_DN; const int kb = r / 32, nb = r % 32;
            tr_item(which ? F.in27 : F.in4, D, kb * 64, nb * 32, (bf16*)(ws + (which ? WS_WDN2 : WS_WDN1)), FF, 0, 0, nullptr, 0, scr, lane); continue; }
        r -= 2 * I_DN;
        if (r < I_IN) { const int kb = r / 77, nb = r % 77, n0 = nb * 32;
            tr_item(F.in6, INC, kb * 64, n0, (bf16*)(ws + WS_WIN), D, n0 < 1696 ? 0 : 96, 0, F.in5, 0, scr, lane); continue; }
        r -= I_IN;
        if (r < I_GT) { const int kb = r / 64, nb = r % 64;
            tr_item(F.in6, INC, kb * 64, 2464 + nb * 32, (bf16*)(ws + WS_WGT), D, -2464, 0, F.in5, 0, scr, lane); continue; }
        r -= I_GT;
        if (r < 2 * I_BR) { const int which = r / I_BR; r -= which * I_BR; const int kb = r / 32, nb = r % 32;
            tr_item(which ? F.in22 : F.in21, D, kb * 64, nb * 32, (bf16*)(ws + (which ? WS_WBA : WS_WBR)), 512, 0, 0, nullptr, 0, scr, lane); continue; }
        r -= 2 * I_BR;
        { const int kb = r / 32, nb = r % 32; tr_item(F.in23, D, kb * 64, nb * 32, (bf16*)(ws + WS_WOUT), 2048, 0, 0, nullptr, 1024, scr, lane); }
    }
    { GAS v4u* z = (GAS v4u*)(ws + WS_WIN + (size_t)1696 * D * 2); for (int i = gw * 64 + lane; i < 12288; i += NGW * 64) z[i] = (v4u){0u, 0u, 0u, 0u}; }
    { bf16* WL = (bf16*)(ws + WS_WLO);
      for (int i = gw * 64 + lane; i < 1536 * 256; i += NGW * 64) { const int n = i >> 8, k = i & 255, grp = n >> 9, nn = n & 511; float v = 0.f;
          if (grp == 0) { if (k < 32) v = F.in9[k * 512 + nn]; } else if (grp == 1) { if (k >= 32 && k < 64) v = F.in11[(k - 32) * 512 + nn]; } else { if (k >= 64 && k < 160) v = F.in12[(k - 64) * 512 + nn]; }
          WL[i] = (bf16)f2bf(v); } }
    { const float* x = F.in0; bf16* XB = (bf16*)(ws + WS_XB); float* part = (float*)(ws + WS_PART);
      for (int m = gw; m < M; m += NGW) { const GAS f32x4* xr = (const GAS f32x4*)(x + (size_t)m * D) + lane; f32x4 v[4]; float s = 0.f;
#pragma unroll
          for (int j = 0; j < 4; ++j) { v[j] = xr[64 * j]; s += (v[j].x * v[j].x + v[j].y * v[j].y) + (v[j].z * v[j].z + v[j].w * v[j].w); }
          s = wave_sum(s);
          GAS unsigned long long* o8 = (GAS unsigned long long*)(XB + (size_t)m * D) + lane;
#pragma unroll
          for (int j = 0; j < 4; ++j) o8[64 * j] = (unsigned long long)pk2(v[j].x, v[j].y) | ((unsigned long long)pk2(v[j].z, v[j].w) << 32);
          if (lane < 16) part[(size_t)m * 16 + lane] = lane == 0 ? s : 0.f; } }
}
__device__ __forceinline__ void p4_lora_in(Frame& F) {
    const bf16* RKVL = (const bf16*)(F.ws + WS_RKVL); bf16* LA = (bf16*)(F.ws + WS_LA); const float* mu = F.in7 + 1536;
    const int gw = F.vcu * NWAVES + F.wave, NGW = F.G * NWAVES, lane = fresh_tid() & 63, c0 = 4 * lane;
    for (int m = gw; m < M; m += NGW) {
        float o[4] = {0.f, 0.f, 0.f, 0.f};
        if (c0 < 160) {
            const v2u cu = *(const GAS v2u*)(RKVL + (size_t)m * 1792 + 1536 + c0);
            v2u pu = (v2u){0u, 0u}; if ((m & (T - 1)) != 0) pu = *(const GAS v2u*)(RKVL + (size_t)(m - 1) * 1792 + 1536 + c0);
            const float cur[4] = {bflo(cu.x), bfhi(cu.x), bflo(cu.y), bfhi(cu.y)}, prv[4] = {bflo(pu.x), bfhi(pu.x), bflo(pu.y), bfhi(pu.y)};
            const f32x4 mv = *(const GAS f32x4*)(mu + c0);
#pragma unroll
            for (int j = 0; j < 4; ++j) { const float p = cur[j] + (prv[j] - cur[j]) * mv[j]; const int c = c0 + j;
                o[j] = c < 32 ? tanhf(p) : (c < 64 ? p : 1.0f / (1.0f + __expf(-p))); }
        }
        *(GAS v2u*)(LA + (size_t)m * 256 + c0) = (v2u){pk2(o[0], o[1]), pk2(o[2], o[3])};
    }
}
__device__ __forceinline__ float sum8(float v) { v += __shfl_xor(v, 1); v += __shfl_xor(v, 2); v += __shfl_xor(v, 4); return v; }
__device__ __forceinline__ void unpack8(const v4u u, float (&f)[8]) { f[0] = bflo(u.x); f[1] = bfhi(u.x); f[2] = bflo(u.y); f[3] = bfhi(u.y); f[4] = bflo(u.z); f[5] = bfhi(u.z); f[6] = bflo(u.w); f[7] = bfhi(u.w); }
__device__ __forceinline__ v4u pack8u(const float (&f)[8]) { return (v4u){pk2(f[0], f[1]), pk2(f[2], f[3]), pk2(f[4], f[5]), pk2(f[6], f[7])}; }
__device__ __forceinline__ void ld8f(const float* p, float (&f)[8]) { const f32x4 a = *(const GAS f32x4*)p, b = *(const GAS f32x4*)(p + 4); f[0] = a.x; f[1] = a.y; f[2] = a.z; f[3] = a.w; f[4] = b.x; f[5] = b.y; f[6] = b.z; f[7] = b.w; }
__device__ __forceinline__ void p6_prep(Frame& F) {
    const bf16* RKVL = (const bf16*)(F.ws + WS_RKVL); bf16* REC = (bf16*)(F.ws + WS_REC); f32x4* SC = (f32x4*)(F.ws + WS_SC);
    constexpr size_t SL = REC_SLOT / 2;
    const int gw = F.vcu * NWAVES + F.wave, NGW = F.G * NWAVES, lane = fresh_tid() & 63, h = lane >> 3, c0 = 8 * lane, n0 = 8 * (lane & 7);
    float mur[8], muk[8], muv[8], kkw[8], kaw[8], rkw[8];
    ld8f(F.in7 + c0, mur); ld8f(F.in7 + 512 + c0, muk); ld8f(F.in7 + 1024 + c0, muv); ld8f(F.in13 + c0, kkw); ld8f(F.in14 + c0, kaw); ld8f(F.in15 + c0, rkw);
    for (int m = gw; m < M; m += NGW) {
        const int b = m >> 12, t = m & (T - 1); const bool hp = t != 0;
        const bf16* cr = RKVL + (size_t)m * 1792 + c0; const bf16* pr = cr - (hp ? 1792 : 0);
        const size_t ri = ((size_t)(b * 8 + h) * T + t) * 64 + n0;
        const v4u ur = *(const GAS v4u*)cr, uk = *(const GAS v4u*)(cr + 512), uv = *(const GAS v4u*)(cr + 1024);
        const v4u pr_ = *(const GAS v4u*)pr, pk_ = *(const GAS v4u*)(pr + 512), pv_ = *(const GAS v4u*)(pr + 1024);
        const v4u ua = *(const GAS v4u*)(REC + 4 * SL + ri);
        float r[8], k[8], v[8], rp[8], kp[8], vp[8], a[8];
        unpack8(ur, r); unpack8(uk, k); unpack8(uv, v); unpack8(pr_, rp); unpack8(pk_, kp); unpack8(pv_, vp); unpack8(ua, a);
        float kk[8], ss = 0.f;
#pragma unroll
        for (int j = 0; j < 8; ++j) { const float rpj = hp ? rp[j] : 0.f, kpj = hp ? kp[j] : 0.f, vpj = hp ? vp[j] : 0.f;
            r[j] += (rpj - r[j]) * mur[j]; k[j] += (kpj - k[j]) * muk[j]; v[j] += (vpj - v[j]) * muv[j];
            kk[j] = k[j] * kkw[j]; ss += kk[j] * kk[j]; }
        const float inv = 1.0f / fmaxf(sqrtf(sum8(ss)), 1e-12f);
        float an[8], bn[8], kn[8];
#pragma unroll
        for (int j = 0; j < 8; ++j) { kk[j] *= inv; an[j] = -kk[j]; bn[j] = kk[j] * a[j]; kn[j] = k[j] * (1.0f + (a[j] - 1.0f) * kaw[j]); }
        const v4u oa = pack8u(an), orr = pack8u(r), ok = pack8u(kn), ob = pack8u(bn), ov = pack8u(v);
        float rq[8], kq[8], bq[8]; unpack8(orr, rq); unpack8(ok, kq); unpack8(ob, bq);
        float sb = 0.f, sk = 0.f, sbo = 0.f;
#pragma unroll
        for (int j = 0; j < 8; ++j) { sb += bq[j] * rq[j]; sk += kq[j] * rq[j]; sbo += rq[j] * kq[j] * rkw[j]; }
        sb = sum8(sb); sk = sum8(sk); sbo = sum8(sbo);
        *(GAS v4u*)(REC + 1 * SL + ri) = oa; *(GAS v4u*)(REC + 2 * SL + ri) = orr; *(GAS v4u*)(REC + 3 * SL + ri) = ok; *(GAS v4u*)(REC + 4 * SL + ri) = ob; *(GAS v4u*)(REC + 5 * SL + ri) = ov;
        if ((lane & 7) == 0) SC[(size_t)(b * 8 + h) * T + t] = (f32x4){sb, sk, sbo, 0.f};
    }
}
constexpr int KS_STRIDE = 144, VT_STRIDE = 528, ATT_KS_OFF = 0, ATT_VT_OFF = 256 * KS_STRIDE;
__device__ __forceinline__ void p6_attention(Frame& F) {
    bf16* ATTQ = (bf16*)(F.ws + WS_ATTQ); const bf16* ATTKV = (const bf16*)(F.ws + WS_ATTKV);
    const float* qn = F.in18; const float* kn = F.in19; const float* sinks = F.in20;
    LAS unsigned char* Ks = F.lds + ATT_KS_OFF; LAS unsigned char* Vt = F.lds + ATT_VT_OFF;
    const int tid = fresh_tid(), lane = tid & 63, w = F.wave, g = lane >> 4, n16 = lane & 15;
    for (int unit = F.vcu; unit < BATCH * 2 * 32; unit += F.G) {
        const int nb = unit & 31, kvh = (unit >> 5) & 1, b = unit >> 6; const int m0 = b * T + nb * 128;
#pragma unroll
        for (int i = 0; i < 4; ++i) { const int e = tid + 512 * i, key = e >> 3, dg = e & 7; const bool valid = nb > 0 || key >= 128;
            v4u ku = (v4u){0u, 0u, 0u, 0u}, vu = (v4u){0u, 0u, 0u, 0u};
            if (valid) { const bf16* src = ATTKV + (size_t)(m0 - 128 + key) * 256 + kvh * 64 + dg * 8; ku = *(const GAS v4u*)src; vu = *(const GAS v4u*)(src + 128); }
            float kf[8] = {bflo(ku.x), bfhi(ku.x), bflo(ku.y), bfhi(ku.y), bflo(ku.z), bfhi(ku.z), bflo(ku.w), bfhi(ku.w)};
            float ss = 0.f;
#pragma unroll
            for (int j = 0; j < 8; ++j) ss += kf[j] * kf[j];
            ss += __shfl_xor(ss, 1); ss += __shfl_xor(ss, 2); ss += __shfl_xor(ss, 4);
            const float rs = 1.0f / sqrtf(ss * (1.0f / 64.0f) + RMS_EPS);
#pragma unroll
            for (int j = 0; j < 8; ++j) kf[j] *= rs * kn[dg * 8 + j];
            *(LAS v4u*)(Ks + key * KS_STRIDE + dg * 16) = (v4u){pk2(kf[0], kf[1]), pk2(kf[2], kf[3]), pk2(kf[4], kf[5]), pk2(kf[6], kf[7])};
            const unsigned vv[4] = {vu.x, vu.y, vu.z, vu.w};
#pragma unroll
            for (int j = 0; j < 8; ++j) *(LAS bf16*)(Vt + (dg * 8 + j) * VT_STRIDE + key * 2) = (bf16)((vv[j >> 1] >> ((j & 1) * 16)) & 0xffffu);
        }
        __syncthreads();
        const int hq = kvh * 4 + (w >> 1), qbase = (w & 1) * 64; const float sink = sinks[hq];
        for (int qt = 0; qt < 4; ++qt) {
            const int q0 = qbase + 16 * qt, qi = q0 + n16, kt0 = q0 >> 4;
            bf16* qp = ATTQ + (size_t)(m0 + qi) * 512 + hq * 64 + 8 * g;
            const v4u qa = *(const GAS v4u*)qp, qb = *(const GAS v4u*)(qp + 32);
            float q[16] = {bflo(qa.x), bfhi(qa.x), bflo(qa.y), bfhi(qa.y), bflo(qa.z), bfhi(qa.z), bflo(qa.w), bfhi(qa.w),
                           bflo(qb.x), bfhi(qb.x), bflo(qb.y), bfhi(qb.y), bflo(qb.z), bfhi(qb.z), bflo(qb.w), bfhi(qb.w)};
            float ss = 0.f;
#pragma unroll
            for (int j = 0; j < 16; ++j) ss += q[j] * q[j];
            ss += __shfl_xor(ss, 16); ss += __shfl_xor(ss, 32);
            const float rs = 0.125f / sqrtf(ss * (1.0f / 64.0f) + RMS_EPS);
#pragma unroll
            for (int j = 0; j < 16; ++j) q[j] *= rs * qn[(j >> 3) * 32 + 8 * g + (j & 7)];
            const v4u qf0 = (v4u){pk2(q[0], q[1]), pk2(q[2], q[3]), pk2(q[4], q[5]), pk2(q[6], q[7])}, qf1 = (v4u){pk2(q[8], q[9]), pk2(q[10], q[11]), pk2(q[12], q[13]), pk2(q[14], q[15])};
            const bf16x8 bq0 = __builtin_bit_cast(bf16x8, qf0), bq1 = __builtin_bit_cast(bf16x8, qf1);
            f32x4 st[10]; float mx = -INFINITY;
#pragma unroll
            for (int i = 0; i < 10; ++i) { const int kt = kt0 + i, ktc = kt < 16 ? kt : 15;
                const LAS unsigned char* kp = Ks + (16 * ktc + n16) * KS_STRIDE + 16 * g;
                const bf16x8 a0 = *(const LAS bf16x8*)kp, a1 = *(const LAS bf16x8*)(kp + 64);
                f32x4 acc = (f32x4){0.f, 0.f, 0.f, 0.f};
                acc = __builtin_amdgcn_mfma_f32_16x16x32_bf16(a0, bq0, acc, 0, 0, 0);
                acc = __builtin_amdgcn_mfma_f32_16x16x32_bf16(a1, bq1, acc, 0, 0, 0);
#pragma unroll
                for (int r = 0; r < 4; ++r) { const int kj = 16 * kt + 4 * g + r; const bool ok = (kj > qi) && (kj <= qi + 128) && (nb > 0 || kj >= 128);
                    acc[r] = ok ? acc[r] : -INFINITY; mx = fmaxf(mx, acc[r]); }
                st[i] = acc; }
            mx = fmaxf(mx, __shfl_xor(mx, 16)); mx = fmaxf(mx, __shfl_xor(mx, 32)); mx = fmaxf(mx, sink);
            float den = 0.f;
#pragma unroll
            for (int i = 0; i < 10; ++i)
#pragma unroll
                for (int r = 0; r < 4; ++r) { const float p = __expf(st[i][r] - mx); st[i][r] = p; den += p; }
            den += __shfl_xor(den, 16); den += __shfl_xor(den, 32); den += __expf(sink - mx);
            const float inv = 1.0f / den;
            f32x4 o[4];
#pragma unroll
            for (int dt = 0; dt < 4; ++dt) o[dt] = (f32x4){0.f, 0.f, 0.f, 0.f};
#pragma unroll
            for (int j = 0; j < 5; ++j) { const int ka = kt0 + 2 * j, kb2 = ka + 1, kac = ka < 16 ? ka : 15, kbc = kb2 < 16 ? kb2 : 15;
                const v4u pu = (v4u){pk2(st[2 * j][0], st[2 * j][1]), pk2(st[2 * j][2], st[2 * j][3]), pk2(st[2 * j + 1][0], st[2 * j + 1][1]), pk2(st[2 * j + 1][2], st[2 * j + 1][3])};
                const bf16x8 pf = __builtin_bit_cast(bf16x8, pu);
#pragma unroll
                for (int dt = 0; dt < 4; ++dt) { const LAS unsigned char* vp = Vt + (16 * dt + n16) * VT_STRIDE;
                    const v2u va = *(const LAS v2u*)(vp + (16 * kac + 4 * g) * 2), vb = *(const LAS v2u*)(vp + (16 * kbc + 4 * g) * 2);
                    const bf16x8 af = __builtin_bit_cast(bf16x8, (v4u){va.x, va.y, vb.x, vb.y});
                    o[dt] = __builtin_amdgcn_mfma_f32_16x16x32_bf16(af, pf, o[dt], 0, 0, 0); } }
            bf16* op = ATTQ + (size_t)(m0 + qi) * 512 + hq * 64 + 4 * g;
#pragma unroll
            for (int dt = 0; dt < 4; ++dt) *(GAS v2u*)(op + 16 * dt) = (v2u){pk2(o[dt][0] * inv, o[dt][1] * inv), pk2(o[dt][2] * inv, o[dt][3] * inv)};
        }
        __syncthreads();
    }
}
constexpr int SC_NS = 32, SC_AW = 0, SC_WV = 16384, SC_KV = 24576, SC_BV = 32768, SC_VS = 40960, SC_YB = 49152, SC_BUF = 51200;
struct ScanPre { v4u ulw, ua, ur, uk, ub; unsigned uv; f32x4 sc; };
__device__ __forceinline__ ScanPre scan_issue(Frame& F, int bh, int quarter, int t0, int lt) {
    const unsigned char* REC = F.ws + WS_REC; const f32x4* SC = (const f32x4*)(F.ws + WS_SC);
    const size_t eoff = ((size_t)bh * T + t0) * 128 + (size_t)lt * 16;
    ScanPre p;
    p.ulw = *(const GAS v4u*)(REC + 0 * REC_SLOT + eoff); p.ua = *(const GAS v4u*)(REC + 1 * REC_SLOT + eoff); p.ur = *(const GAS v4u*)(REC + 2 * REC_SLOT + eoff);
    p.uk = *(const GAS v4u*)(REC + 3 * REC_SLOT + eoff); p.ub = *(const GAS v4u*)(REC + 4 * REC_SLOT + eoff);
    const int s = lt >> 3, rp = 2 * (lt & 7);
    p.uv = *(const GAS unsigned*)(REC + 5 * REC_SLOT + (((size_t)bh * T + t0 + s) * 64 + 16 * quarter + rp) * 2);
    p.sc = *(const GAS f32x4*)(SC + (size_t)bh * T + t0 + s);
    return p;
}
__device__ __forceinline__ void scan_commit(const ScanPre& p, LAS unsigned char* buf, int lt) {
    const v4u ulw = p.ulw, ua = p.ua, ur = p.ur, uk = p.uk, ub = p.ub; const unsigned uv = p.uv; const f32x4 sc = p.sc;
    const int s = lt >> 3, e0 = 8 * (lt & 7), rp = 2 * (lt & 7);
    const unsigned lw4[4] = {ulw.x, ulw.y, ulw.z, ulw.w}, a4[4] = {ua.x, ua.y, ua.z, ua.w}, r4[4] = {ur.x, ur.y, ur.z, ur.w}, k4[4] = {uk.x, uk.y, uk.z, uk.w}, b4[4] = {ub.x, ub.y, ub.z, ub.w};
    float w[8], av[8], wr[8], kv[8], bv[8];
#pragma unroll
    for (int i = 0; i < 4; ++i) {
        w[2 * i] = __expf(bflo(lw4[i])); w[2 * i + 1] = __expf(bfhi(lw4[i]));
        av[2 * i] = bflo(a4[i]); av[2 * i + 1] = bfhi(a4[i]);
        wr[2 * i] = w[2 * i] * bflo(r4[i]); wr[2 * i + 1] = w[2 * i + 1] * bfhi(r4[i]);
        kv[2 * i] = bflo(k4[i]); kv[2 * i + 1] = bfhi(k4[i]);
        bv[2 * i] = bflo(b4[i]); bv[2 * i + 1] = bfhi(b4[i]); }
    LAS f32x4* AW = (LAS f32x4*)(buf + SC_AW); const int q0 = e0 >> 2;
#pragma unroll
    for (int qq = 0; qq < 2; ++qq)
#pragma unroll
        for (int hh = 0; hh < 2; ++hh) { const int e = 4 * qq + 2 * hh; AW[(s * 2 + hh) * 16 + q0 + qq] = (f32x4){av[e], wr[e], av[e + 1], wr[e + 1]}; }
    LAS f32x4* WV = (LAS f32x4*)(buf + SC_WV); LAS f32x4* KV = (LAS f32x4*)(buf + SC_KV); LAS f32x4* BV = (LAS f32x4*)(buf + SC_BV);
#pragma unroll
    for (int qq = 0; qq < 2; ++qq) { const int e = 4 * qq;
        WV[s * 16 + q0 + qq] = (f32x4){w[e], w[e + 1], w[e + 2], w[e + 3]}; KV[s * 16 + q0 + qq] = (f32x4){kv[e], kv[e + 1], kv[e + 2], kv[e + 3]}; BV[s * 16 + q0 + qq] = (f32x4){bv[e], bv[e + 1], bv[e + 2], bv[e + 3]}; }
    LAS f32x4* VS = (LAS f32x4*)(buf + SC_VS); const float v0 = bflo(uv), v1 = bfhi(uv);
    VS[s * 16 + rp] = (f32x4){v0, v0 * sc.y, sc.x, 0.f}; VS[s * 16 + rp + 1] = (f32x4){v1, v1 * sc.y, sc.x, 0.f};
}
__device__ __forceinline__ void scan_flush(Frame& F, int bh, int quarter, int t0, const LAS unsigned char* buf, int lt) {
    if (lt < 128) { const int s = lt >> 2, c4 = lt & 3; const int b = bh >> 3, h = bh & 7;
        float* yraw = (float*)(F.ws + WS_YRAW);
        const f32x4 y = *(const LAS f32x4*)(buf + SC_YB + (s * 16 + 4 * c4) * 4);
        *(GAS f32x4*)(yraw + (size_t)(b * T + t0 + s) * 512 + h * 64 + 16 * quarter + 4 * c4) = y; }
}
__device__ __forceinline__ void p7_scan(Frame& F) {
    const int w = F.wave, tid = fresh_tid(), lane = tid & 63, rl = lane >> 4, q = lane & 15, lt = tid - 256;
    constexpr int NBLK = T / SC_NS;
#define SCAN_BAR() do { asm volatile("s_waitcnt lgkmcnt(0)" ::: "memory"); __builtin_amdgcn_s_barrier(); asm volatile("" ::: "memory"); } while (0)
    for (int unit = F.vcu; unit < 256; unit += F.G) {
        const int bh = unit >> 2, quarter = unit & 3;
        ScanPre pre;
        if (w >= 4) { pre = scan_issue(F, bh, quarter, 0, lt); scan_commit(pre, F.lds, lt); pre = scan_issue(F, bh, quarter, SC_NS, lt); }
        SCAN_BAR();
        float S0 = 0.f, S1 = 0.f, S2 = 0.f, S3 = 0.f;
        for (int nb = 0; nb < NBLK; ++nb) {
            LAS unsigned char* cur = F.lds + (nb & 1) * SC_BUF; LAS unsigned char* oth = F.lds + ((nb + 1) & 1) * SC_BUF;
            if (w >= 4) {
                if (nb > 0) scan_flush(F, bh, quarter, (nb - 1) * SC_NS, oth, lt);
                if (nb + 1 < NBLK) scan_commit(pre, oth, lt);
                if (nb + 2 < NBLK) pre = scan_issue(F, bh, quarter, (nb + 2) * SC_NS, lt);
            } else {
                const LAS f32x4* AW = (const LAS f32x4*)(cur + SC_AW); const LAS f32x4* WV = (const LAS f32x4*)(cur + SC_WV); const LAS f32x4* KV = (const LAS f32x4*)(cur + SC_KV);
                const LAS f32x4* BV = (const LAS f32x4*)(cur + SC_BV); const LAS f32x4* VS = (const LAS f32x4*)(cur + SC_VS); LAS float* YB = (LAS float*)(cur + SC_YB);
                const int rowl = 4 * w + rl;
                f32x4 aw0 = AW[q], aw1 = AW[16 + q], wv = WV[q], kv = KV[q], bv = BV[q], vs = VS[rowl];
#pragma unroll 8
                for (int s = 0; s < SC_NS; ++s) {
                    const int sn = s + 1;
                    const f32x4 n_aw0 = AW[(sn * 2) * 16 + q], n_aw1 = AW[(sn * 2 + 1) * 16 + q], n_wv = WV[sn * 16 + q], n_kv = KV[sn * 16 + q], n_bv = BV[sn * 16 + q], n_vs = VS[sn * 16 + rowl];
                    __builtin_amdgcn_sched_barrier(0);
                    float sa = S0 * aw0.x; sa = fmaf(S1, aw0.z, sa); sa = fmaf(S2, aw1.x, sa); sa = fmaf(S3, aw1.z, sa);
                    float z = S0 * aw0.y; z = fmaf(S1, aw0.w, z); z = fmaf(S2, aw1.y, z); z = fmaf(S3, aw1.w, z);
                    const float t0_ = fmaf(vs.x, kv.x, S0 * wv.x), t1_ = fmaf(vs.x, kv.y, S1 * wv.y), t2_ = fmaf(vs.x, kv.z, S2 * wv.z), t3_ = fmaf(vs.x, kv.w, S3 * wv.w);
                    sa = row16_sum(sa); z = row16_sum(z);
                    S0 = fmaf(sa, bv.x, t0_); S1 = fmaf(sa, bv.y, t1_); S2 = fmaf(sa, bv.z, t2_); S3 = fmaf(sa, bv.w, t3_);
                    YB[s * 16 + rowl] = fmaf(sa, vs.z, z) + vs.y;
                    aw0 = n_aw0; aw1 = n_aw1; wv = n_wv; kv = n_kv; bv = n_bv; vs = n_vs;
                }
            }
            SCAN_BAR();
        }
        if (w >= 4) scan_flush(F, bh, quarter, T - SC_NS, F.lds + ((NBLK - 1) & 1) * SC_BUF, lt);
        asm volatile("s_waitcnt vmcnt(0)" ::: "memory"); SCAN_BAR();
    }
#undef SCAN_BAR
}
__device__ __forceinline__ void p8_post(Frame& F) {
    const float* yraw = (const float*)(F.ws + WS_YRAW); const bf16* RV = (const bf16*)(F.ws + WS_REC + 5 * REC_SLOT); const f32x4* SC = (const f32x4*)(F.ws + WS_SC);
    const bf16* Gt = (const bf16*)(F.ws + WS_G); bf16* YR = (bf16*)(F.ws + WS_YR);
    const int gw = F.vcu * NWAVES + F.wave, NGW = F.G * NWAVES, lane = fresh_tid() & 63, h = lane >> 3, c0 = 8 * lane, n0 = 8 * (lane & 7);
    float lw[8], lb[8]; ld8f(F.in16 + c0, lw); ld8f(F.in17 + c0, lb);
    for (int m = gw; m < M; m += NGW) {
        const int b = m >> 12, t = m & (T - 1); const size_t rt = (size_t)(b * 8 + h) * T + t;
        float y[8]; ld8f(yraw + (size_t)m * 512 + c0, y);
        const v4u uv = *(const GAS v4u*)(RV + rt * 64 + n0), ug = *(const GAS v4u*)(Gt + (size_t)m * 512 + c0); const float bonus = SC[rt].z;
        float v[8], g[8]; unpack8(uv, v); unpack8(ug, g);
        float s1 = 0.f;
#pragma unroll
        for (int j = 0; j < 8; ++j) s1 += y[j];
        const float mean = sum8(s1) * (1.0f / 64.0f); float s2 = 0.f;
#pragma unroll
        for (int j = 0; j < 8; ++j) { y[j] -= mean; s2 += y[j] * y[j]; }
        const float rstd = 1.0f / sqrtf(sum8(s2) * (1.0f / 64.0f) + GN_EPS);
        float o[8];
#pragma unroll
        for (int j = 0; j < 8; ++j) o[j] = (y[j] * rstd * lw[j] + lb[j] + bonus * v[j]) * g[j];
        *(GAS v4u*)(YR + (size_t)m * 512 + c0) = pack8u(o);
    }
}
__device__ __forceinline__ void p13_final(Frame& F) {
    const float* part = (const float*)(F.ws + WS_PART + 3 * 2 * MiB); const float* gn = F.in28;
    const int gw = F.vcu * NWAVES + F.wave, NGW = F.G * NWAVES, lane = fresh_tid() & 63;
    for (int m = gw; m < M; m += NGW) {
        float s = lane < 16 ? part[(size_t)m * 16 + lane] : 0.f; s = wave_sum(s);
        const float rs = 1.0f / sqrtf(s * (1.0f / 1024.0f) + RMS_EPS);
        GAS f32x4* xr = (GAS f32x4*)(F.out + (size_t)m * D) + lane; const GAS f32x4* gr = (const GAS f32x4*)gn + lane;
#pragma unroll
        for (int j = 0; j < 4; ++j) { const f32x4 v = xr[64 * j], g4 = gr[64 * j]; xr[64 * j] = v * rs * g4; }
    }
}
struct Args { const float* in[29]; float* out; unsigned char* ws; };
__global__ void __launch_bounds__(NWAVES * 64, 2) fwd_megakernel(Args args) {
    extern __shared__ __attribute__((aligned(16))) unsigned char lds[];
    cg::grid_group grid = cg::this_grid();
    Frame F;
    F.lds = (LAS unsigned char*)lds;
    F.tid = threadIdx.x; F.lane = F.tid & 63; F.wave = __builtin_amdgcn_readfirstlane(F.tid >> 6);
    F.G = gridDim.x; { const int bx = blockIdx.x; F.vcu = (F.G % 8 == 0) ? (bx % 8) * (F.G / 8) + bx / 8 : bx; }
F.in0 = args.in[0]; F.in1 = args.in[1]; F.in2 = args.in[2]; F.in3 = args.in[3]; F.in4 = args.in[4]; F.in5 = args.in[5]; F.in6 = args.in[6]; F.in7 = args.in[7]; F.in8 = args.in[8]; F.in9 = args.in[9]; F.in10 = args.in[10]; F.in11 = args.in[11]; F.in12 = args.in[12]; F.in13 = args.in[13]; F.in14 = args.in[14]; F.in15 = args.in[15]; F.in16 = args.in[16]; F.in17 = args.in[17]; F.in18 = args.in[18]; F.in19 = args.in[19]; F.in20 = args.in[20]; F.in21 = args.in[21]; F.in22 = args.in[22]; F.in23 = args.in[23]; F.in24 = args.in[24]; F.in25 = args.in[25]; F.in26 = args.in[26]; F.in27 = args.in[27]; F.in28 = args.in[28];
    F.out = args.out; F.ws = args.ws;
    unsigned char* ws = args.ws;
    bf16* XB = (bf16*)(ws + WS_XB); bf16* HB = (bf16*)(ws + WS_H);
    float* PA = (float*)(ws + WS_PART); float* PB = PA + (size_t)M * 16; float* PC = PB + (size_t)M * 16; float* PD = PC + (size_t)M * 16;
    using pg8::gemm_phase; using pg8::StaticOrder; using pg8::Gemm;
    volatile LAS unsigned* bst = (volatile LAS unsigned*)(F.lds + RING_BYTES);
    if (F.tid == 0) { bst[0] = 0u; bst[1] = 0u; }
    __syncthreads();
    XcdBarrier bar = xcd_barrier_post((unsigned*)ws, bst);
#define SYNC() xcd_barrier(bar)
#define RUN_GEMM(EPI, Aptr, Bptr, NN, KK, ...) do { Gemm g_{(const pg8::bf16_t*)(Aptr), (const pg8::bf16_t*)(Bptr), M, (NN), (KK)}; StaticOrder S_; S_.init(M, (NN), F.G, (int)blockIdx.x); \
        pg8::EPI E_{__VA_ARGS__}; gemm_phase<pg8::EPI, StaticOrder, true, true>(F.lds, g_, S_, E_); } while (0)

    p0_prologue(F); grid.sync();
    RUN_GEMM(EpiGU, XB, ws + WS_WGU1, 2 * FF, D, HB, PA); SYNC();
    RUN_GEMM(EpiRes, HB, ws + WS_WDN1, D, FF, F.in0, F.out, XB, PB, 0.5f); SYNC();
    RUN_GEMM(EpiProj, XB, ws + WS_WIN, 2560, D, (bf16*)(ws + WS_RKVL), (bf16*)(ws + WS_ATTQ), (bf16*)(ws + WS_ATTKV), PB); SYNC();
    p4_lora_in(F); SYNC();
    RUN_GEMM(EpiLora, ws + WS_LA, ws + WS_WLO, 1536, 256, (bf16*)(ws + WS_REC), (bf16*)(ws + WS_REC + 4 * REC_SLOT), (bf16*)(ws + WS_G), F.in8, F.in10); SYNC();
    p6_prep(F); p6_attention(F); SYNC();
    p7_scan(F); SYNC();
    p8_post(F); SYNC();
    RUN_GEMM(EpiGate, XB, ws + WS_WGT, 2048, D, (bf16*)(ws + WS_GATES), PB); SYNC();
    RUN_GEMM(EpiBranch, ws + WS_YR, ws + WS_WBR, D, 512, (const bf16*)(ws + WS_GATES), (bf16*)(ws + WS_MERGED), 0);
    RUN_GEMM(EpiBranch, ws + WS_ATTQ, ws + WS_WBA, D, 512, (const bf16*)(ws + WS_GATES), (bf16*)(ws + WS_MERGED), 1024); SYNC();
    RUN_GEMM(EpiRes, ws + WS_MERGED, ws + WS_WOUT, D, 2048, F.out, F.out, XB, PC, 1.0f); SYNC();
    RUN_GEMM(EpiGU, XB, ws + WS_WGU2, 2 * FF, D, HB, PC); SYNC();
    RUN_GEMM(EpiRes, HB, ws + WS_WDN2, D, FF, F.out, F.out, (bf16*)nullptr, PD, 0.5f); SYNC();
    p13_final(F);
}

extern "C" void kernel_launch(void* const* d_in, const int* in_sizes, int n_in, void* d_out, int out_size, void* d_ws, size_t ws_size, hipStream_t stream) {
    static int grid = 0;
    if (grid == 0) {
        if (n_in != 29 || in_sizes[0] != M * D || out_size != M * D || ws_size < WS_END) { fprintf(stderr, "kernel_launch: unexpected shapes (n_in %d, ws %zu)\n", n_in, ws_size); grid = -1; return; }
        int dev = 0, cus = 0, per_cu = 0;
        hipGetDevice(&dev); hipDeviceGetAttribute(&cus, hipDeviceAttributeMultiprocessorCount, dev);
        if (hipFuncSetAttribute((const void*)fwd_megakernel, hipFuncAttributeMaxDynamicSharedMemorySize, LDS_BYTES) != hipSuccess) { fprintf(stderr, "kernel_launch: hipFuncSetAttribute failed\n"); grid = -1; return; }
        hipOccupancyMaxActiveBlocksPerMultiprocessor(&per_cu, (const void*)fwd_megakernel, NWAVES * 64, LDS_BYTES);
        (void)hipGetLastError();
        if (per_cu < 1) fprintf(stderr, "kernel_launch: occupancy query says %d blocks/CU\n", per_cu);
        grid = cus;
    }
    if (grid < 0) return;
    if (hipMemsetAsync(d_ws, 0, 16384, stream) != hipSuccess) { fprintf(stderr, "kernel_launch: memset failed\n"); return; }
    Args a{};
    for (int i = 0; i < 29; ++i) a.in[i] = (const float*)d_in[i];
    a.out = (float*)d_out; a.ws = (unsigned char*)d_ws;
    void* kargs[] = {&a};
    hipError_t e = hipLaunchCooperativeKernel((const void*)fwd_megakernel, dim3(grid), dim3(NWAVES * 64), kargs, LDS_BYTES, stream);
    if (e != hipSuccess) fprintf(stderr, "kernel_launch: cooperative launch failed: %s (grid %d)\n", hipGetErrorString(e), grid);
}
```

```cpp
#include <hip/hip_runtime.h>
#include <hip/hip_cooperative_groups.h>
#include <cstdio>
#include <cstdint>
namespace cg = cooperative_groups;
namespace pg8 {
#define PG8_LAS __attribute__((address_space(3)))
typedef unsigned short bf16_t;
typedef short bf16x8 __attribute__((ext_vector_type(8)));
typedef float f32x4 __attribute__((ext_vector_type(4)));
typedef unsigned u32x4 __attribute__((ext_vector_type(4)));
constexpr int BM = 256, BK = 64, HALF = 128, HTB = HALF * BK * 2  , STAGE_BYTES = 8 * HTB, NXCD = 8, WGM = 8;

__host__ __device__ __forceinline__ int lds_byte(int r, int c) { const int st = (r >> 4) * 2 + (c >> 5), rr = r & 15, cc = c & 31, ob = rr * 64 + cc * 2; return st * 1024 + (ob ^ (((ob >> 9) & 1) << 5)); }
__host__ __device__ __forceinline__ void stage_rc(int b, int& R, int& C) { const int st = b / 1024, sb = b % 1024, swz = sb ^ (((sb >> 9) & 1) << 5); R = (st >> 1) * 16 + swz / 64; C = (st & 1) * 32 + (swz % 64) / 2; }
__host__ __device__ __forceinline__ int perm32(int rho) { const int n = rho >> 4, i = rho & 15; return 8 * (i >> 2) + 4 * n + (i & 3); }

struct Unit { int pm, pn; };
struct Gemm { const bf16_t* A; const bf16_t* Bt; int M, N, K; };

struct StaticOrder {
    int nM, nN, nwg, G, c;
    __host__ __device__ void init(int M, int N, int G_, int c_) { nM = M / BM; nN = N / BM; nwg = nM * nN; G = G_; c = c_; }
    __host__ __device__ bool next(int i, Unit& u) const {
        const long L = (long)i * G + c; if (L >= nwg) return false;
        int wgid = (int)L; { const int q = nwg / NXCD, r = nwg % NXCD, xcd = wgid % NXCD, off = wgid / NXCD; wgid = (xcd < r ? xcd * (q + 1) : r * (q + 1) + (xcd - r) * q) + off; }
        const int nig = WGM * nN, gid = wgid / nig, fm = gid * WGM, gsz = (nM - fm) < WGM ? (nM - fm) : WGM;
        u.pm = fm + ((wgid % nig) % gsz); u.pn = (wgid % nig) / gsz; return true;
    }
    __device__ __forceinline__ void a_ready(const Unit&) const {}
    __device__ __forceinline__ void done(const Unit&) const {}
};

__device__ __forceinline__ unsigned cvt_pk_bf16(float lo, float hi) { unsigned r; asm volatile("v_cvt_pk_bf16_f32 %0, %1, %2" : "=v"(r) : "v"(lo), "v"(hi)); return r; }
__device__ __forceinline__ u32x4 pack8(f32x4 v0, f32x4 v1) {
    u32x4 w;
    asm volatile("s_nop 1\n\tv_cvt_pk_bf16_f32 %0, %4, %5\n\tv_cvt_pk_bf16_f32 %1, %6, %7\n\tv_cvt_pk_bf16_f32 %2, %8, %9\n\tv_cvt_pk_bf16_f32 %3, %10, %11"
                 : "=&v"(w.x), "=&v"(w.y), "=&v"(w.z), "=&v"(w.w)
                 : "v"(v0[0]), "v"(v0[1]), "v"(v0[2]), "v"(v0[3]), "v"(v1[0]), "v"(v1[1]), "v"(v1[2]), "v"(v1[3]));
    return w;
}
__device__ __forceinline__ float bf_lo(unsigned u) { return __uint_as_float(u << 16); }
__device__ __forceinline__ float bf_hi(unsigned u) { return __uint_as_float(u & 0xffff0000u); }
__device__ __forceinline__ void rows_rstd(const float* part, int row0, int fq, float (&rs)[2][4]) {
#pragma unroll
    for (int ai = 0; ai < 2; ++ai)
#pragma unroll
        for (int m = 0; m < 4; ++m) { const f32x4 a = *(const f32x4*)(part + (size_t)(row0 + ai * HALF + m * 16) * 16 + 4 * fq);
            float s = (a[0] + a[1]) + (a[2] + a[3]); s += __shfl_xor(s, 16); s += __shfl_xor(s, 32);
            rs[ai][m] = __builtin_amdgcn_rsqf(s * (1.0f / 1024.0f) + 1e-6f); }
    asm volatile("" ::: "memory");
}
__device__ __forceinline__ float fexp_(float x) { return __builtin_amdgcn_exp2f(x * 1.44269504089f); }
__device__ __forceinline__ float sigmoidf_(float x) { return __builtin_amdgcn_rcpf(1.0f + fexp_(-x)); }

struct EpiGU {
    static constexpr bool PERM = true, AFTER_DRAIN = false;
    bf16_t* H; const float* part;
    __device__ __forceinline__ void operator()(const f32x4 (&acc)[2][2][4][2], const Unit& u, int wr, int wc, int fr, int fq) const {
        const int row0 = u.pm * BM + wr * 64 + fr, col0 = u.pn * 128 + wc * 32 + 8 * fq;
        float rsv[2][4]; rows_rstd(part, row0, fq, rsv);
#pragma unroll
        for (int ai = 0; ai < 2; ++ai)
#pragma unroll
            for (int m = 0; m < 4; ++m) { const int row = row0 + ai * HALF + m * 16; const float rs = rsv[ai][m];
                f32x4 h0, h1;
#pragma unroll
                for (int j = 0; j < 4; ++j) { const float g0 = acc[ai][0][m][0][j] * rs, u0 = acc[ai][1][m][0][j] * rs, g1 = acc[ai][0][m][1][j] * rs, u1 = acc[ai][1][m][1][j] * rs;
                    h0[j] = g0 * u0 * __builtin_amdgcn_rcpf(1.0f + fexp_(-g0)); h1[j] = g1 * u1 * __builtin_amdgcn_rcpf(1.0f + fexp_(-g1)); }
                *(u32x4*)(H + (size_t)row * 2816 + col0) = pack8(h0, h1); asm volatile("" ::: "memory"); }
    }
};
struct EpiRes {
    static constexpr bool PERM = true, AFTER_DRAIN = false;
    const float* xin; float* xout; bf16_t* xb; float* part; float alpha;
    __device__ __forceinline__ void operator()(const f32x4 (&acc)[2][2][4][2], const Unit& u, int wr, int wc, int fr, int fq) const {
        const int row0 = u.pm * BM + wr * 64 + fr, col0 = u.pn * BM + wc * 32 + 8 * fq;
#pragma unroll
        for (int ai = 0; ai < 2; ++ai)
#pragma unroll
            for (int m = 0; m < 4; ++m) { const int row = row0 + ai * HALF + m * 16; float ss = 0.f;
#pragma unroll
                for (int bj = 0; bj < 2; ++bj) { const size_t off = (size_t)row * 1024 + col0 + bj * HALF;
                    const f32x4 r0 = *(const f32x4*)(xin + off), r1 = *(const f32x4*)(xin + off + 4);
                    const f32x4 v0 = r0 + acc[ai][bj][m][0] * alpha, v1 = r1 + acc[ai][bj][m][1] * alpha;
                    *(f32x4*)(xout + off) = v0; *(f32x4*)(xout + off + 4) = v1;
                    if (xb) *(u32x4*)(xb + off) = pack8(v0, v1);
                    ss += (v0[0] * v0[0] + v0[1] * v0[1]) + (v0[2] * v0[2] + v0[3] * v0[3]) + (v1[0] * v1[0] + v1[1] * v1[1]) + (v1[2] * v1[2] + v1[3] * v1[3]); }
                ss += __shfl_xor(ss, 16); ss += __shfl_xor(ss, 32);
                if (fq == 0) part[(size_t)row * 16 + u.pn * 4 + wc] = ss; asm volatile("" ::: "memory"); }
    }
};
struct EpiProj {
    static constexpr bool PERM = true, AFTER_DRAIN = false;
    bf16_t* rkvl; bf16_t* attq; bf16_t* attkv; const float* part;
    __device__ __forceinline__ void operator()(const f32x4 (&acc)[2][2][4][2], const Unit& u, int wr, int wc, int fr, int fq) const {
        bf16_t* base; int ldc, colt;
        if (u.pn < 7) { base = rkvl; ldc = 1792; colt = u.pn * BM; } else if (u.pn < 9) { base = attq; ldc = 512; colt = (u.pn - 7) * BM; } else { base = attkv; ldc = 256; colt = 0; }
        const int row0 = u.pm * BM + wr * 64 + fr, col0 = colt + wc * 32 + 8 * fq;
        float rsv[2][4]; rows_rstd(part, row0, fq, rsv);
#pragma unroll
        for (int ai = 0; ai < 2; ++ai)
#pragma unroll
            for (int m = 0; m < 4; ++m) { const int row = row0 + ai * HALF + m * 16; const float rs = rsv[ai][m];
#pragma unroll
                for (int bj = 0; bj < 2; ++bj) *(u32x4*)(base + (size_t)row * ldc + col0 + bj * HALF) = pack8(acc[ai][bj][m][0] * rs, acc[ai][bj][m][1] * rs); }
    }
};
struct EpiGate {
    static constexpr bool PERM = true, AFTER_DRAIN = false;
    bf16_t* gates; const float* part;
    __device__ __forceinline__ void operator()(const f32x4 (&acc)[2][2][4][2], const Unit& u, int wr, int wc, int fr, int fq) const {
        const int row0 = u.pm * BM + wr * 64 + fr, col0 = u.pn * BM + wc * 32 + 8 * fq;
        float rsv[2][4]; rows_rstd(part, row0, fq, rsv);
#pragma unroll
        for (int ai = 0; ai < 2; ++ai)
#pragma unroll
            for (int m = 0; m < 4; ++m) { const int row = row0 + ai * HALF + m * 16; const float rs = rsv[ai][m];
#pragma unroll
                for (int bj = 0; bj < 2; ++bj) { f32x4 v0, v1;
#pragma unroll
                    for (int j = 0; j < 4; ++j) { v0[j] = sigmoidf_(acc[ai][bj][m][0][j] * rs); v1[j] = sigmoidf_(acc[ai][bj][m][1][j] * rs); }
                    *(u32x4*)(gates + (size_t)row * 2048 + col0 + bj * HALF) = pack8(v0, v1); } }
    }
};
struct EpiLora {
    static constexpr bool PERM = true, AFTER_DRAIN = false;
    bf16_t* rec_lw; bf16_t* rec_a; bf16_t* g; const float* w0; const float* a0;
    template <int KIND> __device__ __forceinline__ void body(const f32x4 (&acc)[2][2][4][2], const Unit& u, int wr, int wc, int fr, int fq) const {
        const int row0 = u.pm * BM + wr * 64 + fr, col0 = (u.pn & 1) * BM + wc * 32 + 8 * fq;
#pragma unroll
        for (int ai = 0; ai < 2; ++ai)
#pragma unroll
            for (int m = 0; m < 4; ++m) { const int row = row0 + ai * HALF + m * 16; const int b = row >> 12, t = row & 4095;
#pragma unroll
                for (int bj = 0; bj < 2; ++bj) { const int c = col0 + bj * HALF; f32x4 v0 = acc[ai][bj][m][0], v1 = acc[ai][bj][m][1];
                    if (KIND != 2) { const float* bias = (KIND == 0 ? w0 : a0) + c; v0 = v0 + *(const f32x4*)bias; v1 = v1 + *(const f32x4*)(bias + 4); }
                    if (KIND == 2) { *(u32x4*)(g + (size_t)row * 512 + c) = pack8(v0, v1); }
                    else {
#pragma unroll
                        for (int j = 0; j < 4; ++j) {
                            if (KIND == 0) { const float y0 = -v0[j], y1 = -v1[j];
                                const float sp0 = fmaxf(y0, 0.f) + __logf(1.0f + fexp_(-fabsf(y0))), sp1 = fmaxf(y1, 0.f) + __logf(1.0f + fexp_(-fabsf(y1)));
                                v0[j] = -fexp_(-sp0 - 0.5f); v1[j] = -fexp_(-sp1 - 0.5f); }
                            else { v0[j] = sigmoidf_(v0[j]); v1[j] = sigmoidf_(v1[j]); } }
                        bf16_t* dst = (KIND == 0 ? rec_lw : rec_a) + ((size_t)((b * 8 + (c >> 6)) * 4096 + t)) * 64 + (c & 63);
                        *(u32x4*)dst = pack8(v0, v1); } }
                asm volatile("" ::: "memory"); }
    }
    __device__ __forceinline__ void operator()(const f32x4 (&acc)[2][2][4][2], const Unit& u, int wr, int wc, int fr, int fq) const {
        const int kind = u.pn >> 1;
        if (kind == 0) body<0>(acc, u, wr, wc, fr, fq); else if (kind == 1) body<1>(acc, u, wr, wc, fr, fq); else body<2>(acc, u, wr, wc, fr, fq);
    }
};
struct EpiBranch {
    static constexpr bool PERM = true, AFTER_DRAIN = false;
    const bf16_t* gates; bf16_t* merged; int goff;
    __device__ __forceinline__ void operator()(const f32x4 (&acc)[2][2][4][2], const Unit& u, int wr, int wc, int fr, int fq) const {
        const int row0 = u.pm * BM + wr * 64 + fr, col0 = goff + u.pn * BM + wc * 32 + 8 * fq;
#pragma unroll
        for (int ai = 0; ai < 2; ++ai)
#pragma unroll
            for (int m = 0; m < 4; ++m) { const int row = row0 + ai * HALF + m * 16;
#pragma unroll
                for (int bj = 0; bj < 2; ++bj) { const size_t off = (size_t)row * 2048 + col0 + bj * HALF; const u32x4 gq = *(const u32x4*)(gates + off);
                    f32x4 v0 = acc[ai][bj][m][0], v1 = acc[ai][bj][m][1];
                    v0[0] *= bf_lo(gq.x); v0[1] *= bf_hi(gq.x); v0[2] *= bf_lo(gq.y); v0[3] *= bf_hi(gq.y);
                    v1[0] *= bf_lo(gq.z); v1[1] *= bf_hi(gq.z); v1[2] *= bf_lo(gq.w); v1[3] *= bf_hi(gq.w);
                    *(u32x4*)(merged + off) = pack8(v0, v1); } asm volatile("" ::: "memory"); }
    }
};

template <class Epi, class Sched, bool ALIGN_EPI = false, bool SP2 = false>
__device__ __forceinline__ void gemm_phase(PG8_LAS unsigned char* lds, const Gemm g, const Sched& S, const Epi& E) {
    int tid_ = threadIdx.x; asm volatile("" : "+v"(tid_));
    const int tid = tid_, wid = __builtin_amdgcn_readfirstlane(tid >> 6), lane = tid & 63, wr = wid >> 2, wc = wid & 3, fr = lane & 15, fq = lane >> 4;
    const int K = g.K, nt = K / BK;
    unsigned voffA[2], voffB[2];
#pragma unroll
    for (int i = 0; i < 2; ++i) { int R, C; stage_rc(tid * 16 + i * 8192, R, C); const int Rb = Epi::PERM ? ((R & ~31) + perm32(R & 31)) : R;
        voffA[i] = (unsigned)(R * K + C) * 2u; voffB[i] = (unsigned)(Rb * K + C) * 2u; }
    const size_t kstep = (size_t)(BK * 2);
    const size_t hstep = (size_t)HALF * K * 2;
    const size_t tstep = 2 * hstep;
    const unsigned ldsw = (unsigned)wid * 1024u;
    const int aoff = lds_byte(wr * 64 + fr, fq * 8), boff = lds_byte(wc * 32 + fr, fq * 8);
#define PG8_SA(b, h) (((b) * 2 + (h)) * HTB)
#define PG8_SB(b, h) ((4 + (b) * 2 + (h)) * HTB)
#define PG8_STAGE(bufoff, gbase, voff) do { _Pragma("unroll") for (int _i = 0; _i < 2; ++_i) \
        __builtin_amdgcn_global_load_lds((const unsigned*)((const char*)(gbase) + (voff)[_i]), (PG8_LAS unsigned*)(lds + (bufoff) + ldsw + _i * 8192), 16, 0, 0); } while (0)
#define PG8_LDA(dst, b, h) do { _Pragma("unroll") for (int m = 0; m < 4; ++m) _Pragma("unroll") for (int k = 0; k < 2; ++k) dst[m][k] = *(const PG8_LAS bf16x8*)(lds + PG8_SA(b, h) + aoff + m * 2048 + k * 1024); } while (0)
#define PG8_LDB(dst, b, h) do { _Pragma("unroll") for (int n = 0; n < 2; ++n) _Pragma("unroll") for (int k = 0; k < 2; ++k) dst[n][k] = *(const PG8_LAS bf16x8*)(lds + PG8_SB(b, h) + boff + n * 2048 + k * 1024); } while (0)
#define PG8_MMA(ai, bj, At, Bt) do { __builtin_amdgcn_s_setprio(1); _Pragma("unroll") for (int m = 0; m < 4; ++m) _Pragma("unroll") for (int n = 0; n < 2; ++n) _Pragma("unroll") for (int k = 0; k < 2; ++k) \
        acc[ai][bj][m][n] = __builtin_amdgcn_mfma_f32_16x16x32_bf16(Bt[n][k], At[m][k], acc[ai][bj][m][n], 0, 0, 0); __builtin_amdgcn_s_setprio(0); } while (0)
#define PG8_WAIT_V(n) asm volatile("s_waitcnt vmcnt(" #n ")" ::: "memory")
#define PG8_WAIT_L(n) asm volatile("s_waitcnt lgkmcnt(" #n ")" ::: "memory")
#define PG8_BAR __builtin_amdgcn_s_barrier()
#define PG8_SCHED __builtin_amdgcn_sched_barrier(0)
    Unit cur, nxt; int ui = 0;
    if (!S.next(0, cur)) return;
    f32x4 acc[2][2][4][2];
#pragma unroll
    for (int a = 0; a < 2; ++a)
#pragma unroll
        for (int b = 0; b < 2; ++b)
#pragma unroll
            for (int m = 0; m < 4; ++m)
#pragma unroll
                for (int n = 0; n < 2; ++n) acc[a][b][m][n] = (f32x4){0.f, 0.f, 0.f, 0.f};
    bf16x8 At[4][2], B0[2][2], B1[2][2];
    const char* cA = (const char*)g.A + (size_t)cur.pm * tstep; const char* cB = (const char*)g.Bt + (size_t)cur.pn * tstep;
    S.a_ready(cur);
    if constexpr (SP2) {
        PG8_STAGE(PG8_SB(0, 0), cB, voffB); PG8_STAGE(PG8_SB(0, 1), cB + hstep, voffB); PG8_STAGE(PG8_SA(0, 0), cA, voffA); PG8_STAGE(PG8_SA(0, 1), cA + hstep, voffA);
        if (wr == 1) PG8_BAR;
        PG8_WAIT_V(2); PG8_BAR;
        PG8_STAGE(PG8_SB(1, 0), cB + kstep, voffB); PG8_STAGE(PG8_SA(1, 0), cA + kstep, voffA); PG8_STAGE(PG8_SB(1, 1), cB + hstep + kstep, voffB);
        PG8_WAIT_V(6); PG8_BAR;
    } else {
        PG8_STAGE(PG8_SB(0, 0), cB, voffB); PG8_STAGE(PG8_SA(0, 0), cA, voffA); PG8_STAGE(PG8_SB(0, 1), cB + hstep, voffB); PG8_STAGE(PG8_SA(0, 1), cA + hstep, voffA);
        if (wr == 1) PG8_BAR;
        PG8_WAIT_V(4); PG8_BAR;
        PG8_STAGE(PG8_SB(1, 0), cB + kstep, voffB); PG8_STAGE(PG8_SA(1, 0), cA + kstep, voffA); PG8_STAGE(PG8_SB(1, 1), cB + hstep + kstep, voffB);
        PG8_WAIT_V(6); PG8_BAR;
    }
    for (;;) {
        const bool has_next = S.next(ui + 1, nxt);
        const char* nA = has_next ? (const char*)g.A + (size_t)nxt.pm * tstep : cA; const char* nB = has_next ? (const char*)g.Bt + (size_t)nxt.pn * tstep : cB;
        for (int t = 0; t < nt; t += 2) {
            const bool last = (t == nt - 2);
            const char* a1 = cA + (size_t)(t + 1) * kstep;
            const char* a2 = last ? nA : cA + (size_t)(t + 2) * kstep; const char* b2 = last ? nB : cB + (size_t)(t + 2) * kstep;
            const char* a3 = a2 + kstep; const char* b3 = b2 + kstep;
            if (last && has_next) S.a_ready(nxt);
            if constexpr (SP2) {
            PG8_LDB(B0, 0, 0); PG8_LDB(B1, 0, 1); PG8_SCHED; PG8_LDA(At, 0, 0); PG8_STAGE(PG8_SA(1, 1), a1 + hstep, voffA);
            PG8_WAIT_V(8); PG8_WAIT_L(0); PG8_BAR; PG8_MMA(0, 0, At, B0); PG8_MMA(0, 1, At, B1); PG8_BAR; PG8_SCHED;
            PG8_LDA(At, 0, 1); PG8_STAGE(PG8_SB(0, 0), b2, voffB); PG8_STAGE(PG8_SB(0, 1), b2 + hstep, voffB); PG8_STAGE(PG8_SA(0, 0), a2, voffA);
            PG8_WAIT_V(8); PG8_WAIT_L(0); PG8_BAR; PG8_MMA(1, 0, At, B0); PG8_MMA(1, 1, At, B1); PG8_BAR; PG8_SCHED;
            PG8_LDB(B0, 1, 0); PG8_LDB(B1, 1, 1); PG8_SCHED; PG8_LDA(At, 1, 0); PG8_STAGE(PG8_SA(0, 1), a2 + hstep, voffA);
            PG8_WAIT_V(8); PG8_WAIT_L(0); PG8_BAR; PG8_MMA(0, 0, At, B0); PG8_MMA(0, 1, At, B1); PG8_BAR; PG8_SCHED;
            PG8_LDA(At, 1, 1); PG8_STAGE(PG8_SB(1, 0), b3, voffB); PG8_STAGE(PG8_SB(1, 1), b3 + hstep, voffB); PG8_STAGE(PG8_SA(1, 0), a3, voffA);
            PG8_WAIT_V(8); PG8_WAIT_L(0); PG8_BAR; PG8_MMA(1, 0, At, B0); PG8_MMA(1, 1, At, B1); PG8_BAR; PG8_SCHED;
            } else {
            PG8_LDB(B0, 0, 0); PG8_SCHED; PG8_LDA(At, 0, 0); PG8_STAGE(PG8_SA(1, 1), a1 + hstep, voffA);
            PG8_WAIT_L(8); PG8_BAR; PG8_WAIT_L(0); PG8_MMA(0, 0, At, B0); PG8_BAR; PG8_SCHED;
            PG8_LDB(B1, 0, 1); PG8_STAGE(PG8_SB(0, 0), b2, voffB);
            PG8_BAR; PG8_WAIT_L(0); PG8_MMA(0, 1, At, B1); PG8_BAR;
            PG8_LDA(At, 0, 1); PG8_STAGE(PG8_SA(0, 0), a2, voffA);
            PG8_BAR; PG8_WAIT_L(0); PG8_MMA(1, 0, At, B0); PG8_BAR; PG8_SCHED;
            PG8_STAGE(PG8_SB(0, 1), b2 + hstep, voffB);
            PG8_WAIT_V(6); PG8_BAR; PG8_MMA(1, 1, At, B1); PG8_BAR;
            PG8_LDB(B0, 1, 0); PG8_SCHED; PG8_LDA(At, 1, 0); PG8_STAGE(PG8_SA(0, 1), a2 + hstep, voffA);
            PG8_WAIT_L(8); PG8_BAR; PG8_WAIT_L(0); PG8_MMA(0, 0, At, B0); PG8_BAR; PG8_SCHED;
            PG8_LDB(B1, 1, 1); PG8_STAGE(PG8_SB(1, 0), b3, voffB);
            PG8_BAR; PG8_WAIT_L(0); PG8_MMA(0, 1, At, B1); PG8_BAR;
            PG8_LDA(At, 1, 1); PG8_STAGE(PG8_SA(1, 0), a3, voffA);
            PG8_BAR; PG8_WAIT_L(0); PG8_MMA(1, 0, At, B0); PG8_BAR; PG8_SCHED;
            PG8_STAGE(PG8_SB(1, 1), b3 + hstep, voffB);
            PG8_WAIT_V(6); PG8_BAR; PG8_MMA(1, 1, At, B1); PG8_BAR;
            }
        }
        if constexpr (ALIGN_EPI) { if (wr == 0) PG8_BAR; }
        if constexpr (!Epi::AFTER_DRAIN) { E(acc, cur, wr, wc, fr, fq); S.done(cur); }
        if (!has_next) break;
#pragma unroll
        for (int a = 0; a < 2; ++a)
#pragma unroll
            for (int b = 0; b < 2; ++b)
#pragma unroll
                for (int m = 0; m < 4; ++m)
#pragma unroll
                    for (int n = 0; n < 2; ++n) acc[a][b][m][n] = (f32x4){0.f, 0.f, 0.f, 0.f};
        cur = nxt; cA = nA; cB = nB; ++ui;
        if constexpr (ALIGN_EPI) { if (wr == 1) PG8_BAR; }
    }
    PG8_WAIT_V(0);
    if constexpr (!ALIGN_EPI) { if (wr == 0) PG8_BAR; }
    PG8_BAR;
    if constexpr (Epi::AFTER_DRAIN) { E.fused(acc, cur, wr, wc, fr, fq, lds, wid, lane); S.done(cur); }
#undef PG8_SA
#undef PG8_SB
#undef PG8_STAGE
#undef PG8_LDA
#undef PG8_LDB
#undef PG8_MMA
#undef PG8_WAIT_V
#undef PG8_WAIT_L
#undef PG8_BAR
#undef PG8_SCHED
}
}
constexpr int NWAVES = 8;
constexpr int BATCH = 8, T = 4096, D = 1024, M = BATCH * T, FF = 2816, NH = 8, HD = 64, INC = 4512;
constexpr float RMS_EPS = 1e-6f, GN_EPS = 64e-5f;
constexpr size_t MiB = 1u << 20;
constexpr size_t WS_PART = 1 * MiB;
constexpr size_t WS_SC = 9 * MiB;
constexpr size_t WS_WGU1 = 13 * MiB, WS_WDN1 = WS_WGU1 + 11 * MiB, WS_WGU2 = WS_WDN1 + 5632 * 1024, WS_WDN2 = WS_WGU2 + 11 * MiB;
constexpr size_t WS_WIN = WS_WDN2 + 5632 * 1024, WS_WGT = WS_WIN + 5 * MiB, WS_WLO = WS_WGT + 4 * MiB, WS_WBR = WS_WLO + 768 * 1024, WS_WBA = WS_WBR + 1 * MiB, WS_WOUT = WS_WBA + 1 * MiB;
constexpr size_t WS_XB = 62 * MiB;
constexpr size_t WS_ATTQ = 126 * MiB;
constexpr size_t WS_ATTKV = 158 * MiB;
constexpr size_t WS_RKVL = 174 * MiB;
constexpr size_t WS_G = 286 * MiB;
constexpr size_t WS_REC = 318 * MiB, REC_SLOT = 32 * MiB;
constexpr size_t WS_H = 126 * MiB;
constexpr size_t WS_YRAW = WS_RKVL;
constexpr size_t WS_MERGED = WS_RKVL;
constexpr size_t WS_GATES = WS_REC;
constexpr size_t WS_YR = WS_REC + 4 * REC_SLOT;
constexpr size_t WS_LA = WS_REC + 5 * REC_SLOT;
constexpr size_t WS_END = WS_REC + 6 * REC_SLOT;
static_assert(WS_WOUT + 4 * MiB <= WS_XB && WS_H + (size_t)M * FF * 2 <= WS_REC && WS_MERGED + (size_t)M * 2048 * 2 <= WS_REC, "ws map");
constexpr int RING_BYTES = 131072, LDS_BYTES = 147456;

#define GAS __attribute__((address_space(1)))
#define LAS __attribute__((address_space(3)))
typedef unsigned short bf16;
typedef unsigned v4u __attribute__((ext_vector_type(4)));
typedef unsigned v2u __attribute__((ext_vector_type(2)));
typedef float f32x4 __attribute__((ext_vector_type(4)));
typedef float f32x2 __attribute__((ext_vector_type(2)));
typedef short bf16x8 __attribute__((ext_vector_type(8)));
#define LDS_WAIT() asm volatile("s_waitcnt lgkmcnt(0)" ::: "memory")
__device__ __forceinline__ unsigned f2bf(float f) { unsigned u = __builtin_bit_cast(unsigned, f); return (u + 0x7fffu + ((u >> 16) & 1u)) >> 16; }
__device__ __forceinline__ unsigned pk2(float lo, float hi) { return f2bf(lo) | (f2bf(hi) << 16); }
__device__ __forceinline__ float bflo(unsigned u) { return __uint_as_float(u << 16); }
__device__ __forceinline__ float bfhi(unsigned u) { return __uint_as_float(u & 0xffff0000u); }
__device__ __forceinline__ float bf1(bf16 h) { return __uint_as_float((unsigned)h << 16); }
__device__ __forceinline__ float wave_sum(float v) {
#pragma unroll
    for (int o = 1; o < 64; o <<= 1) v += __shfl_xor(v, o);
    return v;
}
template <int CTRL> __device__ __forceinline__ float dppf(float x) { return __builtin_bit_cast(float, __builtin_amdgcn_update_dpp(0, __builtin_bit_cast(int, x), CTRL, 0xf, 0xf, false)); }
__device__ __forceinline__ float row16_sum(float x) { x += dppf<0xB1>(x); x += dppf<0x4E>(x); x += dppf<0x141>(x); x += dppf<0x140>(x); return x; }

#define RLX_AGENT __ATOMIC_RELAXED, __HIP_MEMORY_SCOPE_AGENT
#define XB_TMO      128
#define XB_XCNT(j)  (256  + 64 * (j))
#define XB_XSUB(j)  (1280 + 64 * (j))
#define XB_XGEN(j)  (2304 + 64 * (j))
#define XB_TOP      3328
#define XB_TOPGEN   3392
#define XCD_BAR_WORDS 3456
#define XB_SPIN_CAP (1u << 18)

__device__ __forceinline__ unsigned xb_ld(unsigned* p)              { return __hip_atomic_load(p, __ATOMIC_RELAXED, __HIP_MEMORY_SCOPE_AGENT); }
__device__ __forceinline__ unsigned xb_add(unsigned* p, unsigned v) { return __hip_atomic_fetch_add(p, v, __ATOMIC_RELAXED, __HIP_MEMORY_SCOPE_AGENT); }
__device__ __forceinline__ unsigned xb_xcc_id() { return (unsigned)__builtin_amdgcn_s_getreg((3 << 11) | 20) & 0xFu; }
#define XB_SPIN(cond, bar) do { unsigned _sp = 0; while (cond) { __builtin_amdgcn_s_sleep(1); \
    if ((++_sp & 255u) == 0u) { if (xb_ld(&(bar)[XB_TMO])) break; if (_sp > XB_SPIN_CAP) { atomicAdd(&(bar)[XB_TMO], 1u); break; } } } } while (0)

struct XcdBarrier {
    unsigned* bar; unsigned x;
    volatile LAS unsigned* st;
};

__device__ __forceinline__ XcdBarrier xcd_barrier_post(unsigned* bar, volatile LAS unsigned* st) {
    XcdBarrier b; b.bar = bar; b.x = xb_xcc_id(); b.st = st;
    if (threadIdx.x == 0) (void)xb_add(&bar[XB_XCNT(b.x)], 1u);
    return b;
}
__device__ __forceinline__ void xcd_barrier_complete(unsigned* bar, unsigned x, unsigned& nloc, unsigned& nx) {
    const unsigned G = gridDim.x * gridDim.y * gridDim.z;
    unsigned sum, cnt, mine, sp = 0u;
    for (;;) {
        sum = 0u; cnt = 0u; mine = 0u;
#pragma unroll
        for (unsigned j = 0; j < 16; ++j) { const unsigned c = xb_ld(&bar[XB_XCNT(j)]); sum += c; cnt += (c > 0u) ? 1u : 0u; mine = (j == x) ? c : mine; }
        if (sum == G) break;
        __builtin_amdgcn_s_sleep(1);
        if ((++sp & 255u) == 0u) { if (xb_ld(&bar[XB_TMO])) break; if (sp > XB_SPIN_CAP) { atomicAdd(&bar[XB_TMO], 1u); break; } }
    }
    nloc = mine > 0u ? mine : 1u; nx = cnt > 0u ? cnt : 1u;
}

__device__ __forceinline__ void xcd_barrier(const XcdBarrier& b) {
    asm volatile("s_waitcnt vmcnt(0)" ::: "memory");
    __syncthreads();
    if (threadIdx.x == 0) {
        unsigned* bar = b.bar;
        __builtin_amdgcn_s_waitcnt(0);
        unsigned nloc = b.st[0], nx = b.st[1];
        if (nloc == 0u) { xcd_barrier_complete(bar, b.x, nloc, nx); b.st[0] = nloc; b.st[1] = nx; }
        const unsigned old = xb_add(&bar[XB_XSUB(b.x)], 1u);
        const unsigned gen = old / nloc;
        if (old + 1u == (gen + 1u) * nloc) {
            __builtin_amdgcn_fence(__ATOMIC_RELEASE, "agent");
            asm volatile("s_waitcnt vmcnt(0)" ::: "memory");
            const unsigned og = xb_add(&bar[XB_TOP], 1u);
            const unsigned tg = og / nx;
            if (og + 1u == (tg + 1u) * nx) xb_add(&bar[XB_TOPGEN], 1u);
            else XB_SPIN(xb_ld(&bar[XB_TOPGEN]) == tg, bar);
            __builtin_amdgcn_fence(__ATOMIC_ACQUIRE, "agent");
            xb_add(&bar[XB_XGEN(b.x)], 1u);
            asm volatile("s_waitcnt vmcnt(0)" ::: "memory");
        } else {
            XB_SPIN(xb_ld(&bar[XB_XGEN(b.x)]) == gen, bar);
            __builtin_amdgcn_fence(__ATOMIC_ACQUIRE, "agent");
            asm volatile("s_waitcnt vmcnt(0)" ::: "memory");
        }
    }
    __syncthreads();
}

__device__ __forceinline__ int fresh_tid() { int t = threadIdx.x; asm volatile("" : "+v"(t)); return t; }
struct Frame {
    LAS unsigned char* lds;
    int tid, lane, wave, vcu, G;
    const float *in0, *in1, *in2, *in3, *in4, *in5, *in6, *in7, *in8, *in9, *in10, *in11, *in12, *in13, *in14, *in15, *in16, *in17, *in18, *in19, *in20, *in21, *in22, *in23, *in24, *in25, *in26, *in27, *in28; float* out; unsigned char* ws;
};

__device__ __forceinline__ void tr_item(const float* W, int ldn, int k0, int n0, bf16* WT, int ldk, int drow0, int dk0, const float* scale, int dup, LAS float* scr, int lane) {
#pragma unroll 8
    for (int i = 0; i < 32; ++i) { const int kk = 2 * i + (lane >> 5); float v = W[(size_t)(k0 + kk) * ldn + n0 + (lane & 31)]; if (scale) v *= scale[k0 + kk]; scr[kk * 33 + (lane & 31)] = v; }
    LDS_WAIT(); asm volatile("" ::: "memory");
    const int c = lane & 7;
#pragma unroll
    for (int j = 0; j < 4; ++j) { const int n = (lane >> 3) + 8 * j; const LAS float* s = scr + (8 * c) * 33 + n;
        v4u o; o.x = pk2(s[0 * 33], s[1 * 33]); o.y = pk2(s[2 * 33], s[3 * 33]); o.z = pk2(s[4 * 33], s[5 * 33]); o.w = pk2(s[6 * 33], s[7 * 33]);
        bf16* dp = WT + (size_t)(drow0 + n0 + n) * ldk + dk0 + k0 + 8 * c;
        *(GAS v4u*)dp = o; if (dup) *(GAS v4u*)(dp + dup) = o; }
    LDS_WAIT(); asm volatile("" ::: "memory");
}
__device__ __forceinline__ void p0_prologue(Frame& F) {
    LAS float* scr = (LAS float*)(F.lds + F.wave * 16384);
    unsigned char* ws = F.ws;
    const int gw = F.vcu * NWAVES + F.wave, NGW = F.G * NWAVES, lane = fresh_tid() & 63;
    constexpr int I_GU = 16 * 88, I_DN = 44 * 32, I_IN = 16 * 77, I_GT = 16 * 64, I_BR = 8 * 32, I_OUT = 16 * 32;
    constexpr int NITEMS = 4 * I_GU + 2 * I_DN + I_IN + I_GT + 2 * I_BR + I_OUT;
    for (int it = gw; it < NITEMS; it += NGW) {
        int r = it;
        if (r < 4 * I_GU) {
            const int which = r / I_GU; r -= which * I_GU; const int kb = r / 88, nb = r % 88, n0 = nb * 32;
            const float* W = which == 0 ? F.in2 : which == 1 ? F.in3 : which == 2 ? F.in25 : F.in26;
            tr_item(W, FF, kb * 64, n0, (bf16*)(ws + (which < 2 ? WS_WGU1 : WS_WGU2)), D, (n0 >> 7) * 256 + (which & 1) * 128 + (n0 & 127) - n0, 0, which < 2 ? F.in1 : F.in24, 0, scr, lane);
            continue; }
        r -= 4 * I_GU;
        if (r < 2 * I_DN) { const int which = r / I_DN; r -= which * I_DN; const int kb = r / 32, nb = r % 32;
            tr_item(which ? F.in27 : F.in4, D, kb * 64, nb * 32, (bf16*)(ws + (which ? WS_WDN2 : WS_WDN1)), FF, 0, 0, nullptr, 0, scr, lane); continue; }
        r -= 2 * I_DN;
        if (r < I_IN) { const int kb = r / 77, nb = r % 77, n0 = nb * 32;
            tr_item(F.in6, INC, kb * 64, n0, (bf16*)(ws + WS_WIN), D, n0 < 1696 ? 0 : 96, 0, F.in5, 0, scr, lane); continue; }
        r -= I_IN;
        if (r < I_GT) { const int kb = r / 64, nb = r % 64;
            tr_item(F.in6, INC, kb * 64, 2464 + nb * 32, (bf16*)(ws + WS_WGT), D, -2464, 0, F.in5, 0, scr, lane); continue; }
        r -= I_GT;
        if (r < 2 * I_BR) { const int which = r / I_BR; r -= which * I_BR; const int kb = r / 32, nb = r % 32;
            tr_item(which ? F.in22 : F.in21, D, kb * 64, nb * 32, (bf16*)(ws + (which ? WS_WBA : WS_WBR)), 512, 0, 0, nullptr, 0, scr, lane); continue; }
        r -= 2 * I_BR;
        { const int kb = r / 32, nb = r % 32; tr_item(F.in23, D, kb * 64, nb * 32, (bf16*)(ws + WS_WOUT), 2048, 0, 0, nullptr, 1024, scr, lane); }
    }
    { GAS v4u* z = (GAS v4u*)(ws + WS_WIN + (size_t)1696 * D * 2); for (int i = gw * 64 + lane; i < 12288; i += NGW * 64) z[i] = (v4u){0u, 0u, 0u, 0u}; }
    { bf16* WL = (bf16*)(ws + WS_WLO);
      for (int i = gw * 64 + lane; i < 1536 * 256; i += NGW * 64) { const int n = i >> 8, k = i & 255, grp = n >> 9, nn = n & 511; float v = 0.f;
          if (grp == 0) { if (k < 32) v = F.in9[k * 512 + nn]; } else if (grp == 1) { if (k >= 32 && k < 64) v = F.in11[(k - 32) * 512 + nn]; } else { if (k >= 64 && k < 160) v = F.in12[(k - 64) * 512 + nn]; }
          WL[i] = (bf16)f2bf(v); } }
    { const float* x = F.in0; bf16* XB = (bf16*)(ws + WS_XB); float* part = (float*)(ws + WS_PART);
      for (int m = gw; m < M; m += NGW) { const GAS f32x4* xr = (const GAS f32x4*)(x + (size_t)m * D) + lane; f32x4 v[4]; float s = 0.f;
#pragma unroll
          for (int j = 0; j < 4; ++j) { v[j] = xr[64 * j]; s += (v[j].x * v[j].x + v[j].y * v[j].y) + (v[j].z * v[j].z + v[j].w * v[j].w); }
          s = wave_sum(s);
          GAS unsigned long long* o8 = (GAS unsigned long long*)(XB + (size_t)m * D) + lane;
#pragma unroll
          for (int j = 0; j < 4; ++j) o8[64 * j] = (unsigned long long)pk2(v[j].x, v[j].y) | ((unsigned long long)pk2(v[j].z, v[j].w) << 32);
          if (lane < 16) part[(size_t)m * 16 + lane] = lane == 0 ? s : 0.f; } }
}
__device__ __forceinline__ void p4_lora_in(Frame& F) {
    const bf16* RKVL = (const bf16*)(F.ws + WS_RKVL); bf16* LA = (bf16*)(F.ws + WS_LA); const float* mu = F.in7 + 1536;
    const int gw = F.vcu * NWAVES + F.wave, NGW = F.G * NWAVES, lane = fresh_tid() & 63, c0 = 4 * lane;
    for (int m = gw; m < M; m += NGW) {
        float o[4] = {0.f, 0.f, 0.f, 0.f};
        if (c0 < 160) {
            const v2u cu = *(const GAS v2u*)(RKVL + (size_t)m * 1792 + 1536 + c0);
            v2u pu = (v2u){0u, 0u}; if ((m & (T - 1)) != 0) pu = *(const GAS v2u*)(RKVL + (size_t)(m - 1) * 1792 + 1536 + c0);
            const float cur[4] = {bflo(cu.x), bfhi(cu.x), bflo(cu.y), bfhi(cu.y)}, prv[4] = {bflo(pu.x), bfhi(pu.x), bflo(pu.y), bfhi(pu.y)};
            const f32x4 mv = *(const GAS f32x4*)(mu + c0);
#pragma unroll
            for (int j = 0; j < 4; ++j) { const float p = cur[j] + (prv[j] - cur[j]) * mv[j]; const int c = c0 + j;
                o[j] = c < 32 ? tanhf(p) : (c < 64 ? p : 1.0f / (1.0f + __expf(-p))); }
        }
        *(GAS v2u*)(LA + (size_t)m * 256 + c0) = (v2u){pk2(o[0], o[1]), pk2(o[2], o[3])};
    }
}
__device__ __forceinline__ float sum8(float v) { v += __shfl_xor(v, 1); v += __shfl_xor(v, 2); v += __shfl_xor(v, 4); return v; }
__device__ __forceinline__ void unpack8(const v4u u, float (&f)[8]) { f[0] = bflo(u.x); f[1] = bfhi(u.x); f[2] = bflo(u.y); f[3] = bfhi(u.y); f[4] = bflo(u.z); f[5] = bfhi(u.z); f[6] = bflo(u.w); f[7] = bfhi(u.w); }
__device__ __forceinline__ v4u pack8u(const float (&f)[8]) { return (v4u){pk2(f[0], f[1]), pk2(f[2], f[3]), pk2(f[4], f[5]), pk2(f[6], f[7])}; }
__device__ __forceinline__ void ld8f(const float* p, float (&f)[8]) { const f32x4 a = *(const GAS f32x4*)p, b = *(const GAS f32x4*)(p + 4); f[0] = a.x; f[1] = a.y; f[2] = a.z; f[3] = a.w; f[4] = b.x; f[5] = b.y; f[6] = b.z; f[7] = b.w; }
__device__ __forceinline__ void p6_prep(Frame& F) {
    const bf16* RKVL = (const bf16*)(F.ws + WS_RKVL); bf16* REC = (bf16*)(F.ws + WS_REC); f32x4* SC = (f32x4*)(F.ws + WS_SC);
    constexpr size_t SL = REC_SLOT / 2;
    const int gw = F.vcu * NWAVES + F.wave, NGW = F.G * NWAVES, lane = fresh_tid() & 63, h = lane >> 3, c0 = 8 * lane, n0 = 8 * (lane & 7);
    float mur[8], muk[8], muv[8], kkw[8], kaw[8], rkw[8];
    ld8f(F.in7 + c0, mur); ld8f(F.in7 + 512 + c0, muk); ld8f(F.in7 + 1024 + c0, muv); ld8f(F.in13 + c0, kkw); ld8f(F.in14 + c0, kaw); ld8f(F.in15 + c0, rkw);
    for (int m = gw; m < M; m += NGW) {
        const int b = m >> 12, t = m & (T - 1); const bool hp = t != 0;
        const bf16* cr = RKVL + (size_t)m * 1792 + c0; const bf16* pr = cr - (hp ? 1792 : 0);
        const size_t ri = ((size_t)(b * 8 + h) * T + t) * 64 + n0;
        const v4u ur = *(const GAS v4u*)cr, uk = *(const GAS v4u*)(cr + 512), uv = *(const GAS v4u*)(cr + 1024);
        const v4u pr_ = *(const GAS v4u*)pr, pk_ = *(const GAS v4u*)(pr + 512), pv_ = *(const GAS v4u*)(pr + 1024);
        const v4u ua = *(const GAS v4u*)(REC + 4 * SL + ri);
        float r[8], k[8], v[8], rp[8], kp[8], vp[8], a[8];
        unpack8(ur, r); unpack8(uk, k); unpack8(uv, v); unpack8(pr_, rp); unpack8(pk_, kp); unpack8(pv_, vp); unpack8(ua, a);
        float kk[8], ss = 0.f;
#pragma unroll
        for (int j = 0; j < 8; ++j) { const float rpj = hp ? rp[j] : 0.f, kpj = hp ? kp[j] : 0.f, vpj = hp ? vp[j] : 0.f;
            r[j] += (rpj - r[j]) * mur[j]; k[j] += (kpj - k[j]) * muk[j]; v[j] += (vpj - v[j]) * muv[j];
            kk[j] = k[j] * kkw[j]; ss += kk[j] * kk[j]; }
        const float inv = 1.0f / fmaxf(sqrtf(sum8(ss)), 1e-12f);
        float an[8], bn[8], kn[8];
#pragma unroll
        for (int j = 0; j < 8; ++j) { kk[j] *= inv; an[j] = -kk[j]; bn[j] = kk[j] * a[j]; kn[j] = k[j] * (1.0f + (a[j] - 1.0f) * kaw[j]); }
        const v4u oa = pack8u(an), orr = pack8u(r), ok = pack8u(kn), ob = pack8u(bn), ov = pack8u(v);
        float rq[8], kq[8], bq[8]; unpack8(orr, rq); unpack8(ok, kq); unpack8(ob, bq);
        float sb = 0.f, sk = 0.f, sbo = 0.f;
#pragma unroll
        for (int j = 0; j < 8; ++j) { sb += bq[j] * rq[j]; sk += kq[j] * rq[j]; sbo += rq[j] * kq[j] * rkw[j]; }
        sb = sum8(sb); sk = sum8(sk); sbo = sum8(sbo);
        *(GAS v4u*)(REC + 1 * SL + ri) = oa; *(GAS v4u*)(REC + 2 * SL + ri) = orr; *(GAS v4u*)(REC + 3 * SL + ri) = ok; *(GAS v4u*)(REC + 4 * SL + ri) = ob; *(GAS v4u*)(REC + 5 * SL + ri) = ov;
        if ((lane & 7) == 0) SC[(size_t)(b * 8 + h) * T + t] = (f32x4){sb, sk, sbo, 0.f};
    }
}
constexpr int KS_STRIDE = 144, VT_STRIDE = 528, ATT_KS_OFF = 0, ATT_VT_OFF = 256 * KS_STRIDE;
__device__ __forceinline__ void p6_attention(Frame& F) {
    bf16* ATTQ = (bf16*)(F.ws + WS_ATTQ); const bf16* ATTKV = (const bf16*)(F.ws + WS_ATTKV);
    const float* qn = F.in18; const float* kn = F.in19; const float* sinks = F.in20;
    LAS unsigned char* Ks = F.lds + ATT_KS_OFF; LAS unsigned char* Vt = F.lds + ATT_VT_OFF;
    const int tid = fresh_tid(), lane = tid & 63, w = F.wave, g = lane >> 4, n16 = lane & 15;
    for (int unit = F.vcu; unit < BATCH * 2 * 32; unit += F.G) {
        const int nb = unit & 31, kvh = (unit >> 5) & 1, b = unit >> 6; const int m0 = b * T + nb * 128;
#pragma unroll
        for (int i = 0; i < 4; ++i) { const int e = tid + 512 * i, key = e >> 3, dg = e & 7; const bool valid = nb > 0 || key >= 128;
            v4u ku = (v4u){0u, 0u, 0u, 0u}, vu = (v4u){0u, 0u, 0u, 0u};
            if (valid) { const bf16* src = ATTKV + (size_t)(m0 - 128 + key) * 256 + kvh * 64 + dg * 8; ku = *(const GAS v4u*)src; vu = *(const GAS v4u*)(src + 128); }
            float kf[8] = {bflo(ku.x), bfhi(ku.x), bflo(ku.y), bfhi(ku.y), bflo(ku.z), bfhi(ku.z), bflo(ku.w), bfhi(ku.w)};
            float ss = 0.f;
#pragma unroll
            for (int j = 0; j < 8; ++j) ss += kf[j] * kf[j];
            ss += __shfl_xor(ss, 1); ss += __shfl_xor(ss, 2); ss += __shfl_xor(ss, 4);
            const float rs = 1.0f / sqrtf(ss * (1.0f / 64.0f) + RMS_EPS);
#pragma unroll
            for (int j = 0; j < 8; ++j) kf[j] *= rs * kn[dg * 8 + j];
            *(LAS v4u*)(Ks + key * KS_STRIDE + dg * 16) = (v4u){pk2(kf[0], kf[1]), pk2(kf[2], kf[3]), pk2(kf[4], kf[5]), pk2(kf[6], kf[7])};
            const unsigned vv[4] = {vu.x, vu.y, vu.z, vu.w};
#pragma unroll
            for (int j = 0; j < 8; ++j) *(LAS bf16*)(Vt + (dg * 8 + j) * VT_STRIDE + key * 2) = (bf16)((vv[j >> 1] >> ((j & 1) * 16)) & 0xffffu);
        }
        __syncthreads();
        const int hq = kvh * 4 + (w >> 1), qbase = (w & 1) * 64; const float sink = sinks[hq];
        for (int qt = 0; qt < 4; ++qt) {
            const int q0 = qbase + 16 * qt, qi = q0 + n16, kt0 = q0 >> 4;
            bf16* qp = ATTQ + (size_t)(m0 + qi) * 512 + hq * 64 + 8 * g;
            const v4u qa = *(const GAS v4u*)qp, qb = *(const GAS v4u*)(qp + 32);
            float q[16] = {bflo(qa.x), bfhi(qa.x), bflo(qa.y), bfhi(qa.y), bflo(qa.z), bfhi(qa.z), bflo(qa.w), bfhi(qa.w),
                           bflo(qb.x), bfhi(qb.x), bflo(qb.y), bfhi(qb.y), bflo(qb.z), bfhi(qb.z), bflo(qb.w), bfhi(qb.w)};
            float ss = 0.f;
#pragma unroll
            for (int j = 0; j < 16; ++j) ss += q[j] * q[j];
            ss += __shfl_xor(ss, 16); ss += __shfl_xor(ss, 32);
            const float rs = 0.125f / sqrtf(ss * (1.0f / 64.0f) + RMS_EPS);
#pragma unroll
            for (int j = 0; j < 16; ++j) q[j] *= rs * qn[(j >> 3) * 32 + 8 * g + (j & 7)];
            const v4u qf0 = (v4u){pk2(q[0], q[1]), pk2(q[2], q[3]), pk2(q[4], q[5]), pk2(q[6], q[7])}, qf1 = (v4u){pk2(q[8], q[9]), pk2(q[10], q[11]), pk2(q[12], q[13]), pk2(q[14], q[15])};
            const bf16x8 bq0 = __builtin_bit_cast(bf16x8, qf0), bq1 = __builtin_bit_cast(bf16x8, qf1);
            f32x4 st[10]; float mx = -INFINITY;
#pragma unroll
            for (int i = 0; i < 10; ++i) { const int kt = kt0 + i, ktc = kt < 16 ? kt : 15;
                const LAS unsigned char* kp = Ks + (16 * ktc + n16) * KS_STRIDE + 16 * g;
                const bf16x8 a0 = *(const LAS bf16x8*)kp, a1 = *(const LAS bf16x8*)(kp + 64);
                f32x4 acc = (f32x4){0.f, 0.f, 0.f, 0.f};
                acc = __builtin_amdgcn_mfma_f32_16x16x32_bf16(a0, bq0, acc, 0, 0, 0);
                acc = __builtin_amdgcn_mfma_f32_16x16x32_bf16(a1, bq1, acc, 0, 0, 0);
#pragma unroll
                for (int r = 0; r < 4; ++r) { const int kj = 16 * kt + 4 * g + r; const bool ok = (kj > qi) && (kj <= qi + 128) && (nb > 0 || kj >= 128);
                    acc[r] = ok ? acc[r] : -INFINITY; mx = fmaxf(mx, acc[r]); }
                st[i] = acc; }
            mx = fmaxf(mx, __shfl_xor(mx, 16)); mx = fmaxf(mx, __shfl_xor(mx, 32)); mx = fmaxf(mx, sink);
            float den = 0.f;
#pragma unroll
            for (int i = 0; i < 10; ++i)
#pragma unroll
                for (int r = 0; r < 4; ++r) { const float p = __expf(st[i][r] - mx); st[i][r] = p; den += p; }
            den += __shfl_xor(den, 16); den += __shfl_xor(den, 32); den += __expf(sink - mx);
            const float inv = 1.0f / den;
            f32x4 o[4];
#pragma unroll
            for (int dt = 0; dt < 4; ++dt) o[dt] = (f32x4){0.f, 0.f, 0.f, 0.f};
#pragma unroll
            for (int j = 0; j < 5; ++j) { const int ka = kt0 + 2 * j, kb2 = ka + 1, kac = ka < 16 ? ka : 15, kbc = kb2 < 16 ? kb2 : 15;
                const v4u pu = (v4u){pk2(st[2 * j][0], st[2 * j][1]), pk2(st[2 * j][2], st[2 * j][3]), pk2(st[2 * j + 1][0], st[2 * j + 1][1]), pk2(st[2 * j + 1][2], st[2 * j + 1][3])};
                const bf16x8 pf = __builtin_bit_cast(bf16x8, pu);
#pragma unroll
                for (int dt = 0; dt < 4; ++dt) { const LAS unsigned char* vp = Vt + (16 * dt + n16) * VT_STRIDE;
                    const v2u va = *(const LAS v2u*)(vp + (16 * kac + 4 * g) * 2), vb = *(const LAS v2u*)(vp + (16 * kbc + 4 * g) * 2);
                    const bf16x8 af = __builtin_bit_cast(bf16x8, (v4u){va.x, va.y, vb.x, vb.y});
                    o[dt] = __builtin_amdgcn_mfma_f32_16x16x32_bf16(af, pf, o[dt], 0, 0, 0); } }
            bf16* op = ATTQ + (size_t)(m0 + qi) * 512 + hq * 64 + 4 * g;
#pragma unroll
            for (int dt = 0; dt < 4; ++dt) *(GAS v2u*)(op + 16 * dt) = (v2u){pk2(o[dt][0] * inv, o[dt][1] * inv), pk2(o[dt][2] * inv, o[dt][3] * inv)};
        }
        __syncthreads();
    }
}
constexpr int SC_NS = 32, SC_AW = 0, SC_WV = 16384, SC_KV = 24576, SC_BV = 32768, SC_VS = 40960, SC_YB = 49152, SC_BUF = 51200;
struct ScanPre { v4u ulw, ua, ur, uk, ub; unsigned uv; f32x4 sc; };
__device__ __forceinline__ ScanPre scan_issue(Frame& F, int bh, int quarter, int t0, int lt) {
    const unsigned char* REC = F.ws + WS_REC; const f32x4* SC = (const f32x4*)(F.ws + WS_SC);
    const size_t eoff = ((size_t)bh * T + t0) * 128 + (size_t)lt * 16;
    ScanPre p;
    p.ulw = *(const GAS v4u*)(REC + 0 * REC_SLOT + eoff); p.ua = *(const GAS v4u*)(REC + 1 * REC_SLOT + eoff); p.ur = *(const GAS v4u*)(REC + 2 * REC_SLOT + eoff);
    p.uk = *(const GAS v4u*)(REC + 3 * REC_SLOT + eoff); p.ub = *(const GAS v4u*)(REC + 4 * REC_SLOT + eoff);
    const int s = lt >> 3, rp = 2 * (lt & 7);
    p.uv = *(const GAS unsigned*)(REC + 5 * REC_SLOT + (((size_t)bh * T + t0 + s) * 64 + 16 * quarter + rp) * 2);
    p.sc = *(const GAS f32x4*)(SC + (size_t)bh * T + t0 + s);
    return p;
}
__device__ __forceinline__ void scan_commit(const ScanPre& p, LAS unsigned char* buf, int lt) {
    const v4u ulw = p.ulw, ua = p.ua, ur = p.ur, uk = p.uk, ub = p.ub; const unsigned uv = p.uv; const f32x4 sc = p.sc;
    const int s = lt >> 3, e0 = 8 * (lt & 7), rp = 2 * (lt & 7);
    const unsigned lw4[4] = {ulw.x, ulw.y, ulw.z, ulw.w}, a4[4] = {ua.x, ua.y, ua.z, ua.w}, r4[4] = {ur.x, ur.y, ur.z, ur.w}, k4[4] = {uk.x, uk.y, uk.z, uk.w}, b4[4] = {ub.x, ub.y, ub.z, ub.w};
    float w[8], av[8], wr[8], kv[8], bv[8];
#pragma unroll
    for (int i = 0; i < 4; ++i) {
        w[2 * i] = __expf(bflo(lw4[i])); w[2 * i + 1] = __expf(bfhi(lw4[i]));
        av[2 * i] = bflo(a4[i]); av[2 * i + 1] = bfhi(a4[i]);
        wr[2 * i] = w[2 * i] * bflo(r4[i]); wr[2 * i + 1] = w[2 * i + 1] * bfhi(r4[i]);
        kv[2 * i] = bflo(k4[i]); kv[2 * i + 1] = bfhi(k4[i]);
        bv[2 * i] = bflo(b4[i]); bv[2 * i + 1] = bfhi(b4[i]); }
    LAS f32x4* AW = (LAS f32x4*)(buf + SC_AW); const int q0 = e0 >> 2;
#pragma unroll
    for (int qq = 0; qq < 2; ++qq)
#pragma unroll
        for (int hh = 0; hh < 2; ++hh) { const int e = 4 * qq + 2 * hh; AW[(s * 2 + hh) * 16 + q0 + qq] = (f32x4){av[e], wr[e], av[e + 1], wr[e + 1]}; }
    LAS f32x4* WV = (LAS f32x4*)(buf + SC_WV); LAS f32x4* KV = (LAS f32x4*)(buf + SC_KV); LAS f32x4* BV = (LAS f32x4*)(buf + SC_BV);
#pragma unroll
    for (int qq = 0; qq < 2; ++qq) { const int e = 4 * qq;
        WV[s * 16 + q0 + qq] = (f32x4){w[e], w[e + 1], w[e + 2], w[e + 3]}; KV[s * 16 + q0 + qq] = (f32x4){kv[e], kv[e + 1], kv[e + 2], kv[e + 3]}; BV[s * 16 + q0 + qq] = (f32x4){bv[e], bv[e + 1], bv[e + 2], bv[e + 3]}; }
    LAS f32x4* VS = (LAS f32x4*)(buf + SC_VS); const float v0 = bflo(uv), v1 = bfhi(uv);
    VS[s * 16 + rp] = (f32x4){v0, v0 * sc.y, sc.x, 0.f}; VS[s * 16 + rp + 1] = (f32x4){v1, v1 * sc.y, sc.x, 0.f};
}
__device__ __forceinline__ void scan_flush(Frame& F, int bh, int quarter, int t0, const LAS unsigned char* buf, int lt) {
    if (lt < 128) { const int s = lt >> 2, c4 = lt & 3; const int b = bh >> 3, h = bh & 7;
        float* yraw = (float*)(F.ws + WS_YRAW);
        const f32x4 y = *(const LAS f32x4*)(buf + SC_YB + (s * 16 + 4 * c4) * 4);
        *(GAS f32x4*)(yraw + (size_t)(b * T + t0 + s) * 512 + h * 64 + 16 * quarter + 4 * c4) = y; }
}
__device__ __forceinline__ void p7_scan(Frame& F) {
    const int w = F.wave, tid = fresh_tid(), lane = tid & 63, rl = lane >> 4, q = lane & 15, lt = tid - 256;
    constexpr int NBLK = T / SC_NS;
#define SCAN_BAR() do { asm volatile("s_waitcnt lgkmcnt(0)" ::: "memory"); __builtin_amdgcn_s_barrier(); asm volatile("" ::: "memory"); } while (0)
    for (int unit = F.vcu; unit < 256; unit += F.G) {
        const int bh = unit >> 2, quarter = unit & 3;
        ScanPre pre;
        if (w >= 4) { pre = scan_issue(F, bh, quarter, 0, lt); scan_commit(pre, F.lds, lt); pre = scan_issue(F, bh, quarter, SC_NS, lt); }
        SCAN_BAR();
        float S0 = 0.f, S1 = 0.f, S2 = 0.f, S3 = 0.f;
        for (int nb = 0; nb < NBLK; ++nb) {
            LAS unsigned char* cur = F.lds + (nb & 1) * SC_BUF; LAS unsigned char* oth = F.lds + ((nb + 1) & 1) * SC_BUF;
            if (w >= 4) {
                if (nb > 0) scan_flush(F, bh, quarter, (nb - 1) * SC_NS, oth, lt);
                if (nb + 1 < NBLK) scan_commit(pre, oth, lt);
                if (nb + 2 < NBLK) pre = scan_issue(F, bh, quarter, (nb + 2) * SC_NS, lt);
            } else {
                const LAS f32x4* AW = (const LAS f32x4*)(cur + SC_AW); const LAS f32x4* WV = (const LAS f32x4*)(cur + SC_WV); const LAS f32x4* KV = (const LAS f32x4*)(cur + SC_KV);
                const LAS f32x4* BV = (const LAS f32x4*)(cur + SC_BV); const LAS f32x4* VS = (const LAS f32x4*)(cur + SC_VS); LAS float* YB = (LAS float*)(cur + SC_YB);
                const int rowl = 4 * w + rl;
                f32x4 aw0 = AW[q], aw1 = AW[16 + q], wv = WV[q], kv = KV[q], bv = BV[q], vs = VS[rowl];
#pragma unroll 8
                for (int s = 0; s < SC_NS; ++s) {
                    const int sn = s + 1;
                    const f32x4 n_aw0 = AW[(sn * 2) * 16 + q], n_aw1 = AW[(sn * 2 + 1) * 16 + q], n_wv = WV[sn * 16 + q], n_kv = KV[sn * 16 + q], n_bv = BV[sn * 16 + q], n_vs = VS[sn * 16 + rowl];
                    __builtin_amdgcn_sched_barrier(0);
                    float sa = S0 * aw0.x; sa = fmaf(S1, aw0.z, sa); sa = fmaf(S2, aw1.x, sa); sa = fmaf(S3, aw1.z, sa);
                    float z = S0 * aw0.y; z = fmaf(S1, aw0.w, z); z = fmaf(S2, aw1.y, z); z = fmaf(S3, aw1.w, z);
                    const float t0_ = fmaf(vs.x, kv.x, S0 * wv.x), t1_ = fmaf(vs.x, kv.y, S1 * wv.y), t2_ = fmaf(vs.x, kv.z, S2 * wv.z), t3_ = fmaf(vs.x, kv.w, S3 * wv.w);
                    sa = row16_sum(sa); z = row16_sum(z);
                    S0 = fmaf(sa, bv.x, t0_); S1 = fmaf(sa, bv.y, t1_); S2 = fmaf(sa, bv.z, t2_); S3 = fmaf(sa, bv.w, t3_);
                    YB[s * 16 + rowl] = fmaf(sa, vs.z, z) + vs.y;
                    aw0 = n_aw0; aw1 = n_aw1; wv = n_wv; kv = n_kv; bv = n_bv; vs = n_vs;
                }
            }
            SCAN_BAR();
        }
        if (w >= 4) scan_flush(F, bh, quarter, T - SC_NS, F.lds + ((NBLK - 1) & 1) * SC_BUF, lt);
        asm volatile("s_waitcnt vmcnt(0)" ::: "memory"); SCAN_BAR();
    }
#undef SCAN_BAR
}
__device__ __forceinline__ void p8_post(Frame& F) {
    const float* yraw = (const float*)(F.ws + WS_YRAW); const bf16* RV = (const bf16*)(F.ws + WS_REC + 5 * REC_SLOT); const f32x4* SC = (const f32x4*)(F.ws + WS_SC);
    const bf16* Gt = (const bf16*)(F.ws + WS_G); bf16* YR = (bf16*)(F.ws + WS_YR);
    const int gw = F.vcu * NWAVES + F.wave, NGW = F.G * NWAVES, lane = fresh_tid() & 63, h = lane >> 3, c0 = 8 * lane, n0 = 8 * (lane & 7);
    float lw[8], lb[8]; ld8f(F.in16 + c0, lw); ld8f(F.in17 + c0, lb);
    for (int m = gw; m < M; m += NGW) {
        const int b = m >> 12, t = m & (T - 1); const size_t rt = (size_t)(b * 8 + h) * T + t;
        float y[8]; ld8f(yraw + (size_t)m * 512 + c0, y);
        const v4u uv = *(const GAS v4u*)(RV + rt * 64 + n0), ug = *(const GAS v4u*)(Gt + (size_t)m * 512 + c0); const float bonus = SC[rt].z;
        float v[8], g[8]; unpack8(uv, v); unpack8(ug, g);
        float s1 = 0.f;
#pragma unroll
        for (int j = 0; j < 8; ++j) s1 += y[j];
        const float mean = sum8(s1) * (1.0f / 64.0f); float s2 = 0.f;
#pragma unroll
        for (int j = 0; j < 8; ++j) { y[j] -= mean; s2 += y[j] * y[j]; }
        const float rstd = 1.0f / sqrtf(sum8(s2) * (1.0f / 64.0f) + GN_EPS);
        float o[8];
#pragma unroll
        for (int j = 0; j < 8; ++j) o[j] = (y[j] * rstd * lw[j] + lb[j] + bonus * v[j]) * g[j];
        *(GAS v4u*)(YR + (size_t)m * 512 + c0) = pack8u(o);
    }
}
__device__ __forceinline__ void p13_final(Frame& F) {
    const float* part = (const float*)(F.ws + WS_PART + 3 * 2 * MiB); const float* gn = F.in28;
    const int gw = F.vcu * NWAVES + F.wave, NGW = F.G * NWAVES, lane = fresh_tid() & 63;
    for (int m = gw; m < M; m += NGW) {
        float s = lane < 16 ? part[(size_t)m * 16 + lane] : 0.f; s = wave_sum(s);
        const float rs = 1.0f / sqrtf(s * (1.0f / 1024.0f) + RMS_EPS);
        GAS f32x4* xr = (GAS f32x4*)(F.out + (size_t)m * D) + lane; const GAS f32x4* gr = (const GAS f32x4*)gn + lane;
#pragma unroll
        for (int j = 0; j < 4; ++j) { const f32x4 v = xr[64 * j], g4 = gr[64 * j]; xr[64 * j] = v * rs * g4; }
    }
}
struct Args { const float* in[29]; float* out; unsigned char* ws; };
__global__ void __launch_bounds__(NWAVES * 64, 2) fwd_megakernel(Args args) {
    extern __shared__ __attribute__((aligned(16))) unsigned char lds[];
    cg::grid_group grid = cg::this_grid();
    Frame F;
    F.lds = (LAS unsigned char*)lds;
    F.tid = threadIdx.x; F.lane = F.tid & 63; F.wave = __builtin_amdgcn_readfirstlane(F.tid >> 6);
    F.G = gridDim.x; { const int bx = blockIdx.x; F.vcu = (F.G % 8 == 0) ? (bx % 8) * (F.G / 8) + bx / 8 : bx; }
F.in0 = args.in[0]; F.in1 = args.in[1]; F.in2 = args.in[2]; F.in3 = args.in[3]; F.in4 = args.in[4]; F.in5 = args.in[5]; F.in6 = args.in[6]; F.in7 = args.in[7]; F.in8 = args.in[8]; F.in9 = args.in[9]; F.in10 = args.in[10]; F.in11 = args.in[11]; F.in12 = args.in[12]; F.in13 = args.in[13]; F.in14 = args.in[14]; F.in15 = args.in[15]; F.in16 = args.in[16]; F.in17 = args.in[17]; F.in18 = args.in[18]; F.in19 = args.in[19]; F.in20 = args.in[20]; F.in21 = args.in[21]; F.in22 = args.in[22]; F.in23 = args.in[23]; F.in24 = args.in[24]; F.in25 = args.in[25]; F.in26 = args.in[26]; F.in27 = args.in[27]; F.in28 = args.in[28];
    F.out = args.out; F.ws = args.ws;
    unsigned char* ws = args.ws;
    bf16* XB = (bf16*)(ws + WS_XB); bf16* HB = (bf16*)(ws + WS_H);
    float* PA = (float*)(ws + WS_PART); float* PB = PA + (size_t)M * 16; float* PC = PB + (size_t)M * 16; float* PD = PC + (size_t)M * 16;
    using pg8::gemm_phase; using pg8::StaticOrder; using pg8::Gemm;
    volatile LAS unsigned* bst = (volatile LAS unsigned*)(F.lds + RING_BYTES);
    if (F.tid == 0) { bst[0] = 0u; bst[1] = 0u; }
    __syncthreads();
    XcdBarrier bar = xcd_barrier_post((unsigned*)ws, bst);
#define SYNC() xcd_barrier(bar)
#define RUN_GEMM(EPI, Aptr, Bptr, NN, KK, ...) do { Gemm g_{(const pg8::bf16_t*)(Aptr), (const pg8::bf16_t*)(Bptr), M, (NN), (KK)}; StaticOrder S_; S_.init(M, (NN), F.G, (int)blockIdx.x); \
        pg8::EPI E_{__VA_ARGS__}; gemm_phase<pg8::EPI, StaticOrder, true, true>(F.lds, g_, S_, E_); } while (0)

    p0_prologue(F); grid.sync();
    RUN_GEMM(EpiGU, XB, ws + WS_WGU1, 2 * FF, D, HB, PA); SYNC();
    RUN_GEMM(EpiRes, HB, ws + WS_WDN1, D, FF, F.in0, F.out, XB, PB, 0.5f); SYNC();
    RUN_GEMM(EpiProj, XB, ws + WS_WIN, 2560, D, (bf16*)(ws + WS_RKVL), (bf16*)(ws + WS_ATTQ), (bf16*)(ws + WS_ATTKV), PB); SYNC();
    p4_lora_in(F); SYNC();
    RUN_GEMM(EpiLora, ws + WS_LA, ws + WS_WLO, 1536, 256, (bf16*)(ws + WS_REC), (bf16*)(ws + WS_REC + 4 * REC_SLOT), (bf16*)(ws + WS_G), F.in8, F.in10); SYNC();
    p6_prep(F); p6_attention(F); SYNC();
    p7_scan(F); SYNC();
    p8_post(F); SYNC();
    RUN_GEMM(EpiGate, XB, ws + WS_WGT, 2048, D, (bf16*)(ws + WS_GATES), PB); SYNC();
    RUN_GEMM(EpiBranch, ws + WS_YR, ws + WS_WBR, D, 512, (const bf16*)(ws + WS_GATES), (bf16*)(ws + WS_MERGED), 0);
    RUN_GEMM(EpiBranch, ws + WS_ATTQ, ws + WS_WBA, D, 512, (const bf16*)(ws + WS_GATES), (bf16*)(ws + WS_MERGED), 1024); SYNC();
    RUN_GEMM(EpiRes, ws + WS_MERGED, ws + WS_WOUT, D, 2048, F.out, F.out, XB, PC, 1.0f); SYNC();
    RUN_GEMM(EpiGU, XB, ws + WS_WGU2, 2 * FF, D, HB, PC); SYNC();
    RUN_GEMM(EpiRes, HB, ws + WS_WDN2, D, FF, F.out, F.out, (bf16*)nullptr, PD, 0.5f); SYNC();
    p13_final(F);
}

extern "C" void kernel_launch(void* const* d_in, const int* in_sizes, int n_in, void* d_out, int out_size, void* d_ws, size_t ws_size, hipStream_t stream) {
    static int grid = 0;
    if (grid == 0) {
        if (n_in != 29 || in_sizes[0] != M * D || out_size != M * D || ws_size < WS_END) { fprintf(stderr, "kernel_launch: unexpected shapes (n_in %d, ws %zu)\n", n_in, ws_size); grid = -1; return; }
        int dev = 0, cus = 0, per_cu = 0;
        hipGetDevice(&dev); hipDeviceGetAttribute(&cus, hipDeviceAttributeMultiprocessorCount, dev);
        if (hipFuncSetAttribute((const void*)fwd_megakernel, hipFuncAttributeMaxDynamicSharedMemorySize, LDS_BYTES) != hipSuccess) { fprintf(stderr, "kernel_launch: hipFuncSetAttribute failed\n"); grid = -1; return; }
        hipOccupancyMaxActiveBlocksPerMultiprocessor(&per_cu, (const void*)fwd_megakernel, NWAVES * 64, LDS_BYTES);
        (void)hipGetLastError();
        if (per_cu < 1) fprintf(stderr, "kernel_launch: occupancy query says %d blocks/CU\n", per_cu);
        grid = cus;
    }
    if (grid < 0) return;
    if (hipMemsetAsync(d_ws, 0, 16384, stream) != hipSuccess) { fprintf(stderr, "kernel_launch: memset failed\n"); return; }
    Args a{};
    for (int i = 0; i < 29; ++i) a.in[i] = (const float*)d_in[i];
    a.out = (float*)d_out; a.ws = (unsigned char*)d_ws;
    void* kargs[] = {&a};
    hipError_t e = hipLaunchCooperativeKernel((const void*)fwd_megakernel, dim3(grid), dim3(NWAVES * 64), kargs, LDS_BYTES, stream);
    if (e != hipSuccess) fprintf(stderr, "kernel_launch: cooperative launch failed: %s (grid %d)\n", hipGetErrorString(e), grid);
}
```

```cpp
#include <hip/hip_runtime.h>
#include <hip/hip_cooperative_groups.h>
#include <cstdio>
#include <cstdint>
namespace cg = cooperative_groups;
namespace pg8 {
#define PG8_LAS __attribute__((address_space(3)))
typedef unsigned short bf16_t;
typedef short bf16x8 __attribute__((ext_vector_type(8)));
typedef float f32x4 __attribute__((ext_vector_type(4)));
typedef unsigned u32x4 __attribute__((ext_vector_type(4)));
constexpr int BM = 256, BK = 64, HALF = 128, HTB = HALF * BK * 2  , STAGE_BYTES = 8 * HTB, NXCD = 8, WGM = 8;

__host__ __device__ __forceinline__ int lds_byte(int r, int c) { const int st = (r >> 4) * 2 + (c >> 5), rr = r & 15, cc = c & 31, ob = rr * 64 + cc * 2; return st * 1024 + (ob ^ (((ob >> 9) & 1) << 5)); }
__host__ __device__ __forceinline__ void stage_rc(int b, int& R, int& C) { const int st = b / 1024, sb = b % 1024, swz = sb ^ (((sb >> 9) & 1) << 5); R = (st >> 1) * 16 + swz / 64; C = (st & 1) * 32 + (swz % 64) / 2; }
__host__ __device__ __forceinline__ int perm32(int rho) { const int n = rho >> 4, i = rho & 15; return 8 * (i >> 2) + 4 * n + (i & 3); }

struct Unit { int pm, pn; };
struct Gemm { const bf16_t* A; const bf16_t* Bt; int M, N, K; };

struct StaticOrder {
    int nM, nN, nwg, G, c;
    __host__ __device__ void init(int M, int N, int G_, int c_) { nM = M / BM; nN = N / BM; nwg = nM * nN; G = G_; c = c_; }
    __host__ __device__ bool next(int i, Unit& u) const {
        const long L = (long)i * G + c; if (L >= nwg) return false;
        int wgid = (int)L; { const int q = nwg / NXCD, r = nwg % NXCD, xcd = wgid % NXCD, off = wgid / NXCD; wgid = (xcd < r ? xcd * (q + 1) : r * (q + 1) + (xcd - r) * q) + off; }
        const int nig = WGM * nN, gid = wgid / nig, fm = gid * WGM, gsz = (nM - fm) < WGM ? (nM - fm) : WGM;
        u.pm = fm + ((wgid % nig) % gsz); u.pn = (wgid % nig) / gsz; return true;
    }
    __device__ __forceinline__ void a_ready(const Unit&) const {}
    __device__ __forceinline__ void done(const Unit&) const {}
};

__device__ __forceinline__ unsigned cvt_pk_bf16(float lo, float hi) { unsigned r; asm volatile("v_cvt_pk_bf16_f32 %0, %1, %2" : "=v"(r) : "v"(lo), "v"(hi)); return r; }
__device__ __forceinline__ u32x4 pack8(f32x4 v0, f32x4 v1) {
    u32x4 w;
    asm volatile("s_nop 1\n\tv_cvt_pk_bf16_f32 %0, %4, %5\n\tv_cvt_pk_bf16_f32 %1, %6, %7\n\tv_cvt_pk_bf16_f32 %2, %8, %9\n\tv_cvt_pk_bf16_f32 %3, %10, %11"
                 : "=&v"(w.x), "=&v"(w.y), "=&v"(w.z), "=&v"(w.w)
                 : "v"(v0[0]), "v"(v0[1]), "v"(v0[2]), "v"(v0[3]), "v"(v1[0]), "v"(v1[1]), "v"(v1[2]), "v"(v1[3]));
    return w;
}
__device__ __forceinline__ float bf_lo(unsigned u) { return __uint_as_float(u << 16); }
__device__ __forceinline__ float bf_hi(unsigned u) { return __uint_as_float(u & 0xffff0000u); }
__device__ __forceinline__ void rows_rstd(const float* part, int row0, int fq, float (&rs)[2][4]) {
#pragma unroll
    for (int ai = 0; ai < 2; ++ai)
#pragma unroll
        for (int m = 0; m < 4; ++m) { const f32x4 a = *(const f32x4*)(part + (size_t)(row0 + ai * HALF + m * 16) * 16 + 4 * fq);
            float s = (a[0] + a[1]) + (a[2] + a[3]); s += __shfl_xor(s, 16); s += __shfl_xor(s, 32);
            rs[ai][m] = __builtin_amdgcn_rsqf(s * (1.0f / 1024.0f) + 1e-6f); }
    asm volatile("" ::: "memory");
}
__device__ __forceinline__ float fexp_(float x) { return __builtin_amdgcn_exp2f(x * 1.44269504089f); }
__device__ __forceinline__ float sigmoidf_(float x) { return __builtin_amdgcn_rcpf(1.0f + fexp_(-x)); }

struct EpiGU {
    static constexpr bool PERM = true, AFTER_DRAIN = false;
    bf16_t* H; const float* part;
    __device__ __forceinline__ void operator()(const f32x4 (&acc)[2][2][4][2], const Unit& u, int wr, int wc, int fr, int fq) const {
        const int row0 = u.pm * BM + wr * 64 + fr, col0 = u.pn * 128 + wc * 32 + 8 * fq;
        float rsv[2][4]; rows_rstd(part, row0, fq, rsv);
#pragma unroll
        for (int ai = 0; ai < 2; ++ai)
#pragma unroll
            for (int m = 0; m < 4; ++m) { const int row = row0 + ai * HALF + m * 16; const float rs = rsv[ai][m];
                f32x4 h0, h1;
#pragma unroll
                for (int j = 0; j < 4; ++j) { const float g0 = acc[ai][0][m][0][j] * rs, u0 = acc[ai][1][m][0][j] * rs, g1 = acc[ai][0][m][1][j] * rs, u1 = acc[ai][1][m][1][j] * rs;
                    h0[j] = g0 * u0 * __builtin_amdgcn_rcpf(1.0f + fexp_(-g0)); h1[j] = g1 * u1 * __builtin_amdgcn_rcpf(1.0f + fexp_(-g1)); }
                *(u32x4*)(H + (size_t)row * 2816 + col0) = pack8(h0, h1); asm volatile("" ::: "memory"); }
    }
};
struct EpiRes {
    static constexpr bool PERM = true, AFTER_DRAIN = false;
    const float* xin; float* xout; bf16_t* xb; float* part; float alpha;
    __device__ __forceinline__ void operator()(const f32x4 (&acc)[2][2][4][2], const Unit& u, int wr, int wc, int fr, int fq) const {
        const int row0 = u.pm * BM + wr * 64 + fr, col0 = u.pn * BM + wc * 32 + 8 * fq;
#pragma unroll
        for (int ai = 0; ai < 2; ++ai)
#pragma unroll
            for (int m = 0; m < 4; ++m) { const int row = row0 + ai * HALF + m * 16; float ss = 0.f;
#pragma unroll
                for (int bj = 0; bj < 2; ++bj) { const size_t off = (size_t)row * 1024 + col0 + bj * HALF;
                    const f32x4 r0 = *(const f32x4*)(xin + off), r1 = *(const f32x4*)(xin + off + 4);
                    const f32x4 v0 = r0 + acc[ai][bj][m][0] * alpha, v1 = r1 + acc[ai][bj][m][1] * alpha;
                    *(f32x4*)(xout + off) = v0; *(f32x4*)(xout + off + 4) = v1;
                    if (xb) *(u32x4*)(xb + off) = pack8(v0, v1);
                    ss += (v0[0] * v0[0] + v0[1] * v0[1]) + (v0[2] * v0[2] + v0[3] * v0[3]) + (v1[0] * v1[0] + v1[1] * v1[1]) + (v1[2] * v1[2] + v1[3] * v1[3]); }
                ss += __shfl_xor(ss, 16); ss += __shfl_xor(ss, 32);
                if (fq == 0) part[(size_t)row * 16 + u.pn * 4 + wc] = ss; asm volatile("" ::: "memory"); }
    }
};
struct EpiProj {
    static constexpr bool PERM = true, AFTER_DRAIN = false;
    bf16_t* rkvl; bf16_t* attq; bf16_t* attkv; const float* part;
    __device__ __forceinline__ void operator()(const f32x4 (&acc)[2][2][4][2], const Unit& u, int wr, int wc, int fr, int fq) const {
        bf16_t* base; int ldc, colt;
        if (u.pn < 7) { base = rkvl; ldc = 1792; colt = u.pn * BM; } else if (u.pn < 9) { base = attq; ldc = 512; colt = (u.pn - 7) * BM; } else { base = attkv; ldc = 256; colt = 0; }
        const int row0 = u.pm * BM + wr * 64 + fr, col0 = colt + wc * 32 + 8 * fq;
        float rsv[2][4]; rows_rstd(part, row0, fq, rsv);
#pragma unroll
        for (int ai = 0; ai < 2; ++ai)
#pragma unroll
            for (int m = 0; m < 4; ++m) { const int row = row0 + ai * HALF + m * 16; const float rs = rsv[ai][m];
#pragma unroll
                for (int bj = 0; bj < 2; ++bj) *(u32x4*)(base + (size_t)row * ldc + col0 + bj * HALF) = pack8(acc[ai][bj][m][0] * rs, acc[ai][bj][m][1] * rs); }
    }
};
struct EpiGate {
    static constexpr bool PERM = true, AFTER_DRAIN = false;
    bf16_t* gates; const float* part;
    __device__ __forceinline__ void operator()(const f32x4 (&acc)[2][2][4][2], const Unit& u, int wr, int wc, int fr, int fq) const {
        const int row0 = u.pm * BM + wr * 64 + fr, col0 = u.pn * BM + wc * 32 + 8 * fq;
        float rsv[2][4]; rows_rstd(part, row0, fq, rsv);
#pragma unroll
        for (int ai = 0; ai < 2; ++ai)
#pragma unroll
            for (int m = 0; m < 4; ++m) { const int row = row0 + ai * HALF + m * 16; const float rs = rsv[ai][m];
#pragma unroll
                for (int bj = 0; bj < 2; ++bj) { f32x4 v0, v1;
#pragma unroll
                    for (int j = 0; j < 4; ++j) { v0[j] = sigmoidf_(acc[ai][bj][m][0][j] * rs); v1[j] = sigmoidf_(acc[ai][bj][m][1][j] * rs); }
                    *(u32x4*)(gates + (size_t)row * 2048 + col0 + bj * HALF) = pack8(v0, v1); } }
    }
};
struct EpiLora {
    static constexpr bool PERM = true, AFTER_DRAIN = false;
    bf16_t* rec_lw; bf16_t* rec_a; bf16_t* g; const float* w0; const float* a0;
    template <int KIND> __device__ __forceinline__ void body(const f32x4 (&acc)[2][2][4][2], const Unit& u, int wr, int wc, int fr, int fq) const {
        const int row0 = u.pm * BM + wr * 64 + fr, col0 = (u.pn & 1) * BM + wc * 32 + 8 * fq;
#pragma unroll
        for (int ai = 0; ai < 2; ++ai)
#pragma unroll
            for (int m = 0; m < 4; ++m) { const int row = row0 + ai * HALF + m * 16; const int b = row >> 12, t = row & 4095;
#pragma unroll
                for (int bj = 0; bj < 2; ++bj) { const int c = col0 + bj * HALF; f32x4 v0 = acc[ai][bj][m][0], v1 = acc[ai][bj][m][1];
                    if (KIND != 2) { const float* bias = (KIND == 0 ? w0 : a0) + c; v0 = v0 + *(const f32x4*)bias; v1 = v1 + *(const f32x4*)(bias + 4); }
                    if (KIND == 2) { *(u32x4*)(g + (size_t)row * 512 + c) = pack8(v0, v1); }
                    else {
#pragma unroll
                        for (int j = 0; j < 4; ++j) {
                            if (KIND == 0) { const float y0 = -v0[j], y1 = -v1[j];
                                const float sp0 = fmaxf(y0, 0.f) + __logf(1.0f + fexp_(-fabsf(y0))), sp1 = fmaxf(y1, 0.f) + __logf(1.0f + fexp_(-fabsf(y1)));
                                v0[j] = -fexp_(-sp0 - 0.5f); v1[j] = -fexp_(-sp1 - 0.5f); }
                            else { v0[j] = sigmoidf_(v0[j]); v1[j] = sigmoidf_(v1[j]); } }
                        bf16_t* dst = (KIND == 0 ? rec_lw : rec_a) + ((size_t)((b * 8 + (c >> 6)) * 4096 + t)) * 64 + (c & 63);
                        *(u32x4*)dst = pack8(v0, v1); } }
                asm volatile("" ::: "memory"); }
    }
    __device__ __forceinline__ void operator()(const f32x4 (&acc)[2][2][4][2], const Unit& u, int wr, int wc, int fr, int fq) const {
        const int kind = u.pn >> 1;
        if (kind == 0) body<0>(acc, u, wr, wc, fr, fq); else if (kind == 1) body<1>(acc, u, wr, wc, fr, fq); else body<2>(acc, u, wr, wc, fr, fq);
    }
};
struct EpiBranch {
    static constexpr bool PERM = true, AFTER_DRAIN = false;
    const bf16_t* gates; bf16_t* merged; int goff; int accum;
    __device__ __forceinline__ void operator()(const f32x4 (&acc)[2][2][4][2], const Unit& u, int wr, int wc, int fr, int fq) const {
        const int row0 = u.pm * BM + wr * 64 + fr, col0 = u.pn * BM + wc * 32 + 8 * fq;
#pragma unroll
        for (int ai = 0; ai < 2; ++ai)
#pragma unroll
            for (int m = 0; m < 4; ++m) { const int row = row0 + ai * HALF + m * 16;
#pragma unroll
                for (int bj = 0; bj < 2; ++bj) { const int c = col0 + bj * HALF; const u32x4 gq = *(const u32x4*)(gates + (size_t)row * 2048 + goff + c);
                    bf16_t* mp = merged + (size_t)row * 1024 + c;
                    f32x4 v0 = acc[ai][bj][m][0], v1 = acc[ai][bj][m][1];
                    v0[0] *= bf_lo(gq.x); v0[1] *= bf_hi(gq.x); v0[2] *= bf_lo(gq.y); v0[3] *= bf_hi(gq.y);
                    v1[0] *= bf_lo(gq.z); v1[1] *= bf_hi(gq.z); v1[2] *= bf_lo(gq.w); v1[3] *= bf_hi(gq.w);
                    if (accum) { const u32x4 pq = *(const u32x4*)mp;
                        v0[0] += bf_lo(pq.x); v0[1] += bf_hi(pq.x); v0[2] += bf_lo(pq.y); v0[3] += bf_hi(pq.y);
                        v1[0] += bf_lo(pq.z); v1[1] += bf_hi(pq.z); v1[2] += bf_lo(pq.w); v1[3] += bf_hi(pq.w); }
                    *(u32x4*)mp = pack8(v0, v1); } asm volatile("" ::: "memory"); }
    }
};

template <class Epi, class Sched, bool ALIGN_EPI = false, bool SP2 = false>
__device__ __forceinline__ void gemm_phase(PG8_LAS unsigned char* lds, const Gemm g, const Sched& S, const Epi& E) {
    int tid_ = threadIdx.x; asm volatile("" : "+v"(tid_));
    const int tid = tid_, wid = __builtin_amdgcn_readfirstlane(tid >> 6), lane = tid & 63, wr = wid >> 2, wc = wid & 3, fr = lane & 15, fq = lane >> 4;
    const int K = g.K, nt = K / BK;
    unsigned voffA[2], voffB[2];
#pragma unroll
    for (int i = 0; i < 2; ++i) { int R, C; stage_rc(tid * 16 + i * 8192, R, C); const int Rb = Epi::PERM ? ((R & ~31) + perm32(R & 31)) : R;
        voffA[i] = (unsigned)(R * K + C) * 2u; voffB[i] = (unsigned)(Rb * K + C) * 2u; }
    const size_t kstep = (size_t)(BK * 2);
    const size_t hstep = (size_t)HALF * K * 2;
    const size_t tstep = 2 * hstep;
    const unsigned ldsw = (unsigned)wid * 1024u;
    const int aoff = lds_byte(wr * 64 + fr, fq * 8), boff = lds_byte(wc * 32 + fr, fq * 8);
#define PG8_SA(b, h) (((b) * 2 + (h)) * HTB)
#define PG8_SB(b, h) ((4 + (b) * 2 + (h)) * HTB)
#define PG8_STAGE(bufoff, gbase, voff) do { _Pragma("unroll") for (int _i = 0; _i < 2; ++_i) \
        __builtin_amdgcn_global_load_lds((const unsigned*)((const char*)(gbase) + (voff)[_i]), (PG8_LAS unsigned*)(lds + (bufoff) + ldsw + _i * 8192), 16, 0, 0); } while (0)
#define PG8_LDA(dst, b, h) do { _Pragma("unroll") for (int m = 0; m < 4; ++m) _Pragma("unroll") for (int k = 0; k < 2; ++k) dst[m][k] = *(const PG8_LAS bf16x8*)(lds + PG8_SA(b, h) + aoff + m * 2048 + k * 1024); } while (0)
#define PG8_LDB(dst, b, h) do { _Pragma("unroll") for (int n = 0; n < 2; ++n) _Pragma("unroll") for (int k = 0; k < 2; ++k) dst[n][k] = *(const PG8_LAS bf16x8*)(lds + PG8_SB(b, h) + boff + n * 2048 + k * 1024); } while (0)
#define PG8_MMA(ai, bj, At, Bt) do { __builtin_amdgcn_s_setprio(1); _Pragma("unroll") for (int m = 0; m < 4; ++m) _Pragma("unroll") for (int n = 0; n < 2; ++n) _Pragma("unroll") for (int k = 0; k < 2; ++k) \
        acc[ai][bj][m][n] = __builtin_amdgcn_mfma_f32_16x16x32_bf16(Bt[n][k], At[m][k], acc[ai][bj][m][n], 0, 0, 0); __builtin_amdgcn_s_setprio(0); } while (0)
#define PG8_WAIT_V(n) asm volatile("s_waitcnt vmcnt(" #n ")" ::: "memory")
#define PG8_WAIT_L(n) asm volatile("s_waitcnt lgkmcnt(" #n ")" ::: "memory")
#define PG8_BAR __builtin_amdgcn_s_barrier()
#define PG8_SCHED __builtin_amdgcn_sched_barrier(0)
    Unit cur, nxt; int ui = 0;
    if (!S.next(0, cur)) return;
    f32x4 acc[2][2][4][2];
#pragma unroll
    for (int a = 0; a < 2; ++a)
#pragma unroll
        for (int b = 0; b < 2; ++b)
#pragma unroll
            for (int m = 0; m < 4; ++m)
#pragma unroll
                for (int n = 0; n < 2; ++n) acc[a][b][m][n] = (f32x4){0.f, 0.f, 0.f, 0.f};
    bf16x8 At[4][2], B0[2][2], B1[2][2];
    const char* cA = (const char*)g.A + (size_t)cur.pm * tstep; const char* cB = (const char*)g.Bt + (size_t)cur.pn * tstep;
    S.a_ready(cur);
    if constexpr (SP2) {
        PG8_STAGE(PG8_SB(0, 0), cB, voffB); PG8_STAGE(PG8_SB(0, 1), cB + hstep, voffB); PG8_STAGE(PG8_SA(0, 0), cA, voffA); PG8_STAGE(PG8_SA(0, 1), cA + hstep, voffA);
        if (wr == 1) PG8_BAR;
        PG8_WAIT_V(2); PG8_BAR;
        PG8_STAGE(PG8_SB(1, 0), cB + kstep, voffB); PG8_STAGE(PG8_SA(1, 0), cA + kstep, voffA); PG8_STAGE(PG8_SB(1, 1), cB + hstep + kstep, voffB);
        PG8_WAIT_V(6); PG8_BAR;
    } else {
        PG8_STAGE(PG8_SB(0, 0), cB, voffB); PG8_STAGE(PG8_SA(0, 0), cA, voffA); PG8_STAGE(PG8_SB(0, 1), cB + hstep, voffB); PG8_STAGE(PG8_SA(0, 1), cA + hstep, voffA);
        if (wr == 1) PG8_BAR;
        PG8_WAIT_V(4); PG8_BAR;
        PG8_STAGE(PG8_SB(1, 0), cB + kstep, voffB); PG8_STAGE(PG8_SA(1, 0), cA + kstep, voffA); PG8_STAGE(PG8_SB(1, 1), cB + hstep + kstep, voffB);
        PG8_WAIT_V(6); PG8_BAR;
    }
    for (;;) {
        const bool has_next = S.next(ui + 1, nxt);
        const char* nA = has_next ? (const char*)g.A + (size_t)nxt.pm * tstep : cA; const char* nB = has_next ? (const char*)g.Bt + (size_t)nxt.pn * tstep : cB;
        for (int t = 0; t < nt; t += 2) {
            const bool last = (t == nt - 2);
            const char* a1 = cA + (size_t)(t + 1) * kstep;
            const char* a2 = last ? nA : cA + (size_t)(t + 2) * kstep; const char* b2 = last ? nB : cB + (size_t)(t + 2) * kstep;
            const char* a3 = a2 + kstep; const char* b3 = b2 + kstep;
            if (last && has_next) S.a_ready(nxt);
            if constexpr (SP2) {
            PG8_LDB(B0, 0, 0); PG8_LDB(B1, 0, 1); PG8_SCHED; PG8_LDA(At, 0, 0); PG8_STAGE(PG8_SA(1, 1), a1 + hstep, voffA);
            PG8_WAIT_V(8); PG8_WAIT_L(0); PG8_BAR; PG8_MMA(0, 0, At, B0); PG8_MMA(0, 1, At, B1); PG8_BAR; PG8_SCHED;
            PG8_LDA(At, 0, 1); PG8_STAGE(PG8_SB(0, 0), b2, voffB); PG8_STAGE(PG8_SB(0, 1), b2 + hstep, voffB); PG8_STAGE(PG8_SA(0, 0), a2, voffA);
            PG8_WAIT_V(8); PG8_WAIT_L(0); PG8_BAR; PG8_MMA(1, 0, At, B0); PG8_MMA(1, 1, At, B1); PG8_BAR; PG8_SCHED;
            PG8_LDB(B0, 1, 0); PG8_LDB(B1, 1, 1); PG8_SCHED; PG8_LDA(At, 1, 0); PG8_STAGE(PG8_SA(0, 1), a2 + hstep, voffA);
            PG8_WAIT_V(8); PG8_WAIT_L(0); PG8_BAR; PG8_MMA(0, 0, At, B0); PG8_MMA(0, 1, At, B1); PG8_BAR; PG8_SCHED;
            PG8_LDA(At, 1, 1); PG8_STAGE(PG8_SB(1, 0), b3, voffB); PG8_STAGE(PG8_SB(1, 1), b3 + hstep, voffB); PG8_STAGE(PG8_SA(1, 0), a3, voffA);
            PG8_WAIT_V(8); PG8_WAIT_L(0); PG8_BAR; PG8_MMA(1, 0, At, B0); PG8_MMA(1, 1, At, B1); PG8_BAR; PG8_SCHED;
            } else {
            PG8_LDB(B0, 0, 0); PG8_SCHED; PG8_LDA(At, 0, 0); PG8_STAGE(PG8_SA(1, 1), a1 + hstep, voffA);
            PG8_WAIT_L(8); PG8_BAR; PG8_WAIT_L(0); PG8_MMA(0, 0, At, B0); PG8_BAR; PG8_SCHED;
            PG8_LDB(B1, 0, 1); PG8_STAGE(PG8_SB(0, 0), b2, voffB);
            PG8_BAR; PG8_WAIT_L(0); PG8_MMA(0, 1, At, B1); PG8_BAR;
            PG8_LDA(At, 0, 1); PG8_STAGE(PG8_SA(0, 0), a2, voffA);
            PG8_BAR; PG8_WAIT_L(0); PG8_MMA(1, 0, At, B0); PG8_BAR; PG8_SCHED;
            PG8_STAGE(PG8_SB(0, 1), b2 + hstep, voffB);
            PG8_WAIT_V(6); PG8_BAR; PG8_MMA(1, 1, At, B1); PG8_BAR;
            PG8_LDB(B0, 1, 0); PG8_SCHED; PG8_LDA(At, 1, 0); PG8_STAGE(PG8_SA(0, 1), a2 + hstep, voffA);
            PG8_WAIT_L(8); PG8_BAR; PG8_WAIT_L(0); PG8_MMA(0, 0, At, B0); PG8_BAR; PG8_SCHED;
            PG8_LDB(B1, 1, 1); PG8_STAGE(PG8_SB(1, 0), b3, voffB);
            PG8_BAR; PG8_WAIT_L(0); PG8_MMA(0, 1, At, B1); PG8_BAR;
            PG8_LDA(At, 1, 1); PG8_STAGE(PG8_SA(1, 0), a3, voffA);
            PG8_BAR; PG8_WAIT_L(0); PG8_MMA(1, 0, At, B0); PG8_BAR; PG8_SCHED;
            PG8_STAGE(PG8_SB(1, 1), b3 + hstep, voffB);
            PG8_WAIT_V(6); PG8_BAR; PG8_MMA(1, 1, At, B1); PG8_BAR;
            }
        }
        if constexpr (ALIGN_EPI) { if (wr == 0) PG8_BAR; }
        if constexpr (!Epi::AFTER_DRAIN) { E(acc, cur, wr, wc, fr, fq); S.done(cur); }
        if (!has_next) break;
#pragma unroll
        for (int a = 0; a < 2; ++a)
#pragma unroll
            for (int b = 0; b < 2; ++b)
#pragma unroll
                for (int m = 0; m < 4; ++m)
#pragma unroll
                    for (int n = 0; n < 2; ++n) acc[a][b][m][n] = (f32x4){0.f, 0.f, 0.f, 0.f};
        cur = nxt; cA = nA; cB = nB; ++ui;
        if constexpr (ALIGN_EPI) { if (wr == 1) PG8_BAR; }
    }
    PG8_WAIT_V(0);
    if constexpr (!ALIGN_EPI) { if (wr == 0) PG8_BAR; }
    PG8_BAR;
    if constexpr (Epi::AFTER_DRAIN) { E.fused(acc, cur, wr, wc, fr, fq, lds, wid, lane); S.done(cur); }
#undef PG8_SA
#undef PG8_SB
#undef PG8_STAGE
#undef PG8_LDA
#undef PG8_LDB
#undef PG8_MMA
#undef PG8_WAIT_V
#undef PG8_WAIT_L
#undef PG8_BAR
#undef PG8_SCHED
}
}
constexpr int NWAVES = 8;
constexpr int BATCH = 8, T = 4096, D = 1024, M = BATCH * T, FF = 2816, NH = 8, HD = 64, INC = 4512;
constexpr float RMS_EPS = 1e-6f, GN_EPS = 64e-5f;
constexpr size_t MiB = 1u << 20;
constexpr size_t WS_PART = 1 * MiB;
constexpr size_t WS_SC = 9 * MiB;
constexpr size_t WS_WGU1 = 13 * MiB, WS_WDN1 = WS_WGU1 + 11 * MiB, WS_WGU2 = WS_WDN1 + 5632 * 1024, WS_WDN2 = WS_WGU2 + 11 * MiB;
constexpr size_t WS_WIN = WS_WDN2 + 5632 * 1024, WS_WGT = WS_WIN + 5 * MiB, WS_WLO = WS_WGT + 4 * MiB, WS_WBR = WS_WLO + 768 * 1024, WS_WBA = WS_WBR + 1 * MiB, WS_WOUT = WS_WBA + 1 * MiB;
constexpr size_t WS_XB = 62 * MiB;
constexpr size_t WS_ATTQ = 126 * MiB;
constexpr size_t WS_ATTKV = 158 * MiB;
constexpr size_t WS_RKVL = 174 * MiB;
constexpr size_t WS_G = 286 * MiB;
constexpr size_t WS_REC = 318 * MiB, REC_SLOT = 32 * MiB;
constexpr size_t WS_H = 126 * MiB;
constexpr size_t WS_YRAW = WS_RKVL;
constexpr size_t WS_MERGED = WS_RKVL;
constexpr size_t WS_GATES = WS_REC;
constexpr size_t WS_YR = WS_REC + 4 * REC_SLOT;
constexpr size_t WS_LA = WS_REC + 5 * REC_SLOT;
constexpr size_t WS_END = WS_REC + 6 * REC_SLOT;
static_assert(WS_WOUT + 4 * MiB <= WS_XB && WS_H + (size_t)M * FF * 2 <= WS_REC && WS_MERGED + (size_t)M * 2048 * 2 <= WS_REC, "ws map");
constexpr int RING_BYTES = 131072, LDS_BYTES = 147456;

#define GAS __attribute__((address_space(1)))
#define LAS __attribute__((address_space(3)))
typedef unsigned short bf16;
typedef unsigned v4u __attribute__((ext_vector_type(4)));
typedef unsigned v2u __attribute__((ext_vector_type(2)));
typedef float f32x4 __attribute__((ext_vector_type(4)));
typedef float f32x2 __attribute__((ext_vector_type(2)));
typedef short bf16x8 __attribute__((ext_vector_type(8)));
#define LDS_WAIT() asm volatile("s_waitcnt lgkmcnt(0)" ::: "memory")
__device__ __forceinline__ unsigned f2bf(float f) { unsigned u = __builtin_bit_cast(unsigned, f); return (u + 0x7fffu + ((u >> 16) & 1u)) >> 16; }
__device__ __forceinline__ unsigned pk2(float lo, float hi) { return f2bf(lo) | (f2bf(hi) << 16); }
__device__ __forceinline__ float bflo(unsigned u) { return __uint_as_float(u << 16); }
__device__ __forceinline__ float bfhi(unsigned u) { return __uint_as_float(u & 0xffff0000u); }
__device__ __forceinline__ float bf1(bf16 h) { return __uint_as_float((unsigned)h << 16); }
__device__ __forceinline__ float wave_sum(float v) {
#pragma unroll
    for (int o = 1; o < 64; o <<= 1) v += __shfl_xor(v, o);
    return v;
}
template <int CTRL> __device__ __forceinline__ float dppf(float x) { return __builtin_bit_cast(float, __builtin_amdgcn_update_dpp(0, __builtin_bit_cast(int, x), CTRL, 0xf, 0xf, false)); }
__device__ __forceinline__ float row16_sum(float x) { x += dppf<0xB1>(x); x += dppf<0x4E>(x); x += dppf<0x141>(x); x += dppf<0x140>(x); return x; }

#define RLX_AGENT __ATOMIC_RELAXED, __HIP_MEMORY_SCOPE_AGENT
#define XB_TMO      128
#define XB_XCNT(j)  (256  + 64 * (j))
#define XB_XSUB(j)  (1280 + 64 * (j))
#define XB_XGEN(j)  (2304 + 64 * (j))
#define XB_TOP      3328
#define XB_TOPGEN   3392
#define XCD_BAR_WORDS 3456
#define XB_SPIN_CAP (1u << 18)

__device__ __forceinline__ unsigned xb_ld(unsigned* p)              { return __hip_atomic_load(p, __ATOMIC_RELAXED, __HIP_MEMORY_SCOPE_AGENT); }
__device__ __forceinline__ unsigned xb_add(unsigned* p, unsigned v) { return __hip_atomic_fetch_add(p, v, __ATOMIC_RELAXED, __HIP_MEMORY_SCOPE_AGENT); }
__device__ __forceinline__ unsigned xb_xcc_id() { return (unsigned)__builtin_amdgcn_s_getreg((3 << 11) | 20) & 0xFu; }
#define XB_SPIN(cond, bar) do { unsigned _sp = 0; while (cond) { __builtin_amdgcn_s_sleep(1); \
    if ((++_sp & 255u) == 0u) { if (xb_ld(&(bar)[XB_TMO])) break; if (_sp > XB_SPIN_CAP) { atomicAdd(&(bar)[XB_TMO], 1u); break; } } } } while (0)

struct XcdBarrier {
    unsigned* bar; unsigned x;
    volatile LAS unsigned* st;
};

__device__ __forceinline__ XcdBarrier xcd_barrier_post(unsigned* bar, volatile LAS unsigned* st) {
    XcdBarrier b; b.bar = bar; b.x = xb_xcc_id(); b.st = st;
    if (threadIdx.x == 0) (void)xb_add(&bar[XB_XCNT(b.x)], 1u);
    return b;
}
__device__ __forceinline__ void xcd_barrier_complete(unsigned* bar, unsigned x, unsigned& nloc, unsigned& nx) {
    const unsigned G = gridDim.x * gridDim.y * gridDim.z;
    unsigned sum, cnt, mine, sp = 0u;
    for (;;) {
        sum = 0u; cnt = 0u; mine = 0u;
#pragma unroll
        for (unsigned j = 0; j < 16; ++j) { const unsigned c = xb_ld(&bar[XB_XCNT(j)]); sum += c; cnt += (c > 0u) ? 1u : 0u; mine = (j == x) ? c : mine; }
        if (sum == G) break;
        __builtin_amdgcn_s_sleep(1);
        if ((++sp & 255u) == 0u) { if (xb_ld(&bar[XB_TMO])) break; if (sp > XB_SPIN_CAP) { atomicAdd(&bar[XB_TMO], 1u); break; } }
    }
    nloc = mine > 0u ? mine : 1u; nx = cnt > 0u ? cnt : 1u;
}

__device__ __forceinline__ void xcd_barrier(const XcdBarrier& b) {
    asm volatile("s_waitcnt vmcnt(0)" ::: "memory");
    __syncthreads();
    if (threadIdx.x == 0) {
        unsigned* bar = b.bar;
        __builtin_amdgcn_s_waitcnt(0);
        unsigned nloc = b.st[0], nx = b.st[1];
        if (nloc == 0u) { xcd_barrier_complete(bar, b.x, nloc, nx); b.st[0] = nloc; b.st[1] = nx; }
        const unsigned old = xb_add(&bar[XB_XSUB(b.x)], 1u);
        const unsigned gen = old / nloc;
        if (old + 1u == (gen + 1u) * nloc) {
            __builtin_amdgcn_fence(__ATOMIC_RELEASE, "agent");
            asm volatile("s_waitcnt vmcnt(0)" ::: "memory");
            const unsigned og = xb_add(&bar[XB_TOP], 1u);
            const unsigned tg = og / nx;
            if (og + 1u == (tg + 1u) * nx) xb_add(&bar[XB_TOPGEN], 1u);
            else XB_SPIN(xb_ld(&bar[XB_TOPGEN]) == tg, bar);
            __builtin_amdgcn_fence(__ATOMIC_ACQUIRE, "agent");
            xb_add(&bar[XB_XGEN(b.x)], 1u);
            asm volatile("s_waitcnt vmcnt(0)" ::: "memory");
        } else {
            XB_SPIN(xb_ld(&bar[XB_XGEN(b.x)]) == gen, bar);
            __builtin_amdgcn_fence(__ATOMIC_ACQUIRE, "agent");
            asm volatile("s_waitcnt vmcnt(0)" ::: "memory");
        }
    }
    __syncthreads();
}

__device__ __forceinline__ int fresh_tid() { int t = threadIdx.x; asm volatile("" : "+v"(t)); return t; }
struct Frame {
    LAS unsigned char* lds;
    int tid, lane, wave, vcu, G;
    const float *in0, *in1, *in2, *in3, *in4, *in5, *in6, *in7, *in8, *in9, *in10, *in11, *in12, *in13, *in14, *in15, *in16, *in17, *in18, *in19, *in20, *in21, *in22, *in23, *in24, *in25, *in26, *in27, *in28; float* out; unsigned char* ws;
};

__device__ __forceinline__ void tr_item(const float* W, int ldn, int k0, int n0, bf16* WT, int ldk, int drow0, int dk0, const float* scale, int dup, LAS float* scr, int lane) {
#pragma unroll 8
    for (int i = 0; i < 32; ++i) { const int kk = 2 * i + (lane >> 5); float v = W[(size_t)(k0 + kk) * ldn + n0 + (lane & 31)]; if (scale) v *= scale[k0 + kk]; scr[kk * 33 + (lane & 31)] = v; }
    LDS_WAIT(); asm volatile("" ::: "memory");
    const int c = lane & 7;
#pragma unroll
    for (int j = 0; j < 4; ++j) { const int n = (lane >> 3) + 8 * j; const LAS float* s = scr + (8 * c) * 33 + n;
        v4u o; o.x = pk2(s[0 * 33], s[1 * 33]); o.y = pk2(s[2 * 33], s[3 * 33]); o.z = pk2(s[4 * 33], s[5 * 33]); o.w = pk2(s[6 * 33], s[7 * 33]);
        bf16* dp = WT + (size_t)(drow0 + n0 + n) * ldk + dk0 + k0 + 8 * c;
        *(GAS v4u*)dp = o; if (dup) *(GAS v4u*)(dp + dup) = o; }
    LDS_WAIT(); asm volatile("" ::: "memory");
}
__device__ __forceinline__ void p0_prologue(Frame& F) {
    LAS float* scr = (LAS float*)(F.lds + F.wave * 16384);
    unsigned char* ws = F.ws;
    const int gw = F.vcu * NWAVES + F.wave, NGW = F.G * NWAVES, lane = fresh_tid() & 63;
    constexpr int I_GU = 16 * 88, I_DN = 44 * 32, I_IN = 16 * 77, I_GT = 16 * 64, I_BR = 8 * 32, I_OUT = 16 * 32;
    constexpr int NITEMS = 4 * I_GU + 2 * I_DN + I_IN + I_GT + 2 * I_BR + I_OUT;
    for (int it = gw; it < NITEMS; it += NGW) {
        int r = it;
        if (r < 4 * I_GU) {
            const int which = r / I_GU; r -= which * I_GU; const int kb = r / 88, nb = r % 88, n0 = nb * 32;
            const float* W = which == 0 ? F.in2 : which == 1 ? F.in3 : which == 2 ? F.in25 : F.in26;
            tr_item(W, FF, kb * 64, n0, (bf16*)(ws + (which < 2 ? WS_WGU1 : WS_WGU2)), D, (n0 >> 7) * 256 + (which & 1) * 128 + (n0 & 127) - n0, 0, which < 2 ? F.in1 : F.in24, 0, scr, lane);
            continue; }
        r -= 4 * I_GU;
        if (r < 2 * I_DN) { const int which = r / I_DN; r -= which * I_DN; const int kb = r / 32, nb = r % 32;
            tr_item(which ? F.in27 : F.in4, D, kb * 64, nb * 32, (bf16*)(ws + (which ? WS_WDN2 : WS_WDN1)), FF, 0, 0, nullptr, 0, scr, lane); continue; }
        r -= 2 * I_DN;
        if (r < I_IN) { const int kb = r / 77, nb = r % 77, n0 = nb * 32;
            tr_item(F.in6, INC, kb * 64, n0, (bf16*)(ws + WS_WIN), D, n0 < 1696 ? 0 : 96, 0, F.in5, 0, scr, lane); continue; }
        r -= I_IN;
        if (r < I_GT) { const int kb = r / 64, nb = r % 64;
            tr_item(F.in6, INC, kb * 64, 2464 + nb * 32, (bf16*)(ws + WS_WGT), D, -2464, 0, F.in5, 0, scr, lane); continue; }
        r -= I_GT;
        if (r < 2 * I_BR) { const int which = r / I_BR; r -= which * I_BR; const int kb = r / 32, nb = r % 32;
            tr_item(which ? F.in22 : F.in21, D, kb * 64, nb * 32, (bf16*)(ws + (which ? WS_WBA : WS_WBR)), 512, 0, 0, nullptr, 0, scr, lane); continue; }
        r -= 2 * I_BR;
        { const int kb = r / 32, nb = r % 32; tr_item(F.in23, D, kb * 64, nb * 32, (bf16*)(ws + WS_WOUT), D, 0, 0, nullptr, 0, scr, lane); }
    }
    { GAS v4u* z = (GAS v4u*)(ws + WS_WIN + (size_t)1696 * D * 2); for (int i = gw * 64 + lane; i < 12288; i += NGW * 64) z[i] = (v4u){0u, 0u, 0u, 0u}; }
    { bf16* WL = (bf16*)(ws + WS_WLO);
      for (int i = gw * 64 + lane; i < 1536 * 256; i += NGW * 64) { const int n = i >> 8, k = i & 255, grp = n >> 9, nn = n & 511; float v = 0.f;
          if (grp == 0) { if (k < 32) v = F.in9[k * 512 + nn]; } else if (grp == 1) { if (k >= 32 && k < 64) v = F.in11[(k - 32) * 512 + nn]; } else { if (k >= 64 && k < 160) v = F.in12[(k - 64) * 512 + nn]; }
          WL[i] = (bf16)f2bf(v); } }
    { const float* x = F.in0; bf16* XB = (bf16*)(ws + WS_XB); float* part = (float*)(ws + WS_PART);
      for (int m = gw; m < M; m += NGW) { const GAS f32x4* xr = (const GAS f32x4*)(x + (size_t)m * D) + lane; f32x4 v[4]; float s = 0.f;
#pragma unroll
          for (int j = 0; j < 4; ++j) { v[j] = xr[64 * j]; s += (v[j].x * v[j].x + v[j].y * v[j].y) + (v[j].z * v[j].z + v[j].w * v[j].w); }
          s = wave_sum(s);
          GAS unsigned long long* o8 = (GAS unsigned long long*)(XB + (size_t)m * D) + lane;
#pragma unroll
          for (int j = 0; j < 4; ++j) o8[64 * j] = (unsigned long long)pk2(v[j].x, v[j].y) | ((unsigned long long)pk2(v[j].z, v[j].w) << 32);
          if (lane < 16) part[(size_t)m * 16 + lane] = lane == 0 ? s : 0.f; } }
}
__device__ __forceinline__ void p4_lora_in(Frame& F) {
    const bf16* RKVL = (const bf16*)(F.ws + WS_RKVL); bf16* LA = (bf16*)(F.ws + WS_LA); const float* mu = F.in7 + 1536;
    const int gw = F.vcu * NWAVES + F.wave, NGW = F.G * NWAVES, lane = fresh_tid() & 63, c0 = 4 * lane;
    for (int m = gw; m < M; m += NGW) {
        float o[4] = {0.f, 0.f, 0.f, 0.f};
        if (c0 < 160) {
            const v2u cu = *(const GAS v2u*)(RKVL + (size_t)m * 1792 + 1536 + c0);
            v2u pu = (v2u){0u, 0u}; if ((m & (T - 1)) != 0) pu = *(const GAS v2u*)(RKVL + (size_t)(m - 1) * 1792 + 1536 + c0);
            const float cur[4] = {bflo(cu.x), bfhi(cu.x), bflo(cu.y), bfhi(cu.y)}, prv[4] = {bflo(pu.x), bfhi(pu.x), bflo(pu.y), bfhi(pu.y)};
            const f32x4 mv = *(const GAS f32x4*)(mu + c0);
#pragma unroll
            for (int j = 0; j < 4; ++j) { const float p = cur[j] + (prv[j] - cur[j]) * mv[j]; const int c = c0 + j;
                o[j] = c < 32 ? tanhf(p) : (c < 64 ? p : 1.0f / (1.0f + __expf(-p))); }
        }
        *(GAS v2u*)(LA + (size_t)m * 256 + c0) = (v2u){pk2(o[0], o[1]), pk2(o[2], o[3])};
    }
}
__device__ __forceinline__ float sum8(float v) { v += __shfl_xor(v, 1); v += __shfl_xor(v, 2); v += __shfl_xor(v, 4); return v; }
__device__ __forceinline__ void unpack8(const v4u u, float (&f)[8]) { f[0] = bflo(u.x); f[1] = bfhi(u.x); f[2] = bflo(u.y); f[3] = bfhi(u.y); f[4] = bflo(u.z); f[5] = bfhi(u.z); f[6] = bflo(u.w); f[7] = bfhi(u.w); }
__device__ __forceinline__ v4u pack8u(const float (&f)[8]) { return (v4u){pk2(f[0], f[1]), pk2(f[2], f[3]), pk2(f[4], f[5]), pk2(f[6], f[7])}; }
__device__ __forceinline__ void ld8f(const float* p, float (&f)[8]) { const f32x4 a = *(const GAS f32x4*)p, b = *(const GAS f32x4*)(p + 4); f[0] = a.x; f[1] = a.y; f[2] = a.z; f[3] = a.w; f[4] = b.x; f[5] = b.y; f[6] = b.z; f[7] = b.w; }
__device__ __forceinline__ void p6_prep(Frame& F) {
    const bf16* RKVL = (const bf16*)(F.ws + WS_RKVL); bf16* REC = (bf16*)(F.ws + WS_REC); f32x4* SC = (f32x4*)(F.ws + WS_SC);
    constexpr size_t SL = REC_SLOT / 2;
    const int gw = F.vcu * NWAVES + F.wave, NGW = F.G * NWAVES, lane = fresh_tid() & 63, h = lane >> 3, c0 = 8 * lane, n0 = 8 * (lane & 7);
    float mur[8], muk[8], muv[8], kkw[8], kaw[8], rkw[8];
    ld8f(F.in7 + c0, mur); ld8f(F.in7 + 512 + c0, muk); ld8f(F.in7 + 1024 + c0, muv); ld8f(F.in13 + c0, kkw); ld8f(F.in14 + c0, kaw); ld8f(F.in15 + c0, rkw);
    for (int m = gw; m < M; m += NGW) {
        const int b = m >> 12, t = m & (T - 1); const bool hp = t != 0;
        const bf16* cr = RKVL + (size_t)m * 1792 + c0; const bf16* pr = cr - (hp ? 1792 : 0);
        const size_t ri = ((size_t)(b * 8 + h) * T + t) * 64 + n0;
        const v4u ur = *(const GAS v4u*)cr, uk = *(const GAS v4u*)(cr + 512), uv = *(const GAS v4u*)(cr + 1024);
        const v4u pr_ = *(const GAS v4u*)pr, pk_ = *(const GAS v4u*)(pr + 512), pv_ = *(const GAS v4u*)(pr + 1024);
        const v4u ua = *(const GAS v4u*)(REC + 4 * SL + ri);
        float r[8], k[8], v[8], rp[8], kp[8], vp[8], a[8];
        unpack8(ur, r); unpack8(uk, k); unpack8(uv, v); unpack8(pr_, rp); unpack8(pk_, kp); unpack8(pv_, vp); unpack8(ua, a);
        float kk[8], ss = 0.f;
#pragma unroll
        for (int j = 0; j < 8; ++j) { const float rpj = hp ? rp[j] : 0.f, kpj = hp ? kp[j] : 0.f, vpj = hp ? vp[j] : 0.f;
            r[j] += (rpj - r[j]) * mur[j]; k[j] += (kpj - k[j]) * muk[j]; v[j] += (vpj - v[j]) * muv[j];
            kk[j] = k[j] * kkw[j]; ss += kk[j] * kk[j]; }
        const float inv = 1.0f / fmaxf(sqrtf(sum8(ss)), 1e-12f);
        float an[8], bn[8], kn[8];
#pragma unroll
        for (int j = 0; j < 8; ++j) { kk[j] *= inv; an[j] = -kk[j]; bn[j] = kk[j] * a[j]; kn[j] = k[j] * (1.0f + (a[j] - 1.0f) * kaw[j]); }
        const v4u oa = pack8u(an), orr = pack8u(r), ok = pack8u(kn), ob = pack8u(bn), ov = pack8u(v);
        float rq[8], kq[8], bq[8]; unpack8(orr, rq); unpack8(ok, kq); unpack8(ob, bq);
        float sb = 0.f, sk = 0.f, sbo = 0.f;
#pragma unroll
        for (int j = 0; j < 8; ++j) { sb += bq[j] * rq[j]; sk += kq[j] * rq[j]; sbo += rq[j] * kq[j] * rkw[j]; }
        sb = sum8(sb); sk = sum8(sk); sbo = sum8(sbo);
        *(GAS v4u*)(REC + 1 * SL + ri) = oa; *(GAS v4u*)(REC + 2 * SL + ri) = orr; *(GAS v4u*)(REC + 3 * SL + ri) = ok; *(GAS v4u*)(REC + 4 * SL + ri) = ob; *(GAS v4u*)(REC + 5 * SL + ri) = ov;
        if ((lane & 7) == 0) SC[(size_t)(b * 8 + h) * T + t] = (f32x4){sb, sk, sbo, 0.f};
    }
}
constexpr int KS_STRIDE = 144, VT_STRIDE = 528, ATT_KS_OFF = 0, ATT_VT_OFF = 256 * KS_STRIDE;
__device__ __forceinline__ void p6_attention(Frame& F) {
    bf16* ATTQ = (bf16*)(F.ws + WS_ATTQ); const bf16* ATTKV = (const bf16*)(F.ws + WS_ATTKV);
    const float* qn = F.in18; const float* kn = F.in19; const float* sinks = F.in20;
    LAS unsigned char* Ks = F.lds + ATT_KS_OFF; LAS unsigned char* Vt = F.lds + ATT_VT_OFF;
    const int tid = fresh_tid(), lane = tid & 63, w = F.wave, g = lane >> 4, n16 = lane & 15;
    for (int unit = F.vcu; unit < BATCH * 2 * 32; unit += F.G) {
        const int nb = unit & 31, kvh = (unit >> 5) & 1, b = unit >> 6; const int m0 = b * T + nb * 128;
#pragma unroll
        for (int i = 0; i < 4; ++i) { const int e = tid + 512 * i, key = e >> 3, dg = e & 7; const bool valid = nb > 0 || key >= 128;
            v4u ku = (v4u){0u, 0u, 0u, 0u}, vu = (v4u){0u, 0u, 0u, 0u};
            if (valid) { const bf16* src = ATTKV + (size_t)(m0 - 128 + key) * 256 + kvh * 64 + dg * 8; ku = *(const GAS v4u*)src; vu = *(const GAS v4u*)(src + 128); }
            float kf[8] = {bflo(ku.x), bfhi(ku.x), bflo(ku.y), bfhi(ku.y), bflo(ku.z), bfhi(ku.z), bflo(ku.w), bfhi(ku.w)};
            float ss = 0.f;
#pragma unroll
            for (int j = 0; j < 8; ++j) ss += kf[j] * kf[j];
            ss += __shfl_xor(ss, 1); ss += __shfl_xor(ss, 2); ss += __shfl_xor(ss, 4);
            const float rs = 1.0f / sqrtf(ss * (1.0f / 64.0f) + RMS_EPS);
#pragma unroll
            for (int j = 0; j < 8; ++j) kf[j] *= rs * kn[dg * 8 + j];
            *(LAS v4u*)(Ks + key * KS_STRIDE + dg * 16) = (v4u){pk2(kf[0], kf[1]), pk2(kf[2], kf[3]), pk2(kf[4], kf[5]), pk2(kf[6], kf[7])};
            const unsigned vv[4] = {vu.x, vu.y, vu.z, vu.w};
#pragma unroll
            for (int j = 0; j < 8; ++j) *(LAS bf16*)(Vt + (dg * 8 + j) * VT_STRIDE + key * 2) = (bf16)((vv[j >> 1] >> ((j & 1) * 16)) & 0xffffu);
        }
        __syncthreads();
        const int hq = kvh * 4 + (w >> 1), qbase = (w & 1) * 64; const float sink = sinks[hq];
        for (int qt = 0; qt < 4; ++qt) {
            const int q0 = qbase + 16 * qt, qi = q0 + n16, kt0 = q0 >> 4;
            bf16* qp = ATTQ + (size_t)(m0 + qi) * 512 + hq * 64 + 8 * g;
            const v4u qa = *(const GAS v4u*)qp, qb = *(const GAS v4u*)(qp + 32);
            float q[16] = {bflo(qa.x), bfhi(qa.x), bflo(qa.y), bfhi(qa.y), bflo(qa.z), bfhi(qa.z), bflo(qa.w), bfhi(qa.w),
                           bflo(qb.x), bfhi(qb.x), bflo(qb.y), bfhi(qb.y), bflo(qb.z), bfhi(qb.z), bflo(qb.w), bfhi(qb.w)};
            float ss = 0.f;
#pragma unroll
            for (int j = 0; j < 16; ++j) ss += q[j] * q[j];
            ss += __shfl_xor(ss, 16); ss += __shfl_xor(ss, 32);
            const float rs = 0.125f / sqrtf(ss * (1.0f / 64.0f) + RMS_EPS);
#pragma unroll
            for (int j = 0; j < 16; ++j) q[j] *= rs * qn[(j >> 3) * 32 + 8 * g + (j & 7)];
            const v4u qf0 = (v4u){pk2(q[0], q[1]), pk2(q[2], q[3]), pk2(q[4], q[5]), pk2(q[6], q[7])}, qf1 = (v4u){pk2(q[8], q[9]), pk2(q[10], q[11]), pk2(q[12], q[13]), pk2(q[14], q[15])};
            const bf16x8 bq0 = __builtin_bit_cast(bf16x8, qf0), bq1 = __builtin_bit_cast(bf16x8, qf1);
            f32x4 st[10]; float mx = -INFINITY;
#pragma unroll
            for (int i = 0; i < 10; ++i) { const int kt = kt0 + i, ktc = kt < 16 ? kt : 15;
                const LAS unsigned char* kp = Ks + (16 * ktc + n16) * KS_STRIDE + 16 * g;
                const bf16x8 a0 = *(const LAS bf16x8*)kp, a1 = *(const LAS bf16x8*)(kp + 64);
                f32x4 acc = (f32x4){0.f, 0.f, 0.f, 0.f};
                acc = __builtin_amdgcn_mfma_f32_16x16x32_bf16(a0, bq0, acc, 0, 0, 0);
                acc = __builtin_amdgcn_mfma_f32_16x16x32_bf16(a1, bq1, acc, 0, 0, 0);
#pragma unroll
                for (int r = 0; r < 4; ++r) { const int kj = 16 * kt + 4 * g + r; const bool ok = (kj > qi) && (kj <= qi + 128) && (nb > 0 || kj >= 128);
                    acc[r] = ok ? acc[r] : -INFINITY; mx = fmaxf(mx, acc[r]); }
                st[i] = acc; }
            mx = fmaxf(mx, __shfl_xor(mx, 16)); mx = fmaxf(mx, __shfl_xor(mx, 32)); mx = fmaxf(mx, sink);
            float den = 0.f;
#pragma unroll
            for (int i = 0; i < 10; ++i)
#pragma unroll
                for (int r = 0; r < 4; ++r) { const float p = __expf(st[i][r] - mx); st[i][r] = p; den += p; }
            den += __shfl_xor(den, 16); den += __shfl_xor(den, 32); den += __expf(sink - mx);
            const float inv = 1.0f / den;
            f32x4 o[4];
#pragma unroll
            for (int dt = 0; dt < 4; ++dt) o[dt] = (f32x4){0.f, 0.f, 0.f, 0.f};
#pragma unroll
            for (int j = 0; j < 5; ++j) { const int ka = kt0 + 2 * j, kb2 = ka + 1, kac = ka < 16 ? ka : 15, kbc = kb2 < 16 ? kb2 : 15;
                const v4u pu = (v4u){pk2(st[2 * j][0], st[2 * j][1]), pk2(st[2 * j][2], st[2 * j][3]), pk2(st[2 * j + 1][0], st[2 * j + 1][1]), pk2(st[2 * j + 1][2], st[2 * j + 1][3])};
                const bf16x8 pf = __builtin_bit_cast(bf16x8, pu);
#pragma unroll
                for (int dt = 0; dt < 4; ++dt) { const LAS unsigned char* vp = Vt + (16 * dt + n16) * VT_STRIDE;
                    const v2u va = *(const LAS v2u*)(vp + (16 * kac + 4 * g) * 2), vb = *(const LAS v2u*)(vp + (16 * kbc + 4 * g) * 2);
                    const bf16x8 af = __builtin_bit_cast(bf16x8, (v4u){va.x, va.y, vb.x, vb.y});
                    o[dt] = __builtin_amdgcn_mfma_f32_16x16x32_bf16(af, pf, o[dt], 0, 0, 0); } }
            bf16* op = ATTQ + (size_t)(m0 + qi) * 512 + hq * 64 + 4 * g;
#pragma unroll
            for (int dt = 0; dt < 4; ++dt) *(GAS v2u*)(op + 16 * dt) = (v2u){pk2(o[dt][0] * inv, o[dt][1] * inv), pk2(o[dt][2] * inv, o[dt][3] * inv)};
        }
        __syncthreads();
    }
}
constexpr int SC_NS = 32, SC_AW = 0, SC_WV = 16384, SC_KV = 24576, SC_BV = 32768, SC_VS = 40960, SC_YB = 49152, SC_BUF = 51200;
struct ScanPre { v4u ulw, ua, ur, uk, ub; unsigned uv; f32x4 sc; };
__device__ __forceinline__ ScanPre scan_issue(Frame& F, int bh, int quarter, int t0, int lt) {
    const unsigned char* REC = F.ws + WS_REC; const f32x4* SC = (const f32x4*)(F.ws + WS_SC);
    const size_t eoff = ((size_t)bh * T + t0) * 128 + (size_t)lt * 16;
    ScanPre p;
    p.ulw = *(const GAS v4u*)(REC + 0 * REC_SLOT + eoff); p.ua = *(const GAS v4u*)(REC + 1 * REC_SLOT + eoff); p.ur = *(const GAS v4u*)(REC + 2 * REC_SLOT + eoff);
    p.uk = *(const GAS v4u*)(REC + 3 * REC_SLOT + eoff); p.ub = *(const GAS v4u*)(REC + 4 * REC_SLOT + eoff);
    const int s = lt >> 3, rp = 2 * (lt & 7);
    p.uv = *(const GAS unsigned*)(REC + 5 * REC_SLOT + (((size_t)bh * T + t0 + s) * 64 + 16 * quarter + rp) * 2);
    p.sc = *(const GAS f32x4*)(SC + (size_t)bh * T + t0 + s);
    return p;
}
__device__ __forceinline__ void scan_commit(const ScanPre& p, LAS unsigned char* buf, int lt) {
    const v4u ulw = p.ulw, ua = p.ua, ur = p.ur, uk = p.uk, ub = p.ub; const unsigned uv = p.uv; const f32x4 sc = p.sc;
    const int s = lt >> 3, e0 = 8 * (lt & 7), rp = 2 * (lt & 7);
    const unsigned lw4[4] = {ulw.x, ulw.y, ulw.z, ulw.w}, a4[4] = {ua.x, ua.y, ua.z, ua.w}, r4[4] = {ur.x, ur.y, ur.z, ur.w}, k4[4] = {uk.x, uk.y, uk.z, uk.w}, b4[4] = {ub.x, ub.y, ub.z, ub.w};
    float w[8], av[8], wr[8], kv[8], bv[8];
#pragma unroll
    for (int i = 0; i < 4; ++i) {
        w[2 * i] = __expf(bflo(lw4[i])); w[2 * i + 1] = __expf(bfhi(lw4[i]));
        av[2 * i] = bflo(a4[i]); av[2 * i + 1] = bfhi(a4[i]);
        wr[2 * i] = w[2 * i] * bflo(r4[i]); wr[2 * i + 1] = w[2 * i + 1] * bfhi(r4[i]);
        kv[2 * i] = bflo(k4[i]); kv[2 * i + 1] = bfhi(k4[i]);
        bv[2 * i] = bflo(b4[i]); bv[2 * i + 1] = bfhi(b4[i]); }
    LAS f32x4* AW = (LAS f32x4*)(buf + SC_AW); const int q0 = e0 >> 2;
#pragma unroll
    for (int qq = 0; qq < 2; ++qq)
#pragma unroll
        for (int hh = 0; hh < 2; ++hh) { const int e = 4 * qq + 2 * hh; AW[(s * 2 + hh) * 16 + q0 + qq] = (f32x4){av[e], wr[e], av[e + 1], wr[e + 1]}; }
    LAS f32x4* WV = (LAS f32x4*)(buf + SC_WV); LAS f32x4* KV = (LAS f32x4*)(buf + SC_KV); LAS f32x4* BV = (LAS f32x4*)(buf + SC_BV);
#pragma unroll
    for (int qq = 0; qq < 2; ++qq) { const int e = 4 * qq;
        WV[s * 16 + q0 + qq] = (f32x4){w[e], w[e + 1], w[e + 2], w[e + 3]}; KV[s * 16 + q0 + qq] = (f32x4){kv[e], kv[e + 1], kv[e + 2], kv[e + 3]}; BV[s * 16 + q0 + qq] = (f32x4){bv[e], bv[e + 1], bv[e + 2], bv[e + 3]}; }
    LAS f32x4* VS = (LAS f32x4*)(buf + SC_VS); const float v0 = bflo(uv), v1 = bfhi(uv);
    VS[s * 16 + rp] = (f32x4){v0, v0 * sc.y, sc.x, 0.f}; VS[s * 16 + rp + 1] = (f32x4){v1, v1 * sc.y, sc.x, 0.f};
}
__device__ __forceinline__ void scan_flush(Frame& F, int bh, int quarter, int t0, const LAS unsigned char* buf, int lt) {
    if (lt < 128) { const int s = lt >> 2, c4 = lt & 3; const int b = bh >> 3, h = bh & 7;
        float* yraw = (float*)(F.ws + WS_YRAW);
        const f32x4 y = *(const LAS f32x4*)(buf + SC_YB + (s * 16 + 4 * c4) * 4);
        *(GAS f32x4*)(yraw + (size_t)(b * T + t0 + s) * 512 + h * 64 + 16 * quarter + 4 * c4) = y; }
}
__device__ __forceinline__ void p7_scan(Frame& F) {
    const int w = F.wave, tid = fresh_tid(), lane = tid & 63, rl = lane >> 4, q = lane & 15, lt = tid - 256;
    constexpr int NBLK = T / SC_NS;
#define SCAN_BAR() do { asm volatile("s_waitcnt lgkmcnt(0)" ::: "memory"); __builtin_amdgcn_s_barrier(); asm volatile("" ::: "memory"); } while (0)
    for (int unit = F.vcu; unit < 256; unit += F.G) {
        const int bh = unit >> 2, quarter = unit & 3;
        ScanPre pre;
        if (w >= 4) { pre = scan_issue(F, bh, quarter, 0, lt); scan_commit(pre, F.lds, lt); pre = scan_issue(F, bh, quarter, SC_NS, lt); }
        SCAN_BAR();
        float S0 = 0.f, S1 = 0.f, S2 = 0.f, S3 = 0.f;
        for (int nb = 0; nb < NBLK; ++nb) {
            LAS unsigned char* cur = F.lds + (nb & 1) * SC_BUF; LAS unsigned char* oth = F.lds + ((nb + 1) & 1) * SC_BUF;
            if (w >= 4) {
                if (nb > 0) scan_flush(F, bh, quarter, (nb - 1) * SC_NS, oth, lt);
                if (nb + 1 < NBLK) scan_commit(pre, oth, lt);
                if (nb + 2 < NBLK) pre = scan_issue(F, bh, quarter, (nb + 2) * SC_NS, lt);
            } else {
                const LAS f32x4* AW = (const LAS f32x4*)(cur + SC_AW); const LAS f32x4* WV = (const LAS f32x4*)(cur + SC_WV); const LAS f32x4* KV = (const LAS f32x4*)(cur + SC_KV);
                const LAS f32x4* BV = (const LAS f32x4*)(cur + SC_BV); const LAS f32x4* VS = (const LAS f32x4*)(cur + SC_VS); LAS float* YB = (LAS float*)(cur + SC_YB);
                const int rowl = 4 * w + rl;
                f32x4 aw0 = AW[q], aw1 = AW[16 + q], wv = WV[q], kv = KV[q], bv = BV[q], vs = VS[rowl];
#pragma unroll 8
                for (int s = 0; s < SC_NS; ++s) {
                    const int sn = s + 1;
                    const f32x4 n_aw0 = AW[(sn * 2) * 16 + q], n_aw1 = AW[(sn * 2 + 1) * 16 + q], n_wv = WV[sn * 16 + q], n_kv = KV[sn * 16 + q], n_bv = BV[sn * 16 + q], n_vs = VS[sn * 16 + rowl];
                    __builtin_amdgcn_sched_barrier(0);
                    float sa = S0 * aw0.x; sa = fmaf(S1, aw0.z, sa); sa = fmaf(S2, aw1.x, sa); sa = fmaf(S3, aw1.z, sa);
                    float z = S0 * aw0.y; z = fmaf(S1, aw0.w, z); z = fmaf(S2, aw1.y, z); z = fmaf(S3, aw1.w, z);
                    const float t0_ = fmaf(vs.x, kv.x, S0 * wv.x), t1_ = fmaf(vs.x, kv.y, S1 * wv.y), t2_ = fmaf(vs.x, kv.z, S2 * wv.z), t3_ = fmaf(vs.x, kv.w, S3 * wv.w);
                    sa = row16_sum(sa); z = row16_sum(z);
                    S0 = fmaf(sa, bv.x, t0_); S1 = fmaf(sa, bv.y, t1_); S2 = fmaf(sa, bv.z, t2_); S3 = fmaf(sa, bv.w, t3_);
                    YB[s * 16 + rowl] = fmaf(sa, vs.z, z) + vs.y;
                    aw0 = n_aw0; aw1 = n_aw1; wv = n_wv; kv = n_kv; bv = n_bv; vs = n_vs;
                }
            }
            SCAN_BAR();
        }
        if (w >= 4) scan_flush(F, bh, quarter, T - SC_NS, F.lds + ((NBLK - 1) & 1) * SC_BUF, lt);
        asm volatile("s_waitcnt vmcnt(0)" ::: "memory"); SCAN_BAR();
    }
#undef SCAN_BAR
}
__device__ __forceinline__ void p8_post(Frame& F) {
    const float* yraw = (const float*)(F.ws + WS_YRAW); const bf16* RV = (const bf16*)(F.ws + WS_REC + 5 * REC_SLOT); const f32x4* SC = (const f32x4*)(F.ws + WS_SC);
    const bf16* Gt = (const bf16*)(F.ws + WS_G); bf16* YR = (bf16*)(F.ws + WS_YR);
    const int gw = F.vcu * NWAVES + F.wave, NGW = F.G * NWAVES, lane = fresh_tid() & 63, h = lane >> 3, c0 = 8 * lane, n0 = 8 * (lane & 7);
    float lw[8], lb[8]; ld8f(F.in16 + c0, lw); ld8f(F.in17 + c0, lb);
    for (int m = gw; m < M; m += NGW) {
        const int b = m >> 12, t = m & (T - 1); const size_t rt = (size_t)(b * 8 + h) * T + t;
        float y[8]; ld8f(yraw + (size_t)m * 512 + c0, y);
        const v4u uv = *(const GAS v4u*)(RV + rt * 64 + n0), ug = *(const GAS v4u*)(Gt + (size_t)m * 512 + c0); const float bonus = SC[rt].z;
        float v[8], g[8]; unpack8(uv, v); unpack8(ug, g);
        float s1 = 0.f;
#pragma unroll
        for (int j = 0; j < 8; ++j) s1 += y[j];
        const float mean = sum8(s1) * (1.0f / 64.0f); float s2 = 0.f;
#pragma unroll
        for (int j = 0; j < 8; ++j) { y[j] -= mean; s2 += y[j] * y[j]; }
        const float rstd = 1.0f / sqrtf(sum8(s2) * (1.0f / 64.0f) + GN_EPS);
        float o[8];
#pragma unroll
        for (int j = 0; j < 8; ++j) o[j] = (y[j] * rstd * lw[j] + lb[j] + bonus * v[j]) * g[j];
        *(GAS v4u*)(YR + (size_t)m * 512 + c0) = pack8u(o);
    }
}
__device__ __forceinline__ void p13_final(Frame& F) {
    const float* part = (const float*)(F.ws + WS_PART + 3 * 2 * MiB); const float* gn = F.in28;
    const int gw = F.vcu * NWAVES + F.wave, NGW = F.G * NWAVES, lane = fresh_tid() & 63;
    for (int m = gw; m < M; m += NGW) {
        float s = lane < 16 ? part[(size_t)m * 16 + lane] : 0.f; s = wave_sum(s);
        const float rs = 1.0f / sqrtf(s * (1.0f / 1024.0f) + RMS_EPS);
        GAS f32x4* xr = (GAS f32x4*)(F.out + (size_t)m * D) + lane; const GAS f32x4* gr = (const GAS f32x4*)gn + lane;
#pragma unroll
        for (int j = 0; j < 4; ++j) { const f32x4 v = xr[64 * j], g4 = gr[64 * j]; xr[64 * j] = v * rs * g4; }
    }
}
struct Args { const float* in[29]; float* out; unsigned char* ws; };
__global__ void __launch_bounds__(NWAVES * 64, 2) fwd_megakernel(Args args) {
    extern __shared__ __attribute__((aligned(16))) unsigned char lds[];
    cg::grid_group grid = cg::this_grid();
    Frame F;
    F.lds = (LAS unsigned char*)lds;
    F.tid = threadIdx.x; F.lane = F.tid & 63; F.wave = __builtin_amdgcn_readfirstlane(F.tid >> 6);
    F.G = gridDim.x; { const int bx = blockIdx.x; F.vcu = (F.G % 8 == 0) ? (bx % 8) * (F.G / 8) + bx / 8 : bx; }
F.in0 = args.in[0]; F.in1 = args.in[1]; F.in2 = args.in[2]; F.in3 = args.in[3]; F.in4 = args.in[4]; F.in5 = args.in[5]; F.in6 = args.in[6]; F.in7 = args.in[7]; F.in8 = args.in[8]; F.in9 = args.in[9]; F.in10 = args.in[10]; F.in11 = args.in[11]; F.in12 = args.in[12]; F.in13 = args.in[13]; F.in14 = args.in[14]; F.in15 = args.in[15]; F.in16 = args.in[16]; F.in17 = args.in[17]; F.in18 = args.in[18]; F.in19 = args.in[19]; F.in20 = args.in[20]; F.in21 = args.in[21]; F.in22 = args.in[22]; F.in23 = args.in[23]; F.in24 = args.in[24]; F.in25 = args.in[25]; F.in26 = args.in[26]; F.in27 = args.in[27]; F.in28 = args.in[28];
    F.out = args.out; F.ws = args.ws;
    unsigned char* ws = args.ws;
    bf16* XB = (bf16*)(ws + WS_XB); bf16* HB = (bf16*)(ws + WS_H);
    float* PA = (float*)(ws + WS_PART); float* PB = PA + (size_t)M * 16; float* PC = PB + (size_t)M * 16; float* PD = PC + (size_t)M * 16;
    using pg8::gemm_phase; using pg8::StaticOrder; using pg8::Gemm;
    volatile LAS unsigned* bst = (volatile LAS unsigned*)(F.lds + RING_BYTES);
    if (F.tid == 0) { bst[0] = 0u; bst[1] = 0u; }
    __syncthreads();
    XcdBarrier bar = xcd_barrier_post((unsigned*)ws, bst);
#define SYNC() xcd_barrier(bar)
#define RUN_GEMM(EPI, Aptr, Bptr, NN, KK, ...) do { Gemm g_{(const pg8::bf16_t*)(Aptr), (const pg8::bf16_t*)(Bptr), M, (NN), (KK)}; StaticOrder S_; S_.init(M, (NN), F.G, (int)blockIdx.x); \
        pg8::EPI E_{__VA_ARGS__}; gemm_phase<pg8::EPI, StaticOrder, true, true>(F.lds, g_, S_, E_); } while (0)

    p0_prologue(F); grid.sync();
    RUN_GEMM(EpiGU, XB, ws + WS_WGU1, 2 * FF, D, HB, PA); SYNC();
    RUN_GEMM(EpiRes, HB, ws + WS_WDN1, D, FF, F.in0, F.out, XB, PB, 0.5f); SYNC();
    RUN_GEMM(EpiProj, XB, ws + WS_WIN, 2560, D, (bf16*)(ws + WS_RKVL), (bf16*)(ws + WS_ATTQ), (bf16*)(ws + WS_ATTKV), PB); SYNC();
    p4_lora_in(F); SYNC();
    RUN_GEMM(EpiLora, ws + WS_LA, ws + WS_WLO, 1536, 256, (bf16*)(ws + WS_REC), (bf16*)(ws + WS_REC + 4 * REC_SLOT), (bf16*)(ws + WS_G), F.in8, F.in10); SYNC();
    p6_prep(F); p6_attention(F); SYNC();
    p7_scan(F); SYNC();
    p8_post(F); SYNC();
    RUN_GEMM(EpiGate, XB, ws + WS_WGT, 2048, D, (bf16*)(ws + WS_GATES), PB); SYNC();
    RUN_GEMM(EpiBranch, ws + WS_YR, ws + WS_WBR, D, 512, (const bf16*)(ws + WS_GATES), (bf16*)(ws + WS_MERGED), 0, 0);
    RUN_GEMM(EpiBranch, ws + WS_ATTQ, ws + WS_WBA, D, 512, (const bf16*)(ws + WS_GATES), (bf16*)(ws + WS_MERGED), 1024, 1); SYNC();
    RUN_GEMM(EpiRes, ws + WS_MERGED, ws + WS_WOUT, D, D, F.out, F.out, XB, PC, 1.0f); SYNC();
    RUN_GEMM(EpiGU, XB, ws + WS_WGU2, 2 * FF, D, HB, PC); SYNC();
    RUN_GEMM(EpiRes, HB, ws + WS_WDN2, D, FF, F.out, F.out, (bf16*)nullptr, PD, 0.5f); SYNC();
    p13_final(F);
}

extern "C" void kernel_launch(void* const* d_in, const int* in_sizes, int n_in, void* d_out, int out_size, void* d_ws, size_t ws_size, hipStream_t stream) {
    static int grid = 0;
    if (grid == 0) {
        if (n_in != 29 || in_sizes[0] != M * D || out_size != M * D || ws_size < WS_END) { fprintf(stderr, "kernel_launch: unexpected shapes (n_in %d, ws %zu)\n", n_in, ws_size); grid = -1; return; }
        int dev = 0, cus = 0, per_cu = 0;
        hipGetDevice(&dev); hipDeviceGetAttribute(&cus, hipDeviceAttributeMultiprocessorCount, dev);
        if (hipFuncSetAttribute((const void*)fwd_megakernel, hipFuncAttributeMaxDynamicSharedMemorySize, LDS_BYTES) != hipSuccess) { fprintf(stderr, "kernel_launch: hipFuncSetAttribute failed\n"); grid = -1; return; }
        hipOccupancyMaxActiveBlocksPerMultiprocessor(&per_cu, (const void*)fwd_megakernel, NWAVES * 64, LDS_BYTES);
        (void)hipGetLastError();
        if (per_cu < 1) fprintf(stderr, "kernel_launch: occupancy query says %d blocks/CU\n", per_cu);
        grid = cus;
    }
    if (grid < 0) return;
    if (hipMemsetAsync(d_ws, 0, 16384, stream) != hipSuccess) { fprintf(stderr, "kernel_launch: memset failed\n"); return; }
    Args a{};
    for (int i = 0; i < 29; ++i) a.in[i] = (const float*)d_in[i];
    a.out = (float*)d_out; a.ws = (unsigned char*)d_ws;
    void* kargs[] = {&a};
    hipError_t e = hipLaunchCooperativeKernel((const void*)fwd_megakernel, dim3(grid), dim3(NWAVES * 64), kargs, LDS_BYTES, stream);
    if (e != hipSuccess) fprintf(stderr, "kernel_launch: cooperative launch failed: %s (grid %d)\n", hipGetErrorString(e), grid);
}
```

```cpp
#include <hip/hip_runtime.h>
#include <hip/hip_cooperative_groups.h>
#include <cstdio>
#include <cstdint>
namespace cg = cooperative_groups;
namespace pg8 {
#define PG8_LAS __attribute__((address_space(3)))
typedef unsigned short bf16_t;
typedef short bf16x8 __attribute__((ext_vector_type(8)));
typedef float f32x4 __attribute__((ext_vector_type(4)));
typedef unsigned u32x4 __attribute__((ext_vector_type(4)));
constexpr int BM = 256, BK = 64, HALF = 128, HTB = HALF * BK * 2  , STAGE_BYTES = 8 * HTB, NXCD = 8, WGM = 8;

__host__ __device__ __forceinline__ int lds_byte(int r, int c) { const int st = (r >> 4) * 2 + (c >> 5), rr = r & 15, cc = c & 31, ob = rr * 64 + cc * 2; return st * 1024 + (ob ^ (((ob >> 9) & 1) << 5)); }
__host__ __device__ __forceinline__ void stage_rc(int b, int& R, int& C) { const int st = b / 1024, sb = b % 1024, swz = sb ^ (((sb >> 9) & 1) << 5); R = (st >> 1) * 16 + swz / 64; C = (st & 1) * 32 + (swz % 64) / 2; }
__host__ __device__ __forceinline__ int perm32(int rho) { const int n = rho >> 4, i = rho & 15; return 8 * (i >> 2) + 4 * n + (i & 3); }

struct Unit { int pm, pn; };
struct Gemm { const bf16_t* A; const bf16_t* Bt; int M, N, K; };

struct StaticOrder {
    int nM, nN, nwg, G, c;
    __host__ __device__ void init(int M, int N, int G_, int c_) { nM = M / BM; nN = N / BM; nwg = nM * nN; G = G_; c = c_; }
    __host__ __device__ bool next(int i, Unit& u) const {
        const long L = (long)i * G + c; if (L >= nwg) return false;
        int wgid = (int)L; { const int q = nwg / NXCD, r = nwg % NXCD, xcd = wgid % NXCD, off = wgid / NXCD; wgid = (xcd < r ? xcd * (q + 1) : r * (q + 1) + (xcd - r) * q) + off; }
        const int nig = WGM * nN, gid = wgid / nig, fm = gid * WGM, gsz = (nM - fm) < WGM ? (nM - fm) : WGM;
        u.pm = fm + ((wgid % nig) % gsz); u.pn = (wgid % nig) / gsz; return true;
    }
    __device__ __forceinline__ void a_ready(const Unit&) const {}
    __device__ __forceinline__ void done(const Unit&) const {}
};

__device__ __forceinline__ unsigned cvt_pk_bf16(float lo, float hi) { unsigned r; asm volatile("v_cvt_pk_bf16_f32 %0, %1, %2" : "=v"(r) : "v"(lo), "v"(hi)); return r; }
__device__ __forceinline__ u32x4 pack8(f32x4 v0, f32x4 v1) {
    u32x4 w;
    asm volatile("s_nop 1\n\tv_cvt_pk_bf16_f32 %0, %4, %5\n\tv_cvt_pk_bf16_f32 %1, %6, %7\n\tv_cvt_pk_bf16_f32 %2, %8, %9\n\tv_cvt_pk_bf16_f32 %3, %10, %11"
                 : "=&v"(w.x), "=&v"(w.y), "=&v"(w.z), "=&v"(w.w)
                 : "v"(v0[0]), "v"(v0[1]), "v"(v0[2]), "v"(v0[3]), "v"(v1[0]), "v"(v1[1]), "v"(v1[2]), "v"(v1[3]));
    return w;
}
__device__ __forceinline__ float bf_lo(unsigned u) { return __uint_as_float(u << 16); }
__device__ __forceinline__ float bf_hi(unsigned u) { return __uint_as_float(u & 0xffff0000u); }
__device__ __forceinline__ void rows_rstd(const float* part, int row0, int fq, float (&rs)[2][4]) {
#pragma unroll
    for (int ai = 0; ai < 2; ++ai)
#pragma unroll
        for (int m = 0; m < 4; ++m) { const f32x4 a = *(const f32x4*)(part + (size_t)(row0 + ai * HALF + m * 16) * 16 + 4 * fq);
            float s = (a[0] + a[1]) + (a[2] + a[3]); s += __shfl_xor(s, 16); s += __shfl_xor(s, 32);
            rs[ai][m] = __builtin_amdgcn_rsqf(s * (1.0f / 1024.0f) + 1e-6f); }
    asm volatile("" ::: "memory");
}
__device__ __forceinline__ float fexp_(float x) { return __builtin_amdgcn_exp2f(x * 1.44269504089f); }
__device__ __forceinline__ float sigmoidf_(float x) { return __builtin_amdgcn_rcpf(1.0f + fexp_(-x)); }

struct EpiGU {
    static constexpr bool PERM = true, AFTER_DRAIN = false;
    bf16_t* H; const float* part;
    __device__ __forceinline__ void operator()(const f32x4 (&acc)[2][2][4][2], const Unit& u, int wr, int wc, int fr, int fq) const {
        const int row0 = u.pm * BM + wr * 64 + fr, col0 = u.pn * 128 + wc * 32 + 8 * fq;
        float rsv[2][4]; rows_rstd(part, row0, fq, rsv);
#pragma unroll
        for (int ai = 0; ai < 2; ++ai)
#pragma unroll
            for (int m = 0; m < 4; ++m) { const int row = row0 + ai * HALF + m * 16; const float rs = rsv[ai][m];
                f32x4 h0, h1;
#pragma unroll
                for (int j = 0; j < 4; ++j) { const float g0 = acc[ai][0][m][0][j] * rs, u0 = acc[ai][1][m][0][j] * rs, g1 = acc[ai][0][m][1][j] * rs, u1 = acc[ai][1][m][1][j] * rs;
                    h0[j] = g0 * u0 * __builtin_amdgcn_rcpf(1.0f + fexp_(-g0)); h1[j] = g1 * u1 * __builtin_amdgcn_rcpf(1.0f + fexp_(-g1)); }
                *(u32x4*)(H + (size_t)row * 2816 + col0) = pack8(h0, h1); asm volatile("" ::: "memory"); }
    }
};
struct EpiRes {
    static constexpr bool PERM = true, AFTER_DRAIN = false;
    const float* xin; float* xout; bf16_t* xb; float* part; float alpha;
    __device__ __forceinline__ void operator()(const f32x4 (&acc)[2][2][4][2], const Unit& u, int wr, int wc, int fr, int fq) const {
        const int row0 = u.pm * BM + wr * 64 + fr, col0 = u.pn * BM + wc * 32 + 8 * fq;
#pragma unroll
        for (int ai = 0; ai < 2; ++ai)
#pragma unroll
            for (int m = 0; m < 4; ++m) { const int row = row0 + ai * HALF + m * 16; float ss = 0.f;
#pragma unroll
                for (int bj = 0; bj < 2; ++bj) { const size_t off = (size_t)row * 1024 + col0 + bj * HALF;
                    const f32x4 r0 = *(const f32x4*)(xin + off), r1 = *(const f32x4*)(xin + off + 4);
                    const f32x4 v0 = r0 + acc[ai][bj][m][0] * alpha, v1 = r1 + acc[ai][bj][m][1] * alpha;
                    *(f32x4*)(xout + off) = v0; *(f32x4*)(xout + off + 4) = v1;
                    if (xb) *(u32x4*)(xb + off) = pack8(v0, v1);
                    ss += (v0[0] * v0[0] + v0[1] * v0[1]) + (v0[2] * v0[2] + v0[3] * v0[3]) + (v1[0] * v1[0] + v1[1] * v1[1]) + (v1[2] * v1[2] + v1[3] * v1[3]); }
                ss += __shfl_xor(ss, 16); ss += __shfl_xor(ss, 32);
                if (fq == 0) part[(size_t)row * 16 + u.pn * 4 + wc] = ss; asm volatile("" ::: "memory"); }
    }
};
struct EpiProj {
    static constexpr bool PERM = true, AFTER_DRAIN = false;
    bf16_t* rkvl; bf16_t* attq; bf16_t* attkv; const float* part;
    __device__ __forceinline__ void operator()(const f32x4 (&acc)[2][2][4][2], const Unit& u, int wr, int wc, int fr, int fq) const {
        bf16_t* base; int ldc, colt;
        if (u.pn < 7) { base = rkvl; ldc = 1792; colt = u.pn * BM; } else if (u.pn < 9) { base = attq; ldc = 512; colt = (u.pn - 7) * BM; } else { base = attkv; ldc = 256; colt = 0; }
        const int row0 = u.pm * BM + wr * 64 + fr, col0 = colt + wc * 32 + 8 * fq;
        float rsv[2][4]; rows_rstd(part, row0, fq, rsv);
#pragma unroll
        for (int ai = 0; ai < 2; ++ai)
#pragma unroll
            for (int m = 0; m < 4; ++m) { const int row = row0 + ai * HALF + m * 16; const float rs = rsv[ai][m];
#pragma unroll
                for (int bj = 0; bj < 2; ++bj) *(u32x4*)(base + (size_t)row * ldc + col0 + bj * HALF) = pack8(acc[ai][bj][m][0] * rs, acc[ai][bj][m][1] * rs); }
    }
};
struct EpiGate {
    static constexpr bool PERM = true, AFTER_DRAIN = false;
    bf16_t* gates; const float* part;
    __device__ __forceinline__ void operator()(const f32x4 (&acc)[2][2][4][2], const Unit& u, int wr, int wc, int fr, int fq) const {
        const int row0 = u.pm * BM + wr * 64 + fr, col0 = u.pn * BM + wc * 32 + 8 * fq;
        float rsv[2][4]; rows_rstd(part, row0, fq, rsv);
#pragma unroll
        for (int ai = 0; ai < 2; ++ai)
#pragma unroll
            for (int m = 0; m < 4; ++m) { const int row = row0 + ai * HALF + m * 16; const float rs = rsv[ai][m];
#pragma unroll
                for (int bj = 0; bj < 2; ++bj) { f32x4 v0, v1;
#pragma unroll
                    for (int j = 0; j < 4; ++j) { v0[j] = sigmoidf_(acc[ai][bj][m][0][j] * rs); v1[j] = sigmoidf_(acc[ai][bj][m][1][j] * rs); }
                    *(u32x4*)(gates + (size_t)row * 2048 + col0 + bj * HALF) = pack8(v0, v1); } }
    }
};
struct EpiLora {
    static constexpr bool PERM = true, AFTER_DRAIN = false;
    bf16_t* rec_lw; bf16_t* rec_a; bf16_t* g; const float* w0; const float* a0;
    template <int KIND> __device__ __forceinline__ void body(const f32x4 (&acc)[2][2][4][2], const Unit& u, int wr, int wc, int fr, int fq) const {
        const int row0 = u.pm * BM + wr * 64 + fr, col0 = (u.pn & 1) * BM + wc * 32 + 8 * fq;
#pragma unroll
        for (int ai = 0; ai < 2; ++ai)
#pragma unroll
            for (int m = 0; m < 4; ++m) { const int row = row0 + ai * HALF + m * 16; const int b = row >> 12, t = row & 4095;
#pragma unroll
                for (int bj = 0; bj < 2; ++bj) { const int c = col0 + bj * HALF; f32x4 v0 = acc[ai][bj][m][0], v1 = acc[ai][bj][m][1];
                    if (KIND != 2) { const float* bias = (KIND == 0 ? w0 : a0) + c; v0 = v0 + *(const f32x4*)bias; v1 = v1 + *(const f32x4*)(bias + 4); }
                    if (KIND == 2) { *(u32x4*)(g + (size_t)row * 512 + c) = pack8(v0, v1); }
                    else {
#pragma unroll
                        for (int j = 0; j < 4; ++j) {
                            if (KIND == 0) { const float y0 = -v0[j], y1 = -v1[j];
                                const float sp0 = fmaxf(y0, 0.f) + __logf(1.0f + fexp_(-fabsf(y0))), sp1 = fmaxf(y1, 0.f) + __logf(1.0f + fexp_(-fabsf(y1)));
                                v0[j] = -fexp_(-sp0 - 0.5f); v1[j] = -fexp_(-sp1 - 0.5f); }
                            else { v0[j] = sigmoidf_(v0[j]); v1[j] = sigmoidf_(v1[j]); } }
                        bf16_t* dst = (KIND == 0 ? rec_lw : rec_a) + ((size_t)((b * 8 + (c >> 6)) * 4096 + t)) * 64 + (c & 63);
                        *(u32x4*)dst = pack8(v0, v1); } }
                asm volatile("" ::: "memory"); }
    }
    __device__ __forceinline__ void operator()(const f32x4 (&acc)[2][2][4][2], const Unit& u, int wr, int wc, int fr, int fq) const {
        const int kind = u.pn >> 1;
        if (kind == 0) body<0>(acc, u, wr, wc, fr, fq); else if (kind == 1) body<1>(acc, u, wr, wc, fr, fq); else body<2>(acc, u, wr, wc, fr, fq);
    }
};
struct EpiBranch {
    static constexpr bool PERM = true, AFTER_DRAIN = false;
    const bf16_t* gates; bf16_t* merged; int goff; int accum;
    __device__ __forceinline__ void operator()(const f32x4 (&acc)[2][2][4][2], const Unit& u, int wr, int wc, int fr, int fq) const {
        const int row0 = u.pm * BM + wr * 64 + fr, col0 = u.pn * BM + wc * 32 + 8 * fq;
#pragma unroll
        for (int ai = 0; ai < 2; ++ai)
#pragma unroll
            for (int m = 0; m < 4; ++m) { const int row = row0 + ai * HALF + m * 16;
#pragma unroll
                for (int bj = 0; bj < 2; ++bj) { const int c = col0 + bj * HALF; const u32x4 gq = *(const u32x4*)(gates + (size_t)row * 2048 + goff + c);
                    bf16_t* mp = merged + (size_t)row * 1024 + c;
                    f32x4 v0 = acc[ai][bj][m][0], v1 = acc[ai][bj][m][1];
                    v0[0] *= bf_lo(gq.x); v0[1] *= bf_hi(gq.x); v0[2] *= bf_lo(gq.y); v0[3] *= bf_hi(gq.y);
                    v1[0] *= bf_lo(gq.z); v1[1] *= bf_hi(gq.z); v1[2] *= bf_lo(gq.w); v1[3] *= bf_hi(gq.w);
                    if (accum) { const u32x4 pq = *(const u32x4*)mp;
                        v0[0] += bf_lo(pq.x); v0[1] += bf_hi(pq.x); v0[2] += bf_lo(pq.y); v0[3] += bf_hi(pq.y);
                        v1[0] += bf_lo(pq.z); v1[1] += bf_hi(pq.z); v1[2] += bf_lo(pq.w); v1[3] += bf_hi(pq.w); }
                    *(u32x4*)mp = pack8(v0, v1); } asm volatile("" ::: "memory"); }
    }
};

template <class Epi, class Sched, bool ALIGN_EPI = false, bool SP2 = false>
__device__ __forceinline__ void gemm_phase(PG8_LAS unsigned char* lds, const Gemm g, const Sched& S, const Epi& E) {
    int tid_ = threadIdx.x; asm volatile("" : "+v"(tid_));
    const int tid = tid_, wid = __builtin_amdgcn_readfirstlane(tid >> 6), lane = tid & 63, wr = wid >> 2, wc = wid & 3, fr = lane & 15, fq = lane >> 4;
    const int K = g.K, nt = K / BK;
    unsigned voffA[2], voffB[2];
#pragma unroll
    for (int i = 0; i < 2; ++i) { int R, C; stage_rc(tid * 16 + i * 8192, R, C); const int Rb = Epi::PERM ? ((R & ~31) + perm32(R & 31)) : R;
        voffA[i] = (unsigned)(R * K + C) * 2u; voffB[i] = (unsigned)(Rb * K + C) * 2u; }
    const size_t kstep = (size_t)(BK * 2);
    const size_t hstep = (size_t)HALF * K * 2;
    const size_t tstep = 2 * hstep;
    const unsigned ldsw = (unsigned)wid * 1024u;
    const int aoff = lds_byte(wr * 64 + fr, fq * 8), boff = lds_byte(wc * 32 + fr, fq * 8);
#define PG8_SA(b, h) (((b) * 2 + (h)) * HTB)
#define PG8_SB(b, h) ((4 + (b) * 2 + (h)) * HTB)
#define PG8_STAGE(bufoff, gbase, voff) do { _Pragma("unroll") for (int _i = 0; _i < 2; ++_i) \
        __builtin_amdgcn_global_load_lds((const unsigned*)((const char*)(gbase) + (voff)[_i]), (PG8_LAS unsigned*)(lds + (bufoff) + ldsw + _i * 8192), 16, 0, 0); } while (0)
#define PG8_LDA(dst, b, h) do { _Pragma("unroll") for (int m = 0; m < 4; ++m) _Pragma("unroll") for (int k = 0; k < 2; ++k) dst[m][k] = *(const PG8_LAS bf16x8*)(lds + PG8_SA(b, h) + aoff + m * 2048 + k * 1024); } while (0)
#define PG8_LDB(dst, b, h) do { _Pragma("unroll") for (int n = 0; n < 2; ++n) _Pragma("unroll") for (int k = 0; k < 2; ++k) dst[n][k] = *(const PG8_LAS bf16x8*)(lds + PG8_SB(b, h) + boff + n * 2048 + k * 1024); } while (0)
#define PG8_MMA(ai, bj, At, Bt) do { __builtin_amdgcn_s_setprio(1); _Pragma("unroll") for (int m = 0; m < 4; ++m) _Pragma("unroll") for (int n = 0; n < 2; ++n) _Pragma("unroll") for (int k = 0; k < 2; ++k) \
        acc[ai][bj][m][n] = __builtin_amdgcn_mfma_f32_16x16x32_bf16(Bt[n][k], At[m][k], acc[ai][bj][m][n], 0, 0, 0); __builtin_amdgcn_s_setprio(0); } while (0)
#define PG8_WAIT_V(n) asm volatile("s_waitcnt vmcnt(" #n ")" ::: "memory")
#define PG8_WAIT_L(n) asm volatile("s_waitcnt lgkmcnt(" #n ")" ::: "memory")
#define PG8_BAR __builtin_amdgcn_s_barrier()
#define PG8_SCHED __builtin_amdgcn_sched_barrier(0)
    Unit cur, nxt; int ui = 0;
    if (!S.next(0, cur)) return;
    f32x4 acc[2][2][4][2];
#pragma unroll
    for (int a = 0; a < 2; ++a)
#pragma unroll
        for (int b = 0; b < 2; ++b)
#pragma unroll
            for (int m = 0; m < 4; ++m)
#pragma unroll
                for (int n = 0; n < 2; ++n) acc[a][b][m][n] = (f32x4){0.f, 0.f, 0.f, 0.f};
    bf16x8 At[4][2], B0[2][2], B1[2][2];
    const char* cA = (const char*)g.A + (size_t)cur.pm * tstep; const char* cB = (const char*)g.Bt + (size_t)cur.pn * tstep;
    S.a_ready(cur);
    if constexpr (SP2) {
        PG8_STAGE(PG8_SB(0, 0), cB, voffB); PG8_STAGE(PG8_SB(0, 1), cB + hstep, voffB); PG8_STAGE(PG8_SA(0, 0), cA, voffA); PG8_STAGE(PG8_SA(0, 1), cA + hstep, voffA);
        if (wr == 1) PG8_BAR;
        PG8_WAIT_V(2); PG8_BAR;
        PG8_STAGE(PG8_SB(1, 0), cB + kstep, voffB); PG8_STAGE(PG8_SA(1, 0), cA + kstep, voffA); PG8_STAGE(PG8_SB(1, 1), cB + hstep + kstep, voffB);
        PG8_WAIT_V(6); PG8_BAR;
    } else {
        PG8_STAGE(PG8_SB(0, 0), cB, voffB); PG8_STAGE(PG8_SA(0, 0), cA, voffA); PG8_STAGE(PG8_SB(0, 1), cB + hstep, voffB); PG8_STAGE(PG8_SA(0, 1), cA + hstep, voffA);
        if (wr == 1) PG8_BAR;
        PG8_WAIT_V(4); PG8_BAR;
        PG8_STAGE(PG8_SB(1, 0), cB + kstep, voffB); PG8_STAGE(PG8_SA(1, 0), cA + kstep, voffA); PG8_STAGE(PG8_SB(1, 1), cB + hstep + kstep, voffB);
        PG8_WAIT_V(6); PG8_BAR;
    }
    for (;;) {
        const bool has_next = S.next(ui + 1, nxt);
        const char* nA = has_next ? (const char*)g.A + (size_t)nxt.pm * tstep : cA; const char* nB = has_next ? (const char*)g.Bt + (size_t)nxt.pn * tstep : cB;
        for (int t = 0; t < nt; t += 2) {
            const bool last = (t == nt - 2);
            const char* a1 = cA + (size_t)(t + 1) * kstep;
            const char* a2 = last ? nA : cA + (size_t)(t + 2) * kstep; const char* b2 = last ? nB : cB + (size_t)(t + 2) * kstep;
            const char* a3 = a2 + kstep; const char* b3 = b2 + kstep;
            if (last && has_next) S.a_ready(nxt);
            if constexpr (SP2) {
            PG8_LDB(B0, 0, 0); PG8_LDB(B1, 0, 1); PG8_SCHED; PG8_LDA(At, 0, 0); PG8_STAGE(PG8_SA(1, 1), a1 + hstep, voffA);
            PG8_WAIT_V(8); PG8_WAIT_L(0); PG8_BAR; PG8_MMA(0, 0, At, B0); PG8_MMA(0, 1, At, B1); PG8_BAR; PG8_SCHED;
            PG8_LDA(At, 0, 1); PG8_STAGE(PG8_SB(0, 0), b2, voffB); PG8_STAGE(PG8_SB(0, 1), b2 + hstep, voffB); PG8_STAGE(PG8_SA(0, 0), a2, voffA);
            PG8_WAIT_V(8); PG8_WAIT_L(0); PG8_BAR; PG8_MMA(1, 0, At, B0); PG8_MMA(1, 1, At, B1); PG8_BAR; PG8_SCHED;
            PG8_LDB(B0, 1, 0); PG8_LDB(B1, 1, 1); PG8_SCHED; PG8_LDA(At, 1, 0); PG8_STAGE(PG8_SA(0, 1), a2 + hstep, voffA);
            PG8_WAIT_V(8); PG8_WAIT_L(0); PG8_BAR; PG8_MMA(0, 0, At, B0); PG8_MMA(0, 1, At, B1); PG8_BAR; PG8_SCHED;
            PG8_LDA(At, 1, 1); PG8_STAGE(PG8_SB(1, 0), b3, voffB); PG8_STAGE(PG8_SB(1, 1), b3 + hstep, voffB); PG8_STAGE(PG8_SA(1, 0), a3, voffA);
            PG8_WAIT_V(8); PG8_WAIT_L(0); PG8_BAR; PG8_MMA(1, 0, At, B0); PG8_MMA(1, 1, At, B1); PG8_BAR; PG8_SCHED;
            } else {
            PG8_LDB(B0, 0, 0); PG8_SCHED; PG8_LDA(At, 0, 0); PG8_STAGE(PG8_SA(1, 1), a1 + hstep, voffA);
            PG8_WAIT_L(8); PG8_BAR; PG8_WAIT_L(0); PG8_MMA(0, 0, At, B0); PG8_BAR; PG8_SCHED;
            PG8_LDB(B1, 0, 1); PG8_STAGE(PG8_SB(0, 0), b2, voffB);
            PG8_BAR; PG8_WAIT_L(0); PG8_MMA(0, 1, At, B1); PG8_BAR;
            PG8_LDA(At, 0, 1); PG8_STAGE(PG8_SA(0, 0), a2, voffA);
            PG8_BAR; PG8_WAIT_L(0); PG8_MMA(1, 0, At, B0); PG8_BAR; PG8_SCHED;
            PG8_STAGE(PG8_SB(0, 1), b2 + hstep, voffB);
            PG8_WAIT_V(6); PG8_BAR; PG8_MMA(1, 1, At, B1); PG8_BAR;
            PG8_LDB(B0, 1, 0); PG8_SCHED; PG8_LDA(At, 1, 0); PG8_STAGE(PG8_SA(0, 1), a2 + hstep, voffA);
            PG8_WAIT_L(8); PG8_BAR; PG8_WAIT_L(0); PG8_MMA(0, 0, At, B0); PG8_BAR; PG8_SCHED;
            PG8_LDB(B1, 1, 1); PG8_STAGE(PG8_SB(1, 0), b3, voffB);
            PG8_BAR; PG8_WAIT_L(0); PG8_MMA(0, 1, At, B1); PG8_BAR;
            PG8_LDA(At, 1, 1); PG8_STAGE(PG8_SA(1, 0), a3, voffA);
            PG8_BAR; PG8_WAIT_L(0); PG8_MMA(1, 0, At, B0); PG8_BAR; PG8_SCHED;
            PG8_STAGE(PG8_SB(1, 1), b3 + hstep, voffB);
            PG8_WAIT_V(6); PG8_BAR; PG8_MMA(1, 1, At, B1); PG8_BAR;
            }
        }
        if constexpr (ALIGN_EPI) { if (wr == 0) PG8_BAR; }
        if constexpr (!Epi::AFTER_DRAIN) { E(acc, cur, wr, wc, fr, fq); S.done(cur); }
        if (!has_next) break;
#pragma unroll
        for (int a = 0; a < 2; ++a)
#pragma unroll
            for (int b = 0; b < 2; ++b)
#pragma unroll
                for (int m = 0; m < 4; ++m)
#pragma unroll
                    for (int n = 0; n < 2; ++n) acc[a][b][m][n] = (f32x4){0.f, 0.f, 0.f, 0.f};
        cur = nxt; cA = nA; cB = nB; ++ui;
        if constexpr (ALIGN_EPI) { if (wr == 1) PG8_BAR; }
    }
    PG8_WAIT_V(0);
    if constexpr (!ALIGN_EPI) { if (wr == 0) PG8_BAR; }
    PG8_BAR;
    if constexpr (Epi::AFTER_DRAIN) { E.fused(acc, cur, wr, wc, fr, fq, lds, wid, lane); S.done(cur); }
#undef PG8_SA
#undef PG8_SB
#undef PG8_STAGE
#undef PG8_LDA
#undef PG8_LDB
#undef PG8_MMA
#undef PG8_WAIT_V
#undef PG8_WAIT_L
#undef PG8_BAR
#undef PG8_SCHED
}
}
constexpr int NWAVES = 8;
constexpr int BATCH = 8, T = 4096, D = 1024, M = BATCH * T, FF = 2816, NH = 8, HD = 64, INC = 4512;
constexpr float RMS_EPS = 1e-6f, GN_EPS = 64e-5f;
constexpr size_t MiB = 1u << 20;
constexpr size_t WS_PART = 1 * MiB;
constexpr size_t WS_SC = 9 * MiB;
constexpr size_t WS_WGU1 = 13 * MiB, WS_WDN1 = WS_WGU1 + 11 * MiB, WS_WGU2 = WS_WDN1 + 5632 * 1024, WS_WDN2 = WS_WGU2 + 11 * MiB;
constexpr size_t WS_WIN = WS_WDN2 + 5632 * 1024, WS_WGT = WS_WIN + 5 * MiB, WS_WLO = WS_WGT + 4 * MiB, WS_WBR = WS_WLO + 768 * 1024, WS_WBA = WS_WBR + 1 * MiB, WS_WOUT = WS_WBA + 1 * MiB;
constexpr size_t WS_XB = 62 * MiB;
constexpr size_t WS_ATTQ = 126 * MiB;
constexpr size_t WS_ATTKV = 158 * MiB;
constexpr size_t WS_RKVL = 174 * MiB;
constexpr size_t WS_G = 286 * MiB;
constexpr size_t WS_REC = 318 * MiB, REC_SLOT = 32 * MiB;
constexpr size_t WS_H = 126 * MiB;
constexpr size_t WS_YRAW = WS_RKVL;
constexpr size_t WS_MERGED = WS_RKVL;
constexpr size_t WS_GATES = WS_REC;
constexpr size_t WS_YR = WS_REC + 4 * REC_SLOT;
constexpr size_t WS_LA = WS_REC + 5 * REC_SLOT;
constexpr size_t WS_END = WS_REC + 6 * REC_SLOT;
static_assert(WS_WOUT + 4 * MiB <= WS_XB && WS_H + (size_t)M * FF * 2 <= WS_REC && WS_MERGED + (size_t)M * 2048 * 2 <= WS_REC, "ws map");
constexpr int RING_BYTES = 131072, LDS_BYTES = 147456;

#define GAS __attribute__((address_space(1)))
#define LAS __attribute__((address_space(3)))
typedef unsigned short bf16;
typedef unsigned v4u __attribute__((ext_vector_type(4)));
typedef unsigned v2u __attribute__((ext_vector_type(2)));
typedef float f32x4 __attribute__((ext_vector_type(4)));
typedef float f32x2 __attribute__((ext_vector_type(2)));
typedef short bf16x8 __attribute__((ext_vector_type(8)));
#define LDS_WAIT() asm volatile("s_waitcnt lgkmcnt(0)" ::: "memory")
__device__ __forceinline__ unsigned f2bf(float f) { unsigned u = __builtin_bit_cast(unsigned, f); return (u + 0x7fffu + ((u >> 16) & 1u)) >> 16; }
__device__ __forceinline__ unsigned pk2(float lo, float hi) { return f2bf(lo) | (f2bf(hi) << 16); }
__device__ __forceinline__ float bflo(unsigned u) { return __uint_as_float(u << 16); }
__device__ __forceinline__ float bfhi(unsigned u) { return __uint_as_float(u & 0xffff0000u); }
__device__ __forceinline__ float bf1(bf16 h) { return __uint_as_float((unsigned)h << 16); }
__device__ __forceinline__ float wave_sum(float v) {
#pragma unroll
    for (int o = 1; o < 64; o <<= 1) v += __shfl_xor(v, o);
    return v;
}
template <int CTRL> __device__ __forceinline__ float dppf(float x) { return __builtin_bit_cast(float, __builtin_amdgcn_update_dpp(0, __builtin_bit_cast(int, x), CTRL, 0xf, 0xf, false)); }
__device__ __forceinline__ float row16_sum(float x) { x += dppf<0xB1>(x); x += dppf<0x4E>(x); x += dppf<0x141>(x); x += dppf<0x140>(x); return x; }

#define RLX_AGENT __ATOMIC_RELAXED, __HIP_MEMORY_SCOPE_AGENT
#define XB_TMO      128
#define XB_XCNT(j)  (256  + 64 * (j))
#define XB_XSUB(j)  (1280 + 64 * (j))
#define XB_XGEN(j)  (2304 + 64 * (j))
#define XB_TOP      3328
#define XB_TOPGEN   3392
#define XCD_BAR_WORDS 3456
#define XB_SPIN_CAP (1u << 18)

__device__ __forceinline__ unsigned xb_ld(unsigned* p)              { return __hip_atomic_load(p, __ATOMIC_RELAXED, __HIP_MEMORY_SCOPE_AGENT); }
__device__ __forceinline__ unsigned xb_add(unsigned* p, unsigned v) { return __hip_atomic_fetch_add(p, v, __ATOMIC_RELAXED, __HIP_MEMORY_SCOPE_AGENT); }
__device__ __forceinline__ unsigned xb_xcc_id() { return (unsigned)__builtin_amdgcn_s_getreg((3 << 11) | 20) & 0xFu; }
#define XB_SPIN(cond, bar) do { unsigned _sp = 0; while (cond) { __builtin_amdgcn_s_sleep(1); \
    if ((++_sp & 255u) == 0u) { if (xb_ld(&(bar)[XB_TMO])) break; if (_sp > XB_SPIN_CAP) { atomicAdd(&(bar)[XB_TMO], 1u); break; } } } } while (0)

struct XcdBarrier {
    unsigned* bar; unsigned x;
    volatile LAS unsigned* st;
};

__device__ __forceinline__ XcdBarrier xcd_barrier_post(unsigned* bar, volatile LAS unsigned* st) {
    XcdBarrier b; b.bar = bar; b.x = xb_xcc_id(); b.st = st;
    if (threadIdx.x == 0) (void)xb_add(&bar[XB_XCNT(b.x)], 1u);
    return b;
}
__device__ __forceinline__ void xcd_barrier_complete(unsigned* bar, unsigned x, unsigned& nloc, unsigned& nx) {
    const unsigned G = gridDim.x * gridDim.y * gridDim.z;
    unsigned sum, cnt, mine, sp = 0u;
    for (;;) {
        sum = 0u; cnt = 0u; mine = 0u;
#pragma unroll
        for (unsigned j = 0; j < 16; ++j) { const unsigned c = xb_ld(&bar[XB_XCNT(j)]); sum += c; cnt += (c > 0u) ? 1u : 0u; mine = (j == x) ? c : mine; }
        if (sum == G) break;
        __builtin_amdgcn_s_sleep(1);
        if ((++sp & 255u) == 0u) { if (xb_ld(&bar[XB_TMO])) break; if (sp > XB_SPIN_CAP) { atomicAdd(&bar[XB_TMO], 1u); break; } }
    }
    nloc = mine > 0u ? mine : 1u; nx = cnt > 0u ? cnt : 1u;
}

__device__ __forceinline__ void xcd_barrier(const XcdBarrier& b) {
    asm volatile("s_waitcnt vmcnt(0)" ::: "memory");
    __syncthreads();
    if (threadIdx.x == 0) {
        unsigned* bar = b.bar;
        __builtin_amdgcn_s_waitcnt(0);
        unsigned nloc = b.st[0], nx = b.st[1];
        if (nloc == 0u) { xcd_barrier_complete(bar, b.x, nloc, nx); b.st[0] = nloc; b.st[1] = nx; }
        const unsigned old = xb_add(&bar[XB_XSUB(b.x)], 1u);
        const unsigned gen = old / nloc;
        if (old + 1u == (gen + 1u) * nloc) {
            __builtin_amdgcn_fence(__ATOMIC_RELEASE, "agent");
            asm volatile("s_waitcnt vmcnt(0)" ::: "memory");
            const unsigned og = xb_add(&bar[XB_TOP], 1u);
            const unsigned tg = og / nx;
            if (og + 1u == (tg + 1u) * nx) xb_add(&bar[XB_TOPGEN], 1u);
            else XB_SPIN(xb_ld(&bar[XB_TOPGEN]) == tg, bar);
            __builtin_amdgcn_fence(__ATOMIC_ACQUIRE, "agent");
            xb_add(&bar[XB_XGEN(b.x)], 1u);
            asm volatile("s_waitcnt vmcnt(0)" ::: "memory");
        } else {
            XB_SPIN(xb_ld(&bar[XB_XGEN(b.x)]) == gen, bar);
            __builtin_amdgcn_fence(__ATOMIC_ACQUIRE, "agent");
            asm volatile("s_waitcnt vmcnt(0)" ::: "memory");
        }
    }
    __syncthreads();
}

__device__ __forceinline__ int fresh_tid() { int t = threadIdx.x; asm volatile("" : "+v"(t)); return t; }
struct Frame {
    LAS unsigned char* lds;
    int tid, lane, wave, vcu, G;
    const float *in0, *in1, *in2, *in3, *in4, *in5, *in6, *in7, *in8, *in9, *in10, *in11, *in12, *in13, *in14, *in15, *in16, *in17, *in18, *in19, *in20, *in21, *in22, *in23, *in24, *in25, *in26, *in27, *in28; float* out; unsigned char* ws;
};

__device__ __forceinline__ void tr_item(const float* W, int ldn, int k0, int n0, bf16* WT, int ldk, int drow0, int dk0, const float* scale, int dup, LAS float* scr, int lane) {
#pragma unroll 8
    for (int i = 0; i < 32; ++i) { const int kk = 2 * i + (lane >> 5); float v = W[(size_t)(k0 + kk) * ldn + n0 + (lane & 31)]; if (scale) v *= scale[k0 + kk]; scr[kk * 33 + (lane & 31)] = v; }
    LDS_WAIT(); asm volatile("" ::: "memory");
    const int c = lane & 7;
#pragma unroll
    for (int j = 0; j < 4; ++j) { const int n = (lane >> 3) + 8 * j; const LAS float* s = scr + (8 * c) * 33 + n;
        v4u o; o.x = pk2(s[0 * 33], s[1 * 33]); o.y = pk2(s[2 * 33], s[3 * 33]); o.z = pk2(s[4 * 33], s[5 * 33]); o.w = pk2(s[6 * 33], s[7 * 33]);
        bf16* dp = WT + (size_t)(drow0 + n0 + n) * ldk + dk0 + k0 + 8 * c;
        *(GAS v4u*)dp = o; if (dup) *(GAS v4u*)(dp + dup) = o; }
    LDS_WAIT(); asm volatile("" ::: "memory");
}
__device__ __forceinline__ void p0_prologue(Frame& F) {
    LAS float* scr = (LAS float*)(F.lds + F.wave * 16384);
    unsigned char* ws = F.ws;
    const int gw = F.vcu * NWAVES + F.wave, NGW = F.G * NWAVES, lane = fresh_tid() & 63;
    constexpr int I_GU = 16 * 88, I_DN = 44 * 32, I_IN = 16 * 77, I_GT = 16 * 64, I_BR = 8 * 32, I_OUT = 16 * 32;
    constexpr int NITEMS = 4 * I_GU + 2 * I_DN + I_IN + I_GT + 2 * I_BR + I_OUT;
    for (int it = gw; it < NITEMS; it += NGW) {
        int r = it;
        if (r < 4 * I_GU) {
            const int which = r / I_GU; r -= which * I_GU; const int kb = r / 88, nb = r % 88, n0 = nb * 32;
            const float* W = which == 0 ? F.in2 : which == 1 ? F.in3 : which == 2 ? F.in25 : F.in26;
            tr_item(W, FF, kb * 64, n0, (bf16*)(ws + (which < 2 ? WS_WGU1 : WS_WGU2)), D, (n0 >> 7) * 256 + (which & 1) * 128 + (n0 & 127) - n0, 0, which < 2 ? F.in1 : F.in24, 0, scr, lane);
            continue; }
        r -= 4 * I_GU;
        if (r < 2 * I_DN) { const int which = r / I_DN; r -= which * I_DN; const int kb = r / 32, nb = r % 32;
            tr_item(which ? F.in27 : F.in4, D, kb * 64, nb * 32, (bf16*)(ws + (which ? WS_WDN2 : WS_WDN1)), FF, 0, 0, nullptr, 0, scr, lane); continue; }
        r -= 2 * I_DN;
        if (r < I_IN) { const int kb = r / 77, nb = r % 77, n0 = nb * 32;
            tr_item(F.in6, INC, kb * 64, n0, (bf16*)(ws + WS_WIN), D, n0 < 1696 ? 0 : 96, 0, F.in5, 0, scr, lane); continue; }
        r -= I_IN;
        if (r < I_GT) { const int kb = r / 64, nb = r % 64;
            tr_item(F.in6, INC, kb * 64, 2464 + nb * 32, (bf16*)(ws + WS_WGT), D, -2464, 0, F.in5, 0, scr, lane); continue; }
        r -= I_GT;
        if (r < 2 * I_BR) { const int which = r / I_BR; r -= which * I_BR; const int kb = r / 32, nb = r % 32;
            tr_item(which ? F.in22 : F.in21, D, kb * 64, nb * 32, (bf16*)(ws + (which ? WS_WBA : WS_WBR)), 512, 0, 0, nullptr, 0, scr, lane); continue; }
        r -= 2 * I_BR;
        { const int kb = r / 32, nb = r % 32; tr_item(F.in23, D, kb * 64, nb * 32, (bf16*)(ws + WS_WOUT), D, 0, 0, nullptr, 0, scr, lane); }
    }
    { GAS v4u* z = (GAS v4u*)(ws + WS_WIN + (size_t)1696 * D * 2); for (int i = gw * 64 + lane; i < 12288; i += NGW * 64) z[i] = (v4u){0u, 0u, 0u, 0u}; }
    { bf16* WL = (bf16*)(ws + WS_WLO);
      for (int i = gw * 64 + lane; i < 1536 * 256; i += NGW * 64) { const int n = i >> 8, k = i & 255, grp = n >> 9, nn = n & 511; float v = 0.f;
          if (grp == 0) { if (k < 32) v = F.in9[k * 512 + nn]; } else if (grp == 1) { if (k >= 32 && k < 64) v = F.in11[(k - 32) * 512 + nn]; } else { if (k >= 64 && k < 160) v = F.in12[(k - 64) * 512 + nn]; }
          WL[i] = (bf16)f2bf(v); } }
    { const float* x = F.in0; bf16* XB = (bf16*)(ws + WS_XB); float* part = (float*)(ws + WS_PART);
      for (int m = gw; m < M; m += NGW) { const GAS f32x4* xr = (const GAS f32x4*)(x + (size_t)m * D) + lane; f32x4 v[4]; float s = 0.f;
#pragma unroll
          for (int j = 0; j < 4; ++j) { v[j] = xr[64 * j]; s += (v[j].x * v[j].x + v[j].y * v[j].y) + (v[j].z * v[j].z + v[j].w * v[j].w); }
          s = wave_sum(s);
          GAS unsigned long long* o8 = (GAS unsigned long long*)(XB + (size_t)m * D) + lane;
#pragma unroll
          for (int j = 0; j < 4; ++j) o8[64 * j] = (unsigned long long)pk2(v[j].x, v[j].y) | ((unsigned long long)pk2(v[j].z, v[j].w) << 32);
          if (lane < 16) part[(size_t)m * 16 + lane] = lane == 0 ? s : 0.f; } }
}
__device__ __forceinline__ void p4_lora_in(Frame& F) {
    const bf16* RKVL = (const bf16*)(F.ws + WS_RKVL); bf16* LA = (bf16*)(F.ws + WS_LA); const float* mu = F.in7 + 1536;
    const int gw = F.vcu * NWAVES + F.wave, NGW = F.G * NWAVES, lane = fresh_tid() & 63, c0 = 4 * lane;
    for (int m = gw; m < M; m += NGW) {
        float o[4] = {0.f, 0.f, 0.f, 0.f};
        if (c0 < 160) {
            const v2u cu = *(const GAS v2u*)(RKVL + (size_t)m * 1792 + 1536 + c0);
            v2u pu = (v2u){0u, 0u}; if ((m & (T - 1)) != 0) pu = *(const GAS v2u*)(RKVL + (size_t)(m - 1) * 1792 + 1536 + c0);
            const float cur[4] = {bflo(cu.x), bfhi(cu.x), bflo(cu.y), bfhi(cu.y)}, prv[4] = {bflo(pu.x), bfhi(pu.x), bflo(pu.y), bfhi(pu.y)};
            const f32x4 mv = *(const GAS f32x4*)(mu + c0);
#pragma unroll
            for (int j = 0; j < 4; ++j) { const float p = cur[j] + (prv[j] - cur[j]) * mv[j]; const int c = c0 + j;
                o[j] = c < 32 ? tanhf(p) : (c < 64 ? p : 1.0f / (1.0f + __expf(-p))); }
        }
        *(GAS v2u*)(LA + (size_t)m * 256 + c0) = (v2u){pk2(o[0], o[1]), pk2(o[2], o[3])};
    }
}
__device__ __forceinline__ float sum8(float v) { v += __shfl_xor(v, 1); v += __shfl_xor(v, 2); v += __shfl_xor(v, 4); return v; }
__device__ __forceinline__ void unpack8(const v4u u, float (&f)[8]) { f[0] = bflo(u.x); f[1] = bfhi(u.x); f[2] = bflo(u.y); f[3] = bfhi(u.y); f[4] = bflo(u.z); f[5] = bfhi(u.z); f[6] = bflo(u.w); f[7] = bfhi(u.w); }
__device__ __forceinline__ v4u pack8u(const float (&f)[8]) { return (v4u){pk2(f[0], f[1]), pk2(f[2], f[3]), pk2(f[4], f[5]), pk2(f[6], f[7])}; }
__device__ __forceinline__ void ld8f(const float* p, float (&f)[8]) { const f32x4 a = *(const GAS f32x4*)p, b = *(const GAS f32x4*)(p + 4); f[0] = a.x; f[1] = a.y; f[2] = a.z; f[3] = a.w; f[4] = b.x; f[5] = b.y; f[6] = b.z; f[7] = b.w; }
__device__ __forceinline__ void p6_prep(Frame& F) {
    const bf16* RKVL = (const bf16*)(F.ws + WS_RKVL); bf16* REC = (bf16*)(F.ws + WS_REC); f32x4* SC = (f32x4*)(F.ws + WS_SC);
    constexpr size_t SL = REC_SLOT / 2;
    const int gw = F.vcu * NWAVES + F.wave, NGW = F.G * NWAVES, lane = fresh_tid() & 63, h = lane >> 3, c0 = 8 * lane, n0 = 8 * (lane & 7);
    float mur[8], muk[8], muv[8], kkw[8], kaw[8], rkw[8];
    ld8f(F.in7 + c0, mur); ld8f(F.in7 + 512 + c0, muk); ld8f(F.in7 + 1024 + c0, muv); ld8f(F.in13 + c0, kkw); ld8f(F.in14 + c0, kaw); ld8f(F.in15 + c0, rkw);
    for (int m = gw; m < M; m += NGW) {
        const int b = m >> 12, t = m & (T - 1); const bool hp = t != 0;
        const bf16* cr = RKVL + (size_t)m * 1792 + c0; const bf16* pr = cr - (hp ? 1792 : 0);
        const size_t ri = ((size_t)(b * 8 + h) * T + t) * 64 + n0;
        const v4u ur = *(const GAS v4u*)cr, uk = *(const GAS v4u*)(cr + 512), uv = *(const GAS v4u*)(cr + 1024);
        const v4u pr_ = *(const GAS v4u*)pr, pk_ = *(const GAS v4u*)(pr + 512), pv_ = *(const GAS v4u*)(pr + 1024);
        const v4u ua = *(const GAS v4u*)(REC + 4 * SL + ri);
        float r[8], k[8], v[8], rp[8], kp[8], vp[8], a[8];
        unpack8(ur, r); unpack8(uk, k); unpack8(uv, v); unpack8(pr_, rp); unpack8(pk_, kp); unpack8(pv_, vp); unpack8(ua, a);
        float kk[8], ss = 0.f;
#pragma unroll
        for (int j = 0; j < 8; ++j) { const float rpj = hp ? rp[j] : 0.f, kpj = hp ? kp[j] : 0.f, vpj = hp ? vp[j] : 0.f;
            r[j] += (rpj - r[j]) * mur[j]; k[j] += (kpj - k[j]) * muk[j]; v[j] += (vpj - v[j]) * muv[j];
            kk[j] = k[j] * kkw[j]; ss += kk[j] * kk[j]; }
        const float inv = 1.0f / fmaxf(sqrtf(sum8(ss)), 1e-12f);
        float an[8], bn[8], kn[8];
#pragma unroll
        for (int j = 0; j < 8; ++j) { kk[j] *= inv; an[j] = -kk[j]; bn[j] = kk[j] * a[j]; kn[j] = k[j] * (1.0f + (a[j] - 1.0f) * kaw[j]); }
        const v4u oa = pack8u(an), orr = pack8u(r), ok = pack8u(kn), ob = pack8u(bn), ov = pack8u(v);
        float rq[8], kq[8], bq[8]; unpack8(orr, rq); unpack8(ok, kq); unpack8(ob, bq);
        float sb = 0.f, sk = 0.f, sbo = 0.f;
#pragma unroll
        for (int j = 0; j < 8; ++j) { sb += bq[j] * rq[j]; sk += kq[j] * rq[j]; sbo += rq[j] * kq[j] * rkw[j]; }
        sb = sum8(sb); sk = sum8(sk); sbo = sum8(sbo);
        *(GAS v4u*)(REC + 1 * SL + ri) = oa; *(GAS v4u*)(REC + 2 * SL + ri) = orr; *(GAS v4u*)(REC + 3 * SL + ri) = ok; *(GAS v4u*)(REC + 4 * SL + ri) = ob; *(GAS v4u*)(REC + 5 * SL + ri) = ov;
        if ((lane & 7) == 0) SC[(size_t)(b * 8 + h) * T + t] = (f32x4){sb, sk, sbo, 0.f};
    }
}
constexpr int KS_STRIDE = 144, VT_STRIDE = 528, ATT_KS_OFF = 0, ATT_VT_OFF = 256 * KS_STRIDE;
__device__ __forceinline__ void p6_attention(Frame& F) {
    bf16* ATTQ = (bf16*)(F.ws + WS_ATTQ); const bf16* ATTKV = (const bf16*)(F.ws + WS_ATTKV);
    const float* qn = F.in18; const float* kn = F.in19; const float* sinks = F.in20;
    LAS unsigned char* Ks = F.lds + ATT_KS_OFF; LAS unsigned char* Vt = F.lds + ATT_VT_OFF;
    const int tid = fresh_tid(), lane = tid & 63, w = F.wave, g = lane >> 4, n16 = lane & 15;
    for (int unit = F.vcu; unit < BATCH * 2 * 32; unit += F.G) {
        const int nb = unit & 31, kvh = (unit >> 5) & 1, b = unit >> 6; const int m0 = b * T + nb * 128;
#pragma unroll
        for (int i = 0; i < 4; ++i) { const int e = tid + 512 * i, key = e >> 3, dg = e & 7; const bool valid = nb > 0 || key >= 128;
            v4u ku = (v4u){0u, 0u, 0u, 0u}, vu = (v4u){0u, 0u, 0u, 0u};
            if (valid) { const bf16* src = ATTKV + (size_t)(m0 - 128 + key) * 256 + kvh * 64 + dg * 8; ku = *(const GAS v4u*)src; vu = *(const GAS v4u*)(src + 128); }
            float kf[8] = {bflo(ku.x), bfhi(ku.x), bflo(ku.y), bfhi(ku.y), bflo(ku.z), bfhi(ku.z), bflo(ku.w), bfhi(ku.w)};
            float ss = 0.f;
#pragma unroll
            for (int j = 0; j < 8; ++j) ss += kf[j] * kf[j];
            ss += __shfl_xor(ss, 1); ss += __shfl_xor(ss, 2); ss += __shfl_xor(ss, 4);
            const float rs = 1.0f / sqrtf(ss * (1.0f / 64.0f) + RMS_EPS);
#pragma unroll
            for (int j = 0; j < 8; ++j) kf[j] *= rs * kn[dg * 8 + j];
            *(LAS v4u*)(Ks + key * KS_STRIDE + dg * 16) = (v4u){pk2(kf[0], kf[1]), pk2(kf[2], kf[3]), pk2(kf[4], kf[5]), pk2(kf[6], kf[7])};
            const unsigned vv[4] = {vu.x, vu.y, vu.z, vu.w};
#pragma unroll
            for (int j = 0; j < 8; ++j) *(LAS bf16*)(Vt + (dg * 8 + j) * VT_STRIDE + key * 2) = (bf16)((vv[j >> 1] >> ((j & 1) * 16)) & 0xffffu);
        }
        __syncthreads();
        const int hq = kvh * 4 + (w >> 1), qbase = (w & 1) * 64; const float sink = sinks[hq];
        for (int qt = 0; qt < 4; ++qt) {
            const int q0 = qbase + 16 * qt, qi = q0 + n16, kt0 = q0 >> 4;
            bf16* qp = ATTQ + (size_t)(m0 + qi) * 512 + hq * 64 + 8 * g;
            const v4u qa = *(const GAS v4u*)qp, qb = *(const GAS v4u*)(qp + 32);
            float q[16] = {bflo(qa.x), bfhi(qa.x), bflo(qa.y), bfhi(qa.y), bflo(qa.z), bfhi(qa.z), bflo(qa.w), bfhi(qa.w),
                           bflo(qb.x), bfhi(qb.x), bflo(qb.y), bfhi(qb.y), bflo(qb.z), bfhi(qb.z), bflo(qb.w), bfhi(qb.w)};
            float ss = 0.f;
#pragma unroll
            for (int j = 0; j < 16; ++j) ss += q[j] * q[j];
            ss += __shfl_xor(ss, 16); ss += __shfl_xor(ss, 32);
            const float rs = 0.125f / sqrtf(ss * (1.0f / 64.0f) + RMS_EPS);
#pragma unroll
            for (int j = 0; j < 16; ++j) q[j] *= rs * qn[(j >> 3) * 32 + 8 * g + (j & 7)];
            const v4u qf0 = (v4u){pk2(q[0], q[1]), pk2(q[2], q[3]), pk2(q[4], q[5]), pk2(q[6], q[7])}, qf1 = (v4u){pk2(q[8], q[9]), pk2(q[10], q[11]), pk2(q[12], q[13]), pk2(q[14], q[15])};
            const bf16x8 bq0 = __builtin_bit_cast(bf16x8, qf0), bq1 = __builtin_bit_cast(bf16x8, qf1);
            f32x4 st[10]; float mx = -INFINITY;
#pragma unroll
            for (int i = 0; i < 10; ++i) { const int kt = kt0 + i, ktc = kt < 16 ? kt : 15;
                const LAS unsigned char* kp = Ks + (16 * ktc + n16) * KS_STRIDE + 16 * g;
                const bf16x8 a0 = *(const LAS bf16x8*)kp, a1 = *(const LAS bf16x8*)(kp + 64);
                f32x4 acc = (f32x4){0.f, 0.f, 0.f, 0.f};
                acc = __builtin_amdgcn_mfma_f32_16x16x32_bf16(a0, bq0, acc, 0, 0, 0);
                acc = __builtin_amdgcn_mfma_f32_16x16x32_bf16(a1, bq1, acc, 0, 0, 0);
#pragma unroll
                for (int r = 0; r < 4; ++r) { const int kj = 16 * kt + 4 * g + r; const bool ok = (kj > qi) && (kj <= qi + 128) && (nb > 0 || kj >= 128);
                    acc[r] = ok ? acc[r] : -INFINITY; mx = fmaxf(mx, acc[r]); }
                st[i] = acc; }
            mx = fmaxf(mx, __shfl_xor(mx, 16)); mx = fmaxf(mx, __shfl_xor(mx, 32)); mx = fmaxf(mx, sink);
            float den = 0.f;
#pragma unroll
            for (int i = 0; i < 10; ++i)
#pragma unroll
                for (int r = 0; r < 4; ++r) { const float p = __expf(st[i][r] - mx); st[i][r] = p; den += p; }
            den += __shfl_xor(den, 16); den += __shfl_xor(den, 32); den += __expf(sink - mx);
            const float inv = 1.0f / den;
            f32x4 o[4];
#pragma unroll
            for (int dt = 0; dt < 4; ++dt) o[dt] = (f32x4){0.f, 0.f, 0.f, 0.f};
#pragma unroll
            for (int j = 0; j < 5; ++j) { const int ka = kt0 + 2 * j, kb2 = ka + 1, kac = ka < 16 ? ka : 15, kbc = kb2 < 16 ? kb2 : 15;
                const v4u pu = (v4u){pk2(st[2 * j][0], st[2 * j][1]), pk2(st[2 * j][2], st[2 * j][3]), pk2(st[2 * j + 1][0], st[2 * j + 1][1]), pk2(st[2 * j + 1][2], st[2 * j + 1][3])};
                const bf16x8 pf = __builtin_bit_cast(bf16x8, pu);
#pragma unroll
                for (int dt = 0; dt < 4; ++dt) { const LAS unsigned char* vp = Vt + (16 * dt + n16) * VT_STRIDE;
                    const v2u va = *(const LAS v2u*)(vp + (16 * kac + 4 * g) * 2), vb = *(const LAS v2u*)(vp + (16 * kbc + 4 * g) * 2);
                    const bf16x8 af = __builtin_bit_cast(bf16x8, (v4u){va.x, va.y, vb.x, vb.y});
                    o[dt] = __builtin_amdgcn_mfma_f32_16x16x32_bf16(af, pf, o[dt], 0, 0, 0); } }
            bf16* op = ATTQ + (size_t)(m0 + qi) * 512 + hq * 64 + 4 * g;
#pragma unroll
            for (int dt = 0; dt < 4; ++dt) *(GAS v2u*)(op + 16 * dt) = (v2u){pk2(o[dt][0] * inv, o[dt][1] * inv), pk2(o[dt][2] * inv, o[dt][3] * inv)};
        }
        __syncthreads();
    }
}
constexpr int SC_NS = 32, SC_NP = 16, SC_ARR = 4096, SC_SCL = 9 * SC_ARR, SC_VS = SC_SCL + 512, SC_YB = SC_VS + 4096, SC_BUF = SC_YB + 2048;
struct ScanPre { v2u lw1, a1, r1, k1, b1, lw2, a2, r2, k2, b2; unsigned short v1, v2; f32x4 sc1, sc2; };
__device__ __forceinline__ ScanPre scan_issue(Frame& F, int bh, int quarter, int t0, int lt) {
    const unsigned char* REC = F.ws + WS_REC; const f32x4* SC = (const f32x4*)(F.ws + WS_SC);
    const int pr = lt >> 4, q = lt & 15; const size_t st = (size_t)bh * T + t0 + 2 * pr;
    const size_t e1 = st * 128 + (size_t)q * 8, e2 = e1 + 128;
    ScanPre p;
    p.lw1 = *(const GAS v2u*)(REC + 0 * REC_SLOT + e1); p.a1 = *(const GAS v2u*)(REC + 1 * REC_SLOT + e1); p.r1 = *(const GAS v2u*)(REC + 2 * REC_SLOT + e1); p.k1 = *(const GAS v2u*)(REC + 3 * REC_SLOT + e1); p.b1 = *(const GAS v2u*)(REC + 4 * REC_SLOT + e1);
    p.lw2 = *(const GAS v2u*)(REC + 0 * REC_SLOT + e2); p.a2 = *(const GAS v2u*)(REC + 1 * REC_SLOT + e2); p.r2 = *(const GAS v2u*)(REC + 2 * REC_SLOT + e2); p.k2 = *(const GAS v2u*)(REC + 3 * REC_SLOT + e2); p.b2 = *(const GAS v2u*)(REC + 4 * REC_SLOT + e2);
    const bf16* RV = (const bf16*)(REC + 5 * REC_SLOT) + st * 64 + 16 * quarter + q;
    p.v1 = RV[0]; p.v2 = RV[64];
    p.sc1 = *(const GAS f32x4*)(SC + st); p.sc2 = *(const GAS f32x4*)(SC + st + 1);
    return p;
}
__device__ __forceinline__ void un4(const v2u u, float (&f)[4]) { f[0] = bflo(u.x); f[1] = bfhi(u.x); f[2] = bflo(u.y); f[3] = bfhi(u.y); }
__device__ __forceinline__ void scan_commit(const ScanPre& p, LAS unsigned char* buf, int lt) {
    const int pr = lt >> 4, q = lt & 15, idx = pr * 16 + q;
    float lw1[4], a1[4], r1[4], k1[4], b1[4], lw2[4], a2[4], r2[4], k2[4], b2[4];
    un4(p.lw1, lw1); un4(p.a1, a1); un4(p.r1, r1); un4(p.k1, k1); un4(p.b1, b1); un4(p.lw2, lw2); un4(p.a2, a2); un4(p.r2, r2); un4(p.k2, k2); un4(p.b2, b2);
    float w1[4], w2[4], z1[4], wa2[4], wz2[4], ww[4], bw[4], kw[4];
    float ba = 0.f, ka = 0.f, bz = 0.f, kz = 0.f;
#pragma unroll
    for (int j = 0; j < 4; ++j) { w1[j] = __expf(lw1[j]); w2[j] = __expf(lw2[j]); z1[j] = w1[j] * r1[j]; const float z2 = w2[j] * r2[j];
        wa2[j] = w1[j] * a2[j]; wz2[j] = w1[j] * z2; ww[j] = w1[j] * w2[j]; bw[j] = b1[j] * w2[j]; kw[j] = k1[j] * w2[j];
        ba += b1[j] * a2[j]; ka += k1[j] * a2[j]; bz += b1[j] * z2; kz += k1[j] * z2; }
    ba = row16_sum(ba); ka = row16_sum(ka); bz = row16_sum(bz); kz = row16_sum(kz);
    LAS f32x4* A = (LAS f32x4*)buf;
    A[0 * 256 + idx] = (f32x4){a1[0], z1[0], a1[1], z1[1]}; A[1 * 256 + idx] = (f32x4){a1[2], z1[2], a1[3], z1[3]};
    A[2 * 256 + idx] = (f32x4){wa2[0], wz2[0], wa2[1], wz2[1]}; A[3 * 256 + idx] = (f32x4){wa2[2], wz2[2], wa2[3], wz2[3]};
    A[4 * 256 + idx] = (f32x4){ww[0], ww[1], ww[2], ww[3]}; A[5 * 256 + idx] = (f32x4){bw[0], bw[1], bw[2], bw[3]}; A[6 * 256 + idx] = (f32x4){kw[0], kw[1], kw[2], kw[3]};
    A[7 * 256 + idx] = (f32x4){b2[0], b2[1], b2[2], b2[3]}; A[8 * 256 + idx] = (f32x4){k2[0], k2[1], k2[2], k2[3]};
    if (q == 0) { LAS f32x4* S4 = (LAS f32x4*)(buf + SC_SCL); S4[pr * 2] = (f32x4){ba, ka, bz, kz}; S4[pr * 2 + 1] = (f32x4){p.sc1.x, p.sc2.x, 0.f, 0.f}; }
    const float v1 = bf1(p.v1), v2 = bf1(p.v2);
    ((LAS f32x4*)(buf + SC_VS))[idx] = (f32x4){v1, v2, v1 * p.sc1.y, v2 * p.sc2.y};
}
__device__ __forceinline__ void scan_flush(Frame& F, int bh, int quarter, int t0, const LAS unsigned char* buf, int lt) {
    if (lt < 128) { const int s = lt >> 2, c4 = lt & 3; const int b = bh >> 3, h = bh & 7;
        float* yraw = (float*)(F.ws + WS_YRAW);
        const LAS float* yb = (const LAS float*)(buf + SC_YB) + ((s >> 1) * 16 + 4 * c4) * 2 + (s & 1);
        const f32x4 y = (f32x4){yb[0], yb[2], yb[4], yb[6]};
        *(GAS f32x4*)(yraw + (size_t)(b * T + t0 + s) * 512 + h * 64 + 16 * quarter + 4 * c4) = y; }
}
__device__ __forceinline__ void p7_scan(Frame& F) {
    const int w = F.wave, tid = fresh_tid(), lane = tid & 63, rl = lane >> 4, q = lane & 15, lt = tid - 256;
    constexpr int NBLK = T / SC_NS;
#define SCAN_BAR() do { asm volatile("s_waitcnt lgkmcnt(0)" ::: "memory"); __builtin_amdgcn_s_barrier(); asm volatile("" ::: "memory"); } while (0)
    for (int unit = F.vcu; unit < 256; unit += F.G) {
        const int bh = unit >> 2, quarter = unit & 3;
        ScanPre pre;
        if (w >= 4) { pre = scan_issue(F, bh, quarter, 0, lt); scan_commit(pre, F.lds, lt); pre = scan_issue(F, bh, quarter, SC_NS, lt); }
        SCAN_BAR();
        float S0 = 0.f, S1 = 0.f, S2 = 0.f, S3 = 0.f;
        for (int nb = 0; nb < NBLK; ++nb) {
            LAS unsigned char* cur = F.lds + (nb & 1) * SC_BUF; LAS unsigned char* oth = F.lds + ((nb + 1) & 1) * SC_BUF;
            if (w >= 4) {
                if (nb > 0) scan_flush(F, bh, quarter, (nb - 1) * SC_NS, oth, lt);
                if (nb + 1 < NBLK) scan_commit(pre, oth, lt);
                if (nb + 2 < NBLK) pre = scan_issue(F, bh, quarter, (nb + 2) * SC_NS, lt);
            } else {
                const LAS f32x4* A = (const LAS f32x4*)cur + q; const LAS f32x4* SCL = (const LAS f32x4*)(cur + SC_SCL);
                const int rowl = 4 * w + rl; const LAS f32x4* VS = (const LAS f32x4*)(cur + SC_VS) + rowl; LAS f32x2* YB = (LAS f32x2*)(cur + SC_YB) + rowl;
                f32x4 az1a = A[0], az1b = A[256], az2a = A[512], az2b = A[768], ww = A[1024], b1 = A[1280], k1 = A[1536], b2 = A[1792], k2 = A[2048], c0 = SCL[0], vs = VS[0]; f32x2 c1 = *(const LAS f32x2*)(SCL + 1);
#pragma unroll 4
                for (int pr = 0; pr < SC_NP; ++pr) {
                    const int pn = (pr + 1) * 16;
                    const f32x4 n_az1a = A[pn], n_az1b = A[256 + pn], n_az2a = A[512 + pn], n_az2b = A[768 + pn], n_ww = A[1024 + pn], n_b1 = A[1280 + pn], n_k1 = A[1536 + pn], n_b2 = A[1792 + pn], n_k2 = A[2048 + pn],
                                n_c0 = SCL[2 * pr + 2], n_vs = VS[pn]; const f32x2 n_c1 = *(const LAS f32x2*)(SCL + 2 * pr + 3);
                    __builtin_amdgcn_sched_barrier(0);
                    float sa1 = S0 * az1a.x; sa1 = fmaf(S1, az1a.z, sa1); sa1 = fmaf(S2, az1b.x, sa1); sa1 = fmaf(S3, az1b.z, sa1);
                    float z1 = S0 * az1a.y; z1 = fmaf(S1, az1a.w, z1); z1 = fmaf(S2, az1b.y, z1); z1 = fmaf(S3, az1b.w, z1);
                    float p2 = S0 * az2a.x; p2 = fmaf(S1, az2a.z, p2); p2 = fmaf(S2, az2b.x, p2); p2 = fmaf(S3, az2b.z, p2);
                    float q2 = S0 * az2a.y; q2 = fmaf(S1, az2a.w, q2); q2 = fmaf(S2, az2b.y, q2); q2 = fmaf(S3, az2b.w, q2);
                    float t0_ = fmaf(vs.x, k1.x, S0 * ww.x), t1_ = fmaf(vs.x, k1.y, S1 * ww.y), t2_ = fmaf(vs.x, k1.z, S2 * ww.z), t3_ = fmaf(vs.x, k1.w, S3 * ww.w);
                    t0_ = fmaf(vs.y, k2.x, t0_); t1_ = fmaf(vs.y, k2.y, t1_); t2_ = fmaf(vs.y, k2.z, t2_); t3_ = fmaf(vs.y, k2.w, t3_);
                    sa1 = row16_sum(sa1); z1 = row16_sum(z1); p2 = row16_sum(p2); q2 = row16_sum(q2);
                    const float sa2 = fmaf(sa1, c0.x, fmaf(vs.x, c0.y, p2)), z2 = fmaf(sa1, c0.z, fmaf(vs.x, c0.w, q2));
                    S0 = fmaf(sa2, b2.x, fmaf(sa1, b1.x, t0_)); S1 = fmaf(sa2, b2.y, fmaf(sa1, b1.y, t1_)); S2 = fmaf(sa2, b2.z, fmaf(sa1, b1.z, t2_)); S3 = fmaf(sa2, b2.w, fmaf(sa1, b1.w, t3_));
                    YB[pr * 16] = (f32x2){fmaf(sa1, c1.x, z1) + vs.z, fmaf(sa2, c1.y, z2) + vs.w};
                    az1a = n_az1a; az1b = n_az1b; az2a = n_az2a; az2b = n_az2b; ww = n_ww; b1 = n_b1; k1 = n_k1; b2 = n_b2; k2 = n_k2; c0 = n_c0; c1 = n_c1; vs = n_vs;
                }
            }
            SCAN_BAR();
        }
        if (w >= 4) scan_flush(F, bh, quarter, T - SC_NS, F.lds + ((NBLK - 1) & 1) * SC_BUF, lt);
        asm volatile("s_waitcnt vmcnt(0)" ::: "memory"); SCAN_BAR();
    }
#undef SCAN_BAR
}
__device__ __forceinline__ void p8_post(Frame& F) {
    const float* yraw = (const float*)(F.ws + WS_YRAW); const bf16* RV = (const bf16*)(F.ws + WS_REC + 5 * REC_SLOT); const f32x4* SC = (const f32x4*)(F.ws + WS_SC);
    const bf16* Gt = (const bf16*)(F.ws + WS_G); bf16* YR = (bf16*)(F.ws + WS_YR);
    const int gw = F.vcu * NWAVES + F.wave, NGW = F.G * NWAVES, lane = fresh_tid() & 63, h = lane >> 3, c0 = 8 * lane, n0 = 8 * (lane & 7);
    float lw[8], lb[8]; ld8f(F.in16 + c0, lw); ld8f(F.in17 + c0, lb);
    for (int m = gw; m < M; m += NGW) {
        const int b = m >> 12, t = m & (T - 1); const size_t rt = (size_t)(b * 8 + h) * T + t;
        float y[8]; ld8f(yraw + (size_t)m * 512 + c0, y);
        const v4u uv = *(const GAS v4u*)(RV + rt * 64 + n0), ug = *(const GAS v4u*)(Gt + (size_t)m * 512 + c0); const float bonus = SC[rt].z;
        float v[8], g[8]; unpack8(uv, v); unpack8(ug, g);
        float s1 = 0.f;
#pragma unroll
        for (int j = 0; j < 8; ++j) s1 += y[j];
        const float mean = sum8(s1) * (1.0f / 64.0f); float s2 = 0.f;
#pragma unroll
        for (int j = 0; j < 8; ++j) { y[j] -= mean; s2 += y[j] * y[j]; }
        const float rstd = 1.0f / sqrtf(sum8(s2) * (1.0f / 64.0f) + GN_EPS);
        float o[8];
#pragma unroll
        for (int j = 0; j < 8; ++j) o[j] = (y[j] * rstd * lw[j] + lb[j] + bonus * v[j]) * g[j];
        *(GAS v4u*)(YR + (size_t)m * 512 + c0) = pack8u(o);
    }
}
__device__ __forceinline__ void p13_final(Frame& F) {
    const float* part = (const float*)(F.ws + WS_PART + 3 * 2 * MiB); const float* gn = F.in28;
    const int gw = F.vcu * NWAVES + F.wave, NGW = F.G * NWAVES, lane = fresh_tid() & 63;
    for (int m = gw; m < M; m += NGW) {
        float s = lane < 16 ? part[(size_t)m * 16 + lane] : 0.f; s = wave_sum(s);
        const float rs = 1.0f / sqrtf(s * (1.0f / 1024.0f) + RMS_EPS);
        GAS f32x4* xr = (GAS f32x4*)(F.out + (size_t)m * D) + lane; const GAS f32x4* gr = (const GAS f32x4*)gn + lane;
#pragma unroll
        for (int j = 0; j < 4; ++j) { const f32x4 v = xr[64 * j], g4 = gr[64 * j]; xr[64 * j] = v * rs * g4; }
    }
}
struct Args { const float* in[29]; float* out; unsigned char* ws; };
__global__ void __launch_bounds__(NWAVES * 64, 2) fwd_megakernel(Args args) {
    extern __shared__ __attribute__((aligned(16))) unsigned char lds[];
    cg::grid_group grid = cg::this_grid();
    Frame F;
    F.lds = (LAS unsigned char*)lds;
    F.tid = threadIdx.x; F.lane = F.tid & 63; F.wave = __builtin_amdgcn_readfirstlane(F.tid >> 6);
    F.G = gridDim.x; { const int bx = blockIdx.x; F.vcu = (F.G % 8 == 0) ? (bx % 8) * (F.G / 8) + bx / 8 : bx; }
F.in0 = args.in[0]; F.in1 = args.in[1]; F.in2 = args.in[2]; F.in3 = args.in[3]; F.in4 = args.in[4]; F.in5 = args.in[5]; F.in6 = args.in[6]; F.in7 = args.in[7]; F.in8 = args.in[8]; F.in9 = args.in[9]; F.in10 = args.in[10]; F.in11 = args.in[11]; F.in12 = args.in[12]; F.in13 = args.in[13]; F.in14 = args.in[14]; F.in15 = args.in[15]; F.in16 = args.in[16]; F.in17 = args.in[17]; F.in18 = args.in[18]; F.in19 = args.in[19]; F.in20 = args.in[20]; F.in21 = args.in[21]; F.in22 = args.in[22]; F.in23 = args.in[23]; F.in24 = args.in[24]; F.in25 = args.in[25]; F.in26 = args.in[26]; F.in27 = args.in[27]; F.in28 = args.in[28];
    F.out = args.out; F.ws = args.ws;
    unsigned char* ws = args.ws;
    bf16* XB = (bf16*)(ws + WS_XB); bf16* HB = (bf16*)(ws + WS_H);
    float* PA = (float*)(ws + WS_PART); float* PB = PA + (size_t)M * 16; float* PC = PB + (size_t)M * 16; float* PD = PC + (size_t)M * 16;
    using pg8::gemm_phase; using pg8::StaticOrder; using pg8::Gemm;
    volatile LAS unsigned* bst = (volatile LAS unsigned*)(F.lds + RING_BYTES);
    if (F.tid == 0) { bst[0] = 0u; bst[1] = 0u; }
    __syncthreads();
    XcdBarrier bar = xcd_barrier_post((unsigned*)ws, bst);
#define SYNC() xcd_barrier(bar)
#define RUN_GEMM(EPI, Aptr, Bptr, NN, KK, ...) do { Gemm g_{(const pg8::bf16_t*)(Aptr), (const pg8::bf16_t*)(Bptr), M, (NN), (KK)}; StaticOrder S_; S_.init(M, (NN), F.G, (int)blockIdx.x); \
        pg8::EPI E_{__VA_ARGS__}; gemm_phase<pg8::EPI, StaticOrder, true, true>(F.lds, g_, S_, E_); } while (0)

    p0_prologue(F); grid.sync();
    RUN_GEMM(EpiGU, XB, ws + WS_WGU1, 2 * FF, D, HB, PA); SYNC();
    RUN_GEMM(EpiRes, HB, ws + WS_WDN1, D, FF, F.in0, F.out, XB, PB, 0.5f); SYNC();
    RUN_GEMM(EpiProj, XB, ws + WS_WIN, 2560, D, (bf16*)(ws + WS_RKVL), (bf16*)(ws + WS_ATTQ), (bf16*)(ws + WS_ATTKV), PB); SYNC();
    p4_lora_in(F); SYNC();
    RUN_GEMM(EpiLora, ws + WS_LA, ws + WS_WLO, 1536, 256, (bf16*)(ws + WS_REC), (bf16*)(ws + WS_REC + 4 * REC_SLOT), (bf16*)(ws + WS_G), F.in8, F.in10); SYNC();
    p6_prep(F); p6_attention(F); SYNC();
    p7_scan(F); SYNC();
    p8_post(F); SYNC();
    RUN_GEMM(EpiGate, XB, ws + WS_WGT, 2048, D, (bf16*)(ws + WS_GATES), PB); SYNC();
    RUN_GEMM(EpiBranch, ws + WS_YR, ws + WS_WBR, D, 512, (const bf16*)(ws + WS_GATES), (bf16*)(ws + WS_MERGED), 0, 0);
    RUN_GEMM(EpiBranch, ws + WS_ATTQ, ws + WS_WBA, D, 512, (const bf16*)(ws + WS_GATES), (bf16*)(ws + WS_MERGED), 1024, 1); SYNC();
    RUN_GEMM(EpiRes, ws + WS_MERGED, ws + WS_WOUT, D, D, F.out, F.out, XB, PC, 1.0f); SYNC();
    RUN_GEMM(EpiGU, XB, ws + WS_WGU2, 2 * FF, D, HB, PC); SYNC();
    RUN_GEMM(EpiRes, HB, ws + WS_WDN2, D, FF, F.out, F.out, (bf16*)nullptr, PD, 0.5f); SYNC();
    p13_final(F);
}

extern "C" void kernel_launch(void* const* d_in, const int* in_sizes, int n_in, void* d_out, int out_size, void* d_ws, size_t ws_size, hipStream_t stream) {
    static int grid = 0;
    if (grid == 0) {
        if (n_in != 29 || in_sizes[0] != M * D || out_size != M * D || ws_size < WS_END) { fprintf(stderr, "kernel_launch: unexpected shapes (n_in %d, ws %zu)\n", n_in, ws_size); grid = -1; return; }
        int dev = 0, cus = 0, per_cu = 0;
        hipGetDevice(&dev); hipDeviceGetAttribute(&cus, hipDeviceAttributeMultiprocessorCount, dev);
        if (hipFuncSetAttribute((const void*)fwd_megakernel, hipFuncAttributeMaxDynamicSharedMemorySize, LDS_BYTES) != hipSuccess) { fprintf(stderr, "kernel_launch: hipFuncSetAttribute failed\n"); grid = -1; return; }
        hipOccupancyMaxActiveBlocksPerMultiprocessor(&per_cu, (const void*)fwd_megakernel, NWAVES * 64, LDS_BYTES);
        (void)hipGetLastError();
        if (per_cu < 1) fprintf(stderr, "kernel_launch: occupancy query says %d blocks/CU\n", per_cu);
        grid = cus;
    }
    if (grid < 0) return;
    if (hipMemsetAsync(d_ws, 0, 16384, stream) != hipSuccess) { fprintf(stderr, "kernel_launch: memset failed\n"); return; }
    Args a{};
    for (int i = 0; i < 29; ++i) a.in[i] = (const float*)d_in[i];
    a.out = (float*)d_out; a.ws = (unsigned char*)d_ws;
    void* kargs[] = {&a};
    hipError_t e = hipLaunchCooperativeKernel((const void*)fwd_megakernel, dim3(grid), dim3(NWAVES * 64), kargs, LDS_BYTES, stream);
    if (e != hipSuccess) fprintf(stderr, "kernel_launch: cooperative launch failed: %s (grid %d)\n", hipGetErrorString(e), grid);
}
```

```cpp
#include <hip/hip_runtime.h>
#include <hip/hip_cooperative_groups.h>
#include <cstdio>
#include <cstdint>
namespace cg = cooperative_groups;
namespace pg8 {
#define PG8_LAS __attribute__((address_space(3)))
typedef unsigned short bf16_t;
typedef short bf16x8 __attribute__((ext_vector_type(8)));
typedef float f32x4 __attribute__((ext_vector_type(4)));
typedef unsigned u32x4 __attribute__((ext_vector_type(4)));
constexpr int BM = 256, BK = 64, HALF = 128, HTB = HALF * BK * 2  , STAGE_BYTES = 8 * HTB, NXCD = 8, WGM = 8;

__host__ __device__ __forceinline__ int lds_byte(int r, int c) { const int st = (r >> 4) * 2 + (c >> 5), rr = r & 15, cc = c & 31, ob = rr * 64 + cc * 2; return st * 1024 + (ob ^ (((ob >> 9) & 1) << 5)); }
__host__ __device__ __forceinline__ void stage_rc(int b, int& R, int& C) { const int st = b / 1024, sb = b % 1024, swz = sb ^ (((sb >> 9) & 1) << 5); R = (st >> 1) * 16 + swz / 64; C = (st & 1) * 32 + (swz % 64) / 2; }
__host__ __device__ __forceinline__ int perm32(int rho) { const int n = rho >> 4, i = rho & 15; return 8 * (i >> 2) + 4 * n + (i & 3); }

struct Unit { int pm, pn; };
struct Gemm { const bf16_t* A; const bf16_t* Bt; int M, N, K; };

struct StaticOrder {
    int nM, nN, nwg, G, c;
    __host__ __device__ void init(int M, int N, int G_, int c_) { nM = M / BM; nN = N / BM; nwg = nM * nN; G = G_; c = c_; }
    __host__ __device__ bool next(int i, Unit& u) const {
        const long L = (long)i * G + c; if (L >= nwg) return false;
        int wgid = (int)L; { const int q = nwg / NXCD, r = nwg % NXCD, xcd = wgid % NXCD, off = wgid / NXCD; wgid = (xcd < r ? xcd * (q + 1) : r * (q + 1) + (xcd - r) * q) + off; }
        const int nig = WGM * nN, gid = wgid / nig, fm = gid * WGM, gsz = (nM - fm) < WGM ? (nM - fm) : WGM;
        u.pm = fm + ((wgid % nig) % gsz); u.pn = (wgid % nig) / gsz; return true;
    }
    __device__ __forceinline__ void a_ready(const Unit&) const {}
    __device__ __forceinline__ void done(const Unit&) const {}
};

__device__ __forceinline__ unsigned cvt_pk_bf16(float lo, float hi) { unsigned r; asm volatile("v_cvt_pk_bf16_f32 %0, %1, %2" : "=v"(r) : "v"(lo), "v"(hi)); return r; }
__device__ __forceinline__ u32x4 pack8(f32x4 v0, f32x4 v1) {
    u32x4 w;
    asm volatile("s_nop 1\n\tv_cvt_pk_bf16_f32 %0, %4, %5\n\tv_cvt_pk_bf16_f32 %1, %6, %7\n\tv_cvt_pk_bf16_f32 %2, %8, %9\n\tv_cvt_pk_bf16_f32 %3, %10, %11"
                 : "=&v"(w.x), "=&v"(w.y), "=&v"(w.z), "=&v"(w.w)
                 : "v"(v0[0]), "v"(v0[1]), "v"(v0[2]), "v"(v0[3]), "v"(v1[0]), "v"(v1[1]), "v"(v1[2]), "v"(v1[3]));
    return w;
}
__device__ __forceinline__ float bf_lo(unsigned u) { return __uint_as_float(u << 16); }
__device__ __forceinline__ float bf_hi(unsigned u) { return __uint_as_float(u & 0xffff0000u); }
__device__ __forceinline__ void rows_rstd(const float* part, int row0, int fq, float (&rs)[2][4]) {
#pragma unroll
    for (int ai = 0; ai < 2; ++ai)
#pragma unroll
        for (int m = 0; m < 4; ++m) { const f32x4 a = *(const f32x4*)(part + (size_t)(row0 + ai * HALF + m * 16) * 16 + 4 * fq);
            float s = (a[0] + a[1]) + (a[2] + a[3]); s += __shfl_xor(s, 16); s += __shfl_xor(s, 32);
            rs[ai][m] = __builtin_amdgcn_rsqf(s * (1.0f / 1024.0f) + 1e-6f); }
    asm volatile("" ::: "memory");
}
__device__ __forceinline__ float fexp_(float x) { return __builtin_amdgcn_exp2f(x * 1.44269504089f); }
__device__ __forceinline__ float sigmoidf_(float x) { return __builtin_amdgcn_rcpf(1.0f + fexp_(-x)); }

struct EpiGU {
    static constexpr bool PERM = true, AFTER_DRAIN = false;
    bf16_t* H; const float* part;
    __device__ __forceinline__ void operator()(const f32x4 (&acc)[2][2][4][2], const Unit& u, int wr, int wc, int fr, int fq) const {
        const int row0 = u.pm * BM + wr * 64 + fr, col0 = u.pn * 128 + wc * 32 + 8 * fq;
        float rsv[2][4]; rows_rstd(part, row0, fq, rsv);
#pragma unroll
        for (int ai = 0; ai < 2; ++ai)
#pragma unroll
            for (int m = 0; m < 4; ++m) { const int row = row0 + ai * HALF + m * 16; const float rs = rsv[ai][m];
                f32x4 h0, h1;
#pragma unroll
                for (int j = 0; j < 4; ++j) { const float g0 = acc[ai][0][m][0][j] * rs, u0 = acc[ai][1][m][0][j] * rs, g1 = acc[ai][0][m][1][j] * rs, u1 = acc[ai][1][m][1][j] * rs;
                    h0[j] = g0 * u0 * __builtin_amdgcn_rcpf(1.0f + fexp_(-g0)); h1[j] = g1 * u1 * __builtin_amdgcn_rcpf(1.0f + fexp_(-g1)); }
                *(u32x4*)(H + (size_t)row * 2816 + col0) = pack8(h0, h1); asm volatile("" ::: "memory"); }
    }
};
struct EpiRes {
    static constexpr bool PERM = true, AFTER_DRAIN = false;
    const float* xin; float* xout; bf16_t* xb; float* part; float alpha;
    __device__ __forceinline__ void operator()(const f32x4 (&acc)[2][2][4][2], const Unit& u, int wr, int wc, int fr, int fq) const {
        const int row0 = u.pm * BM + wr * 64 + fr, col0 = u.pn * BM + wc * 32 + 8 * fq;
#pragma unroll
        for (int ai = 0; ai < 2; ++ai)
#pragma unroll
            for (int m = 0; m < 4; ++m) { const int row = row0 + ai * HALF + m * 16; float ss = 0.f;
#pragma unroll
                for (int bj = 0; bj < 2; ++bj) { const size_t off = (size_t)row * 1024 + col0 + bj * HALF;
                    const f32x4 r0 = *(const f32x4*)(xin + off), r1 = *(const f32x4*)(xin + off + 4);
                    const f32x4 v0 = r0 + acc[ai][bj][m][0] * alpha, v1 = r1 + acc[ai][bj][m][1] * alpha;
                    *(f32x4*)(xout + off) = v0; *(f32x4*)(xout + off + 4) = v1;
                    if (xb) *(u32x4*)(xb + off) = pack8(v0, v1);
                    ss += (v0[0] * v0[0] + v0[1] * v0[1]) + (v0[2] * v0[2] + v0[3] * v0[3]) + (v1[0] * v1[0] + v1[1] * v1[1]) + (v1[2] * v1[2] + v1[3] * v1[3]); }
                ss += __shfl_xor(ss, 16); ss += __shfl_xor(ss, 32);
                if (fq == 0) part[(size_t)row * 16 + u.pn * 4 + wc] = ss; asm volatile("" ::: "memory"); }
    }
};
struct EpiProj {
    static constexpr bool PERM = true, AFTER_DRAIN = false;
    bf16_t* rkvl; bf16_t* attq; bf16_t* attkv; const float* part;
    __device__ __forceinline__ void operator()(const f32x4 (&acc)[2][2][4][2], const Unit& u, int wr, int wc, int fr, int fq) const {
        bf16_t* base; int ldc, colt;
        if (u.pn < 7) { base = rkvl; ldc = 1792; colt = u.pn * BM; } else if (u.pn < 9) { base = attq; ldc = 512; colt = (u.pn - 7) * BM; } else { base = attkv; ldc = 256; colt = 0; }
        const int row0 = u.pm * BM + wr * 64 + fr, col0 = colt + wc * 32 + 8 * fq;
        float rsv[2][4]; rows_rstd(part, row0, fq, rsv);
#pragma unroll
        for (int ai = 0; ai < 2; ++ai)
#pragma unroll
            for (int m = 0; m < 4; ++m) { const int row = row0 + ai * HALF + m * 16; const float rs = rsv[ai][m];
#pragma unroll
                for (int bj = 0; bj < 2; ++bj) *(u32x4*)(base + (size_t)row * ldc + col0 + bj * HALF) = pack8(acc[ai][bj][m][0] * rs, acc[ai][bj][m][1] * rs); }
    }
};
struct EpiGate {
    static constexpr bool PERM = true, AFTER_DRAIN = false;
    bf16_t* gates; const float* part;
    __device__ __forceinline__ void operator()(const f32x4 (&acc)[2][2][4][2], const Unit& u, int wr, int wc, int fr, int fq) const {
        const int row0 = u.pm * BM + wr * 64 + fr, col0 = u.pn * BM + wc * 32 + 8 * fq;
        float rsv[2][4]; rows_rstd(part, row0, fq, rsv);
#pragma unroll
        for (int ai = 0; ai < 2; ++ai)
#pragma unroll
            for (int m = 0; m < 4; ++m) { const int row = row0 + ai * HALF + m * 16; const float rs = rsv[ai][m];
#pragma unroll
                for (int bj = 0; bj < 2; ++bj) { f32x4 v0, v1;
#pragma unroll
                    for (int j = 0; j < 4; ++j) { v0[j] = sigmoidf_(acc[ai][bj][m][0][j] * rs); v1[j] = sigmoidf_(acc[ai][bj][m][1][j] * rs); }
                    *(u32x4*)(gates + (size_t)row * 2048 + col0 + bj * HALF) = pack8(v0, v1); } }
    }
};
struct EpiLora {
    static constexpr bool PERM = true, AFTER_DRAIN = false;
    bf16_t* rec_lw; bf16_t* rec_a; bf16_t* g; const float* w0; const float* a0;
    template <int KIND> __device__ __forceinline__ void body(const f32x4 (&acc)[2][2][4][2], const Unit& u, int wr, int wc, int fr, int fq) const {
        const int row0 = u.pm * BM + wr * 64 + fr, col0 = (u.pn & 1) * BM + wc * 32 + 8 * fq;
#pragma unroll
        for (int ai = 0; ai < 2; ++ai)
#pragma unroll
            for (int m = 0; m < 4; ++m) { const int row = row0 + ai * HALF + m * 16; const int b = row >> 12, t = row & 4095;
#pragma unroll
                for (int bj = 0; bj < 2; ++bj) { const int c = col0 + bj * HALF; f32x4 v0 = acc[ai][bj][m][0], v1 = acc[ai][bj][m][1];
                    if (KIND != 2) { const float* bias = (KIND == 0 ? w0 : a0) + c; v0 = v0 + *(const f32x4*)bias; v1 = v1 + *(const f32x4*)(bias + 4); }
                    if (KIND == 2) { *(u32x4*)(g + (size_t)row * 512 + c) = pack8(v0, v1); }
                    else {
#pragma unroll
                        for (int j = 0; j < 4; ++j) {
                            if (KIND == 0) { const float y0 = -v0[j], y1 = -v1[j];
                                const float sp0 = fmaxf(y0, 0.f) + __logf(1.0f + fexp_(-fabsf(y0))), sp1 = fmaxf(y1, 0.f) + __logf(1.0f + fexp_(-fabsf(y1)));
                                v0[j] = -fexp_(-sp0 - 0.5f); v1[j] = -fexp_(-sp1 - 0.5f); }
                            else { v0[j] = sigmoidf_(v0[j]); v1[j] = sigmoidf_(v1[j]); } }
                        bf16_t* dst = (KIND == 0 ? rec_lw : rec_a) + ((size_t)((b * 8 + (c >> 6)) * 4096 + t)) * 64 + (c & 63);
                        *(u32x4*)dst = pack8(v0, v1); } }
                asm volatile("" ::: "memory"); }
    }
    __device__ __forceinline__ void operator()(const f32x4 (&acc)[2][2][4][2], const Unit& u, int wr, int wc, int fr, int fq) const {
        const int kind = u.pn >> 1;
        if (kind == 0) body<0>(acc, u, wr, wc, fr, fq); else if (kind == 1) body<1>(acc, u, wr, wc, fr, fq); else body<2>(acc, u, wr, wc, fr, fq);
    }
};
struct EpiBranch {
    static constexpr bool PERM = true, AFTER_DRAIN = false;
    const bf16_t* gates; bf16_t* merged; int goff; int accum;
    __device__ __forceinline__ void operator()(const f32x4 (&acc)[2][2][4][2], const Unit& u, int wr, int wc, int fr, int fq) const {
        const int row0 = u.pm * BM + wr * 64 + fr, col0 = u.pn * BM + wc * 32 + 8 * fq;
#pragma unroll
        for (int ai = 0; ai < 2; ++ai)
#pragma unroll
            for (int m = 0; m < 4; ++m) { const int row = row0 + ai * HALF + m * 16;
#pragma unroll
                for (int bj = 0; bj < 2; ++bj) { const int c = col0 + bj * HALF; const u32x4 gq = *(const u32x4*)(gates + (size_t)row * 2048 + goff + c);
                    bf16_t* mp = merged + (size_t)row * 1024 + c;
                    f32x4 v0 = acc[ai][bj][m][0], v1 = acc[ai][bj][m][1];
                    v0[0] *= bf_lo(gq.x); v0[1] *= bf_hi(gq.x); v0[2] *= bf_lo(gq.y); v0[3] *= bf_hi(gq.y);
                    v1[0] *= bf_lo(gq.z); v1[1] *= bf_hi(gq.z); v1[2] *= bf_lo(gq.w); v1[3] *= bf_hi(gq.w);
                    if (accum) { const u32x4 pq = *(const u32x4*)mp;
                        v0[0] += bf_lo(pq.x); v0[1] += bf_hi(pq.x); v0[2] += bf_lo(pq.y); v0[3] += bf_hi(pq.y);
                        v1[0] += bf_lo(pq.z); v1[1] += bf_hi(pq.z); v1[2] += bf_lo(pq.w); v1[3] += bf_hi(pq.w); }
                    *(u32x4*)mp = pack8(v0, v1); } asm volatile("" ::: "memory"); }
    }
};

template <class Epi, class Sched, bool ALIGN_EPI = false, bool SP2 = false>
__device__ __forceinline__ void gemm_phase(PG8_LAS unsigned char* lds, const Gemm g, const Sched& S, const Epi& E) {
    int tid_ = threadIdx.x; asm volatile("" : "+v"(tid_));
    const int tid = tid_, wid = __builtin_amdgcn_readfirstlane(tid >> 6), lane = tid & 63, wr = wid >> 2, wc = wid & 3, fr = lane & 15, fq = lane >> 4;
    const int K = g.K, nt = K / BK;
    unsigned voffA[2], voffB[2];
#pragma unroll
    for (int i = 0; i < 2; ++i) { int R, C; stage_rc(tid * 16 + i * 8192, R, C); const int Rb = Epi::PERM ? ((R & ~31) + perm32(R & 31)) : R;
        voffA[i] = (unsigned)(R * K + C) * 2u; voffB[i] = (unsigned)(Rb * K + C) * 2u; }
    const size_t kstep = (size_t)(BK * 2);
    const size_t hstep = (size_t)HALF * K * 2;
    const size_t tstep = 2 * hstep;
    const unsigned ldsw = (unsigned)wid * 1024u;
    const int aoff = lds_byte(wr * 64 + fr, fq * 8), boff = lds_byte(wc * 32 + fr, fq * 8);
#define PG8_SA(b, h) (((b) * 2 + (h)) * HTB)
#define PG8_SB(b, h) ((4 + (b) * 2 + (h)) * HTB)
#define PG8_STAGE(bufoff, gbase, voff) do { _Pragma("unroll") for (int _i = 0; _i < 2; ++_i) \
        __builtin_amdgcn_global_load_lds((const unsigned*)((const char*)(gbase) + (voff)[_i]), (PG8_LAS unsigned*)(lds + (bufoff) + ldsw + _i * 8192), 16, 0, 0); } while (0)
#define PG8_LDA(dst, b, h) do { _Pragma("unroll") for (int m = 0; m < 4; ++m) _Pragma("unroll") for (int k = 0; k < 2; ++k) dst[m][k] = *(const PG8_LAS bf16x8*)(lds + PG8_SA(b, h) + aoff + m * 2048 + k * 1024); } while (0)
#define PG8_LDB(dst, b, h) do { _Pragma("unroll") for (int n = 0; n < 2; ++n) _Pragma("unroll") for (int k = 0; k < 2; ++k) dst[n][k] = *(const PG8_LAS bf16x8*)(lds + PG8_SB(b, h) + boff + n * 2048 + k * 1024); } while (0)
#define PG8_MMA(ai, bj, At, Bt) do { __builtin_amdgcn_s_setprio(1); _Pragma("unroll") for (int m = 0; m < 4; ++m) _Pragma("unroll") for (int n = 0; n < 2; ++n) _Pragma("unroll") for (int k = 0; k < 2; ++k) \
        acc[ai][bj][m][n] = __builtin_amdgcn_mfma_f32_16x16x32_bf16(Bt[n][k], At[m][k], acc[ai][bj][m][n], 0, 0, 0); __builtin_amdgcn_s_setprio(0); } while (0)
#define PG8_WAIT_V(n) asm volatile("s_waitcnt vmcnt(" #n ")" ::: "memory")
#define PG8_WAIT_L(n) asm volatile("s_waitcnt lgkmcnt(" #n ")" ::: "memory")
#define PG8_BAR __builtin_amdgcn_s_barrier()
#define PG8_SCHED __builtin_amdgcn_sched_barrier(0)
    Unit cur, nxt; int ui = 0;
    if (!S.next(0, cur)) return;
    f32x4 acc[2][2][4][2];
#pragma unroll
    for (int a = 0; a < 2; ++a)
#pragma unroll
        for (int b = 0; b < 2; ++b)
#pragma unroll
            for (int m = 0; m < 4; ++m)
#pragma unroll
                for (int n = 0; n < 2; ++n) acc[a][b][m][n] = (f32x4){0.f, 0.f, 0.f, 0.f};
    bf16x8 At[4][2], B0[2][2], B1[2][2];
    const char* cA = (const char*)g.A + (size_t)cur.pm * tstep; const char* cB = (const char*)g.Bt + (size_t)cur.pn * tstep;
    S.a_ready(cur);
    if constexpr (SP2) {
        PG8_STAGE(PG8_SB(0, 0), cB, voffB); PG8_STAGE(PG8_SB(0, 1), cB + hstep, voffB); PG8_STAGE(PG8_SA(0, 0), cA, voffA); PG8_STAGE(PG8_SA(0, 1), cA + hstep, voffA);
        if (wr == 1) PG8_BAR;
        PG8_WAIT_V(2); PG8_BAR;
        PG8_STAGE(PG8_SB(1, 0), cB + kstep, voffB); PG8_STAGE(PG8_SA(1, 0), cA + kstep, voffA); PG8_STAGE(PG8_SB(1, 1), cB + hstep + kstep, voffB);
        PG8_WAIT_V(6); PG8_BAR;
    } else {
        PG8_STAGE(PG8_SB(0, 0), cB, voffB); PG8_STAGE(PG8_SA(0, 0), cA, voffA); PG8_STAGE(PG8_SB(0, 1), cB + hstep, voffB); PG8_STAGE(PG8_SA(0, 1), cA + hstep, voffA);
        if (wr == 1) PG8_BAR;
        PG8_WAIT_V(4); PG8_BAR;
        PG8_STAGE(PG8_SB(1, 0), cB + kstep, voffB); PG8_STAGE(PG8_SA(1, 0), cA + kstep, voffA); PG8_STAGE(PG8_SB(1, 1), cB + hstep + kstep, voffB);
        PG8_WAIT_V(6); PG8_BAR;
    }
    for (;;) {
        const bool has_next = S.next(ui + 1, nxt);
        const char* nA = has_next ? (const char*)g.A + (size_t)nxt.pm * tstep : cA; const char* nB = has_next ? (const char*)g.Bt + (size_t)nxt.pn * tstep : cB;
        for (int t = 0; t < nt; t += 2) {
            const bool last = (t == nt - 2);
            const char* a1 = cA + (size_t)(t + 1) * kstep;
            const char* a2 = last ? nA : cA + (size_t)(t + 2) * kstep; const char* b2 = last ? nB : cB + (size_t)(t + 2) * kstep;
            const char* a3 = a2 + kstep; const char* b3 = b2 + kstep;
            if (last && has_next) S.a_ready(nxt);
            if constexpr (SP2) {
            PG8_LDB(B0, 0, 0); PG8_LDB(B1, 0, 1); PG8_SCHED; PG8_LDA(At, 0, 0); PG8_STAGE(PG8_SA(1, 1), a1 + hstep, voffA);
            PG8_WAIT_V(8); PG8_WAIT_L(0); PG8_BAR; PG8_MMA(0, 0, At, B0); PG8_MMA(0, 1, At, B1); PG8_BAR; PG8_SCHED;
            PG8_LDA(At, 0, 1); PG8_STAGE(PG8_SB(0, 0), b2, voffB); PG8_STAGE(PG8_SB(0, 1), b2 + hstep, voffB); PG8_STAGE(PG8_SA(0, 0), a2, voffA);
            PG8_WAIT_V(8); PG8_WAIT_L(0); PG8_BAR; PG8_MMA(1, 0, At, B0); PG8_MMA(1, 1, At, B1); PG8_BAR; PG8_SCHED;
            PG8_LDB(B0, 1, 0); PG8_LDB(B1, 1, 1); PG8_SCHED; PG8_LDA(At, 1, 0); PG8_STAGE(PG8_SA(0, 1), a2 + hstep, voffA);
            PG8_WAIT_V(8); PG8_WAIT_L(0); PG8_BAR; PG8_MMA(0, 0, At, B0); PG8_MMA(0, 1, At, B1); PG8_BAR; PG8_SCHED;
            PG8_LDA(At, 1, 1); PG8_STAGE(PG8_SB(1, 0), b3, voffB); PG8_STAGE(PG8_SB(1, 1), b3 + hstep, voffB); PG8_STAGE(PG8_SA(1, 0), a3, voffA);
            PG8_WAIT_V(8); PG8_WAIT_L(0); PG8_BAR; PG8_MMA(1, 0, At, B0); PG8_MMA(1, 1, At, B1); PG8_BAR; PG8_SCHED;
            } else {
            PG8_LDB(B0, 0, 0); PG8_SCHED; PG8_LDA(At, 0, 0); PG8_STAGE(PG8_SA(1, 1), a1 + hstep, voffA);
            PG8_WAIT_L(8); PG8_BAR; PG8_WAIT_L(0); PG8_MMA(0, 0, At, B0); PG8_BAR; PG8_SCHED;
            PG8_LDB(B1, 0, 1); PG8_STAGE(PG8_SB(0, 0), b2, voffB);
            PG8_BAR; PG8_WAIT_L(0); PG8_MMA(0, 1, At, B1); PG8_BAR;
            PG8_LDA(At, 0, 1); PG8_STAGE(PG8_SA(0, 0), a2, voffA);
            PG8_BAR; PG8_WAIT_L(0); PG8_MMA(1, 0, At, B0); PG8_BAR; PG8_SCHED;
            PG8_STAGE(PG8_SB(0, 1), b2 + hstep, voffB);
            PG8_WAIT_V(6); PG8_BAR; PG8_MMA(1, 1, At, B1); PG8_BAR;
            PG8_LDB(B0, 1, 0); PG8_SCHED; PG8_LDA(At, 1, 0); PG8_STAGE(PG8_SA(0, 1), a2 + hstep, voffA);
            PG8_WAIT_L(8); PG8_BAR; PG8_WAIT_L(0); PG8_MMA(0, 0, At, B0); PG8_BAR; PG8_SCHED;
            PG8_LDB(B1, 1, 1); PG8_STAGE(PG8_SB(1, 0), b3, voffB);
            PG8_BAR; PG8_WAIT_L(0); PG8_MMA(0, 1, At, B1); PG8_BAR;
            PG8_LDA(At, 1, 1); PG8_STAGE(PG8_SA(1, 0), a3, voffA);
            PG8_BAR; PG8_WAIT_L(0); PG8_MMA(1, 0, At, B0); PG8_BAR; PG8_SCHED;
            PG8_STAGE(PG8_SB(1, 1), b3 + hstep, voffB);
            PG8_WAIT_V(6); PG8_BAR; PG8_MMA(1, 1, At, B1); PG8_BAR;
            }
        }
        if constexpr (ALIGN_EPI) { if (wr == 0) PG8_BAR; }
        if constexpr (!Epi::AFTER_DRAIN) { E(acc, cur, wr, wc, fr, fq); S.done(cur); }
        if (!has_next) break;
#pragma unroll
        for (int a = 0; a < 2; ++a)
#pragma unroll
            for (int b = 0; b < 2; ++b)
#pragma unroll
                for (int m = 0; m < 4; ++m)
#pragma unroll
                    for (int n = 0; n < 2; ++n) acc[a][b][m][n] = (f32x4){0.f, 0.f, 0.f, 0.f};
        cur = nxt; cA = nA; cB = nB; ++ui;
        if constexpr (ALIGN_EPI) { if (wr == 1) PG8_BAR; }
    }
    PG8_WAIT_V(0);
    if constexpr (!ALIGN_EPI) { if (wr == 0) PG8_BAR; }
    PG8_BAR;
    if constexpr (Epi::AFTER_DRAIN) { E.fused(acc, cur, wr, wc, fr, fq, lds, wid, lane); S.done(cur); }
#undef PG8_SA
#undef PG8_SB
#undef PG8_STAGE
#undef PG8_LDA
#undef PG8_LDB
#undef PG8_MMA
#undef PG8_WAIT_V
#undef PG8_WAIT_L
#undef PG8_BAR
#undef PG8_SCHED
}
}
constexpr int NWAVES = 8;
constexpr int BATCH = 8, T = 4096, D = 1024, M = BATCH * T, FF = 2816, NH = 8, HD = 64, INC = 4512;
constexpr float RMS_EPS = 1e-6f, GN_EPS = 64e-5f;
constexpr size_t MiB = 1u << 20;
constexpr size_t WS_PART = 1 * MiB;
constexpr size_t WS_SC = 9 * MiB;
constexpr size_t WS_WGU1 = 13 * MiB, WS_WDN1 = WS_WGU1 + 11 * MiB, WS_WGU2 = WS_WDN1 + 5632 * 1024, WS_WDN2 = WS_WGU2 + 11 * MiB;
constexpr size_t WS_WIN = WS_WDN2 + 5632 * 1024, WS_WGT = WS_WIN + 5 * MiB, WS_WLO = WS_WGT + 4 * MiB, WS_WBR = WS_WLO + 768 * 1024, WS_WBA = WS_WBR + 1 * MiB, WS_WOUT = WS_WBA + 1 * MiB;
constexpr size_t WS_XB = 62 * MiB;
constexpr size_t WS_ATTQ = 126 * MiB;
constexpr size_t WS_ATTKV = 158 * MiB;
constexpr size_t WS_RKVL = 174 * MiB;
constexpr size_t WS_G = 286 * MiB;
constexpr size_t WS_REC = 318 * MiB, REC_SLOT = 32 * MiB;
constexpr size_t WS_H = 126 * MiB;
constexpr size_t WS_YRAW = WS_RKVL;
constexpr size_t WS_MERGED = WS_RKVL;
constexpr size_t WS_GATES = WS_REC;
constexpr size_t WS_YR = WS_REC + 4 * REC_SLOT;
constexpr size_t WS_LA = WS_REC + 5 * REC_SLOT;
constexpr size_t WS_END = WS_REC + 6 * REC_SLOT;
static_assert(WS_WOUT + 4 * MiB <= WS_XB && WS_H + (size_t)M * FF * 2 <= WS_REC && WS_MERGED + (size_t)M * 2048 * 2 <= WS_REC, "ws map");
constexpr int RING_BYTES = 131072, LDS_BYTES = 147456;

#define GAS __attribute__((address_space(1)))
#define LAS __attribute__((address_space(3)))
typedef unsigned short bf16;
typedef unsigned v4u __attribute__((ext_vector_type(4)));
typedef unsigned v2u __attribute__((ext_vector_type(2)));
typedef float f32x4 __attribute__((ext_vector_type(4)));
typedef float f32x2 __attribute__((ext_vector_type(2)));
typedef short bf16x8 __attribute__((ext_vector_type(8)));
#define LDS_WAIT() asm volatile("s_waitcnt lgkmcnt(0)" ::: "memory")
__device__ __forceinline__ unsigned f2bf(float f) { unsigned u = __builtin_bit_cast(unsigned, f); return (u + 0x7fffu + ((u >> 16) & 1u)) >> 16; }
__device__ __forceinline__ unsigned pk2(float lo, float hi) { return f2bf(lo) | (f2bf(hi) << 16); }
__device__ __forceinline__ float bflo(unsigned u) { return __uint_as_float(u << 16); }
__device__ __forceinline__ float bfhi(unsigned u) { return __uint_as_float(u & 0xffff0000u); }
__device__ __forceinline__ float bf1(bf16 h) { return __uint_as_float((unsigned)h << 16); }
__device__ __forceinline__ float wave_sum(float v) {
#pragma unroll
    for (int o = 1; o < 64; o <<= 1) v += __shfl_xor(v, o);
    return v;
}
template <int CTRL> __device__ __forceinline__ float dppf(float x) { return __builtin_bit_cast(float, __builtin_amdgcn_update_dpp(0, __builtin_bit_cast(int, x), CTRL, 0xf, 0xf, false)); }
__device__ __forceinline__ float row16_sum(float x) { x += dppf<0xB1>(x); x += dppf<0x4E>(x); x += dppf<0x141>(x); x += dppf<0x140>(x); return x; }

#define RLX_AGENT __ATOMIC_RELAXED, __HIP_MEMORY_SCOPE_AGENT
#define XB_TMO      128
#define XB_XCNT(j)  (256  + 64 * (j))
#define XB_XSUB(j)  (1280 + 64 * (j))
#define XB_XGEN(j)  (2304 + 64 * (j))
#define XB_TOP      3328
#define XB_TOPGEN   3392
#define XCD_BAR_WORDS 3456
#define XB_SPIN_CAP (1u << 18)

__device__ __forceinline__ unsigned xb_ld(unsigned* p)              { return __hip_atomic_load(p, __ATOMIC_RELAXED, __HIP_MEMORY_SCOPE_AGENT); }
__device__ __forceinline__ unsigned xb_add(unsigned* p, unsigned v) { return __hip_atomic_fetch_add(p, v, __ATOMIC_RELAXED, __HIP_MEMORY_SCOPE_AGENT); }
__device__ __forceinline__ unsigned xb_xcc_id() { return (unsigned)__builtin_amdgcn_s_getreg((3 << 11) | 20) & 0xFu; }
#define XB_SPIN(cond, bar) do { unsigned _sp = 0; while (cond) { __builtin_amdgcn_s_sleep(1); \
    if ((++_sp & 255u) == 0u) { if (xb_ld(&(bar)[XB_TMO])) break; if (_sp > XB_SPIN_CAP) { atomicAdd(&(bar)[XB_TMO], 1u); break; } } } } while (0)

struct XcdBarrier {
    unsigned* bar; unsigned x;
    volatile LAS unsigned* st;
};

__device__ __forceinline__ XcdBarrier xcd_barrier_post(unsigned* bar, volatile LAS unsigned* st) {
    XcdBarrier b; b.bar = bar; b.x = xb_xcc_id(); b.st = st;
    if (threadIdx.x == 0) (void)xb_add(&bar[XB_XCNT(b.x)], 1u);
    return b;
}
__device__ __forceinline__ void xcd_barrier_complete(unsigned* bar, unsigned x, unsigned& nloc, unsigned& nx) {
    const unsigned G = gridDim.x * gridDim.y * gridDim.z;
    unsigned sum, cnt, mine, sp = 0u;
    for (;;) {
        sum = 0u; cnt = 0u; mine = 0u;
#pragma unroll
        for (unsigned j = 0; j < 16; ++j) { const unsigned c = xb_ld(&bar[XB_XCNT(j)]); sum += c; cnt += (c > 0u) ? 1u : 0u; mine = (j == x) ? c : mine; }
        if (sum == G) break;
        __builtin_amdgcn_s_sleep(1);
        if ((++sp & 255u) == 0u) { if (xb_ld(&bar[XB_TMO])) break; if (sp > XB_SPIN_CAP) { atomicAdd(&bar[XB_TMO], 1u); break; } }
    }
    nloc = mine > 0u ? mine : 1u; nx = cnt > 0u ? cnt : 1u;
}

__device__ __forceinline__ void xcd_barrier(const XcdBarrier& b) {
    asm volatile("s_waitcnt vmcnt(0)" ::: "memory");
    __syncthreads();
    if (threadIdx.x == 0) {
        unsigned* bar = b.bar;
        __builtin_amdgcn_s_waitcnt(0);
        unsigned nloc = b.st[0], nx = b.st[1];
        if (nloc == 0u) { xcd_barrier_complete(bar, b.x, nloc, nx); b.st[0] = nloc; b.st[1] = nx; }
        const unsigned old = xb_add(&bar[XB_XSUB(b.x)], 1u);
        const unsigned gen = old / nloc;
        if (old + 1u == (gen + 1u) * nloc) {
            __builtin_amdgcn_fence(__ATOMIC_RELEASE, "agent");
            asm volatile("s_waitcnt vmcnt(0)" ::: "memory");
            const unsigned og = xb_add(&bar[XB_TOP], 1u);
            const unsigned tg = og / nx;
            if (og + 1u == (tg + 1u) * nx) xb_add(&bar[XB_TOPGEN], 1u);
            else XB_SPIN(xb_ld(&bar[XB_TOPGEN]) == tg, bar);
            __builtin_amdgcn_fence(__ATOMIC_ACQUIRE, "agent");
            xb_add(&bar[XB_XGEN(b.x)], 1u);
            asm volatile("s_waitcnt vmcnt(0)" ::: "memory");
        } else {
            XB_SPIN(xb_ld(&bar[XB_XGEN(b.x)]) == gen, bar);
            __builtin_amdgcn_fence(__ATOMIC_ACQUIRE, "agent");
            asm volatile("s_waitcnt vmcnt(0)" ::: "memory");
        }
    }
    __syncthreads();
}

__device__ __forceinline__ int fresh_tid() { int t = threadIdx.x; asm volatile("" : "+v"(t)); return t; }
struct Frame {
    LAS unsigned char* lds;
    int tid, lane, wave, vcu, G;
    const float *in0, *in1, *in2, *in3, *in4, *in5, *in6, *in7, *in8, *in9, *in10, *in11, *in12, *in13, *in14, *in15, *in16, *in17, *in18, *in19, *in20, *in21, *in22, *in23, *in24, *in25, *in26, *in27, *in28; float* out; unsigned char* ws;
};

__device__ __forceinline__ void tr_item(const float* W, int ldn, int k0, int n0, bf16* WT, int ldk, int drow0, int dk0, const float* scale, int dup, LAS float* scr, int lane) {
    float tv[32], ts[32];
#pragma unroll
    for (int i = 0; i < 32; ++i) { const int kk = 2 * i + (lane >> 5); tv[i] = W[(size_t)(k0 + kk) * ldn + n0 + (lane & 31)]; ts[i] = scale ? scale[k0 + kk] : 1.0f; }
#pragma unroll
    for (int i = 0; i < 32; ++i) { const int kk = 2 * i + (lane >> 5); scr[kk * 33 + (lane & 31)] = tv[i] * ts[i]; }
    LDS_WAIT(); asm volatile("" ::: "memory");
    const int c = lane & 7;
#pragma unroll
    for (int j = 0; j < 4; ++j) { const int n = (lane >> 3) + 8 * j; const LAS float* s = scr + (8 * c) * 33 + n;
        v4u o; o.x = pk2(s[0 * 33], s[1 * 33]); o.y = pk2(s[2 * 33], s[3 * 33]); o.z = pk2(s[4 * 33], s[5 * 33]); o.w = pk2(s[6 * 33], s[7 * 33]);
        bf16* dp = WT + (size_t)(drow0 + n0 + n) * ldk + dk0 + k0 + 8 * c;
        *(GAS v4u*)dp = o; if (dup) *(GAS v4u*)(dp + dup) = o; }
    LDS_WAIT(); asm volatile("" ::: "memory");
}
__device__ __forceinline__ void p0_prologue(Frame& F) {
    LAS float* scr = (LAS float*)(F.lds + F.wave * 16384);
    unsigned char* ws = F.ws;
    const int gw = F.vcu * NWAVES + F.wave, NGW = F.G * NWAVES, lane = fresh_tid() & 63;
    constexpr int I_GU = 16 * 88, I_DN = 44 * 32, I_IN = 16 * 77, I_GT = 16 * 64, I_BR = 8 * 32, I_OUT = 16 * 32;
    constexpr int NITEMS = 4 * I_GU + 2 * I_DN + I_IN + I_GT + 2 * I_BR + I_OUT;
    for (int it = gw; it < NITEMS; it += NGW) {
        int r = it;
        if (r < 4 * I_GU) {
            const int which = r / I_GU; r -= which * I_GU; const int kb = r / 88, nb = r % 88, n0 = nb * 32;
            const float* W = which == 0 ? F.in2 : which == 1 ? F.in3 : which == 2 ? F.in25 : F.in26;
            tr_item(W, FF, kb * 64, n0, (bf16*)(ws + (which < 2 ? WS_WGU1 : WS_WGU2)), D, (n0 >> 7) * 256 + (which & 1) * 128 + (n0 & 127) - n0, 0, which < 2 ? F.in1 : F.in24, 0, scr, lane);
            continue; }
        r -= 4 * I_GU;
        if (r < 2 * I_DN) { const int which = r / I_DN; r -= which * I_DN; const int kb = r / 32, nb = r % 32;
            tr_item(which ? F.in27 : F.in4, D, kb * 64, nb * 32, (bf16*)(ws + (which ? WS_WDN2 : WS_WDN1)), FF, 0, 0, nullptr, 0, scr, lane); continue; }
        r -= 2 * I_DN;
        if (r < I_IN) { const int kb = r / 77, nb = r % 77, n0 = nb * 32;
            tr_item(F.in6, INC, kb * 64, n0, (bf16*)(ws + WS_WIN), D, n0 < 1696 ? 0 : 96, 0, F.in5, 0, scr, lane); continue; }
        r -= I_IN;
        if (r < I_GT) { const int kb = r / 64, nb = r % 64;
            tr_item(F.in6, INC, kb * 64, 2464 + nb * 32, (bf16*)(ws + WS_WGT), D, -2464, 0, F.in5, 0, scr, lane); continue; }
        r -= I_GT;
        if (r < 2 * I_BR) { const int which = r / I_BR; r -= which * I_BR; const int kb = r / 32, nb = r % 32;
            tr_item(which ? F.in22 : F.in21, D, kb * 64, nb * 32, (bf16*)(ws + (which ? WS_WBA : WS_WBR)), 512, 0, 0, nullptr, 0, scr, lane); continue; }
        r -= 2 * I_BR;
        { const int kb = r / 32, nb = r % 32; tr_item(F.in23, D, kb * 64, nb * 32, (bf16*)(ws + WS_WOUT), D, 0, 0, nullptr, 0, scr, lane); }
    }
    { GAS v4u* z = (GAS v4u*)(ws + WS_WIN + (size_t)1696 * D * 2); for (int i = gw * 64 + lane; i < 12288; i += NGW * 64) z[i] = (v4u){0u, 0u, 0u, 0u}; }
    { bf16* WL = (bf16*)(ws + WS_WLO);
      for (int i = gw * 64 + lane; i < 1536 * 256; i += NGW * 64) { const int n = i >> 8, k = i & 255, grp = n >> 9, nn = n & 511; float v = 0.f;
          if (grp == 0) { if (k < 32) v = F.in9[k * 512 + nn]; } else if (grp == 1) { if (k >= 32 && k < 64) v = F.in11[(k - 32) * 512 + nn]; } else { if (k >= 64 && k < 160) v = F.in12[(k - 64) * 512 + nn]; }
          WL[i] = (bf16)f2bf(v); } }
    { const float* x = F.in0; bf16* XB = (bf16*)(ws + WS_XB); float* part = (float*)(ws + WS_PART);
      for (int m0 = gw; m0 < M; m0 += 4 * NGW) { f32x4 v[4][4];
#pragma unroll
          for (int r = 0; r < 4; ++r) { const int m = m0 + r * NGW; if (m < M) { const GAS f32x4* xr = (const GAS f32x4*)(x + (size_t)m * D) + lane;
#pragma unroll
              for (int j = 0; j < 4; ++j) v[r][j] = xr[64 * j]; } }
#pragma unroll
          for (int r = 0; r < 4; ++r) { const int m = m0 + r * NGW; if (m < M) { float s = 0.f;
#pragma unroll
              for (int j = 0; j < 4; ++j) s += (v[r][j].x * v[r][j].x + v[r][j].y * v[r][j].y) + (v[r][j].z * v[r][j].z + v[r][j].w * v[r][j].w);
              s = wave_sum(s);
              GAS unsigned long long* o8 = (GAS unsigned long long*)(XB + (size_t)m * D) + lane;
#pragma unroll
              for (int j = 0; j < 4; ++j) o8[64 * j] = (unsigned long long)pk2(v[r][j].x, v[r][j].y) | ((unsigned long long)pk2(v[r][j].z, v[r][j].w) << 32);
              if (lane < 16) part[(size_t)m * 16 + lane] = lane == 0 ? s : 0.f; } } } }
}
__device__ __forceinline__ void p4_lora_in(Frame& F) {
    const bf16* RKVL = (const bf16*)(F.ws + WS_RKVL); bf16* LA = (bf16*)(F.ws + WS_LA); const float* mu = F.in7 + 1536;
    const int gw = F.vcu * NWAVES + F.wave, NGW = F.G * NWAVES, lane = fresh_tid() & 63, c0 = 4 * lane;
    const bool act = c0 < 160; f32x4 mv = (f32x4){0.f, 0.f, 0.f, 0.f}; if (act) mv = *(const GAS f32x4*)(mu + c0);
    for (int m0 = gw; m0 < M; m0 += 4 * NGW) {
        v2u cu[4], pu[4];
#pragma unroll
        for (int rr = 0; rr < 4; ++rr) { const int m = m0 + rr * NGW; cu[rr] = (v2u){0u, 0u}; pu[rr] = (v2u){0u, 0u};
            if (act) { cu[rr] = *(const GAS v2u*)(RKVL + (size_t)m * 1792 + 1536 + c0); if ((m & (T - 1)) != 0) pu[rr] = *(const GAS v2u*)(RKVL + (size_t)(m - 1) * 1792 + 1536 + c0); } }
#pragma unroll
        for (int rr = 0; rr < 4; ++rr) { const int m = m0 + rr * NGW; float o[4] = {0.f, 0.f, 0.f, 0.f};
            if (act) { const float cur[4] = {bflo(cu[rr].x), bfhi(cu[rr].x), bflo(cu[rr].y), bfhi(cu[rr].y)}, prv[4] = {bflo(pu[rr].x), bfhi(pu[rr].x), bflo(pu[rr].y), bfhi(pu[rr].y)};
#pragma unroll
                for (int j = 0; j < 4; ++j) { const float p = cur[j] + (prv[j] - cur[j]) * mv[j]; const int c = c0 + j;
                    o[j] = c < 32 ? tanhf(p) : (c < 64 ? p : 1.0f / (1.0f + __expf(-p))); } }
            *(GAS v2u*)(LA + (size_t)m * 256 + c0) = (v2u){pk2(o[0], o[1]), pk2(o[2], o[3])}; }
    }
}
__device__ __forceinline__ float sum8(float v) { v += __shfl_xor(v, 1); v += __shfl_xor(v, 2); v += __shfl_xor(v, 4); return v; }
__device__ __forceinline__ void unpack8(const v4u u, float (&f)[8]) { f[0] = bflo(u.x); f[1] = bfhi(u.x); f[2] = bflo(u.y); f[3] = bfhi(u.y); f[4] = bflo(u.z); f[5] = bfhi(u.z); f[6] = bflo(u.w); f[7] = bfhi(u.w); }
__device__ __forceinline__ v4u pack8u(const float (&f)[8]) { return (v4u){pk2(f[0], f[1]), pk2(f[2], f[3]), pk2(f[4], f[5]), pk2(f[6], f[7])}; }
__device__ __forceinline__ void ld8f(const float* p, float (&f)[8]) { const f32x4 a = *(const GAS f32x4*)p, b = *(const GAS f32x4*)(p + 4); f[0] = a.x; f[1] = a.y; f[2] = a.z; f[3] = a.w; f[4] = b.x; f[5] = b.y; f[6] = b.z; f[7] = b.w; }
__device__ __forceinline__ void p6_prep(Frame& F) {
    const bf16* RKVL = (const bf16*)(F.ws + WS_RKVL); bf16* REC = (bf16*)(F.ws + WS_REC); f32x4* SC = (f32x4*)(F.ws + WS_SC);
    constexpr size_t SL = REC_SLOT / 2;
    const int gw = F.vcu * NWAVES + F.wave, NGW = F.G * NWAVES, lane = fresh_tid() & 63, h = lane >> 3, c0 = 8 * lane, n0 = 8 * (lane & 7);
    float mur[8], muk[8], muv[8], kkw[8], kaw[8], rkw[8];
    ld8f(F.in7 + c0, mur); ld8f(F.in7 + 512 + c0, muk); ld8f(F.in7 + 1024 + c0, muv); ld8f(F.in13 + c0, kkw); ld8f(F.in14 + c0, kaw); ld8f(F.in15 + c0, rkw);
    for (int m0 = gw; m0 < M; m0 += 2 * NGW) {
        v4u ur[2], uk[2], uv[2], pr_[2], pk_[2], pv_[2], ua[2];
#pragma unroll
        for (int rr = 0; rr < 2; ++rr) { const int m = m0 + rr * NGW, b = m >> 12, t = m & (T - 1); const bool hp = t != 0;
            const bf16* cr = RKVL + (size_t)m * 1792 + c0; const bf16* pr = cr - (hp ? 1792 : 0);
            const size_t ri = ((size_t)(b * 8 + h) * T + t) * 64 + n0;
            ur[rr] = *(const GAS v4u*)cr; uk[rr] = *(const GAS v4u*)(cr + 512); uv[rr] = *(const GAS v4u*)(cr + 1024);
            pr_[rr] = *(const GAS v4u*)pr; pk_[rr] = *(const GAS v4u*)(pr + 512); pv_[rr] = *(const GAS v4u*)(pr + 1024);
            ua[rr] = *(const GAS v4u*)(REC + 4 * SL + ri); }
#pragma unroll
        for (int rr = 0; rr < 2; ++rr) { const int m = m0 + rr * NGW, b = m >> 12, t = m & (T - 1); const bool hp = t != 0;
            const size_t ri = ((size_t)(b * 8 + h) * T + t) * 64 + n0;
            float r[8], k[8], v[8], rp[8], kp[8], vp[8], a[8];
            unpack8(ur[rr], r); unpack8(uk[rr], k); unpack8(uv[rr], v); unpack8(pr_[rr], rp); unpack8(pk_[rr], kp); unpack8(pv_[rr], vp); unpack8(ua[rr], a);
            float kk[8], ss = 0.f;
#pragma unroll
            for (int j = 0; j < 8; ++j) { const float rpj = hp ? rp[j] : 0.f, kpj = hp ? kp[j] : 0.f, vpj = hp ? vp[j] : 0.f;
                r[j] += (rpj - r[j]) * mur[j]; k[j] += (kpj - k[j]) * muk[j]; v[j] += (vpj - v[j]) * muv[j];
                kk[j] = k[j] * kkw[j]; ss += kk[j] * kk[j]; }
            const float inv = 1.0f / fmaxf(sqrtf(sum8(ss)), 1e-12f);
            float an[8], bn[8], kn[8];
#pragma unroll
            for (int j = 0; j < 8; ++j) { kk[j] *= inv; an[j] = -kk[j]; bn[j] = kk[j] * a[j]; kn[j] = k[j] * (1.0f + (a[j] - 1.0f) * kaw[j]); }
            const v4u oa = pack8u(an), orr = pack8u(r), ok = pack8u(kn), ob = pack8u(bn), ov = pack8u(v);
            float rq[8], kq[8], bq[8]; unpack8(orr, rq); unpack8(ok, kq); unpack8(ob, bq);
            float sb = 0.f, sk = 0.f, sbo = 0.f;
#pragma unroll
            for (int j = 0; j < 8; ++j) { sb += bq[j] * rq[j]; sk += kq[j] * rq[j]; sbo += rq[j] * kq[j] * rkw[j]; }
            sb = sum8(sb); sk = sum8(sk); sbo = sum8(sbo);
            *(GAS v4u*)(REC + 1 * SL + ri) = oa; *(GAS v4u*)(REC + 2 * SL + ri) = orr; *(GAS v4u*)(REC + 3 * SL + ri) = ok; *(GAS v4u*)(REC + 4 * SL + ri) = ob; *(GAS v4u*)(REC + 5 * SL + ri) = ov;
            if ((lane & 7) == 0) SC[(size_t)(b * 8 + h) * T + t] = (f32x4){sb, sk, sbo, 0.f}; }
    }
}
constexpr int KS_STRIDE = 144, VT_STRIDE = 528, ATT_KS_OFF = 0, ATT_VT_OFF = 256 * KS_STRIDE;
__device__ __forceinline__ void p6_attention(Frame& F) {
    bf16* ATTQ = (bf16*)(F.ws + WS_ATTQ); const bf16* ATTKV = (const bf16*)(F.ws + WS_ATTKV);
    const float* qn = F.in18; const float* kn = F.in19; const float* sinks = F.in20;
    LAS unsigned char* Ks = F.lds + ATT_KS_OFF; LAS unsigned char* Vt = F.lds + ATT_VT_OFF;
    const int tid = fresh_tid(), lane = tid & 63, w = F.wave, g = lane >> 4, n16 = lane & 15;
    for (int unit = F.vcu; unit < BATCH * 2 * 32; unit += F.G) {
        const int nb = unit & 31, kvh = (unit >> 5) & 1, b = unit >> 6; const int m0 = b * T + nb * 128;
#pragma unroll
        for (int i = 0; i < 4; ++i) { const int e = tid + 512 * i, key = e >> 3, dg = e & 7; const bool valid = nb > 0 || key >= 128;
            v4u ku = (v4u){0u, 0u, 0u, 0u}, vu = (v4u){0u, 0u, 0u, 0u};
            if (valid) { const bf16* src = ATTKV + (size_t)(m0 - 128 + key) * 256 + kvh * 64 + dg * 8; ku = *(const GAS v4u*)src; vu = *(const GAS v4u*)(src + 128); }
            float kf[8] = {bflo(ku.x), bfhi(ku.x), bflo(ku.y), bfhi(ku.y), bflo(ku.z), bfhi(ku.z), bflo(ku.w), bfhi(ku.w)};
            float ss = 0.f;
#pragma unroll
            for (int j = 0; j < 8; ++j) ss += kf[j] * kf[j];
            ss += __shfl_xor(ss, 1); ss += __shfl_xor(ss, 2); ss += __shfl_xor(ss, 4);
            const float rs = 1.0f / sqrtf(ss * (1.0f / 64.0f) + RMS_EPS);
#pragma unroll
            for (int j = 0; j < 8; ++j) kf[j] *= rs * kn[dg * 8 + j];
            *(LAS v4u*)(Ks + key * KS_STRIDE + dg * 16) = (v4u){pk2(kf[0], kf[1]), pk2(kf[2], kf[3]), pk2(kf[4], kf[5]), pk2(kf[6], kf[7])};
            const unsigned vv[4] = {vu.x, vu.y, vu.z, vu.w};
#pragma unroll
            for (int j = 0; j < 8; ++j) *(LAS bf16*)(Vt + (dg * 8 + j) * VT_STRIDE + key * 2) = (bf16)((vv[j >> 1] >> ((j & 1) * 16)) & 0xffffu);
        }
        __syncthreads();
        const int hq = kvh * 4 + (w >> 1), qbase = (w & 1) * 64; const float sink = sinks[hq];
        for (int qt = 0; qt < 4; ++qt) {
            const int q0 = qbase + 16 * qt, qi = q0 + n16, kt0 = q0 >> 4;
            bf16* qp = ATTQ + (size_t)(m0 + qi) * 512 + hq * 64 + 8 * g;
            const v4u qa = *(const GAS v4u*)qp, qb = *(const GAS v4u*)(qp + 32);
            float q[16] = {bflo(qa.x), bfhi(qa.x), bflo(qa.y), bfhi(qa.y), bflo(qa.z), bfhi(qa.z), bflo(qa.w), bfhi(qa.w),
                           bflo(qb.x), bfhi(qb.x), bflo(qb.y), bfhi(qb.y), bflo(qb.z), bfhi(qb.z), bflo(qb.w), bfhi(qb.w)};
            float ss = 0.f;
#pragma unroll
            for (int j = 0; j < 16; ++j) ss += q[j] * q[j];
            ss += __shfl_xor(ss, 16); ss += __shfl_xor(ss, 32);
            const float rs = 0.125f / sqrtf(ss * (1.0f / 64.0f) + RMS_EPS);
#pragma unroll
            for (int j = 0; j < 16; ++j) q[j] *= rs * qn[(j >> 3) * 32 + 8 * g + (j & 7)];
            const v4u qf0 = (v4u){pk2(q[0], q[1]), pk2(q[2], q[3]), pk2(q[4], q[5]), pk2(q[6], q[7])}, qf1 = (v4u){pk2(q[8], q[9]), pk2(q[10], q[11]), pk2(q[12], q[13]), pk2(q[14], q[15])};
            const bf16x8 bq0 = __builtin_bit_cast(bf16x8, qf0), bq1 = __builtin_bit_cast(bf16x8, qf1);
            f32x4 st[10]; float mx = -INFINITY;
#pragma unroll
            for (int i = 0; i < 10; ++i) { const int kt = kt0 + i, ktc = kt < 16 ? kt : 15;
                const LAS unsigned char* kp = Ks + (16 * ktc + n16) * KS_STRIDE + 16 * g;
                const bf16x8 a0 = *(const LAS bf16x8*)kp, a1 = *(const LAS bf16x8*)(kp + 64);
                f32x4 acc = (f32x4){0.f, 0.f, 0.f, 0.f};
                acc = __builtin_amdgcn_mfma_f32_16x16x32_bf16(a0, bq0, acc, 0, 0, 0);
                acc = __builtin_amdgcn_mfma_f32_16x16x32_bf16(a1, bq1, acc, 0, 0, 0);
#pragma unroll
                for (int r = 0; r < 4; ++r) { const int kj = 16 * kt + 4 * g + r; const bool ok = (kj > qi) && (kj <= qi + 128) && (nb > 0 || kj >= 128);
                    acc[r] = ok ? acc[r] : -INFINITY; mx = fmaxf(mx, acc[r]); }
                st[i] = acc; }
            mx = fmaxf(mx, __shfl_xor(mx, 16)); mx = fmaxf(mx, __shfl_xor(mx, 32)); mx = fmaxf(mx, sink);
            float den = 0.f;
#pragma unroll
            for (int i = 0; i < 10; ++i)
#pragma unroll
                for (int r = 0; r < 4; ++r) { const float p = __expf(st[i][r] - mx); st[i][r] = p; den += p; }
            den += __shfl_xor(den, 16); den += __shfl_xor(den, 32); den += __expf(sink - mx);
            const float inv = 1.0f / den;
            f32x4 o[4];
#pragma unroll
            for (int dt = 0; dt < 4; ++dt) o[dt] = (f32x4){0.f, 0.f, 0.f, 0.f};
#pragma unroll
            for (int j = 0; j < 5; ++j) { const int ka = kt0 + 2 * j, kb2 = ka + 1, kac = ka < 16 ? ka : 15, kbc = kb2 < 16 ? kb2 : 15;
                const v4u pu = (v4u){pk2(st[2 * j][0], st[2 * j][1]), pk2(st[2 * j][2], st[2 * j][3]), pk2(st[2 * j + 1][0], st[2 * j + 1][1]), pk2(st[2 * j + 1][2], st[2 * j + 1][3])};
                const bf16x8 pf = __builtin_bit_cast(bf16x8, pu);
#pragma unroll
                for (int dt = 0; dt < 4; ++dt) { const LAS unsigned char* vp = Vt + (16 * dt + n16) * VT_STRIDE;
                    const v2u va = *(const LAS v2u*)(vp + (16 * kac + 4 * g) * 2), vb = *(const LAS v2u*)(vp + (16 * kbc + 4 * g) * 2);
                    const bf16x8 af = __builtin_bit_cast(bf16x8, (v4u){va.x, va.y, vb.x, vb.y});
                    o[dt] = __builtin_amdgcn_mfma_f32_16x16x32_bf16(af, pf, o[dt], 0, 0, 0); } }
            bf16* op = ATTQ + (size_t)(m0 + qi) * 512 + hq * 64 + 4 * g;
#pragma unroll
            for (int dt = 0; dt < 4; ++dt) *(GAS v2u*)(op + 16 * dt) = (v2u){pk2(o[dt][0] * inv, o[dt][1] * inv), pk2(o[dt][2] * inv, o[dt][3] * inv)};
        }
        __syncthreads();
    }
}
constexpr int SC_NS = 32, SC_NP = 16, SC_ARR = 4096, SC_SCL = 9 * SC_ARR, SC_VS = SC_SCL + 512, SC_YB = SC_VS + 4096, SC_BUF = SC_YB + 2048;
struct ScanPre { v2u lw1, a1, r1, k1, b1, lw2, a2, r2, k2, b2; unsigned short v1, v2; f32x4 sc1, sc2; };
__device__ __forceinline__ ScanPre scan_issue(Frame& F, int bh, int quarter, int t0, int lt) {
    const unsigned char* REC = F.ws + WS_REC; const f32x4* SC = (const f32x4*)(F.ws + WS_SC);
    const int pr = lt >> 4, q = lt & 15; const size_t st = (size_t)bh * T + t0 + 2 * pr;
    const size_t e1 = st * 128 + (size_t)q * 8, e2 = e1 + 128;
    ScanPre p;
    p.lw1 = *(const GAS v2u*)(REC + 0 * REC_SLOT + e1); p.a1 = *(const GAS v2u*)(REC + 1 * REC_SLOT + e1); p.r1 = *(const GAS v2u*)(REC + 2 * REC_SLOT + e1); p.k1 = *(const GAS v2u*)(REC + 3 * REC_SLOT + e1); p.b1 = *(const GAS v2u*)(REC + 4 * REC_SLOT + e1);
    p.lw2 = *(const GAS v2u*)(REC + 0 * REC_SLOT + e2); p.a2 = *(const GAS v2u*)(REC + 1 * REC_SLOT + e2); p.r2 = *(const GAS v2u*)(REC + 2 * REC_SLOT + e2); p.k2 = *(const GAS v2u*)(REC + 3 * REC_SLOT + e2); p.b2 = *(const GAS v2u*)(REC + 4 * REC_SLOT + e2);
    const bf16* RV = (const bf16*)(REC + 5 * REC_SLOT) + st * 64 + 16 * quarter + q;
    p.v1 = RV[0]; p.v2 = RV[64];
    p.sc1 = *(const GAS f32x4*)(SC + st); p.sc2 = *(const GAS f32x4*)(SC + st + 1);
    return p;
}
__device__ __forceinline__ void un4(const v2u u, float (&f)[4]) { f[0] = bflo(u.x); f[1] = bfhi(u.x); f[2] = bflo(u.y); f[3] = bfhi(u.y); }
__device__ __forceinline__ void scan_commit(const ScanPre& p, LAS unsigned char* buf, int lt) {
    const int pr = lt >> 4, q = lt & 15, idx = pr * 16 + q;
    float lw1[4], a1[4], r1[4], k1[4], b1[4], lw2[4], a2[4], r2[4], k2[4], b2[4];
    un4(p.lw1, lw1); un4(p.a1, a1); un4(p.r1, r1); un4(p.k1, k1); un4(p.b1, b1); un4(p.lw2, lw2); un4(p.a2, a2); un4(p.r2, r2); un4(p.k2, k2); un4(p.b2, b2);
    float w1[4], w2[4], z1[4], wa2[4], wz2[4], ww[4], bw[4], kw[4];
    float ba = 0.f, ka = 0.f, bz = 0.f, kz = 0.f;
#pragma unroll
    for (int j = 0; j < 4; ++j) { w1[j] = __expf(lw1[j]); w2[j] = __expf(lw2[j]); z1[j] = w1[j] * r1[j]; const float z2 = w2[j] * r2[j];
        wa2[j] = w1[j] * a2[j]; wz2[j] = w1[j] * z2; ww[j] = w1[j] * w2[j]; bw[j] = b1[j] * w2[j]; kw[j] = k1[j] * w2[j];
        ba += b1[j] * a2[j]; ka += k1[j] * a2[j]; bz += b1[j] * z2; kz += k1[j] * z2; }
    ba = row16_sum(ba); ka = row16_sum(ka); bz = row16_sum(bz); kz = row16_sum(kz);
    LAS f32x4* A = (LAS f32x4*)buf;
    A[0 * 256 + idx] = (f32x4){a1[0], z1[0], a1[1], z1[1]}; A[1 * 256 + idx] = (f32x4){a1[2], z1[2], a1[3], z1[3]};
    A[2 * 256 + idx] = (f32x4){wa2[0], wz2[0], wa2[1], wz2[1]}; A[3 * 256 + idx] = (f32x4){wa2[2], wz2[2], wa2[3], wz2[3]};
    A[4 * 256 + idx] = (f32x4){ww[0], ww[1], ww[2], ww[3]}; A[5 * 256 + idx] = (f32x4){bw[0], bw[1], bw[2], bw[3]}; A[6 * 256 + idx] = (f32x4){kw[0], kw[1], kw[2], kw[3]};
    A[7 * 256 + idx] = (f32x4){b2[0], b2[1], b2[2], b2[3]}; A[8 * 256 + idx] = (f32x4){k2[0], k2[1], k2[2], k2[3]};
    if (q == 0) { LAS f32x4* S4 = (LAS f32x4*)(buf + SC_SCL); S4[pr * 2] = (f32x4){ba, ka, bz, kz}; S4[pr * 2 + 1] = (f32x4){p.sc1.x, p.sc2.x, 0.f, 0.f}; }
    const float v1 = bf1(p.v1), v2 = bf1(p.v2);
    ((LAS f32x4*)(buf + SC_VS))[idx] = (f32x4){v1, v2, v1 * p.sc1.y, v2 * p.sc2.y};
}
__device__ __forceinline__ void scan_flush(Frame& F, int bh, int quarter, int t0, const LAS unsigned char* buf, int lt) {
    if (lt < 128) { const int s = lt >> 2, c4 = lt & 3; const int b = bh >> 3, h = bh & 7;
        float* yraw = (float*)(F.ws + WS_YRAW);
        const LAS float* yb = (const LAS float*)(buf + SC_YB) + ((s >> 1) * 16 + 4 * c4) * 2 + (s & 1);
        const f32x4 y = (f32x4){yb[0], yb[2], yb[4], yb[6]};
        *(GAS f32x4*)(yraw + (size_t)(b * T + t0 + s) * 512 + h * 64 + 16 * quarter + 4 * c4) = y; }
}
__device__ __forceinline__ void p7_scan(Frame& F) {
    const int w = F.wave, tid = fresh_tid(), lane = tid & 63, rl = lane >> 4, q = lane & 15, lt = tid - 256;
    constexpr int NBLK = T / SC_NS;
#define SCAN_BAR() do { asm volatile("s_waitcnt lgkmcnt(0)" ::: "memory"); __builtin_amdgcn_s_barrier(); asm volatile("" ::: "memory"); } while (0)
    for (int unit = F.vcu; unit < 256; unit += F.G) {
        const int bh = unit >> 2, quarter = unit & 3;
        ScanPre pre;
        if (w >= 4) { pre = scan_issue(F, bh, quarter, 0, lt); scan_commit(pre, F.lds, lt); pre = scan_issue(F, bh, quarter, SC_NS, lt); }
        SCAN_BAR();
        float S0 = 0.f, S1 = 0.f, S2 = 0.f, S3 = 0.f;
        for (int nb = 0; nb < NBLK; ++nb) {
            LAS unsigned char* cur = F.lds + (nb & 1) * SC_BUF; LAS unsigned char* oth = F.lds + ((nb + 1) & 1) * SC_BUF;
            if (w >= 4) {
                if (nb > 0) scan_flush(F, bh, quarter, (nb - 1) * SC_NS, oth, lt);
                if (nb + 1 < NBLK) scan_commit(pre, oth, lt);
                if (nb + 2 < NBLK) pre = scan_issue(F, bh, quarter, (nb + 2) * SC_NS, lt);
            } else {
                const LAS f32x4* A = (const LAS f32x4*)cur + q; const LAS f32x4* SCL = (const LAS f32x4*)(cur + SC_SCL);
                const int rowl = 4 * w + rl; const LAS f32x4* VS = (const LAS f32x4*)(cur + SC_VS) + rowl; LAS f32x2* YB = (LAS f32x2*)(cur + SC_YB) + rowl;
                f32x4 az1a = A[0], az1b = A[256], az2a = A[512], az2b = A[768], ww = A[1024], b1 = A[1280], k1 = A[1536], b2 = A[1792], k2 = A[2048], c0 = SCL[0], vs = VS[0]; f32x2 c1 = *(const LAS f32x2*)(SCL + 1);
#pragma unroll 4
                for (int pr = 0; pr < SC_NP; ++pr) {
                    const int pn = (pr + 1) * 16;
                    const f32x4 n_az1a = A[pn], n_az1b = A[256 + pn], n_az2a = A[512 + pn], n_az2b = A[768 + pn], n_ww = A[1024 + pn], n_b1 = A[1280 + pn], n_k1 = A[1536 + pn], n_b2 = A[1792 + pn], n_k2 = A[2048 + pn],
                                n_c0 = SCL[2 * pr + 2], n_vs = VS[pn]; const f32x2 n_c1 = *(const LAS f32x2*)(SCL + 2 * pr + 3);
                    __builtin_amdgcn_sched_barrier(0);
                    float sa1 = S0 * az1a.x; sa1 = fmaf(S1, az1a.z, sa1); sa1 = fmaf(S2, az1b.x, sa1); sa1 = fmaf(S3, az1b.z, sa1);
                    float z1 = S0 * az1a.y; z1 = fmaf(S1, az1a.w, z1); z1 = fmaf(S2, az1b.y, z1); z1 = fmaf(S3, az1b.w, z1);
                    float p2 = S0 * az2a.x; p2 = fmaf(S1, az2a.z, p2); p2 = fmaf(S2, az2b.x, p2); p2 = fmaf(S3, az2b.z, p2);
                    float q2 = S0 * az2a.y; q2 = fmaf(S1, az2a.w, q2); q2 = fmaf(S2, az2b.y, q2); q2 = fmaf(S3, az2b.w, q2);
                    float t0_ = fmaf(vs.x, k1.x, S0 * ww.x), t1_ = fmaf(vs.x, k1.y, S1 * ww.y), t2_ = fmaf(vs.x, k1.z, S2 * ww.z), t3_ = fmaf(vs.x, k1.w, S3 * ww.w);
                    t0_ = fmaf(vs.y, k2.x, t0_); t1_ = fmaf(vs.y, k2.y, t1_); t2_ = fmaf(vs.y, k2.z, t2_); t3_ = fmaf(vs.y, k2.w, t3_);
                    sa1 = row16_sum(sa1); z1 = row16_sum(z1); p2 = row16_sum(p2); q2 = row16_sum(q2);
                    const float sa2 = fmaf(sa1, c0.x, fmaf(vs.x, c0.y, p2)), z2 = fmaf(sa1, c0.z, fmaf(vs.x, c0.w, q2));
                    S0 = fmaf(sa2, b2.x, fmaf(sa1, b1.x, t0_)); S1 = fmaf(sa2, b2.y, fmaf(sa1, b1.y, t1_)); S2 = fmaf(sa2, b2.z, fmaf(sa1, b1.z, t2_)); S3 = fmaf(sa2, b2.w, fmaf(sa1, b1.w, t3_));
                    YB[pr * 16] = (f32x2){fmaf(sa1, c1.x, z1) + vs.z, fmaf(sa2, c1.y, z2) + vs.w};
                    az1a = n_az1a; az1b = n_az1b; az2a = n_az2a; az2b = n_az2b; ww = n_ww; b1 = n_b1; k1 = n_k1; b2 = n_b2; k2 = n_k2; c0 = n_c0; c1 = n_c1; vs = n_vs;
                }
            }
            SCAN_BAR();
        }
        if (w >= 4) scan_flush(F, bh, quarter, T - SC_NS, F.lds + ((NBLK - 1) & 1) * SC_BUF, lt);
        asm volatile("s_waitcnt vmcnt(0)" ::: "memory"); SCAN_BAR();
    }
#undef SCAN_BAR
}
__device__ __forceinline__ void p8_post(Frame& F) {
    const float* yraw = (const float*)(F.ws + WS_YRAW); const bf16* RV = (const bf16*)(F.ws + WS_REC + 5 * REC_SLOT); const f32x4* SC = (const f32x4*)(F.ws + WS_SC);
    const bf16* Gt = (const bf16*)(F.ws + WS_G); bf16* YR = (bf16*)(F.ws + WS_YR);
    const int gw = F.vcu * NWAVES + F.wave, NGW = F.G * NWAVES, lane = fresh_tid() & 63, h = lane >> 3, c0 = 8 * lane, n0 = 8 * (lane & 7);
    float lw[8], lb[8]; ld8f(F.in16 + c0, lw); ld8f(F.in17 + c0, lb);
    for (int m0 = gw; m0 < M; m0 += 2 * NGW) {
        float yv[2][8]; v4u uvv[2], ugg[2]; f32x4 scv[2];
#pragma unroll
        for (int rr = 0; rr < 2; ++rr) { const int m = m0 + rr * NGW, b = m >> 12, t = m & (T - 1); const size_t rt = (size_t)(b * 8 + h) * T + t;
            ld8f(yraw + (size_t)m * 512 + c0, yv[rr]); uvv[rr] = *(const GAS v4u*)(RV + rt * 64 + n0); ugg[rr] = *(const GAS v4u*)(Gt + (size_t)m * 512 + c0); scv[rr] = *(const GAS f32x4*)(SC + rt); }
#pragma unroll
        for (int rr = 0; rr < 2; ++rr) { const int m = m0 + rr * NGW; const float bonus = scv[rr].z;
            float v[8], g[8]; unpack8(uvv[rr], v); unpack8(ugg[rr], g);
            float s1 = 0.f;
#pragma unroll
            for (int j = 0; j < 8; ++j) s1 += yv[rr][j];
            const float mean = sum8(s1) * (1.0f / 64.0f); float s2 = 0.f;
#pragma unroll
            for (int j = 0; j < 8; ++j) { yv[rr][j] -= mean; s2 += yv[rr][j] * yv[rr][j]; }
            const float rstd = 1.0f / sqrtf(sum8(s2) * (1.0f / 64.0f) + GN_EPS);
            float o[8];
#pragma unroll
            for (int j = 0; j < 8; ++j) o[j] = (yv[rr][j] * rstd * lw[j] + lb[j] + bonus * v[j]) * g[j];
            *(GAS v4u*)(YR + (size_t)m * 512 + c0) = pack8u(o); }
    }
}
__device__ __forceinline__ void p13_final(Frame& F) {
    const float* part = (const float*)(F.ws + WS_PART + 3 * 2 * MiB); const float* gn = F.in28;
    const int gw = F.vcu * NWAVES + F.wave, NGW = F.G * NWAVES, lane = fresh_tid() & 63;
    f32x4 g4[4];
#pragma unroll
    for (int j = 0; j < 4; ++j) g4[j] = ((const GAS f32x4*)gn)[lane + 64 * j];
    for (int m0 = gw; m0 < M; m0 += 4 * NGW) { f32x4 v[4][4]; float ps[4];
#pragma unroll
        for (int r = 0; r < 4; ++r) { const int m = m0 + r * NGW; ps[r] = 0.f; if (m < M) { GAS f32x4* xr = (GAS f32x4*)(F.out + (size_t)m * D) + lane; ps[r] = lane < 16 ? part[(size_t)m * 16 + lane] : 0.f;
#pragma unroll
            for (int j = 0; j < 4; ++j) v[r][j] = xr[64 * j]; } }
#pragma unroll
        for (int r = 0; r < 4; ++r) { const int m = m0 + r * NGW; if (m < M) { const float rs = 1.0f / sqrtf(wave_sum(ps[r]) * (1.0f / 1024.0f) + RMS_EPS);
            GAS f32x4* xr = (GAS f32x4*)(F.out + (size_t)m * D) + lane;
#pragma unroll
            for (int j = 0; j < 4; ++j) xr[64 * j] = v[r][j] * rs * g4[j]; } }
    }
}
struct Args { const float* in[29]; float* out; unsigned char* ws; };
__global__ void __launch_bounds__(NWAVES * 64, 2) fwd_megakernel(Args args) {
    extern __shared__ __attribute__((aligned(16))) unsigned char lds[];
    cg::grid_group grid = cg::this_grid();
    Frame F;
    F.lds = (LAS unsigned char*)lds;
    F.tid = threadIdx.x; F.lane = F.tid & 63; F.wave = __builtin_amdgcn_readfirstlane(F.tid >> 6);
    F.G = gridDim.x; { const int bx = blockIdx.x; F.vcu = (F.G % 8 == 0) ? (bx % 8) * (F.G / 8) + bx / 8 : bx; }
F.in0 = args.in[0]; F.in1 = args.in[1]; F.in2 = args.in[2]; F.in3 = args.in[3]; F.in4 = args.in[4]; F.in5 = args.in[5]; F.in6 = args.in[6]; F.in7 = args.in[7]; F.in8 = args.in[8]; F.in9 = args.in[9]; F.in10 = args.in[10]; F.in11 = args.in[11]; F.in12 = args.in[12]; F.in13 = args.in[13]; F.in14 = args.in[14]; F.in15 = args.in[15]; F.in16 = args.in[16]; F.in17 = args.in[17]; F.in18 = args.in[18]; F.in19 = args.in[19]; F.in20 = args.in[20]; F.in21 = args.in[21]; F.in22 = args.in[22]; F.in23 = args.in[23]; F.in24 = args.in[24]; F.in25 = args.in[25]; F.in26 = args.in[26]; F.in27 = args.in[27]; F.in28 = args.in[28];
    F.out = args.out; F.ws = args.ws;
    unsigned char* ws = args.ws;
    bf16* XB = (bf16*)(ws + WS_XB); bf16* HB = (bf16*)(ws + WS_H);
    float* PA = (float*)(ws + WS_PART); float* PB = PA + (size_t)M * 16; float* PC = PB + (size_t)M * 16; float* PD = PC + (size_t)M * 16;
    using pg8::gemm_phase; using pg8::StaticOrder; using pg8::Gemm;
    volatile LAS unsigned* bst = (volatile LAS unsigned*)(F.lds + RING_BYTES);
    if (F.tid == 0) { bst[0] = 0u; bst[1] = 0u; }
    __syncthreads();
    XcdBarrier bar = xcd_barrier_post((unsigned*)ws, bst);
#define SYNC() xcd_barrier(bar)
#define RUN_GEMM(EPI, Aptr, Bptr, NN, KK, ...) do { Gemm g_{(const pg8::bf16_t*)(Aptr), (const pg8::bf16_t*)(Bptr), M, (NN), (KK)}; StaticOrder S_; S_.init(M, (NN), F.G, (int)blockIdx.x); \
        pg8::EPI E_{__VA_ARGS__}; gemm_phase<pg8::EPI, StaticOrder, true, true>(F.lds, g_, S_, E_); } while (0)

    p0_prologue(F); grid.sync();
    RUN_GEMM(EpiGU, XB, ws + WS_WGU1, 2 * FF, D, HB, PA); SYNC();
    RUN_GEMM(EpiRes, HB, ws + WS_WDN1, D, FF, F.in0, F.out, XB, PB, 0.5f); SYNC();
    RUN_GEMM(EpiProj, XB, ws + WS_WIN, 2560, D, (bf16*)(ws + WS_RKVL), (bf16*)(ws + WS_ATTQ), (bf16*)(ws + WS_ATTKV), PB); SYNC();
    p4_lora_in(F); SYNC();
    RUN_GEMM(EpiLora, ws + WS_LA, ws + WS_WLO, 1536, 256, (bf16*)(ws + WS_REC), (bf16*)(ws + WS_REC + 4 * REC_SLOT), (bf16*)(ws + WS_G), F.in8, F.in10); SYNC();
    p6_prep(F); p6_attention(F); SYNC();
    p7_scan(F); SYNC();
    p8_post(F); SYNC();
    RUN_GEMM(EpiGate, XB, ws + WS_WGT, 2048, D, (bf16*)(ws + WS_GATES), PB); SYNC();
    RUN_GEMM(EpiBranch, ws + WS_YR, ws + WS_WBR, D, 512, (const bf16*)(ws + WS_GATES), (bf16*)(ws + WS_MERGED), 0, 0);
    RUN_GEMM(EpiBranch, ws + WS_ATTQ, ws + WS_WBA, D, 512, (const bf16*)(ws + WS_GATES), (bf16*)(ws + WS_MERGED), 1024, 1); SYNC();
    RUN_GEMM(EpiRes, ws + WS_MERGED, ws + WS_WOUT, D, D, F.out, F.out, XB, PC, 1.0f); SYNC();
    RUN_GEMM(EpiGU, XB, ws + WS_WGU2, 2 * FF, D, HB, PC); SYNC();
    RUN_GEMM(EpiRes, HB, ws + WS_WDN2, D, FF, F.out, F.out, (bf16*)nullptr, PD, 0.5f); SYNC();
    p13_final(F);
}

extern "C" void kernel_launch(void* const* d_in, const int* in_sizes, int n_in, void* d_out, int out_size, void* d_ws, size_t ws_size, hipStream_t stream) {
    static int grid = 0;
    if (grid == 0) {
        if (n_in != 29 || in_sizes[0] != M * D || out_size != M * D || ws_size < WS_END) { fprintf(stderr, "kernel_launch: unexpected shapes (n_in %d, ws %zu)\n", n_in, ws_size); grid = -1; return; }
        int dev = 0, cus = 0, per_cu = 0;
        hipGetDevice(&dev); hipDeviceGetAttribute(&cus, hipDeviceAttributeMultiprocessorCount, dev);
        if (hipFuncSetAttribute((const void*)fwd_megakernel, hipFuncAttributeMaxDynamicSharedMemorySize, LDS_BYTES) != hipSuccess) { fprintf(stderr, "kernel_launch: hipFuncSetAttribute failed\n"); grid = -1; return; }
        hipOccupancyMaxActiveBlocksPerMultiprocessor(&per_cu, (const void*)fwd_megakernel, NWAVES * 64, LDS_BYTES);
        (void)hipGetLastError();
        if (per_cu < 1) fprintf(stderr, "kernel_launch: occupancy query says %d blocks/CU\n", per_cu);
        grid = cus;
    }
    if (grid < 0) return;
    if (hipMemsetAsync(d_ws, 0, 16384, stream) != hipSuccess) { fprintf(stderr, "kernel_launch: memset failed\n"); return; }
    Args a{};
    for (int i = 0; i < 29; ++i) a.in[i] = (const float*)d_in[i];
    a.out = (float*)d_out; a.ws = (unsigned char*)d_ws;
    void* kargs[] = {&a};
    hipError_t e = hipLaunchCooperativeKernel((const void*)fwd_megakernel, dim3(grid), dim3(NWAVES * 64), kargs, LDS_BYTES, stream);
    if (e != hipSuccess) fprintf(stderr, "kernel_launch: cooperative launch failed: %s (grid %d)\n", hipGetErrorString(e), grid);
}
```

```cpp
#include <hip/hip_runtime.h>
#include <hip/hip_cooperative_groups.h>
#include <cstdio>
#include <cstdint>
namespace cg = cooperative_groups;
namespace pg8 {
#define PG8_LAS __attribute__((address_space(3)))
typedef unsigned short bf16_t;
typedef short bf16x8 __attribute__((ext_vector_type(8)));
typedef float f32x4 __attribute__((ext_vector_type(4)));
typedef unsigned u32x4 __attribute__((ext_vector_type(4)));
constexpr int BM = 256, BK = 64, HALF = 128, HTB = HALF * BK * 2  , STAGE_BYTES = 8 * HTB, NXCD = 8, WGM = 8;

__host__ __device__ __forceinline__ int lds_byte(int r, int c) { const int st = (r >> 4) * 2 + (c >> 5), rr = r & 15, cc = c & 31, ob = rr * 64 + cc * 2; return st * 1024 + (ob ^ (((ob >> 9) & 1) << 5)); }
__host__ __device__ __forceinline__ void stage_rc(int b, int& R, int& C) { const int st = b / 1024, sb = b % 1024, swz = sb ^ (((sb >> 9) & 1) << 5); R = (st >> 1) * 16 + swz / 64; C = (st & 1) * 32 + (swz % 64) / 2; }
__host__ __device__ __forceinline__ int perm32(int rho) { const int n = rho >> 4, i = rho & 15; return 8 * (i >> 2) + 4 * n + (i & 3); }

struct Unit { int pm, pn; };
struct Gemm { const bf16_t* A; const bf16_t* Bt; int M, N, K; };

struct StaticOrder {
    int nM, nN, nwg, G, c;
    __host__ __device__ void init(int M, int N, int G_, int c_) { nM = M / BM; nN = N / BM; nwg = nM * nN; G = G_; c = c_; }
    __host__ __device__ bool next(int i, Unit& u) const {
        const long L = (long)i * G + c; if (L >= nwg) return false;
        int wgid = (int)L; { const int q = nwg / NXCD, r = nwg % NXCD, xcd = wgid % NXCD, off = wgid / NXCD; wgid = (xcd < r ? xcd * (q + 1) : r * (q + 1) + (xcd - r) * q) + off; }
        const int nig = WGM * nN, gid = wgid / nig, fm = gid * WGM, gsz = (nM - fm) < WGM ? (nM - fm) : WGM;
        u.pm = fm + ((wgid % nig) % gsz); u.pn = (wgid % nig) / gsz; return true;
    }
    __device__ __forceinline__ void a_ready(const Unit&) const {}
    __device__ __forceinline__ void done(const Unit&) const {}
};

__device__ __forceinline__ unsigned cvt_pk_bf16(float lo, float hi) { unsigned r; asm volatile("v_cvt_pk_bf16_f32 %0, %1, %2" : "=v"(r) : "v"(lo), "v"(hi)); return r; }
__device__ __forceinline__ u32x4 pack8(f32x4 v0, f32x4 v1) {
    u32x4 w;
    asm volatile("s_nop 1\n\tv_cvt_pk_bf16_f32 %0, %4, %5\n\tv_cvt_pk_bf16_f32 %1, %6, %7\n\tv_cvt_pk_bf16_f32 %2, %8, %9\n\tv_cvt_pk_bf16_f32 %3, %10, %11"
                 : "=&v"(w.x), "=&v"(w.y), "=&v"(w.z), "=&v"(w.w)
                 : "v"(v0[0]), "v"(v0[1]), "v"(v0[2]), "v"(v0[3]), "v"(v1[0]), "v"(v1[1]), "v"(v1[2]), "v"(v1[3]));
    return w;
}
__device__ __forceinline__ float bf_lo(unsigned u) { return __uint_as_float(u << 16); }
__device__ __forceinline__ float bf_hi(unsigned u) { return __uint_as_float(u & 0xffff0000u); }
constexpr int RS_TAB_OFF = 131072 + 64;
struct RsTab { int pm[4]; };
__device__ __forceinline__ void rows_rstd(const RsTab& tb, PG8_LAS unsigned char* lds, const Unit& u, int wr, int fr, float (&rs)[2][4]) {
    const int slot = u.pm == tb.pm[0] ? 0 : (u.pm == tb.pm[1] ? 1 : (u.pm == tb.pm[2] ? 2 : 3));
    const PG8_LAS float* t = (const PG8_LAS float*)(lds + RS_TAB_OFF) + slot * 256 + wr * 64 + fr;
#pragma unroll
    for (int ai = 0; ai < 2; ++ai)
#pragma unroll
        for (int m = 0; m < 4; ++m) rs[ai][m] = t[ai * HALF + m * 16];
}
__device__ __forceinline__ float fexp_(float x) { return __builtin_amdgcn_exp2f(x * 1.44269504089f); }
__device__ __forceinline__ float sigmoidf_(float x) { return __builtin_amdgcn_rcpf(1.0f + fexp_(-x)); }

struct EpiGU {
    static constexpr bool PERM = true, AFTER_DRAIN = false;
    RsTab tb; PG8_LAS unsigned char* lds;
    bf16_t* H; const float* part;
    __device__ __forceinline__ void operator()(const f32x4 (&acc)[2][2][4][2], const Unit& u, int wr, int wc, int fr, int fq) const {
        const int row0 = u.pm * BM + wr * 64 + fr, col0 = u.pn * 128 + wc * 32 + 8 * fq;
        float rsv[2][4]; rows_rstd(tb, lds, u, wr, fr, rsv);
#pragma unroll
        for (int ai = 0; ai < 2; ++ai)
#pragma unroll
            for (int m = 0; m < 4; ++m) { const int row = row0 + ai * HALF + m * 16; const float rs = rsv[ai][m];
                f32x4 h0, h1;
#pragma unroll
                for (int j = 0; j < 4; ++j) { const float g0 = acc[ai][0][m][0][j] * rs, u0 = acc[ai][1][m][0][j] * rs, g1 = acc[ai][0][m][1][j] * rs, u1 = acc[ai][1][m][1][j] * rs;
                    h0[j] = g0 * u0 * __builtin_amdgcn_rcpf(1.0f + fexp_(-g0)); h1[j] = g1 * u1 * __builtin_amdgcn_rcpf(1.0f + fexp_(-g1)); }
                *(u32x4*)(H + (size_t)row * 2816 + col0) = pack8(h0, h1); asm volatile("" ::: "memory"); }
    }
};
struct EpiRes {
    static constexpr bool PERM = true, AFTER_DRAIN = false;
    const float* xin; float* xout; bf16_t* xb; float* part; float alpha;
    __device__ __forceinline__ void operator()(const f32x4 (&acc)[2][2][4][2], const Unit& u, int wr, int wc, int fr, int fq) const {
        const int row0 = u.pm * BM + wr * 64 + fr, col0 = u.pn * BM + wc * 32 + 8 * fq;
#pragma unroll
        for (int ai = 0; ai < 2; ++ai)
#pragma unroll
            for (int m = 0; m < 4; ++m) { const int row = row0 + ai * HALF + m * 16; float ss = 0.f;
#pragma unroll
                for (int bj = 0; bj < 2; ++bj) { const size_t off = (size_t)row * 1024 + col0 + bj * HALF;
                    const f32x4 r0 = *(const f32x4*)(xin + off), r1 = *(const f32x4*)(xin + off + 4);
                    const f32x4 v0 = r0 + acc[ai][bj][m][0] * alpha, v1 = r1 + acc[ai][bj][m][1] * alpha;
                    *(f32x4*)(xout + off) = v0; *(f32x4*)(xout + off + 4) = v1;
                    if (xb) *(u32x4*)(xb + off) = pack8(v0, v1);
                    ss += (v0[0] * v0[0] + v0[1] * v0[1]) + (v0[2] * v0[2] + v0[3] * v0[3]) + (v1[0] * v1[0] + v1[1] * v1[1]) + (v1[2] * v1[2] + v1[3] * v1[3]); }
                ss += __shfl_xor(ss, 16); ss += __shfl_xor(ss, 32);
                if (fq == 0) part[(size_t)row * 16 + u.pn * 4 + wc] = ss; asm volatile("" ::: "memory"); }
    }
};
struct EpiProj {
    static constexpr bool PERM = true, AFTER_DRAIN = false;
    RsTab tb; PG8_LAS unsigned char* lds;
    bf16_t* rkvl; bf16_t* attq; bf16_t* attkv; const float* part;
    __device__ __forceinline__ void operator()(const f32x4 (&acc)[2][2][4][2], const Unit& u, int wr, int wc, int fr, int fq) const {
        bf16_t* base; int ldc, colt;
        if (u.pn < 7) { base = rkvl; ldc = 1792; colt = u.pn * BM; } else if (u.pn < 9) { base = attq; ldc = 512; colt = (u.pn - 7) * BM; } else { base = attkv; ldc = 256; colt = 0; }
        const int row0 = u.pm * BM + wr * 64 + fr, col0 = colt + wc * 32 + 8 * fq;
        float rsv[2][4]; rows_rstd(tb, lds, u, wr, fr, rsv);
#pragma unroll
        for (int ai = 0; ai < 2; ++ai)
#pragma unroll
            for (int m = 0; m < 4; ++m) { const int row = row0 + ai * HALF + m * 16; const float rs = rsv[ai][m];
#pragma unroll
                for (int bj = 0; bj < 2; ++bj) *(u32x4*)(base + (size_t)row * ldc + col0 + bj * HALF) = pack8(acc[ai][bj][m][0] * rs, acc[ai][bj][m][1] * rs); }
    }
};
struct EpiGate {
    static constexpr bool PERM = true, AFTER_DRAIN = false;
    RsTab tb; PG8_LAS unsigned char* lds;
    bf16_t* gates; const float* part;
    __device__ __forceinline__ void operator()(const f32x4 (&acc)[2][2][4][2], const Unit& u, int wr, int wc, int fr, int fq) const {
        const int row0 = u.pm * BM + wr * 64 + fr, col0 = u.pn * BM + wc * 32 + 8 * fq;
        float rsv[2][4]; rows_rstd(tb, lds, u, wr, fr, rsv);
#pragma unroll
        for (int ai = 0; ai < 2; ++ai)
#pragma unroll
            for (int m = 0; m < 4; ++m) { const int row = row0 + ai * HALF + m * 16; const float rs = rsv[ai][m];
#pragma unroll
                for (int bj = 0; bj < 2; ++bj) { f32x4 v0, v1;
#pragma unroll
                    for (int j = 0; j < 4; ++j) { v0[j] = sigmoidf_(acc[ai][bj][m][0][j] * rs); v1[j] = sigmoidf_(acc[ai][bj][m][1][j] * rs); }
                    *(u32x4*)(gates + (size_t)row * 2048 + col0 + bj * HALF) = pack8(v0, v1); } }
    }
};
struct EpiLora {
    static constexpr bool PERM = true, AFTER_DRAIN = false;
    bf16_t* rec_lw; bf16_t* rec_a; bf16_t* g; const float* w0; const float* a0;
    template <int KIND> __device__ __forceinline__ void body(const f32x4 (&acc)[2][2][4][2], const Unit& u, int wr, int wc, int fr, int fq) const {
        const int row0 = u.pm * BM + wr * 64 + fr, col0 = (u.pn & 1) * BM + wc * 32 + 8 * fq;
#pragma unroll
        for (int ai = 0; ai < 2; ++ai)
#pragma unroll
            for (int m = 0; m < 4; ++m) { const int row = row0 + ai * HALF + m * 16; const int b = row >> 12, t = row & 4095;
#pragma unroll
                for (int bj = 0; bj < 2; ++bj) { const int c = col0 + bj * HALF; f32x4 v0 = acc[ai][bj][m][0], v1 = acc[ai][bj][m][1];
                    if (KIND != 2) { const float* bias = (KIND == 0 ? w0 : a0) + c; v0 = v0 + *(const f32x4*)bias; v1 = v1 + *(const f32x4*)(bias + 4); }
                    if (KIND == 2) { *(u32x4*)(g + (size_t)row * 512 + c) = pack8(v0, v1); }
                    else {
#pragma unroll
                        for (int j = 0; j < 4; ++j) {
                            if (KIND == 0) { const float y0 = -v0[j], y1 = -v1[j];
                                const float sp0 = fmaxf(y0, 0.f) + __logf(1.0f + fexp_(-fabsf(y0))), sp1 = fmaxf(y1, 0.f) + __logf(1.0f + fexp_(-fabsf(y1)));
                                v0[j] = -fexp_(-sp0 - 0.5f); v1[j] = -fexp_(-sp1 - 0.5f); }
                            else { v0[j] = sigmoidf_(v0[j]); v1[j] = sigmoidf_(v1[j]); } }
                        bf16_t* dst = (KIND == 0 ? rec_lw : rec_a) + ((size_t)((b * 8 + (c >> 6)) * 4096 + t)) * 64 + (c & 63);
                        *(u32x4*)dst = pack8(v0, v1); } }
                asm volatile("" ::: "memory"); }
    }
    __device__ __forceinline__ void operator()(const f32x4 (&acc)[2][2][4][2], const Unit& u, int wr, int wc, int fr, int fq) const {
        const int kind = u.pn >> 1;
        if (kind == 0) body<0>(acc, u, wr, wc, fr, fq); else if (kind == 1) body<1>(acc, u, wr, wc, fr, fq); else body<2>(acc, u, wr, wc, fr, fq);
    }
};
struct EpiBranch {
    static constexpr bool PERM = true, AFTER_DRAIN = false;
    const bf16_t* gates; bf16_t* merged; int goff; int accum;
    __device__ __forceinline__ void operator()(const f32x4 (&acc)[2][2][4][2], const Unit& u, int wr, int wc, int fr, int fq) const {
        const int row0 = u.pm * BM + wr * 64 + fr, col0 = u.pn * BM + wc * 32 + 8 * fq;
#pragma unroll
        for (int ai = 0; ai < 2; ++ai)
#pragma unroll
            for (int m = 0; m < 4; ++m) { const int row = row0 + ai * HALF + m * 16;
#pragma unroll
                for (int bj = 0; bj < 2; ++bj) { const int c = col0 + bj * HALF; const u32x4 gq = *(const u32x4*)(gates + (size_t)row * 2048 + goff + c);
                    bf16_t* mp = merged + (size_t)row * 1024 + c;
                    f32x4 v0 = acc[ai][bj][m][0], v1 = acc[ai][bj][m][1];
                    v0[0] *= bf_lo(gq.x); v0[1] *= bf_hi(gq.x); v0[2] *= bf_lo(gq.y); v0[3] *= bf_hi(gq.y);
                    v1[0] *= bf_lo(gq.z); v1[1] *= bf_hi(gq.z); v1[2] *= bf_lo(gq.w); v1[3] *= bf_hi(gq.w);
                    if (accum) { const u32x4 pq = *(const u32x4*)mp;
                        v0[0] += bf_lo(pq.x); v0[1] += bf_hi(pq.x); v0[2] += bf_lo(pq.y); v0[3] += bf_hi(pq.y);
                        v1[0] += bf_lo(pq.z); v1[1] += bf_hi(pq.z); v1[2] += bf_lo(pq.w); v1[3] += bf_hi(pq.w); }
                    *(u32x4*)mp = pack8(v0, v1); } asm volatile("" ::: "memory"); }
    }
};

template <class Epi, class Sched, bool ALIGN_EPI = false, bool SP2 = false>
__device__ __forceinline__ void gemm_phase(PG8_LAS unsigned char* lds, const Gemm g, const Sched& S, const Epi& E) {
    int tid_ = threadIdx.x; asm volatile("" : "+v"(tid_));
    const int tid = tid_, wid = __builtin_amdgcn_readfirstlane(tid >> 6), lane = tid & 63, wr = wid >> 2, wc = wid & 3, fr = lane & 15, fq = lane >> 4;
    const int K = g.K, nt = K / BK;
    unsigned voffA[2], voffB[2];
#pragma unroll
    for (int i = 0; i < 2; ++i) { int R, C; stage_rc(tid * 16 + i * 8192, R, C); const int Rb = Epi::PERM ? ((R & ~31) + perm32(R & 31)) : R;
        voffA[i] = (unsigned)(R * K + C) * 2u; voffB[i] = (unsigned)(Rb * K + C) * 2u; }
    const size_t kstep = (size_t)(BK * 2);
    const size_t hstep = (size_t)HALF * K * 2;
    const size_t tstep = 2 * hstep;
    const unsigned ldsw = (unsigned)wid * 1024u;
    const int aoff = lds_byte(wr * 64 + fr, fq * 8), boff = lds_byte(wc * 32 + fr, fq * 8);
#define PG8_SA(b, h) (((b) * 2 + (h)) * HTB)
#define PG8_SB(b, h) ((4 + (b) * 2 + (h)) * HTB)
#define PG8_STAGE(bufoff, gbase, voff) do { _Pragma("unroll") for (int _i = 0; _i < 2; ++_i) \
        __builtin_amdgcn_global_load_lds((const unsigned*)((const char*)(gbase) + (voff)[_i]), (PG8_LAS unsigned*)(lds + (bufoff) + ldsw + _i * 8192), 16, 0, 0); } while (0)
#define PG8_LDA(dst, b, h) do { _Pragma("unroll") for (int m = 0; m < 4; ++m) _Pragma("unroll") for (int k = 0; k < 2; ++k) dst[m][k] = *(const PG8_LAS bf16x8*)(lds + PG8_SA(b, h) + aoff + m * 2048 + k * 1024); } while (0)
#define PG8_LDB(dst, b, h) do { _Pragma("unroll") for (int n = 0; n < 2; ++n) _Pragma("unroll") for (int k = 0; k < 2; ++k) dst[n][k] = *(const PG8_LAS bf16x8*)(lds + PG8_SB(b, h) + boff + n * 2048 + k * 1024); } while (0)
#define PG8_MMA(ai, bj, At, Bt) do { __builtin_amdgcn_s_setprio(1); _Pragma("unroll") for (int m = 0; m < 4; ++m) _Pragma("unroll") for (int n = 0; n < 2; ++n) _Pragma("unroll") for (int k = 0; k < 2; ++k) \
        acc[ai][bj][m][n] = __builtin_amdgcn_mfma_f32_16x16x32_bf16(Bt[n][k], At[m][k], acc[ai][bj][m][n], 0, 0, 0); __builtin_amdgcn_s_setprio(0); } while (0)
#define PG8_WAIT_V(n) asm volatile("s_waitcnt vmcnt(" #n ")" ::: "memory")
#define PG8_WAIT_L(n) asm volatile("s_waitcnt lgkmcnt(" #n ")" ::: "memory")
#define PG8_BAR __builtin_amdgcn_s_barrier()
#define PG8_SCHED __builtin_amdgcn_sched_barrier(0)
    Unit cur, nxt; int ui = 0;
    if (!S.next(0, cur)) return;
    f32x4 acc[2][2][4][2];
#pragma unroll
    for (int a = 0; a < 2; ++a)
#pragma unroll
        for (int b = 0; b < 2; ++b)
#pragma unroll
            for (int m = 0; m < 4; ++m)
#pragma unroll
                for (int n = 0; n < 2; ++n) acc[a][b][m][n] = (f32x4){0.f, 0.f, 0.f, 0.f};
    bf16x8 At[4][2], B0[2][2], B1[2][2];
    const char* cA = (const char*)g.A + (size_t)cur.pm * tstep; const char* cB = (const char*)g.Bt + (size_t)cur.pn * tstep;
    S.a_ready(cur);
    if constexpr (SP2) {
        PG8_STAGE(PG8_SB(0, 0), cB, voffB); PG8_STAGE(PG8_SB(0, 1), cB + hstep, voffB); PG8_STAGE(PG8_SA(0, 0), cA, voffA); PG8_STAGE(PG8_SA(0, 1), cA + hstep, voffA);
        if (wr == 1) PG8_BAR;
        PG8_WAIT_V(2); PG8_BAR;
        PG8_STAGE(PG8_SB(1, 0), cB + kstep, voffB); PG8_STAGE(PG8_SA(1, 0), cA + kstep, voffA); PG8_STAGE(PG8_SB(1, 1), cB + hstep + kstep, voffB);
        PG8_WAIT_V(6); PG8_BAR;
    } else {
        PG8_STAGE(PG8_SB(0, 0), cB, voffB); PG8_STAGE(PG8_SA(0, 0), cA, voffA); PG8_STAGE(PG8_SB(0, 1), cB + hstep, voffB); PG8_STAGE(PG8_SA(0, 1), cA + hstep, voffA);
        if (wr == 1) PG8_BAR;
        PG8_WAIT_V(4); PG8_BAR;
        PG8_STAGE(PG8_SB(1, 0), cB + kstep, voffB); PG8_STAGE(PG8_SA(1, 0), cA + kstep, voffA); PG8_STAGE(PG8_SB(1, 1), cB + hstep + kstep, voffB);
        PG8_WAIT_V(6); PG8_BAR;
    }
    for (;;) {
        const bool has_next = S.next(ui + 1, nxt);
        const char* nA = has_next ? (const char*)g.A + (size_t)nxt.pm * tstep : cA; const char* nB = has_next ? (const char*)g.Bt + (size_t)nxt.pn * tstep : cB;
        for (int t = 0; t < nt; t += 2) {
            const bool last = (t == nt - 2);
            const char* a1 = cA + (size_t)(t + 1) * kstep;
            const char* a2 = last ? nA : cA + (size_t)(t + 2) * kstep; const char* b2 = last ? nB : cB + (size_t)(t + 2) * kstep;
            const char* a3 = a2 + kstep; const char* b3 = b2 + kstep;
            if (last && has_next) S.a_ready(nxt);
            if constexpr (SP2) {
            PG8_LDB(B0, 0, 0); PG8_LDB(B1, 0, 1); PG8_SCHED; PG8_LDA(At, 0, 0); PG8_STAGE(PG8_SA(1, 1), a1 + hstep, voffA);
            PG8_WAIT_V(8); PG8_WAIT_L(0); PG8_BAR; PG8_MMA(0, 0, At, B0); PG8_MMA(0, 1, At, B1); PG8_BAR; PG8_SCHED;
            PG8_LDA(At, 0, 1); PG8_STAGE(PG8_SB(0, 0), b2, voffB); PG8_STAGE(PG8_SB(0, 1), b2 + hstep, voffB); PG8_STAGE(PG8_SA(0, 0), a2, voffA);
            PG8_WAIT_V(8); PG8_WAIT_L(0); PG8_BAR; PG8_MMA(1, 0, At, B0); PG8_MMA(1, 1, At, B1); PG8_BAR; PG8_SCHED;
            PG8_LDB(B0, 1, 0); PG8_LDB(B1, 1, 1); PG8_SCHED; PG8_LDA(At, 1, 0); PG8_STAGE(PG8_SA(0, 1), a2 + hstep, voffA);
            PG8_WAIT_V(8); PG8_WAIT_L(0); PG8_BAR; PG8_MMA(0, 0, At, B0); PG8_MMA(0, 1, At, B1); PG8_BAR; PG8_SCHED;
            PG8_LDA(At, 1, 1); PG8_STAGE(PG8_SB(1, 0), b3, voffB); PG8_STAGE(PG8_SB(1, 1), b3 + hstep, voffB); PG8_STAGE(PG8_SA(1, 0), a3, voffA);
            PG8_WAIT_V(8); PG8_WAIT_L(0); PG8_BAR; PG8_MMA(1, 0, At, B0); PG8_MMA(1, 1, At, B1); PG8_BAR; PG8_SCHED;
            } else {
            PG8_LDB(B0, 0, 0); PG8_SCHED; PG8_LDA(At, 0, 0); PG8_STAGE(PG8_SA(1, 1), a1 + hstep, voffA);
            PG8_WAIT_L(8); PG8_BAR; PG8_WAIT_L(0); PG8_MMA(0, 0, At, B0); PG8_BAR; PG8_SCHED;
            PG8_LDB(B1, 0, 1); PG8_STAGE(PG8_SB(0, 0), b2, voffB);
            PG8_BAR; PG8_WAIT_L(0); PG8_MMA(0, 1, At, B1); PG8_BAR;
            PG8_LDA(At, 0, 1); PG8_STAGE(PG8_SA(0, 0), a2, voffA);
            PG8_BAR; PG8_WAIT_L(0); PG8_MMA(1, 0, At, B0); PG8_BAR; PG8_SCHED;
            PG8_STAGE(PG8_SB(0, 1), b2 + hstep, voffB);
            PG8_WAIT_V(6); PG8_BAR; PG8_MMA(1, 1, At, B1); PG8_BAR;
            PG8_LDB(B0, 1, 0); PG8_SCHED; PG8_LDA(At, 1, 0); PG8_STAGE(PG8_SA(0, 1), a2 + hstep, voffA);
            PG8_WAIT_L(8); PG8_BAR; PG8_WAIT_L(0); PG8_MMA(0, 0, At, B0); PG8_BAR; PG8_SCHED;
            PG8_LDB(B1, 1, 1); PG8_STAGE(PG8_SB(1, 0), b3, voffB);
            PG8_BAR; PG8_WAIT_L(0); PG8_MMA(0, 1, At, B1); PG8_BAR;
            PG8_LDA(At, 1, 1); PG8_STAGE(PG8_SA(1, 0), a3, voffA);
            PG8_BAR; PG8_WAIT_L(0); PG8_MMA(1, 0, At, B0); PG8_BAR; PG8_SCHED;
            PG8_STAGE(PG8_SB(1, 1), b3 + hstep, voffB);
            PG8_WAIT_V(6); PG8_BAR; PG8_MMA(1, 1, At, B1); PG8_BAR;
            }
        }
        if constexpr (ALIGN_EPI) { if (wr == 0) PG8_BAR; }
        if constexpr (!Epi::AFTER_DRAIN) { E(acc, cur, wr, wc, fr, fq); S.done(cur); }
        if (!has_next) break;
#pragma unroll
        for (int a = 0; a < 2; ++a)
#pragma unroll
            for (int b = 0; b < 2; ++b)
#pragma unroll
                for (int m = 0; m < 4; ++m)
#pragma unroll
                    for (int n = 0; n < 2; ++n) acc[a][b][m][n] = (f32x4){0.f, 0.f, 0.f, 0.f};
        cur = nxt; cA = nA; cB = nB; ++ui;
        if constexpr (ALIGN_EPI) { if (wr == 1) PG8_BAR; }
    }
    PG8_WAIT_V(0);
    if constexpr (!ALIGN_EPI) { if (wr == 0) PG8_BAR; }
    PG8_BAR;
    if constexpr (Epi::AFTER_DRAIN) { E.fused(acc, cur, wr, wc, fr, fq, lds, wid, lane); S.done(cur); }
#undef PG8_SA
#undef PG8_SB
#undef PG8_STAGE
#undef PG8_LDA
#undef PG8_LDB
#undef PG8_MMA
#undef PG8_WAIT_V
#undef PG8_WAIT_L
#undef PG8_BAR
#undef PG8_SCHED
}
}
constexpr int NWAVES = 8;
constexpr int BATCH = 8, T = 4096, D = 1024, M = BATCH * T, FF = 2816, NH = 8, HD = 64, INC = 4512;
constexpr float RMS_EPS = 1e-6f, GN_EPS = 64e-5f;
constexpr size_t MiB = 1u << 20;
constexpr size_t WS_PART = 1 * MiB;
constexpr size_t WS_SC = 9 * MiB;
constexpr size_t WS_WGU1 = 13 * MiB, WS_WDN1 = WS_WGU1 + 11 * MiB, WS_WGU2 = WS_WDN1 + 5632 * 1024, WS_WDN2 = WS_WGU2 + 11 * MiB;
constexpr size_t WS_WIN = WS_WDN2 + 5632 * 1024, WS_WGT = WS_WIN + 5 * MiB, WS_WLO = WS_WGT + 4 * MiB, WS_WBR = WS_WLO + 768 * 1024, WS_WBA = WS_WBR + 1 * MiB, WS_WOUT = WS_WBA + 1 * MiB;
constexpr size_t WS_XB = 62 * MiB;
constexpr size_t WS_ATTQ = 126 * MiB;
constexpr size_t WS_ATTKV = 158 * MiB;
constexpr size_t WS_RKVL = 174 * MiB;
constexpr size_t WS_G = 286 * MiB;
constexpr size_t WS_REC = 318 * MiB, REC_SLOT = 32 * MiB;
constexpr size_t WS_H = 126 * MiB;
constexpr size_t WS_YRAW = WS_RKVL;
constexpr size_t WS_MERGED = WS_RKVL;
constexpr size_t WS_GATES = WS_REC;
constexpr size_t WS_YR = WS_REC + 4 * REC_SLOT;
constexpr size_t WS_LA = WS_REC + 5 * REC_SLOT;
constexpr size_t WS_END = WS_REC + 6 * REC_SLOT;
static_assert(WS_WOUT + 4 * MiB <= WS_XB && WS_H + (size_t)M * FF * 2 <= WS_REC && WS_MERGED + (size_t)M * 2048 * 2 <= WS_REC, "ws map");
constexpr int RING_BYTES = 131072, LDS_BYTES = 147456;

#define GAS __attribute__((address_space(1)))
#define LAS __attribute__((address_space(3)))
typedef unsigned short bf16;
typedef unsigned v4u __attribute__((ext_vector_type(4)));
typedef unsigned v2u __attribute__((ext_vector_type(2)));
typedef float f32x4 __attribute__((ext_vector_type(4)));
typedef float f32x2 __attribute__((ext_vector_type(2)));
typedef short bf16x8 __attribute__((ext_vector_type(8)));
#define LDS_WAIT() asm volatile("s_waitcnt lgkmcnt(0)" ::: "memory")
__device__ __forceinline__ unsigned f2bf(float f) { unsigned u = __builtin_bit_cast(unsigned, f); return (u + 0x7fffu + ((u >> 16) & 1u)) >> 16; }
__device__ __forceinline__ unsigned pk2(float lo, float hi) { return f2bf(lo) | (f2bf(hi) << 16); }
__device__ __forceinline__ float bflo(unsigned u) { return __uint_as_float(u << 16); }
__device__ __forceinline__ float bfhi(unsigned u) { return __uint_as_float(u & 0xffff0000u); }
__device__ __forceinline__ float bf1(bf16 h) { return __uint_as_float((unsigned)h << 16); }
__device__ __forceinline__ float wave_sum(float v) {
#pragma unroll
    for (int o = 1; o < 64; o <<= 1) v += __shfl_xor(v, o);
    return v;
}
template <int CTRL> __device__ __forceinline__ float dppf(float x) { return __builtin_bit_cast(float, __builtin_amdgcn_update_dpp(0, __builtin_bit_cast(int, x), CTRL, 0xf, 0xf, false)); }
__device__ __forceinline__ float row16_sum(float x) { x += dppf<0xB1>(x); x += dppf<0x4E>(x); x += dppf<0x141>(x); x += dppf<0x140>(x); return x; }

#define RLX_AGENT __ATOMIC_RELAXED, __HIP_MEMORY_SCOPE_AGENT
#define XB_TMO      128
#define XB_XCNT(j)  (256  + 64 * (j))
#define XB_XSUB(j)  (1280 + 64 * (j))
#define XB_XGEN(j)  (2304 + 64 * (j))
#define XB_TOP      3328
#define XB_TOPGEN   3392
#define XCD_BAR_WORDS 3456
#define XB_SPIN_CAP (1u << 18)

__device__ __forceinline__ unsigned xb_ld(unsigned* p)              { return __hip_atomic_load(p, __ATOMIC_RELAXED, __HIP_MEMORY_SCOPE_AGENT); }
__device__ __forceinline__ unsigned xb_add(unsigned* p, unsigned v) { return __hip_atomic_fetch_add(p, v, __ATOMIC_RELAXED, __HIP_MEMORY_SCOPE_AGENT); }
__device__ __forceinline__ unsigned xb_xcc_id() { return (unsigned)__builtin_amdgcn_s_getreg((3 << 11) | 20) & 0xFu; }
#define XB_SPIN(cond, bar) do { unsigned _sp = 0; while (cond) { __builtin_amdgcn_s_sleep(1); \
    if ((++_sp & 255u) == 0u) { if (xb_ld(&(bar)[XB_TMO])) break; if (_sp > XB_SPIN_CAP) { atomicAdd(&(bar)[XB_TMO], 1u); break; } } } } while (0)

struct XcdBarrier {
    unsigned* bar; unsigned x;
    volatile LAS unsigned* st;
};

__device__ __forceinline__ XcdBarrier xcd_barrier_post(unsigned* bar, volatile LAS unsigned* st) {
    XcdBarrier b; b.bar = bar; b.x = xb_xcc_id(); b.st = st;
    if (threadIdx.x == 0) (void)xb_add(&bar[XB_XCNT(b.x)], 1u);
    return b;
}
__device__ __forceinline__ void xcd_barrier_complete(unsigned* bar, unsigned x, unsigned& nloc, unsigned& nx) {
    const unsigned G = gridDim.x * gridDim.y * gridDim.z;
    unsigned sum, cnt, mine, sp = 0u;
    for (;;) {
        sum = 0u; cnt = 0u; mine = 0u;
#pragma unroll
        for (unsigned j = 0; j < 16; ++j) { const unsigned c = xb_ld(&bar[XB_XCNT(j)]); sum += c; cnt += (c > 0u) ? 1u : 0u; mine = (j == x) ? c : mine; }
        if (sum == G) break;
        __builtin_amdgcn_s_sleep(1);
        if ((++sp & 255u) == 0u) { if (xb_ld(&bar[XB_TMO])) break; if (sp > XB_SPIN_CAP) { atomicAdd(&bar[XB_TMO], 1u); break; } }
    }
    nloc = mine > 0u ? mine : 1u; nx = cnt > 0u ? cnt : 1u;
}

__device__ __forceinline__ void xcd_barrier(const XcdBarrier& b) {
    asm volatile("s_waitcnt vmcnt(0)" ::: "memory");
    __syncthreads();
    if (threadIdx.x == 0) {
        unsigned* bar = b.bar;
        __builtin_amdgcn_s_waitcnt(0);
        unsigned nloc = b.st[0], nx = b.st[1];
        if (nloc == 0u) { xcd_barrier_complete(bar, b.x, nloc, nx); b.st[0] = nloc; b.st[1] = nx; }
        const unsigned old = xb_add(&bar[XB_XSUB(b.x)], 1u);
        const unsigned gen = old / nloc;
        if (old + 1u == (gen + 1u) * nloc) {
            __builtin_amdgcn_fence(__ATOMIC_RELEASE, "agent");
            asm volatile("s_waitcnt vmcnt(0)" ::: "memory");
            const unsigned og = xb_add(&bar[XB_TOP], 1u);
            const unsigned tg = og / nx;
            if (og + 1u == (tg + 1u) * nx) xb_add(&bar[XB_TOPGEN], 1u);
            else XB_SPIN(xb_ld(&bar[XB_TOPGEN]) == tg, bar);
            __builtin_amdgcn_fence(__ATOMIC_ACQUIRE, "agent");
            xb_add(&bar[XB_XGEN(b.x)], 1u);
            asm volatile("s_waitcnt vmcnt(0)" ::: "memory");
        } else {
            XB_SPIN(xb_ld(&bar[XB_XGEN(b.x)]) == gen, bar);
            __builtin_amdgcn_fence(__ATOMIC_ACQUIRE, "agent");
            asm volatile("s_waitcnt vmcnt(0)" ::: "memory");
        }
    }
    __syncthreads();
}

__device__ __forceinline__ int fresh_tid() { int t = threadIdx.x; asm volatile("" : "+v"(t)); return t; }
struct Frame {
    LAS unsigned char* lds;
    int tid, lane, wave, vcu, G;
    const float *in0, *in1, *in2, *in3, *in4, *in5, *in6, *in7, *in8, *in9, *in10, *in11, *in12, *in13, *in14, *in15, *in16, *in17, *in18, *in19, *in20, *in21, *in22, *in23, *in24, *in25, *in26, *in27, *in28; float* out; unsigned char* ws;
};

__device__ __forceinline__ pg8::RsTab fill_rstd(Frame& F, const float* part, int N) {
    pg8::StaticOrder S; S.init(M, N, F.G, (int)blockIdx.x); pg8::Unit u; pg8::RsTab tb; tb.pm[0] = tb.pm[1] = tb.pm[2] = tb.pm[3] = -1;
    for (int i = 0; S.next(i, u); ++i) { if (u.pm == tb.pm[0] || u.pm == tb.pm[1] || u.pm == tb.pm[2] || u.pm == tb.pm[3]) continue;
        if (tb.pm[0] < 0) tb.pm[0] = u.pm; else if (tb.pm[1] < 0) tb.pm[1] = u.pm; else if (tb.pm[2] < 0) tb.pm[2] = u.pm; else tb.pm[3] = u.pm; }
    const int tid = fresh_tid(); LAS float* t = (LAS float*)(F.lds + pg8::RS_TAB_OFF);
#pragma unroll
    for (int h = 0; h < 2; ++h) { const int e = tid + 512 * h, slot = e >> 8, r = e & 255; const int pm = slot == 0 ? tb.pm[0] : slot == 1 ? tb.pm[1] : slot == 2 ? tb.pm[2] : tb.pm[3];
        if (pm >= 0) { const GAS f32x4* p = (const GAS f32x4*)(part + ((size_t)pm * 256 + r) * 16); const f32x4 a = p[0], b = p[1], c = p[2], d = p[3];
            const float sm = ((a[0] + a[1]) + (a[2] + a[3])) + ((b[0] + b[1]) + (b[2] + b[3])) + ((c[0] + c[1]) + (c[2] + c[3])) + ((d[0] + d[1]) + (d[2] + d[3]));
            t[e] = __builtin_amdgcn_rsqf(sm * (1.0f / 1024.0f) + RMS_EPS); } }
    __syncthreads();
    return tb;
}
__device__ __forceinline__ void tr_item(const float* W, int ldn, int k0, int n0, bf16* WT, int ldk, int drow0, int dk0, const float* scale, int dup, LAS float* scr, int lane) {
    float tv[32], ts[32];
#pragma unroll
    for (int i = 0; i < 32; ++i) { const int kk = 2 * i + (lane >> 5); tv[i] = W[(size_t)(k0 + kk) * ldn + n0 + (lane & 31)]; ts[i] = scale ? scale[k0 + kk] : 1.0f; }
#pragma unroll
    for (int i = 0; i < 32; ++i) { const int kk = 2 * i + (lane >> 5); scr[kk * 33 + (lane & 31)] = tv[i] * ts[i]; }
    LDS_WAIT(); asm volatile("" ::: "memory");
    const int c = lane & 7;
#pragma unroll
    for (int j = 0; j < 4; ++j) { const int n = (lane >> 3) + 8 * j; const LAS float* s = scr + (8 * c) * 33 + n;
        v4u o; o.x = pk2(s[0 * 33], s[1 * 33]); o.y = pk2(s[2 * 33], s[3 * 33]); o.z = pk2(s[4 * 33], s[5 * 33]); o.w = pk2(s[6 * 33], s[7 * 33]);
        bf16* dp = WT + (size_t)(drow0 + n0 + n) * ldk + dk0 + k0 + 8 * c;
        *(GAS v4u*)dp = o; if (dup) *(GAS v4u*)(dp + dup) = o; }
    LDS_WAIT(); asm volatile("" ::: "memory");
}
__device__ __forceinline__ void p0_prologue(Frame& F) {
    LAS float* scr = (LAS float*)(F.lds + F.wave * 16384);
    unsigned char* ws = F.ws;
    const int gw = F.vcu * NWAVES + F.wave, NGW = F.G * NWAVES, lane = fresh_tid() & 63;
    constexpr int I_GU = 16 * 88, I_DN = 44 * 32, I_IN = 16 * 77, I_GT = 16 * 64, I_BR = 8 * 32, I_OUT = 16 * 32;
    constexpr int NITEMS = 4 * I_GU + 2 * I_DN + I_IN + I_GT + 2 * I_BR + I_OUT;
    for (int it = gw; it < NITEMS; it += NGW) {
        int r = it;
        if (r < 4 * I_GU) {
            const int which = r / I_GU; r -= which * I_GU; const int kb = r / 88, nb = r % 88, n0 = nb * 32;
            const float* W = which == 0 ? F.in2 : which == 1 ? F.in3 : which == 2 ? F.in25 : F.in26;
            tr_item(W, FF, kb * 64, n0, (bf16*)(ws + (which < 2 ? WS_WGU1 : WS_WGU2)), D, (n0 >> 7) * 256 + (which & 1) * 128 + (n0 & 127) - n0, 0, which < 2 ? F.in1 : F.in24, 0, scr, lane);
            continue; }
        r -= 4 * I_GU;
        if (r < 2 * I_DN) { const int which = r / I_DN; r -= which * I_DN; const int kb = r / 32, nb = r % 32;
            tr_item(which ? F.in27 : F.in4, D, kb * 64, nb * 32, (bf16*)(ws + (which ? WS_WDN2 : WS_WDN1)), FF, 0, 0, nullptr, 0, scr, lane); continue; }
        r -= 2 * I_DN;
        if (r < I_IN) { const int kb = r / 77, nb = r % 77, n0 = nb * 32;
            tr_item(F.in6, INC, kb * 64, n0, (bf16*)(ws + WS_WIN), D, n0 < 1696 ? 0 : 96, 0, F.in5, 0, scr, lane); continue; }
        r -= I_IN;
        if (r < I_GT) { const int kb = r / 64, nb = r % 64;
            tr_item(F.in6, INC, kb * 64, 2464 + nb * 32, (bf16*)(ws + WS_WGT), D, -2464, 0, F.in5, 0, scr, lane); continue; }
        r -= I_GT;
        if (r < 2 * I_BR) { const int which = r / I_BR; r -= which * I_BR; const int kb = r / 32, nb = r % 32;
            tr_item(which ? F.in22 : F.in21, D, kb * 64, nb * 32, (bf16*)(ws + (which ? WS_WBA : WS_WBR)), 512, 0, 0, nullptr, 0, scr, lane); continue; }
        r -= 2 * I_BR;
        { const int kb = r / 32, nb = r % 32; tr_item(F.in23, D, kb * 64, nb * 32, (bf16*)(ws + WS_WOUT), D, 0, 0, nullptr, 0, scr, lane); }
    }
    { GAS v4u* z = (GAS v4u*)(ws + WS_WIN + (size_t)1696 * D * 2); for (int i = gw * 64 + lane; i < 12288; i += NGW * 64) z[i] = (v4u){0u, 0u, 0u, 0u}; }
    { bf16* WL = (bf16*)(ws + WS_WLO);
      for (int i = gw * 64 + lane; i < 1536 * 256; i += NGW * 64) { const int n = i >> 8, k = i & 255, grp = n >> 9, nn = n & 511; float v = 0.f;
          if (grp == 0) { if (k < 32) v = F.in9[k * 512 + nn]; } else if (grp == 1) { if (k >= 32 && k < 64) v = F.in11[(k - 32) * 512 + nn]; } else { if (k >= 64 && k < 160) v = F.in12[(k - 64) * 512 + nn]; }
          WL[i] = (bf16)f2bf(v); } }
    { const float* x = F.in0; bf16* XB = (bf16*)(ws + WS_XB); float* part = (float*)(ws + WS_PART);
      for (int m0 = gw; m0 < M; m0 += 4 * NGW) { f32x4 v[4][4];
#pragma unroll
          for (int r = 0; r < 4; ++r) { const int m = m0 + r * NGW; if (m < M) { const GAS f32x4* xr = (const GAS f32x4*)(x + (size_t)m * D) + lane;
#pragma unroll
              for (int j = 0; j < 4; ++j) v[r][j] = xr[64 * j]; } }
#pragma unroll
          for (int r = 0; r < 4; ++r) { const int m = m0 + r * NGW; if (m < M) { float s = 0.f;
#pragma unroll
              for (int j = 0; j < 4; ++j) s += (v[r][j].x * v[r][j].x + v[r][j].y * v[r][j].y) + (v[r][j].z * v[r][j].z + v[r][j].w * v[r][j].w);
              s = wave_sum(s);
              GAS unsigned long long* o8 = (GAS unsigned long long*)(XB + (size_t)m * D) + lane;
#pragma unroll
              for (int j = 0; j < 4; ++j) o8[64 * j] = (unsigned long long)pk2(v[r][j].x, v[r][j].y) | ((unsigned long long)pk2(v[r][j].z, v[r][j].w) << 32);
              if (lane < 16) part[(size_t)m * 16 + lane] = lane == 0 ? s : 0.f; } } } }
}
__device__ __forceinline__ void p4_lora_in(Frame& F) {
    const bf16* RKVL = (const bf16*)(F.ws + WS_RKVL); bf16* LA = (bf16*)(F.ws + WS_LA); const float* mu = F.in7 + 1536;
    const int gw = F.vcu * NWAVES + F.wave, NGW = F.G * NWAVES, lane = fresh_tid() & 63, c0 = 4 * lane;
    const bool act = c0 < 160; f32x4 mv = (f32x4){0.f, 0.f, 0.f, 0.f}; if (act) mv = *(const GAS f32x4*)(mu + c0);
    for (int m0 = gw; m0 < M; m0 += 4 * NGW) {
        v2u cu[4], pu[4];
#pragma unroll
        for (int rr = 0; rr < 4; ++rr) { const int m = m0 + rr * NGW; cu[rr] = (v2u){0u, 0u}; pu[rr] = (v2u){0u, 0u};
            if (act) { cu[rr] = *(const GAS v2u*)(RKVL + (size_t)m * 1792 + 1536 + c0); if ((m & (T - 1)) != 0) pu[rr] = *(const GAS v2u*)(RKVL + (size_t)(m - 1) * 1792 + 1536 + c0); } }
#pragma unroll
        for (int rr = 0; rr < 4; ++rr) { const int m = m0 + rr * NGW; float o[4] = {0.f, 0.f, 0.f, 0.f};
            if (act) { const float cur[4] = {bflo(cu[rr].x), bfhi(cu[rr].x), bflo(cu[rr].y), bfhi(cu[rr].y)}, prv[4] = {bflo(pu[rr].x), bfhi(pu[rr].x), bflo(pu[rr].y), bfhi(pu[rr].y)};
#pragma unroll
                for (int j = 0; j < 4; ++j) { const float p = cur[j] + (prv[j] - cur[j]) * mv[j]; const int c = c0 + j;
                    o[j] = c < 32 ? tanhf(p) : (c < 64 ? p : 1.0f / (1.0f + __expf(-p))); } }
            *(GAS v2u*)(LA + (size_t)m * 256 + c0) = (v2u){pk2(o[0], o[1]), pk2(o[2], o[3])}; }
    }
}
__device__ __forceinline__ float sum8(float v) { v += __shfl_xor(v, 1); v += __shfl_xor(v, 2); v += __shfl_xor(v, 4); return v; }
__device__ __forceinline__ void unpack8(const v4u u, float (&f)[8]) { f[0] = bflo(u.x); f[1] = bfhi(u.x); f[2] = bflo(u.y); f[3] = bfhi(u.y); f[4] = bflo(u.z); f[5] = bfhi(u.z); f[6] = bflo(u.w); f[7] = bfhi(u.w); }
__device__ __forceinline__ v4u pack8u(const float (&f)[8]) { return (v4u){pk2(f[0], f[1]), pk2(f[2], f[3]), pk2(f[4], f[5]), pk2(f[6], f[7])}; }
__device__ __forceinline__ void ld8f(const float* p, float (&f)[8]) { const f32x4 a = *(const GAS f32x4*)p, b = *(const GAS f32x4*)(p + 4); f[0] = a.x; f[1] = a.y; f[2] = a.z; f[3] = a.w; f[4] = b.x; f[5] = b.y; f[6] = b.z; f[7] = b.w; }
__device__ __forceinline__ void p6_prep(Frame& F) {
    const bf16* RKVL = (const bf16*)(F.ws + WS_RKVL); bf16* REC = (bf16*)(F.ws + WS_REC); f32x4* SC = (f32x4*)(F.ws + WS_SC);
    constexpr size_t SL = REC_SLOT / 2;
    const int gw = F.vcu * NWAVES + F.wave, NGW = F.G * NWAVES, lane = fresh_tid() & 63, h = lane >> 3, c0 = 8 * lane, n0 = 8 * (lane & 7);
    float mur[8], muk[8], muv[8], kkw[8], kaw[8], rkw[8];
    ld8f(F.in7 + c0, mur); ld8f(F.in7 + 512 + c0, muk); ld8f(F.in7 + 1024 + c0, muv); ld8f(F.in13 + c0, kkw); ld8f(F.in14 + c0, kaw); ld8f(F.in15 + c0, rkw);
    for (int m0 = gw; m0 < M; m0 += 2 * NGW) {
        v4u ur[2], uk[2], uv[2], pr_[2], pk_[2], pv_[2], ua[2];
#pragma unroll
        for (int rr = 0; rr < 2; ++rr) { const int m = m0 + rr * NGW, b = m >> 12, t = m & (T - 1); const bool hp = t != 0;
            const bf16* cr = RKVL + (size_t)m * 1792 + c0; const bf16* pr = cr - (hp ? 1792 : 0);
            const size_t ri = ((size_t)(b * 8 + h) * T + t) * 64 + n0;
            ur[rr] = *(const GAS v4u*)cr; uk[rr] = *(const GAS v4u*)(cr + 512); uv[rr] = *(const GAS v4u*)(cr + 1024);
            pr_[rr] = *(const GAS v4u*)pr; pk_[rr] = *(const GAS v4u*)(pr + 512); pv_[rr] = *(const GAS v4u*)(pr + 1024);
            ua[rr] = *(const GAS v4u*)(REC + 4 * SL + ri); }
#pragma unroll
        for (int rr = 0; rr < 2; ++rr) { const int m = m0 + rr * NGW, b = m >> 12, t = m & (T - 1); const bool hp = t != 0;
            const size_t ri = ((size_t)(b * 8 + h) * T + t) * 64 + n0;
            float r[8], k[8], v[8], rp[8], kp[8], vp[8], a[8];
            unpack8(ur[rr], r); unpack8(uk[rr], k); unpack8(uv[rr], v); unpack8(pr_[rr], rp); unpack8(pk_[rr], kp); unpack8(pv_[rr], vp); unpack8(ua[rr], a);
            float kk[8], ss = 0.f;
#pragma unroll
            for (int j = 0; j < 8; ++j) { const float rpj = hp ? rp[j] : 0.f, kpj = hp ? kp[j] : 0.f, vpj = hp ? vp[j] : 0.f;
                r[j] += (rpj - r[j]) * mur[j]; k[j] += (kpj - k[j]) * muk[j]; v[j] += (vpj - v[j]) * muv[j];
                kk[j] = k[j] * kkw[j]; ss += kk[j] * kk[j]; }
            const float inv = 1.0f / fmaxf(sqrtf(sum8(ss)), 1e-12f);
            float an[8], bn[8], kn[8];
#pragma unroll
            for (int j = 0; j < 8; ++j) { kk[j] *= inv; an[j] = -kk[j]; bn[j] = kk[j] * a[j]; kn[j] = k[j] * (1.0f + (a[j] - 1.0f) * kaw[j]); }
            const v4u oa = pack8u(an), orr = pack8u(r), ok = pack8u(kn), ob = pack8u(bn), ov = pack8u(v);
            float rq[8], kq[8], bq[8]; unpack8(orr, rq); unpack8(ok, kq); unpack8(ob, bq);
            float sb = 0.f, sk = 0.f, sbo = 0.f;
#pragma unroll
            for (int j = 0; j < 8; ++j) { sb += bq[j] * rq[j]; sk += kq[j] * rq[j]; sbo += rq[j] * kq[j] * rkw[j]; }
            sb = sum8(sb); sk = sum8(sk); sbo = sum8(sbo);
            *(GAS v4u*)(REC + 1 * SL + ri) = oa; *(GAS v4u*)(REC + 2 * SL + ri) = orr; *(GAS v4u*)(REC + 3 * SL + ri) = ok; *(GAS v4u*)(REC + 4 * SL + ri) = ob; *(GAS v4u*)(REC + 5 * SL + ri) = ov;
            if ((lane & 7) == 0) SC[(size_t)(b * 8 + h) * T + t] = (f32x4){sb, sk, sbo, 0.f}; }
    }
}
constexpr int KS_STRIDE = 144, VT_STRIDE = 528, ATT_KS_OFF = 0, ATT_VT_OFF = 256 * KS_STRIDE;
__device__ __forceinline__ void p6_attention(Frame& F) {
    bf16* ATTQ = (bf16*)(F.ws + WS_ATTQ); const bf16* ATTKV = (const bf16*)(F.ws + WS_ATTKV);
    const float* qn = F.in18; const float* kn = F.in19; const float* sinks = F.in20;
    LAS unsigned char* Ks = F.lds + ATT_KS_OFF; LAS unsigned char* Vt = F.lds + ATT_VT_OFF;
    const int tid = fresh_tid(), lane = tid & 63, w = F.wave, g = lane >> 4, n16 = lane & 15;
    for (int unit = F.vcu; unit < BATCH * 2 * 32; unit += F.G) {
        const int nb = unit & 31, kvh = (unit >> 5) & 1, b = unit >> 6; const int m0 = b * T + nb * 128;
#pragma unroll
        for (int i = 0; i < 4; ++i) { const int e = tid + 512 * i, key = e >> 3, dg = e & 7; const bool valid = nb > 0 || key >= 128;
            v4u ku = (v4u){0u, 0u, 0u, 0u}, vu = (v4u){0u, 0u, 0u, 0u};
            if (valid) { const bf16* src = ATTKV + (size_t)(m0 - 128 + key) * 256 + kvh * 64 + dg * 8; ku = *(const GAS v4u*)src; vu = *(const GAS v4u*)(src + 128); }
            float kf[8] = {bflo(ku.x), bfhi(ku.x), bflo(ku.y), bfhi(ku.y), bflo(ku.z), bfhi(ku.z), bflo(ku.w), bfhi(ku.w)};
            float ss = 0.f;
#pragma unroll
            for (int j = 0; j < 8; ++j) ss += kf[j] * kf[j];
            ss += __shfl_xor(ss, 1); ss += __shfl_xor(ss, 2); ss += __shfl_xor(ss, 4);
            const float rs = 1.0f / sqrtf(ss * (1.0f / 64.0f) + RMS_EPS);
#pragma unroll
            for (int j = 0; j < 8; ++j) kf[j] *= rs * kn[dg * 8 + j];
            *(LAS v4u*)(Ks + key * KS_STRIDE + dg * 16) = (v4u){pk2(kf[0], kf[1]), pk2(kf[2], kf[3]), pk2(kf[4], kf[5]), pk2(kf[6], kf[7])};
            const unsigned vv[4] = {vu.x, vu.y, vu.z, vu.w};
#pragma unroll
            for (int j = 0; j < 8; ++j) *(LAS bf16*)(Vt + (dg * 8 + j) * VT_STRIDE + key * 2) = (bf16)((vv[j >> 1] >> ((j & 1) * 16)) & 0xffffu);
        }
        __syncthreads();
        const int hq = kvh * 4 + (w >> 1), qbase = (w & 1) * 64; const float sink = sinks[hq];
        for (int qt = 0; qt < 4; ++qt) {
            const int q0 = qbase + 16 * qt, qi = q0 + n16, kt0 = q0 >> 4;
            bf16* qp = ATTQ + (size_t)(m0 + qi) * 512 + hq * 64 + 8 * g;
            const v4u qa = *(const GAS v4u*)qp, qb = *(const GAS v4u*)(qp + 32);
            float q[16] = {bflo(qa.x), bfhi(qa.x), bflo(qa.y), bfhi(qa.y), bflo(qa.z), bfhi(qa.z), bflo(qa.w), bfhi(qa.w),
                           bflo(qb.x), bfhi(qb.x), bflo(qb.y), bfhi(qb.y), bflo(qb.z), bfhi(qb.z), bflo(qb.w), bfhi(qb.w)};
            float ss = 0.f;
#pragma unroll
            for (int j = 0; j < 16; ++j) ss += q[j] * q[j];
            ss += __shfl_xor(ss, 16); ss += __shfl_xor(ss, 32);
            const float rs = 0.125f / sqrtf(ss * (1.0f / 64.0f) + RMS_EPS);
#pragma unroll
            for (int j = 0; j < 16; ++j) q[j] *= rs * qn[(j >> 3) * 32 + 8 * g + (j & 7)];
            const v4u qf0 = (v4u){pk2(q[0], q[1]), pk2(q[2], q[3]), pk2(q[4], q[5]), pk2(q[6], q[7])}, qf1 = (v4u){pk2(q[8], q[9]), pk2(q[10], q[11]), pk2(q[12], q[13]), pk2(q[14], q[15])};
            const bf16x8 bq0 = __builtin_bit_cast(bf16x8, qf0), bq1 = __builtin_bit_cast(bf16x8, qf1);
            f32x4 st[10]; float mx = -INFINITY;
#pragma unroll
            for (int i = 0; i < 10; ++i) { const int kt = kt0 + i, ktc = kt < 16 ? kt : 15;
                const LAS unsigned char* kp = Ks + (16 * ktc + n16) * KS_STRIDE + 16 * g;
                const bf16x8 a0 = *(const LAS bf16x8*)kp, a1 = *(const LAS bf16x8*)(kp + 64);
                f32x4 acc = (f32x4){0.f, 0.f, 0.f, 0.f};
                acc = __builtin_amdgcn_mfma_f32_16x16x32_bf16(a0, bq0, acc, 0, 0, 0);
                acc = __builtin_amdgcn_mfma_f32_16x16x32_bf16(a1, bq1, acc, 0, 0, 0);
#pragma unroll
                for (int r = 0; r < 4; ++r) { const int kj = 16 * kt + 4 * g + r; const bool ok = (kj > qi) && (kj <= qi + 128) && (nb > 0 || kj >= 128);
                    acc[r] = ok ? acc[r] : -INFINITY; mx = fmaxf(mx, acc[r]); }
                st[i] = acc; }
            mx = fmaxf(mx, __shfl_xor(mx, 16)); mx = fmaxf(mx, __shfl_xor(mx, 32)); mx = fmaxf(mx, sink);
            float den = 0.f;
#pragma unroll
            for (int i = 0; i < 10; ++i)
#pragma unroll
                for (int r = 0; r < 4; ++r) { const float p = __expf(st[i][r] - mx); st[i][r] = p; den += p; }
            den += __shfl_xor(den, 16); den += __shfl_xor(den, 32); den += __expf(sink - mx);
            const float inv = 1.0f / den;
            f32x4 o[4];
#pragma unroll
            for (int dt = 0; dt < 4; ++dt) o[dt] = (f32x4){0.f, 0.f, 0.f, 0.f};
#pragma unroll
            for (int j = 0; j < 5; ++j) { const int ka = kt0 + 2 * j, kb2 = ka + 1, kac = ka < 16 ? ka : 15, kbc = kb2 < 16 ? kb2 : 15;
                const v4u pu = (v4u){pk2(st[2 * j][0], st[2 * j][1]), pk2(st[2 * j][2], st[2 * j][3]), pk2(st[2 * j + 1][0], st[2 * j + 1][1]), pk2(st[2 * j + 1][2], st[2 * j + 1][3])};
                const bf16x8 pf = __builtin_bit_cast(bf16x8, pu);
#pragma unroll
                for (int dt = 0; dt < 4; ++dt) { const LAS unsigned char* vp = Vt + (16 * dt + n16) * VT_STRIDE;
                    const v2u va = *(const LAS v2u*)(vp + (16 * kac + 4 * g) * 2), vb = *(const LAS v2u*)(vp + (16 * kbc + 4 * g) * 2);
                    const bf16x8 af = __builtin_bit_cast(bf16x8, (v4u){va.x, va.y, vb.x, vb.y});
                    o[dt] = __builtin_amdgcn_mfma_f32_16x16x32_bf16(af, pf, o[dt], 0, 0, 0); } }
            bf16* op = ATTQ + (size_t)(m0 + qi) * 512 + hq * 64 + 4 * g;
#pragma unroll
            for (int dt = 0; dt < 4; ++dt) *(GAS v2u*)(op + 16 * dt) = (v2u){pk2(o[dt][0] * inv, o[dt][1] * inv), pk2(o[dt][2] * inv, o[dt][3] * inv)};
        }
        __syncthreads();
    }
}
constexpr int SC_NS = 32, SC_NP = 16, SC_ARR = 4096, SC_SCL = 9 * SC_ARR, SC_VS = SC_SCL + 512, SC_YB = SC_VS + 4096, SC_BUF = SC_YB + 2048;
struct ScanPre { v2u lw1, a1, r1, k1, b1, lw2, a2, r2, k2, b2; unsigned short v1, v2; f32x4 sc1, sc2; };
__device__ __forceinline__ ScanPre scan_issue(Frame& F, int bh, int quarter, int t0, int lt) {
    const unsigned char* REC = F.ws + WS_REC; const f32x4* SC = (const f32x4*)(F.ws + WS_SC);
    const int pr = lt >> 4, q = lt & 15; const size_t st = (size_t)bh * T + t0 + 2 * pr;
    const size_t e1 = st * 128 + (size_t)q * 8, e2 = e1 + 128;
    ScanPre p;
    p.lw1 = *(const GAS v2u*)(REC + 0 * REC_SLOT + e1); p.a1 = *(const GAS v2u*)(REC + 1 * REC_SLOT + e1); p.r1 = *(const GAS v2u*)(REC + 2 * REC_SLOT + e1); p.k1 = *(const GAS v2u*)(REC + 3 * REC_SLOT + e1); p.b1 = *(const GAS v2u*)(REC + 4 * REC_SLOT + e1);
    p.lw2 = *(const GAS v2u*)(REC + 0 * REC_SLOT + e2); p.a2 = *(const GAS v2u*)(REC + 1 * REC_SLOT + e2); p.r2 = *(const GAS v2u*)(REC + 2 * REC_SLOT + e2); p.k2 = *(const GAS v2u*)(REC + 3 * REC_SLOT + e2); p.b2 = *(const GAS v2u*)(REC + 4 * REC_SLOT + e2);
    const bf16* RV = (const bf16*)(REC + 5 * REC_SLOT) + st * 64 + 16 * quarter + q;
    p.v1 = RV[0]; p.v2 = RV[64];
    p.sc1 = *(const GAS f32x4*)(SC + st); p.sc2 = *(const GAS f32x4*)(SC + st + 1);
    return p;
}
__device__ __forceinline__ void un4(const v2u u, float (&f)[4]) { f[0] = bflo(u.x); f[1] = bfhi(u.x); f[2] = bflo(u.y); f[3] = bfhi(u.y); }
__device__ __forceinline__ void scan_commit(const ScanPre& p, LAS unsigned char* buf, int lt) {
    const int pr = lt >> 4, q = lt & 15, idx = pr * 16 + q;
    float lw1[4], a1[4], r1[4], k1[4], b1[4], lw2[4], a2[4], r2[4], k2[4], b2[4];
    un4(p.lw1, lw1); un4(p.a1, a1); un4(p.r1, r1); un4(p.k1, k1); un4(p.b1, b1); un4(p.lw2, lw2); un4(p.a2, a2); un4(p.r2, r2); un4(p.k2, k2); un4(p.b2, b2);
    float w1[4], w2[4], z1[4], wa2[4], wz2[4], ww[4], bw[4], kw[4];
    float ba = 0.f, ka = 0.f, bz = 0.f, kz = 0.f;
#pragma unroll
    for (int j = 0; j < 4; ++j) { w1[j] = __expf(lw1[j]); w2[j] = __expf(lw2[j]); z1[j] = w1[j] * r1[j]; const float z2 = w2[j] * r2[j];
        wa2[j] = w1[j] * a2[j]; wz2[j] = w1[j] * z2; ww[j] = w1[j] * w2[j]; bw[j] = b1[j] * w2[j]; kw[j] = k1[j] * w2[j];
        ba += b1[j] * a2[j]; ka += k1[j] * a2[j]; bz += b1[j] * z2; kz += k1[j] * z2; }
    ba = row16_sum(ba); ka = row16_sum(ka); bz = row16_sum(bz); kz = row16_sum(kz);
    LAS f32x4* A = (LAS f32x4*)buf;
    A[0 * 256 + idx] = (f32x4){a1[0], z1[0], a1[1], z1[1]}; A[1 * 256 + idx] = (f32x4){a1[2], z1[2], a1[3], z1[3]};
    A[2 * 256 + idx] = (f32x4){wa2[0], wz2[0], wa2[1], wz2[1]}; A[3 * 256 + idx] = (f32x4){wa2[2], wz2[2], wa2[3], wz2[3]};
    A[4 * 256 + idx] = (f32x4){ww[0], ww[1], ww[2], ww[3]}; A[5 * 256 + idx] = (f32x4){bw[0], bw[1], bw[2], bw[3]}; A[6 * 256 + idx] = (f32x4){kw[0], kw[1], kw[2], kw[3]};
    A[7 * 256 + idx] = (f32x4){b2[0], b2[1], b2[2], b2[3]}; A[8 * 256 + idx] = (f32x4){k2[0], k2[1], k2[2], k2[3]};
    if (q == 0) { LAS f32x4* S4 = (LAS f32x4*)(buf + SC_SCL); S4[pr * 2] = (f32x4){ba, ka, bz, kz}; S4[pr * 2 + 1] = (f32x4){p.sc1.x, p.sc2.x, 0.f, 0.f}; }
    const float v1 = bf1(p.v1), v2 = bf1(p.v2);
    ((LAS f32x4*)(buf + SC_VS))[idx] = (f32x4){v1, v2, v1 * p.sc1.y, v2 * p.sc2.y};
}
__device__ __forceinline__ void scan_flush(Frame& F, int bh, int quarter, int t0, const LAS unsigned char* buf, int lt) {
    if (lt < 128) { const int s = lt >> 2, c4 = lt & 3; const int b = bh >> 3, h = bh & 7;
        float* yraw = (float*)(F.ws + WS_YRAW);
        const LAS float* yb = (const LAS float*)(buf + SC_YB) + ((s >> 1) * 16 + 4 * c4) * 2 + (s & 1);
        const f32x4 y = (f32x4){yb[0], yb[2], yb[4], yb[6]};
        *(GAS f32x4*)(yraw + (size_t)(b * T + t0 + s) * 512 + h * 64 + 16 * quarter + 4 * c4) = y; }
}
__device__ __forceinline__ void p7_scan(Frame& F) {
    const int w = F.wave, tid = fresh_tid(), lane = tid & 63, rl = lane >> 4, q = lane & 15, lt = tid - 256;
    constexpr int NBLK = T / SC_NS;
#define SCAN_BAR() do { asm volatile("s_waitcnt lgkmcnt(0)" ::: "memory"); __builtin_amdgcn_s_barrier(); asm volatile("" ::: "memory"); } while (0)
    for (int unit = F.vcu; unit < 256; unit += F.G) {
        const int bh = unit >> 2, quarter = unit & 3;
        ScanPre pre;
        if (w >= 4) { pre = scan_issue(F, bh, quarter, 0, lt); scan_commit(pre, F.lds, lt); pre = scan_issue(F, bh, quarter, SC_NS, lt); }
        SCAN_BAR();
        float S0 = 0.f, S1 = 0.f, S2 = 0.f, S3 = 0.f;
        for (int nb = 0; nb < NBLK; ++nb) {
            LAS unsigned char* cur = F.lds + (nb & 1) * SC_BUF; LAS unsigned char* oth = F.lds + ((nb + 1) & 1) * SC_BUF;
            if (w >= 4) {
                if (nb > 0) scan_flush(F, bh, quarter, (nb - 1) * SC_NS, oth, lt);
                if (nb + 1 < NBLK) scan_commit(pre, oth, lt);
                if (nb + 2 < NBLK) pre = scan_issue(F, bh, quarter, (nb + 2) * SC_NS, lt);
            } else {
                const LAS f32x4* A = (const LAS f32x4*)cur + q; const LAS f32x4* SCL = (const LAS f32x4*)(cur + SC_SCL);
                const int rowl = 4 * w + rl; const LAS f32x4* VS = (const LAS f32x4*)(cur + SC_VS) + rowl; LAS f32x2* YB = (LAS f32x2*)(cur + SC_YB) + rowl;
                f32x4 az1a = A[0], az1b = A[256], az2a = A[512], az2b = A[768], ww = A[1024], b1 = A[1280], k1 = A[1536], b2 = A[1792], k2 = A[2048], c0 = SCL[0], vs = VS[0]; f32x2 c1 = *(const LAS f32x2*)(SCL + 1);
#pragma unroll 4
                for (int pr = 0; pr < SC_NP; ++pr) {
                    const int pn = (pr + 1) * 16;
                    const f32x4 n_az1a = A[pn], n_az1b = A[256 + pn], n_az2a = A[512 + pn], n_az2b = A[768 + pn], n_ww = A[1024 + pn], n_b1 = A[1280 + pn], n_k1 = A[1536 + pn], n_b2 = A[1792 + pn], n_k2 = A[2048 + pn],
                                n_c0 = SCL[2 * pr + 2], n_vs = VS[pn]; const f32x2 n_c1 = *(const LAS f32x2*)(SCL + 2 * pr + 3);
                    __builtin_amdgcn_sched_barrier(0);
                    float sa1 = S0 * az1a.x; sa1 = fmaf(S1, az1a.z, sa1); sa1 = fmaf(S2, az1b.x, sa1); sa1 = fmaf(S3, az1b.z, sa1);
                    float z1 = S0 * az1a.y; z1 = fmaf(S1, az1a.w, z1); z1 = fmaf(S2, az1b.y, z1); z1 = fmaf(S3, az1b.w, z1);
                    float p2 = S0 * az2a.x; p2 = fmaf(S1, az2a.z, p2); p2 = fmaf(S2, az2b.x, p2); p2 = fmaf(S3, az2b.z, p2);
                    float q2 = S0 * az2a.y; q2 = fmaf(S1, az2a.w, q2); q2 = fmaf(S2, az2b.y, q2); q2 = fmaf(S3, az2b.w, q2);
                    float t0_ = fmaf(vs.x, k1.x, S0 * ww.x), t1_ = fmaf(vs.x, k1.y, S1 * ww.y), t2_ = fmaf(vs.x, k1.z, S2 * ww.z), t3_ = fmaf(vs.x, k1.w, S3 * ww.w);
                    t0_ = fmaf(vs.y, k2.x, t0_); t1_ = fmaf(vs.y, k2.y, t1_); t2_ = fmaf(vs.y, k2.z, t2_); t3_ = fmaf(vs.y, k2.w, t3_);
                    sa1 = row16_sum(sa1); z1 = row16_sum(z1); p2 = row16_sum(p2); q2 = row16_sum(q2);
                    const float sa2 = fmaf(sa1, c0.x, fmaf(vs.x, c0.y, p2)), z2 = fmaf(sa1, c0.z, fmaf(vs.x, c0.w, q2));
                    S0 = fmaf(sa2, b2.x, fmaf(sa1, b1.x, t0_)); S1 = fmaf(sa2, b2.y, fmaf(sa1, b1.y, t1_)); S2 = fmaf(sa2, b2.z, fmaf(sa1, b1.z, t2_)); S3 = fmaf(sa2, b2.w, fmaf(sa1, b1.w, t3_));
                    YB[pr * 16] = (f32x2){fmaf(sa1, c1.x, z1) + vs.z, fmaf(sa2, c1.y, z2) + vs.w};
                    az1a = n_az1a; az1b = n_az1b; az2a = n_az2a; az2b = n_az2b; ww = n_ww; b1 = n_b1; k1 = n_k1; b2 = n_b2; k2 = n_k2; c0 = n_c0; c1 = n_c1; vs = n_vs;
                }
            }
            SCAN_BAR();
        }
        if (w >= 4) scan_flush(F, bh, quarter, T - SC_NS, F.lds + ((NBLK - 1) & 1) * SC_BUF, lt);
        asm volatile("s_waitcnt vmcnt(0)" ::: "memory"); SCAN_BAR();
    }
#undef SCAN_BAR
}
__device__ __forceinline__ void p8_post(Frame& F) {
    const float* yraw = (const float*)(F.ws + WS_YRAW); const bf16* RV = (const bf16*)(F.ws + WS_REC + 5 * REC_SLOT); const f32x4* SC = (const f32x4*)(F.ws + WS_SC);
    const bf16* Gt = (const bf16*)(F.ws + WS_G); bf16* YR = (bf16*)(F.ws + WS_YR);
    const int gw = F.vcu * NWAVES + F.wave, NGW = F.G * NWAVES, lane = fresh_tid() & 63, h = lane >> 3, c0 = 8 * lane, n0 = 8 * (lane & 7);
    float lw[8], lb[8]; ld8f(F.in16 + c0, lw); ld8f(F.in17 + c0, lb);
    for (int m0 = gw; m0 < M; m0 += 2 * NGW) {
        float yv[2][8]; v4u uvv[2], ugg[2]; f32x4 scv[2];
#pragma unroll
        for (int rr = 0; rr < 2; ++rr) { const int m = m0 + rr * NGW, b = m >> 12, t = m & (T - 1); const size_t rt = (size_t)(b * 8 + h) * T + t;
            ld8f(yraw + (size_t)m * 512 + c0, yv[rr]); uvv[rr] = *(const GAS v4u*)(RV + rt * 64 + n0); ugg[rr] = *(const GAS v4u*)(Gt + (size_t)m * 512 + c0); scv[rr] = *(const GAS f32x4*)(SC + rt); }
#pragma unroll
        for (int rr = 0; rr < 2; ++rr) { const int m = m0 + rr * NGW; const float bonus = scv[rr].z;
            float v[8], g[8]; unpack8(uvv[rr], v); unpack8(ugg[rr], g);
            float s1 = 0.f;
#pragma unroll
            for (int j = 0; j < 8; ++j) s1 += yv[rr][j];
            const float mean = sum8(s1) * (1.0f / 64.0f); float s2 = 0.f;
#pragma unroll
            for (int j = 0; j < 8; ++j) { yv[rr][j] -= mean; s2 += yv[rr][j] * yv[rr][j]; }
            const float rstd = 1.0f / sqrtf(sum8(s2) * (1.0f / 64.0f) + GN_EPS);
            float o[8];
#pragma unroll
            for (int j = 0; j < 8; ++j) o[j] = (yv[rr][j] * rstd * lw[j] + lb[j] + bonus * v[j]) * g[j];
            *(GAS v4u*)(YR + (size_t)m * 512 + c0) = pack8u(o); }
    }
}
__device__ __forceinline__ void p13_final(Frame& F) {
    const float* part = (const float*)(F.ws + WS_PART + 3 * 2 * MiB); const float* gn = F.in28;
    const int gw = F.vcu * NWAVES + F.wave, NGW = F.G * NWAVES, lane = fresh_tid() & 63;
    f32x4 g4[4];
#pragma unroll
    for (int j = 0; j < 4; ++j) g4[j] = ((const GAS f32x4*)gn)[lane + 64 * j];
    for (int m0 = gw; m0 < M; m0 += 4 * NGW) { f32x4 v[4][4]; float ps[4];
#pragma unroll
        for (int r = 0; r < 4; ++r) { const int m = m0 + r * NGW; ps[r] = 0.f; if (m < M) { GAS f32x4* xr = (GAS f32x4*)(F.out + (size_t)m * D) + lane; ps[r] = lane < 16 ? part[(size_t)m * 16 + lane] : 0.f;
#pragma unroll
            for (int j = 0; j < 4; ++j) v[r][j] = xr[64 * j]; } }
#pragma unroll
        for (int r = 0; r < 4; ++r) { const int m = m0 + r * NGW; if (m < M) { const float rs = 1.0f / sqrtf(wave_sum(ps[r]) * (1.0f / 1024.0f) + RMS_EPS);
            GAS f32x4* xr = (GAS f32x4*)(F.out + (size_t)m * D) + lane;
#pragma unroll
            for (int j = 0; j < 4; ++j) xr[64 * j] = v[r][j] * rs * g4[j]; } }
    }
}
struct Args { const float* in[29]; float* out; unsigned char* ws; };
__global__ void __launch_bounds__(NWAVES * 64, 2) fwd_megakernel(Args args) {
    extern __shared__ __attribute__((aligned(16))) unsigned char lds[];
    cg::grid_group grid = cg::this_grid();
    Frame F;
    F.lds = (LAS unsigned char*)lds;
    F.tid = threadIdx.x; F.lane = F.tid & 63; F.wave = __builtin_amdgcn_readfirstlane(F.tid >> 6);
    F.G = gridDim.x; { const int bx = blockIdx.x; F.vcu = (F.G % 8 == 0) ? (bx % 8) * (F.G / 8) + bx / 8 : bx; }
F.in0 = args.in[0]; F.in1 = args.in[1]; F.in2 = args.in[2]; F.in3 = args.in[3]; F.in4 = args.in[4]; F.in5 = args.in[5]; F.in6 = args.in[6]; F.in7 = args.in[7]; F.in8 = args.in[8]; F.in9 = args.in[9]; F.in10 = args.in[10]; F.in11 = args.in[11]; F.in12 = args.in[12]; F.in13 = args.in[13]; F.in14 = args.in[14]; F.in15 = args.in[15]; F.in16 = args.in[16]; F.in17 = args.in[17]; F.in18 = args.in[18]; F.in19 = args.in[19]; F.in20 = args.in[20]; F.in21 = args.in[21]; F.in22 = args.in[22]; F.in23 = args.in[23]; F.in24 = args.in[24]; F.in25 = args.in[25]; F.in26 = args.in[26]; F.in27 = args.in[27]; F.in28 = args.in[28];
    F.out = args.out; F.ws = args.ws;
    unsigned char* ws = args.ws;
    bf16* XB = (bf16*)(ws + WS_XB); bf16* HB = (bf16*)(ws + WS_H);
    float* PA = (float*)(ws + WS_PART); float* PB = PA + (size_t)M * 16; float* PC = PB + (size_t)M * 16; float* PD = PC + (size_t)M * 16;
    using pg8::gemm_phase; using pg8::StaticOrder; using pg8::Gemm;
    volatile LAS unsigned* bst = (volatile LAS unsigned*)(F.lds + RING_BYTES);
    if (F.tid == 0) { bst[0] = 0u; bst[1] = 0u; }
    __syncthreads();
    XcdBarrier bar = xcd_barrier_post((unsigned*)ws, bst);
#define SYNC() xcd_barrier(bar)
#define RUN_GEMM(EPI, Aptr, Bptr, NN, KK, ...) do { Gemm g_{(const pg8::bf16_t*)(Aptr), (const pg8::bf16_t*)(Bptr), M, (NN), (KK)}; StaticOrder S_; S_.init(M, (NN), F.G, (int)blockIdx.x); \
        pg8::EPI E_{__VA_ARGS__}; gemm_phase<pg8::EPI, StaticOrder, true, true>(F.lds, g_, S_, E_); } while (0)

    p0_prologue(F); grid.sync();
    { const pg8::RsTab tb = fill_rstd(F, PA, 2 * FF); RUN_GEMM(EpiGU, XB, ws + WS_WGU1, 2 * FF, D, tb, F.lds, HB, PA); } SYNC();
    RUN_GEMM(EpiRes, HB, ws + WS_WDN1, D, FF, F.in0, F.out, XB, PB, 0.5f); SYNC();
    { const pg8::RsTab tb = fill_rstd(F, PB, 2560); RUN_GEMM(EpiProj, XB, ws + WS_WIN, 2560, D, tb, F.lds, (bf16*)(ws + WS_RKVL), (bf16*)(ws + WS_ATTQ), (bf16*)(ws + WS_ATTKV), PB); } SYNC();
    p4_lora_in(F); SYNC();
    RUN_GEMM(EpiLora, ws + WS_LA, ws + WS_WLO, 1536, 256, (bf16*)(ws + WS_REC), (bf16*)(ws + WS_REC + 4 * REC_SLOT), (bf16*)(ws + WS_G), F.in8, F.in10); SYNC();
    p6_prep(F); p6_attention(F); SYNC();
    p7_scan(F); SYNC();
    p8_post(F); SYNC();
    { const pg8::RsTab tb = fill_rstd(F, PB, 2048); RUN_GEMM(EpiGate, XB, ws + WS_WGT, 2048, D, tb, F.lds, (bf16*)(ws + WS_GATES), PB); } SYNC();
    RUN_GEMM(EpiBranch, ws + WS_YR, ws + WS_WBR, D, 512, (const bf16*)(ws + WS_GATES), (bf16*)(ws + WS_MERGED), 0, 0);
    RUN_GEMM(EpiBranch, ws + WS_ATTQ, ws + WS_WBA, D, 512, (const bf16*)(ws + WS_GATES), (bf16*)(ws + WS_MERGED), 1024, 1); SYNC();
    RUN_GEMM(EpiRes, ws + WS_MERGED, ws + WS_WOUT, D, D, F.out, F.out, XB, PC, 1.0f); SYNC();
    { const pg8::RsTab tb = fill_rstd(F, PC, 2 * FF); RUN_GEMM(EpiGU, XB, ws + WS_WGU2, 2 * FF, D, tb, F.lds, HB, PC); } SYNC();
    RUN_GEMM(EpiRes, HB, ws + WS_WDN2, D, FF, F.out, F.out, (bf16*)nullptr, PD, 0.5f); SYNC();
    p13_final(F);
}

extern "C" void kernel_launch(void* const* d_in, const int* in_sizes, int n_in, void* d_out, int out_size, void* d_ws, size_t ws_size, hipStream_t stream) {
    static int grid = 0;
    if (grid == 0) {
        if (n_in != 29 || in_sizes[0] != M * D || out_size != M * D || ws_size < WS_END) { fprintf(stderr, "kernel_launch: unexpected shapes (n_in %d, ws %zu)\n", n_in, ws_size); grid = -1; return; }
        int dev = 0, cus = 0, per_cu = 0;
        hipGetDevice(&dev); hipDeviceGetAttribute(&cus, hipDeviceAttributeMultiprocessorCount, dev);
        if (hipFuncSetAttribute((const void*)fwd_megakernel, hipFuncAttributeMaxDynamicSharedMemorySize, LDS_BYTES) != hipSuccess) { fprintf(stderr, "kernel_launch: hipFuncSetAttribute failed\n"); grid = -1; return; }
        hipOccupancyMaxActiveBlocksPerMultiprocessor(&per_cu, (const void*)fwd_megakernel, NWAVES * 64, LDS_BYTES);
        (void)hipGetLastError();
        if (per_cu < 1) fprintf(stderr, "kernel_launch: occupancy query says %d blocks/CU\n", per_cu);
        grid = cus;
    }
    if (grid < 0) return;
    if (hipMemsetAsync(d_ws, 0, 16384, stream) != hipSuccess) { fprintf(stderr, "kernel_launch: memset failed\n"); return; }
    Args a{};
    for (int i = 0; i < 29; ++i) a.in[i] = (const float*)d_in[i];
    a.out = (float*)d_out; a.ws = (unsigned char*)d_ws;
    void* kargs[] = {&a};
    hipError_t e = hipLaunchCooperativeKernel((const void*)fwd_megakernel, dim3(grid), dim3(NWAVES * 64), kargs, LDS_BYTES, stream);
    if (e != hipSuccess) fprintf(stderr, "kernel_launch: cooperative launch failed: %s (grid %d)\n", hipGetErrorString(e), grid);
}
```

```cpp
#include <hip/hip_runtime.h>
#include <hip/hip_cooperative_groups.h>
#include <cstdio>
#include <cstdint>
namespace cg = cooperative_groups;
namespace pg8 {
#define PG8_LAS __attribute__((address_space(3)))
typedef unsigned short bf16_t;
typedef short bf16x8 __attribute__((ext_vector_type(8)));
typedef float f32x4 __attribute__((ext_vector_type(4)));
typedef unsigned u32x4 __attribute__((ext_vector_type(4)));
constexpr int BM = 256, BK = 64, HALF = 128, HTB = HALF * BK * 2  , STAGE_BYTES = 8 * HTB, NXCD = 8, WGM = 8;

__host__ __device__ __forceinline__ int lds_byte(int r, int c) { const int st = (r >> 4) * 2 + (c >> 5), rr = r & 15, cc = c & 31, ob = rr * 64 + cc * 2; return st * 1024 + (ob ^ (((ob >> 9) & 1) << 5)); }
__host__ __device__ __forceinline__ void stage_rc(int b, int& R, int& C) { const int st = b / 1024, sb = b % 1024, swz = sb ^ (((sb >> 9) & 1) << 5); R = (st >> 1) * 16 + swz / 64; C = (st & 1) * 32 + (swz % 64) / 2; }
__host__ __device__ __forceinline__ int perm32(int rho) { const int n = rho >> 4, i = rho & 15; return 8 * (i >> 2) + 4 * n + (i & 3); }

struct Unit { int pm, pn; };
struct Gemm { const bf16_t* A; const bf16_t* Bt; int M, N, K; };

struct StaticOrder {
    int nM, nN, nwg, G, c;
    __host__ __device__ void init(int M, int N, int G_, int c_) { nM = M / BM; nN = N / BM; nwg = nM * nN; G = G_; c = c_; }
    __host__ __device__ bool next(int i, Unit& u) const {
        const long L = (long)i * G + c; if (L >= nwg) return false;
        int wgid = (int)L; { const int q = nwg / NXCD, r = nwg % NXCD, xcd = wgid % NXCD, off = wgid / NXCD; wgid = (xcd < r ? xcd * (q + 1) : r * (q + 1) + (xcd - r) * q) + off; }
        const int nig = WGM * nN, gid = wgid / nig, fm = gid * WGM, gsz = (nM - fm) < WGM ? (nM - fm) : WGM;
        u.pm = fm + ((wgid % nig) % gsz); u.pn = (wgid % nig) / gsz; return true;
    }
    __device__ __forceinline__ void a_ready(const Unit&) const {}
    __device__ __forceinline__ void done(const Unit&) const {}
};

__device__ __forceinline__ unsigned cvt_pk_bf16(float lo, float hi) { unsigned r; asm volatile("v_cvt_pk_bf16_f32 %0, %1, %2" : "=v"(r) : "v"(lo), "v"(hi)); return r; }
__device__ __forceinline__ u32x4 pack8(f32x4 v0, f32x4 v1) {
    u32x4 w;
    asm volatile("s_nop 1\n\tv_cvt_pk_bf16_f32 %0, %4, %5\n\tv_cvt_pk_bf16_f32 %1, %6, %7\n\tv_cvt_pk_bf16_f32 %2, %8, %9\n\tv_cvt_pk_bf16_f32 %3, %10, %11"
                 : "=&v"(w.x), "=&v"(w.y), "=&v"(w.z), "=&v"(w.w)
                 : "v"(v0[0]), "v"(v0[1]), "v"(v0[2]), "v"(v0[3]), "v"(v1[0]), "v"(v1[1]), "v"(v1[2]), "v"(v1[3]));
    return w;
}
__device__ __forceinline__ float bf_lo(unsigned u) { return __uint_as_float(u << 16); }
__device__ __forceinline__ float bf_hi(unsigned u) { return __uint_as_float(u & 0xffff0000u); }
constexpr int RS_TAB_OFF = 131072 + 64;
struct RsTab { int pm[4]; };
__device__ __forceinline__ void rows_rstd(const RsTab& tb, PG8_LAS unsigned char* lds, const Unit& u, int wr, int fr, float (&rs)[2][4]) {
    const int slot = u.pm == tb.pm[0] ? 0 : (u.pm == tb.pm[1] ? 1 : (u.pm == tb.pm[2] ? 2 : 3));
    const PG8_LAS float* t = (const PG8_LAS float*)(lds + RS_TAB_OFF) + slot * 256 + wr * 64 + fr;
#pragma unroll
    for (int ai = 0; ai < 2; ++ai)
#pragma unroll
        for (int m = 0; m < 4; ++m) rs[ai][m] = t[ai * HALF + m * 16];
}
__device__ __forceinline__ float fexp_(float x) { return __builtin_amdgcn_exp2f(x * 1.44269504089f); }
__device__ __forceinline__ float sigmoidf_(float x) { return __builtin_amdgcn_rcpf(1.0f + fexp_(-x)); }

struct EpiGU {
    static constexpr bool PERM = true, AFTER_DRAIN = false;
    RsTab tb; PG8_LAS unsigned char* lds;
    bf16_t* H; const float* part;
    __device__ __forceinline__ void operator()(const f32x4 (&acc)[2][2][4][2], const Unit& u, int wr, int wc, int fr, int fq) const {
        const int row0 = u.pm * BM + wr * 64 + fr, col0 = u.pn * 128 + wc * 32 + 8 * fq;
        float rsv[2][4]; rows_rstd(tb, lds, u, wr, fr, rsv);
#pragma unroll
        for (int ai = 0; ai < 2; ++ai)
#pragma unroll
            for (int m = 0; m < 4; ++m) { const int row = row0 + ai * HALF + m * 16; const float rs = rsv[ai][m];
                f32x4 h0, h1;
#pragma unroll
                for (int j = 0; j < 4; ++j) { const float g0 = acc[ai][0][m][0][j] * rs, u0 = acc[ai][1][m][0][j] * rs, g1 = acc[ai][0][m][1][j] * rs, u1 = acc[ai][1][m][1][j] * rs;
                    h0[j] = g0 * u0 * __builtin_amdgcn_rcpf(1.0f + fexp_(-g0)); h1[j] = g1 * u1 * __builtin_amdgcn_rcpf(1.0f + fexp_(-g1)); }
                *(u32x4*)(H + (size_t)row * 2816 + col0) = pack8(h0, h1); asm volatile("" ::: "memory"); }
    }
};
struct EpiRes {
    static constexpr bool PERM = true, AFTER_DRAIN = false;
    const float* xin; float* xout; bf16_t* xb; float* part; float alpha;
    __device__ __forceinline__ void operator()(const f32x4 (&acc)[2][2][4][2], const Unit& u, int wr, int wc, int fr, int fq) const {
        const int row0 = u.pm * BM + wr * 64 + fr, col0 = u.pn * BM + wc * 32 + 8 * fq;
#pragma unroll
        for (int ai = 0; ai < 2; ++ai)
#pragma unroll
            for (int m = 0; m < 4; ++m) { const int row = row0 + ai * HALF + m * 16; float ss = 0.f;
#pragma unroll
                for (int bj = 0; bj < 2; ++bj) { const size_t off = (size_t)row * 1024 + col0 + bj * HALF;
                    const f32x4 r0 = *(const f32x4*)(xin + off), r1 = *(const f32x4*)(xin + off + 4);
                    const f32x4 v0 = r0 + acc[ai][bj][m][0] * alpha, v1 = r1 + acc[ai][bj][m][1] * alpha;
                    *(f32x4*)(xout + off) = v0; *(f32x4*)(xout + off + 4) = v1;
                    if (xb) *(u32x4*)(xb + off) = pack8(v0, v1);
                    ss += (v0[0] * v0[0] + v0[1] * v0[1]) + (v0[2] * v0[2] + v0[3] * v0[3]) + (v1[0] * v1[0] + v1[1] * v1[1]) + (v1[2] * v1[2] + v1[3] * v1[3]); }
                ss += __shfl_xor(ss, 16); ss += __shfl_xor(ss, 32);
                if (fq == 0) part[(size_t)row * 16 + u.pn * 4 + wc] = ss; asm volatile("" ::: "memory"); }
    }
};
struct EpiProj {
    static constexpr bool PERM = true, AFTER_DRAIN = false;
    RsTab tb; PG8_LAS unsigned char* lds;
    bf16_t* rkvl; bf16_t* attq; bf16_t* attkv; const float* part;
    __device__ __forceinline__ void operator()(const f32x4 (&acc)[2][2][4][2], const Unit& u, int wr, int wc, int fr, int fq) const {
        bf16_t* base; int ldc, colt;
        if (u.pn < 7) { base = rkvl; ldc = 1792; colt = u.pn * BM; } else if (u.pn < 9) { base = attq; ldc = 512; colt = (u.pn - 7) * BM; } else { base = attkv; ldc = 256; colt = 0; }
        const int row0 = u.pm * BM + wr * 64 + fr, col0 = colt + wc * 32 + 8 * fq;
        float rsv[2][4]; rows_rstd(tb, lds, u, wr, fr, rsv);
#pragma unroll
        for (int ai = 0; ai < 2; ++ai)
#pragma unroll
            for (int m = 0; m < 4; ++m) { const int row = row0 + ai * HALF + m * 16; const float rs = rsv[ai][m];
#pragma unroll
                for (int bj = 0; bj < 2; ++bj) *(u32x4*)(base + (size_t)row * ldc + col0 + bj * HALF) = pack8(acc[ai][bj][m][0] * rs, acc[ai][bj][m][1] * rs); }
    }
};
struct EpiGate {
    static constexpr bool PERM = true, AFTER_DRAIN = false;
    RsTab tb; PG8_LAS unsigned char* lds;
    bf16_t* gates; const float* part;
    __device__ __forceinline__ void operator()(const f32x4 (&acc)[2][2][4][2], const Unit& u, int wr, int wc, int fr, int fq) const {
        const int row0 = u.pm * BM + wr * 64 + fr, col0 = u.pn * BM + wc * 32 + 8 * fq;
        float rsv[2][4]; rows_rstd(tb, lds, u, wr, fr, rsv);
#pragma unroll
        for (int ai = 0; ai < 2; ++ai)
#pragma unroll
            for (int m = 0; m < 4; ++m) { const int row = row0 + ai * HALF + m * 16; const float rs = rsv[ai][m];
#pragma unroll
                for (int bj = 0; bj < 2; ++bj) { f32x4 v0, v1;
#pragma unroll
                    for (int j = 0; j < 4; ++j) { v0[j] = sigmoidf_(acc[ai][bj][m][0][j] * rs); v1[j] = sigmoidf_(acc[ai][bj][m][1][j] * rs); }
                    *(u32x4*)(gates + (size_t)row * 2048 + col0 + bj * HALF) = pack8(v0, v1); } }
    }
};
struct EpiLora {
    static constexpr bool PERM = true, AFTER_DRAIN = false;
    bf16_t* rec_lw; bf16_t* rec_a; bf16_t* g; const float* w0; const float* a0;
    template <int KIND> __device__ __forceinline__ void body(const f32x4 (&acc)[2][2][4][2], const Unit& u, int wr, int wc, int fr, int fq) const {
        const int row0 = u.pm * BM + wr * 64 + fr, col0 = (u.pn & 1) * BM + wc * 32 + 8 * fq;
#pragma unroll
        for (int ai = 0; ai < 2; ++ai)
#pragma unroll
            for (int m = 0; m < 4; ++m) { const int row = row0 + ai * HALF + m * 16; const int b = row >> 12, t = row & 4095;
#pragma unroll
                for (int bj = 0; bj < 2; ++bj) { const int c = col0 + bj * HALF; f32x4 v0 = acc[ai][bj][m][0], v1 = acc[ai][bj][m][1];
                    if (KIND != 2) { const float* bias = (KIND == 0 ? w0 : a0) + c; v0 = v0 + *(const f32x4*)bias; v1 = v1 + *(const f32x4*)(bias + 4); }
                    if (KIND == 2) { *(u32x4*)(g + (size_t)row * 512 + c) = pack8(v0, v1); }
                    else {
#pragma unroll
                        for (int j = 0; j < 4; ++j) {
                            if (KIND == 0) { const float y0 = -v0[j], y1 = -v1[j];
                                const float sp0 = fmaxf(y0, 0.f) + __logf(1.0f + fexp_(-fabsf(y0))), sp1 = fmaxf(y1, 0.f) + __logf(1.0f + fexp_(-fabsf(y1)));
                                v0[j] = -fexp_(-sp0 - 0.5f); v1[j] = -fexp_(-sp1 - 0.5f); }
                            else { v0[j] = sigmoidf_(v0[j]); v1[j] = sigmoidf_(v1[j]); } }
                        bf16_t* dst = (KIND == 0 ? rec_lw : rec_a) + ((size_t)((b * 8 + (c >> 6)) * 4096 + t)) * 64 + (c & 63);
                        *(u32x4*)dst = pack8(v0, v1); } }
                asm volatile("" ::: "memory"); }
    }
    __device__ __forceinline__ void operator()(const f32x4 (&acc)[2][2][4][2], const Unit& u, int wr, int wc, int fr, int fq) const {
        const int kind = u.pn >> 1;
        if (kind == 0) body<0>(acc, u, wr, wc, fr, fq); else if (kind == 1) body<1>(acc, u, wr, wc, fr, fq); else body<2>(acc, u, wr, wc, fr, fq);
    }
};
struct EpiBranch {
    static constexpr bool PERM = true, AFTER_DRAIN = false;
    const bf16_t* gates; bf16_t* merged; int goff; int accum;
    __device__ __forceinline__ void operator()(const f32x4 (&acc)[2][2][4][2], const Unit& u, int wr, int wc, int fr, int fq) const {
        const int row0 = u.pm * BM + wr * 64 + fr, col0 = u.pn * BM + wc * 32 + 8 * fq;
#pragma unroll
        for (int ai = 0; ai < 2; ++ai)
#pragma unroll
            for (int m = 0; m < 4; ++m) { const int row = row0 + ai * HALF + m * 16;
#pragma unroll
                for (int bj = 0; bj < 2; ++bj) { const int c = col0 + bj * HALF; const u32x4 gq = *(const u32x4*)(gates + (size_t)row * 2048 + goff + c);
                    bf16_t* mp = merged + (size_t)row * 1024 + c;
                    f32x4 v0 = acc[ai][bj][m][0], v1 = acc[ai][bj][m][1];
                    v0[0] *= bf_lo(gq.x); v0[1] *= bf_hi(gq.x); v0[2] *= bf_lo(gq.y); v0[3] *= bf_hi(gq.y);
                    v1[0] *= bf_lo(gq.z); v1[1] *= bf_hi(gq.z); v1[2] *= bf_lo(gq.w); v1[3] *= bf_hi(gq.w);
                    if (accum) { const u32x4 pq = *(const u32x4*)mp;
                        v0[0] += bf_lo(pq.x); v0[1] += bf_hi(pq.x); v0[2] += bf_lo(pq.y); v0[3] += bf_hi(pq.y);
                        v1[0] += bf_lo(pq.z); v1[1] += bf_hi(pq.z); v1[2] += bf_lo(pq.w); v1[3] += bf_hi(pq.w); }
                    *(u32x4*)mp = pack8(v0, v1); } asm volatile("" ::: "memory"); }
    }
};

template <class Epi, class Sched, bool ALIGN_EPI = false, bool SP2 = false>
__device__ __forceinline__ void gemm_phase(PG8_LAS unsigned char* lds, const Gemm g, const Sched& S, const Epi& E) {
    int tid_ = threadIdx.x; asm volatile("" : "+v"(tid_));
    const int tid = tid_, wid = __builtin_amdgcn_readfirstlane(tid >> 6), lane = tid & 63, wr = wid >> 2, wc = wid & 3, fr = lane & 15, fq = lane >> 4;
    const int K = g.K, nt = K / BK;
    unsigned voffA[2], voffB[2];
#pragma unroll
    for (int i = 0; i < 2; ++i) { int R, C; stage_rc(tid * 16 + i * 8192, R, C); const int Rb = Epi::PERM ? ((R & ~31) + perm32(R & 31)) : R;
        voffA[i] = (unsigned)(R * K + C) * 2u; voffB[i] = (unsigned)(Rb * K + C) * 2u; }
    const size_t kstep = (size_t)(BK * 2);
    const size_t hstep = (size_t)HALF * K * 2;
    const size_t tstep = 2 * hstep;
    const unsigned ldsw = (unsigned)wid * 1024u;
    const int aoff = lds_byte(wr * 64 + fr, fq * 8), boff = lds_byte(wc * 32 + fr, fq * 8);
#define PG8_SA(b, h) (((b) * 2 + (h)) * HTB)
#define PG8_SB(b, h) ((4 + (b) * 2 + (h)) * HTB)
#define PG8_STAGE(bufoff, gbase, voff) do { _Pragma("unroll") for (int _i = 0; _i < 2; ++_i) \
        __builtin_amdgcn_global_load_lds((const unsigned*)((const char*)(gbase) + (voff)[_i]), (PG8_LAS unsigned*)(lds + (bufoff) + ldsw + _i * 8192), 16, 0, 0); } while (0)
#define PG8_LDA(dst, b, h) do { _Pragma("unroll") for (int m = 0; m < 4; ++m) _Pragma("unroll") for (int k = 0; k < 2; ++k) dst[m][k] = *(const PG8_LAS bf16x8*)(lds + PG8_SA(b, h) + aoff + m * 2048 + k * 1024); } while (0)
#define PG8_LDB(dst, b, h) do { _Pragma("unroll") for (int n = 0; n < 2; ++n) _Pragma("unroll") for (int k = 0; k < 2; ++k) dst[n][k] = *(const PG8_LAS bf16x8*)(lds + PG8_SB(b, h) + boff + n * 2048 + k * 1024); } while (0)
#define PG8_MMA(ai, bj, At, Bt) do { __builtin_amdgcn_s_setprio(1); _Pragma("unroll") for (int m = 0; m < 4; ++m) _Pragma("unroll") for (int n = 0; n < 2; ++n) _Pragma("unroll") for (int k = 0; k < 2; ++k) \
        acc[ai][bj][m][n] = __builtin_amdgcn_mfma_f32_16x16x32_bf16(Bt[n][k], At[m][k], acc[ai][bj][m][n], 0, 0, 0); __builtin_amdgcn_s_setprio(0); } while (0)
#define PG8_WAIT_V(n) asm volatile("s_waitcnt vmcnt(" #n ")" ::: "memory")
#define PG8_WAIT_L(n) asm volatile("s_waitcnt lgkmcnt(" #n ")" ::: "memory")
#define PG8_BAR __builtin_amdgcn_s_barrier()
#define PG8_SCHED __builtin_amdgcn_sched_barrier(0)
    Unit cur, nxt; int ui = 0;
    if (!S.next(0, cur)) return;
    f32x4 acc[2][2][4][2];
#pragma unroll
    for (int a = 0; a < 2; ++a)
#pragma unroll
        for (int b = 0; b < 2; ++b)
#pragma unroll
            for (int m = 0; m < 4; ++m)
#pragma unroll
                for (int n = 0; n < 2; ++n) acc[a][b][m][n] = (f32x4){0.f, 0.f, 0.f, 0.f};
    bf16x8 At[4][2], B0[2][2], B1[2][2];
    const char* cA = (const char*)g.A + (size_t)cur.pm * tstep; const char* cB = (const char*)g.Bt + (size_t)cur.pn * tstep;
    S.a_ready(cur);
    if constexpr (SP2) {
        PG8_STAGE(PG8_SB(0, 0), cB, voffB); PG8_STAGE(PG8_SB(0, 1), cB + hstep, voffB); PG8_STAGE(PG8_SA(0, 0), cA, voffA); PG8_STAGE(PG8_SA(0, 1), cA + hstep, voffA);
        if (wr == 1) PG8_BAR;
        PG8_WAIT_V(2); PG8_BAR;
        PG8_STAGE(PG8_SB(1, 0), cB + kstep, voffB); PG8_STAGE(PG8_SA(1, 0), cA + kstep, voffA); PG8_STAGE(PG8_SB(1, 1), cB + hstep + kstep, voffB);
        PG8_WAIT_V(6); PG8_BAR;
    } else {
        PG8_STAGE(PG8_SB(0, 0), cB, voffB); PG8_STAGE(PG8_SA(0, 0), cA, voffA); PG8_STAGE(PG8_SB(0, 1), cB + hstep, voffB); PG8_STAGE(PG8_SA(0, 1), cA + hstep, voffA);
        if (wr == 1) PG8_BAR;
        PG8_WAIT_V(4); PG8_BAR;
        PG8_STAGE(PG8_SB(1, 0), cB + kstep, voffB); PG8_STAGE(PG8_SA(1, 0), cA + kstep, voffA); PG8_STAGE(PG8_SB(1, 1), cB + hstep + kstep, voffB);
        PG8_WAIT_V(6); PG8_BAR;
    }
    for (;;) {
        const bool has_next = S.next(ui + 1, nxt);
        const char* nA = has_next ? (const char*)g.A + (size_t)nxt.pm * tstep : cA; const char* nB = has_next ? (const char*)g.Bt + (size_t)nxt.pn * tstep : cB;
        for (int t = 0; t < nt; t += 2) {
            const bool last = (t == nt - 2);
            const char* a1 = cA + (size_t)(t + 1) * kstep;
            const char* a2 = last ? nA : cA + (size_t)(t + 2) * kstep; const char* b2 = last ? nB : cB + (size_t)(t + 2) * kstep;
            const char* a3 = a2 + kstep; const char* b3 = b2 + kstep;
            if (last && has_next) S.a_ready(nxt);
            if constexpr (SP2) {
            PG8_LDB(B0, 0, 0); PG8_LDB(B1, 0, 1); PG8_SCHED; PG8_LDA(At, 0, 0); PG8_STAGE(PG8_SA(1, 1), a1 + hstep, voffA);
            PG8_WAIT_V(8); PG8_WAIT_L(0); PG8_BAR; PG8_MMA(0, 0, At, B0); PG8_MMA(0, 1, At, B1); PG8_BAR; PG8_SCHED;
            PG8_LDA(At, 0, 1); PG8_STAGE(PG8_SB(0, 0), b2, voffB); PG8_STAGE(PG8_SB(0, 1), b2 + hstep, voffB); PG8_STAGE(PG8_SA(0, 0), a2, voffA);
            PG8_WAIT_V(8); PG8_WAIT_L(0); PG8_BAR; PG8_MMA(1, 0, At, B0); PG8_MMA(1, 1, At, B1); PG8_BAR; PG8_SCHED;
            PG8_LDB(B0, 1, 0); PG8_LDB(B1, 1, 1); PG8_SCHED; PG8_LDA(At, 1, 0); PG8_STAGE(PG8_SA(0, 1), a2 + hstep, voffA);
            PG8_WAIT_V(8); PG8_WAIT_L(0); PG8_BAR; PG8_MMA(0, 0, At, B0); PG8_MMA(0, 1, At, B1); PG8_BAR; PG8_SCHED;
            PG8_LDA(At, 1, 1); PG8_STAGE(PG8_SB(1, 0), b3, voffB); PG8_STAGE(PG8_SB(1, 1), b3 + hstep, voffB); PG8_STAGE(PG8_SA(1, 0), a3, voffA);
            PG8_WAIT_V(8); PG8_WAIT_L(0); PG8_BAR; PG8_MMA(1, 0, At, B0); PG8_MMA(1, 1, At, B1); PG8_BAR; PG8_SCHED;
            } else {
            PG8_LDB(B0, 0, 0); PG8_SCHED; PG8_LDA(At, 0, 0); PG8_STAGE(PG8_SA(1, 1), a1 + hstep, voffA);
            PG8_WAIT_L(8); PG8_BAR; PG8_WAIT_L(0); PG8_MMA(0, 0, At, B0); PG8_BAR; PG8_SCHED;
            PG8_LDB(B1, 0, 1); PG8_STAGE(PG8_SB(0, 0), b2, voffB);
            PG8_BAR; PG8_WAIT_L(0); PG8_MMA(0, 1, At, B1); PG8_BAR;
            PG8_LDA(At, 0, 1); PG8_STAGE(PG8_SA(0, 0), a2, voffA);
            PG8_BAR; PG8_WAIT_L(0); PG8_MMA(1, 0, At, B0); PG8_BAR; PG8_SCHED;
            PG8_STAGE(PG8_SB(0, 1), b2 + hstep, voffB);
            PG8_WAIT_V(6); PG8_BAR; PG8_MMA(1, 1, At, B1); PG8_BAR;
            PG8_LDB(B0, 1, 0); PG8_SCHED; PG8_LDA(At, 1, 0); PG8_STAGE(PG8_SA(0, 1), a2 + hstep, voffA);
            PG8_WAIT_L(8); PG8_BAR; PG8_WAIT_L(0); PG8_MMA(0, 0, At, B0); PG8_BAR; PG8_SCHED;
            PG8_LDB(B1, 1, 1); PG8_STAGE(PG8_SB(1, 0), b3, voffB);
            PG8_BAR; PG8_WAIT_L(0); PG8_MMA(0, 1, At, B1); PG8_BAR;
            PG8_LDA(At, 1, 1); PG8_STAGE(PG8_SA(1, 0), a3, voffA);
            PG8_BAR; PG8_WAIT_L(0); PG8_MMA(1, 0, At, B0); PG8_BAR; PG8_SCHED;
            PG8_STAGE(PG8_SB(1, 1), b3 + hstep, voffB);
            PG8_WAIT_V(6); PG8_BAR; PG8_MMA(1, 1, At, B1); PG8_BAR;
            }
        }
        if constexpr (ALIGN_EPI) { if (wr == 0) PG8_BAR; }
        if constexpr (!Epi::AFTER_DRAIN) { E(acc, cur, wr, wc, fr, fq); S.done(cur); }
        if (!has_next) break;
#pragma unroll
        for (int a = 0; a < 2; ++a)
#pragma unroll
            for (int b = 0; b < 2; ++b)
#pragma unroll
                for (int m = 0; m < 4; ++m)
#pragma unroll
                    for (int n = 0; n < 2; ++n) acc[a][b][m][n] = (f32x4){0.f, 0.f, 0.f, 0.f};
        cur = nxt; cA = nA; cB = nB; ++ui;
        if constexpr (ALIGN_EPI) { if (wr == 1) PG8_BAR; }
    }
    PG8_WAIT_V(0);
    if constexpr (!ALIGN_EPI) { if (wr == 0) PG8_BAR; }
    PG8_BAR;
    if constexpr (Epi::AFTER_DRAIN) { E.fused(acc, cur, wr, wc, fr, fq, lds, wid, lane); S.done(cur); }
#undef PG8_SA
#undef PG8_SB
#undef PG8_STAGE
#undef PG8_LDA
#undef PG8_LDB
#undef PG8_MMA
#undef PG8_WAIT_V
#undef PG8_WAIT_L
#undef PG8_BAR
#undef PG8_SCHED
}
}
constexpr int NWAVES = 8;
constexpr int BATCH = 8, T = 4096, D = 1024, M = BATCH * T, FF = 2816, NH = 8, HD = 64, INC = 4512;
constexpr float RMS_EPS = 1e-6f, GN_EPS = 64e-5f;
constexpr size_t MiB = 1u << 20;
constexpr size_t WS_PART = 1 * MiB;
constexpr size_t WS_SC = 9 * MiB;
constexpr size_t WS_WGU1 = 13 * MiB, WS_WDN1 = WS_WGU1 + 11 * MiB, WS_WGU2 = WS_WDN1 + 5632 * 1024, WS_WDN2 = WS_WGU2 + 11 * MiB;
constexpr size_t WS_WIN = WS_WDN2 + 5632 * 1024, WS_WGT = WS_WIN + 5 * MiB, WS_WLO = WS_WGT + 4 * MiB, WS_WBR = WS_WLO + 768 * 1024, WS_WBA = WS_WBR + 1 * MiB, WS_WOUT = WS_WBA + 1 * MiB;
constexpr size_t WS_XB = 62 * MiB;
constexpr size_t WS_ATTQ = 126 * MiB;
constexpr size_t WS_ATTKV = 158 * MiB;
constexpr size_t WS_RKVL = 174 * MiB;
constexpr size_t WS_G = 286 * MiB;
constexpr size_t WS_REC = 318 * MiB, REC_SLOT = 32 * MiB;
constexpr size_t WS_H = 126 * MiB;
constexpr size_t WS_YRAW = WS_RKVL;
constexpr size_t WS_MERGED = WS_RKVL;
constexpr size_t WS_GATES = WS_REC;
constexpr size_t WS_YR = WS_REC + 4 * REC_SLOT;
constexpr size_t WS_LA = WS_REC + 5 * REC_SLOT;
constexpr size_t WS_END = WS_REC + 6 * REC_SLOT;
static_assert(WS_WOUT + 4 * MiB <= WS_XB && WS_H + (size_t)M * FF * 2 <= WS_REC && WS_MERGED + (size_t)M * 2048 * 2 <= WS_REC, "ws map");
constexpr int RING_BYTES = 131072, LDS_BYTES = 147456;

#define GAS __attribute__((address_space(1)))
#define LAS __attribute__((address_space(3)))
typedef unsigned short bf16;
typedef unsigned v4u __attribute__((ext_vector_type(4)));
typedef unsigned v2u __attribute__((ext_vector_type(2)));
typedef float f32x4 __attribute__((ext_vector_type(4)));
typedef float f32x2 __attribute__((ext_vector_type(2)));
typedef short bf16x8 __attribute__((ext_vector_type(8)));
#define LDS_WAIT() asm volatile("s_waitcnt lgkmcnt(0)" ::: "memory")
__device__ __forceinline__ unsigned f2bf(float f) { unsigned u = __builtin_bit_cast(unsigned, f); return (u + 0x7fffu + ((u >> 16) & 1u)) >> 16; }
__device__ __forceinline__ unsigned pk2(float lo, float hi) { return f2bf(lo) | (f2bf(hi) << 16); }
__device__ __forceinline__ float bflo(unsigned u) { return __uint_as_float(u << 16); }
__device__ __forceinline__ float bfhi(unsigned u) { return __uint_as_float(u & 0xffff0000u); }
__device__ __forceinline__ float bf1(bf16 h) { return __uint_as_float((unsigned)h << 16); }
__device__ __forceinline__ float wave_sum(float v) {
#pragma unroll
    for (int o = 1; o < 64; o <<= 1) v += __shfl_xor(v, o);
    return v;
}
template <int CTRL> __device__ __forceinline__ float dppf(float x) { return __builtin_bit_cast(float, __builtin_amdgcn_update_dpp(0, __builtin_bit_cast(int, x), CTRL, 0xf, 0xf, false)); }
__device__ __forceinline__ float row16_sum(float x) { x += dppf<0xB1>(x); x += dppf<0x4E>(x); x += dppf<0x141>(x); x += dppf<0x140>(x); return x; }

#define RLX_AGENT __ATOMIC_RELAXED, __HIP_MEMORY_SCOPE_AGENT
#define XB_TMO      128
#define XB_XCNT(j)  (256  + 64 * (j))
#define XB_XSUB(j)  (1280 + 64 * (j))
#define XB_XGEN(j)  (2304 + 64 * (j))
#define XB_TOP      3328
#define XB_TOPGEN   3392
#define XCD_BAR_WORDS 3456
#define XB_SPIN_CAP (1u << 18)

__device__ __forceinline__ unsigned xb_ld(unsigned* p)              { return __hip_atomic_load(p, __ATOMIC_RELAXED, __HIP_MEMORY_SCOPE_AGENT); }
__device__ __forceinline__ unsigned xb_add(unsigned* p, unsigned v) { return __hip_atomic_fetch_add(p, v, __ATOMIC_RELAXED, __HIP_MEMORY_SCOPE_AGENT); }
__device__ __forceinline__ unsigned xb_xcc_id() { return (unsigned)__builtin_amdgcn_s_getreg((3 << 11) | 20) & 0xFu; }
#define XB_SPIN(cond, bar) do { unsigned _sp = 0; while (cond) { __builtin_amdgcn_s_sleep(1); \
    if ((++_sp & 255u) == 0u) { if (xb_ld(&(bar)[XB_TMO])) break; if (_sp > XB_SPIN_CAP) { atomicAdd(&(bar)[XB_TMO], 1u); break; } } } } while (0)

struct XcdBarrier {
    unsigned* bar; unsigned x;
    volatile LAS unsigned* st;
};

__device__ __forceinline__ XcdBarrier xcd_barrier_post(unsigned* bar, volatile LAS unsigned* st) {
    XcdBarrier b; b.bar = bar; b.x = xb_xcc_id(); b.st = st;
    if (threadIdx.x == 0) (void)xb_add(&bar[XB_XCNT(b.x)], 1u);
    return b;
}
__device__ __forceinline__ void xcd_barrier_complete(unsigned* bar, unsigned x, unsigned& nloc, unsigned& nx) {
    const unsigned G = gridDim.x * gridDim.y * gridDim.z;
    unsigned sum, cnt, mine, sp = 0u;
    for (;;) {
        sum = 0u; cnt = 0u; mine = 0u;
#pragma unroll
        for (unsigned j = 0; j < 16; ++j) { const unsigned c = xb_ld(&bar[XB_XCNT(j)]); sum += c; cnt += (c > 0u) ? 1u : 0u; mine = (j == x) ? c : mine; }
        if (sum == G) break;
        __builtin_amdgcn_s_sleep(1);
        if ((++sp & 255u) == 0u) { if (xb_ld(&bar[XB_TMO])) break; if (sp > XB_SPIN_CAP) { atomicAdd(&bar[XB_TMO], 1u); break; } }
    }
    nloc = mine > 0u ? mine : 1u; nx = cnt > 0u ? cnt : 1u;
}

__device__ __forceinline__ void xcd_barrier(const XcdBarrier& b) {
    asm volatile("s_waitcnt vmcnt(0)" ::: "memory");
    __syncthreads();
    if (threadIdx.x == 0) {
        unsigned* bar = b.bar;
        __builtin_amdgcn_s_waitcnt(0);
        unsigned nloc = b.st[0], nx = b.st[1];
        if (nloc == 0u) { xcd_barrier_complete(bar, b.x, nloc, nx); b.st[0] = nloc; b.st[1] = nx; }
        const unsigned old = xb_add(&bar[XB_XSUB(b.x)], 1u);
        const unsigned gen = old / nloc;
        if (old + 1u == (gen + 1u) * nloc) {
            __builtin_amdgcn_fence(__ATOMIC_RELEASE, "agent");
            asm volatile("s_waitcnt vmcnt(0)" ::: "memory");
            const unsigned og = xb_add(&bar[XB_TOP], 1u);
            const unsigned tg = og / nx;
            if (og + 1u == (tg + 1u) * nx) xb_add(&bar[XB_TOPGEN], 1u);
            else XB_SPIN(xb_ld(&bar[XB_TOPGEN]) == tg, bar);
            __builtin_amdgcn_fence(__ATOMIC_ACQUIRE, "agent");
            xb_add(&bar[XB_XGEN(b.x)], 1u);
            asm volatile("s_waitcnt vmcnt(0)" ::: "memory");
        } else {
            XB_SPIN(xb_ld(&bar[XB_XGEN(b.x)]) == gen, bar);
            __builtin_amdgcn_fence(__ATOMIC_ACQUIRE, "agent");
            asm volatile("s_waitcnt vmcnt(0)" ::: "memory");
        }
    }
    __syncthreads();
}

__device__ __forceinline__ int fresh_tid() { int t = threadIdx.x; asm volatile("" : "+v"(t)); return t; }
struct Frame {
    LAS unsigned char* lds;
    int tid, lane, wave, vcu, G;
    const float *in0, *in1, *in2, *in3, *in4, *in5, *in6, *in7, *in8, *in9, *in10, *in11, *in12, *in13, *in14, *in15, *in16, *in17, *in18, *in19, *in20, *in21, *in22, *in23, *in24, *in25, *in26, *in27, *in28; float* out; unsigned char* ws;
};

__device__ __forceinline__ pg8::RsTab fill_rstd(Frame& F, const float* part, int N) {
    pg8::StaticOrder S; S.init(M, N, F.G, (int)blockIdx.x); pg8::Unit u; pg8::RsTab tb; tb.pm[0] = tb.pm[1] = tb.pm[2] = tb.pm[3] = -1;
    for (int i = 0; S.next(i, u); ++i) { if (u.pm == tb.pm[0] || u.pm == tb.pm[1] || u.pm == tb.pm[2] || u.pm == tb.pm[3]) continue;
        if (tb.pm[0] < 0) tb.pm[0] = u.pm; else if (tb.pm[1] < 0) tb.pm[1] = u.pm; else if (tb.pm[2] < 0) tb.pm[2] = u.pm; else tb.pm[3] = u.pm; }
    const int tid = fresh_tid(); LAS float* t = (LAS float*)(F.lds + pg8::RS_TAB_OFF);
#pragma unroll
    for (int h = 0; h < 2; ++h) { const int e = tid + 512 * h, slot = e >> 8, r = e & 255; const int pm = slot == 0 ? tb.pm[0] : slot == 1 ? tb.pm[1] : slot == 2 ? tb.pm[2] : tb.pm[3];
        if (pm >= 0) { const GAS f32x4* p = (const GAS f32x4*)(part + ((size_t)pm * 256 + r) * 16); const f32x4 a = p[0], b = p[1], c = p[2], d = p[3];
            const float sm = ((a[0] + a[1]) + (a[2] + a[3])) + ((b[0] + b[1]) + (b[2] + b[3])) + ((c[0] + c[1]) + (c[2] + c[3])) + ((d[0] + d[1]) + (d[2] + d[3]));
            t[e] = __builtin_amdgcn_rsqf(sm * (1.0f / 1024.0f) + RMS_EPS); } }
    __syncthreads();
    return tb;
}
__device__ __forceinline__ void tr_item(const float* W, int ldn, int k0, int n0, bf16* WT, int ldk, int drow0, int dk0, const float* scale, int dup, LAS float* scr, int lane) {
    float tv[32], ts[32];
#pragma unroll
    for (int i = 0; i < 32; ++i) { const int kk = 2 * i + (lane >> 5); tv[i] = W[(size_t)(k0 + kk) * ldn + n0 + (lane & 31)]; ts[i] = scale ? scale[k0 + kk] : 1.0f; }
#pragma unroll
    for (int i = 0; i < 32; ++i) { const int kk = 2 * i + (lane >> 5); scr[kk * 33 + (lane & 31)] = tv[i] * ts[i]; }
    LDS_WAIT(); asm volatile("" ::: "memory");
    const int c = lane & 7;
#pragma unroll
    for (int j = 0; j < 4; ++j) { const int n = (lane >> 3) + 8 * j; const LAS float* s = scr + (8 * c) * 33 + n;
        v4u o; o.x = pk2(s[0 * 33], s[1 * 33]); o.y = pk2(s[2 * 33], s[3 * 33]); o.z = pk2(s[4 * 33], s[5 * 33]); o.w = pk2(s[6 * 33], s[7 * 33]);
        bf16* dp = WT + (size_t)(drow0 + n0 + n) * ldk + dk0 + k0 + 8 * c;
        *(GAS v4u*)dp = o; if (dup) *(GAS v4u*)(dp + dup) = o; }
    LDS_WAIT(); asm volatile("" ::: "memory");
}
__device__ __forceinline__ void p0_prologue(Frame& F) {
    LAS float* scr = (LAS float*)(F.lds + F.wave * 16384);
    unsigned char* ws = F.ws;
    const int gw = F.vcu * NWAVES + F.wave, NGW = F.G * NWAVES, lane = fresh_tid() & 63;
    constexpr int I_GU = 16 * 88, I_DN = 44 * 32, I_IN = 16 * 77, I_GT = 16 * 64, I_BR = 8 * 32, I_OUT = 16 * 32;
    constexpr int NITEMS = 4 * I_GU + 2 * I_DN + I_IN + I_GT + 2 * I_BR + I_OUT;
    for (int it = gw; it < NITEMS; it += NGW) {
        int r = it;
        if (r < 4 * I_GU) {
            const int which = r / I_GU; r -= which * I_GU; const int kb = r / 88, nb = r % 88, n0 = nb * 32;
            const float* W = which == 0 ? F.in2 : which == 1 ? F.in3 : which == 2 ? F.in25 : F.in26;
            tr_item(W, FF, kb * 64, n0, (bf16*)(ws + (which < 2 ? WS_WGU1 : WS_WGU2)), D, (n0 >> 7) * 256 + (which & 1) * 128 + (n0 & 127) - n0, 0, which < 2 ? F.in1 : F.in24, 0, scr, lane);
            continue; }
        r -= 4 * I_GU;
        if (r < 2 * I_DN) { const int which = r / I_DN; r -= which * I_DN; const int kb = r / 32, nb = r % 32;
            tr_item(which ? F.in27 : F.in4, D, kb * 64, nb * 32, (bf16*)(ws + (which ? WS_WDN2 : WS_WDN1)), FF, 0, 0, nullptr, 0, scr, lane); continue; }
        r -= 2 * I_DN;
        if (r < I_IN) { const int kb = r / 77, nb = r % 77, n0 = nb * 32;
            tr_item(F.in6, INC, kb * 64, n0, (bf16*)(ws + WS_WIN), D, n0 < 1696 ? 0 : 96, 0, F.in5, 0, scr, lane); continue; }
        r -= I_IN;
        if (r < I_GT) { const int kb = r / 64, nb = r % 64;
            tr_item(F.in6, INC, kb * 64, 2464 + nb * 32, (bf16*)(ws + WS_WGT), D, -2464, 0, F.in5, 0, scr, lane); continue; }
        r -= I_GT;
        if (r < 2 * I_BR) { const int which = r / I_BR; r -= which * I_BR; const int kb = r / 32, nb = r % 32;
            tr_item(which ? F.in22 : F.in21, D, kb * 64, nb * 32, (bf16*)(ws + (which ? WS_WBA : WS_WBR)), 512, 0, 0, nullptr, 0, scr, lane); continue; }
        r -= 2 * I_BR;
        { const int kb = r / 32, nb = r % 32; tr_item(F.in23, D, kb * 64, nb * 32, (bf16*)(ws + WS_WOUT), D, 0, 0, nullptr, 0, scr, lane); }
    }
    { GAS v4u* z = (GAS v4u*)(ws + WS_WIN + (size_t)1696 * D * 2); for (int i = gw * 64 + lane; i < 12288; i += NGW * 64) z[i] = (v4u){0u, 0u, 0u, 0u}; }
    { bf16* WL = (bf16*)(ws + WS_WLO);
      for (int i = gw * 64 + lane; i < 1536 * 256; i += NGW * 64) { const int n = i >> 8, k = i & 255, grp = n >> 9, nn = n & 511; float v = 0.f;
          if (grp == 0) { if (k < 32) v = F.in9[k * 512 + nn]; } else if (grp == 1) { if (k >= 32 && k < 64) v = F.in11[(k - 32) * 512 + nn]; } else { if (k >= 64 && k < 160) v = F.in12[(k - 64) * 512 + nn]; }
          WL[i] = (bf16)f2bf(v); } }
    { const float* x = F.in0; bf16* XB = (bf16*)(ws + WS_XB); float* part = (float*)(ws + WS_PART);
      for (int m0 = gw; m0 < M; m0 += 4 * NGW) { f32x4 v[4][4];
#pragma unroll
          for (int r = 0; r < 4; ++r) { const int m = m0 + r * NGW; if (m < M) { const GAS f32x4* xr = (const GAS f32x4*)(x + (size_t)m * D) + lane;
#pragma unroll
              for (int j = 0; j < 4; ++j) v[r][j] = xr[64 * j]; } }
#pragma unroll
          for (int r = 0; r < 4; ++r) { const int m = m0 + r * NGW; if (m < M) { float s = 0.f;
#pragma unroll
              for (int j = 0; j < 4; ++j) s += (v[r][j].x * v[r][j].x + v[r][j].y * v[r][j].y) + (v[r][j].z * v[r][j].z + v[r][j].w * v[r][j].w);
              s = wave_sum(s);
              GAS unsigned long long* o8 = (GAS unsigned long long*)(XB + (size_t)m * D) + lane;
#pragma unroll
              for (int j = 0; j < 4; ++j) o8[64 * j] = (unsigned long long)pk2(v[r][j].x, v[r][j].y) | ((unsigned long long)pk2(v[r][j].z, v[r][j].w) << 32);
              if (lane < 16) part[(size_t)m * 16 + lane] = lane == 0 ? s : 0.f; } } } }
}
__device__ __forceinline__ void p4_lora_in(Frame& F) {
    const bf16* RKVL = (const bf16*)(F.ws + WS_RKVL); bf16* LA = (bf16*)(F.ws + WS_LA); const float* mu = F.in7 + 1536;
    const int gw = F.vcu * NWAVES + F.wave, NGW = F.G * NWAVES, lane = fresh_tid() & 63, c0 = 4 * lane;
    const bool act = c0 < 160; f32x4 mv = (f32x4){0.f, 0.f, 0.f, 0.f}; if (act) mv = *(const GAS f32x4*)(mu + c0);
    for (int m0 = gw; m0 < M; m0 += 4 * NGW) {
        v2u cu[4], pu[4];
#pragma unroll
        for (int rr = 0; rr < 4; ++rr) { const int m = m0 + rr * NGW; cu[rr] = (v2u){0u, 0u}; pu[rr] = (v2u){0u, 0u};
            if (act) { cu[rr] = *(const GAS v2u*)(RKVL + (size_t)m * 1792 + 1536 + c0); if ((m & (T - 1)) != 0) pu[rr] = *(const GAS v2u*)(RKVL + (size_t)(m - 1) * 1792 + 1536 + c0); } }
#pragma unroll
        for (int rr = 0; rr < 4; ++rr) { const int m = m0 + rr * NGW; float o[4] = {0.f, 0.f, 0.f, 0.f};
            if (act) { const float cur[4] = {bflo(cu[rr].x), bfhi(cu[rr].x), bflo(cu[rr].y), bfhi(cu[rr].y)}, prv[4] = {bflo(pu[rr].x), bfhi(pu[rr].x), bflo(pu[rr].y), bfhi(pu[rr].y)};
#pragma unroll
                for (int j = 0; j < 4; ++j) { const float p = cur[j] + (prv[j] - cur[j]) * mv[j]; const int c = c0 + j;
                    o[j] = c < 32 ? tanhf(p) : (c < 64 ? p : 1.0f / (1.0f + __expf(-p))); } }
            *(GAS v2u*)(LA + (size_t)m * 256 + c0) = (v2u){pk2(o[0], o[1]), pk2(o[2], o[3])}; }
    }
}
__device__ __forceinline__ float sum8(float v) { v += __shfl_xor(v, 1); v += __shfl_xor(v, 2); v += __shfl_xor(v, 4); return v; }
__device__ __forceinline__ void unpack8(const v4u u, float (&f)[8]) { f[0] = bflo(u.x); f[1] = bfhi(u.x); f[2] = bflo(u.y); f[3] = bfhi(u.y); f[4] = bflo(u.z); f[5] = bfhi(u.z); f[6] = bflo(u.w); f[7] = bfhi(u.w); }
__device__ __forceinline__ v4u pack8u(const float (&f)[8]) { return (v4u){pk2(f[0], f[1]), pk2(f[2], f[3]), pk2(f[4], f[5]), pk2(f[6], f[7])}; }
__device__ __forceinline__ void ld8f(const float* p, float (&f)[8]) { const f32x4 a = *(const GAS f32x4*)p, b = *(const GAS f32x4*)(p + 4); f[0] = a.x; f[1] = a.y; f[2] = a.z; f[3] = a.w; f[4] = b.x; f[5] = b.y; f[6] = b.z; f[7] = b.w; }
__device__ __forceinline__ void p6_prep(Frame& F) {
    const bf16* RKVL = (const bf16*)(F.ws + WS_RKVL); bf16* REC = (bf16*)(F.ws + WS_REC); f32x4* SC = (f32x4*)(F.ws + WS_SC);
    constexpr size_t SL = REC_SLOT / 2;
    const int gw = F.vcu * NWAVES + F.wave, NGW = F.G * NWAVES, lane = fresh_tid() & 63, h = lane >> 3, c0 = 8 * lane, n0 = 8 * (lane & 7);
    float mur[8], muk[8], muv[8], kkw[8], kaw[8], rkw[8];
    ld8f(F.in7 + c0, mur); ld8f(F.in7 + 512 + c0, muk); ld8f(F.in7 + 1024 + c0, muv); ld8f(F.in13 + c0, kkw); ld8f(F.in14 + c0, kaw); ld8f(F.in15 + c0, rkw);
    for (int m0 = gw; m0 < M; m0 += 2 * NGW) {
        v4u ur[2], uk[2], uv[2], pr_[2], pk_[2], pv_[2], ua[2];
#pragma unroll
        for (int rr = 0; rr < 2; ++rr) { const int m = m0 + rr * NGW, b = m >> 12, t = m & (T - 1); const bool hp = t != 0;
            const bf16* cr = RKVL + (size_t)m * 1792 + c0; const bf16* pr = cr - (hp ? 1792 : 0);
            const size_t ri = ((size_t)(b * 8 + h) * T + t) * 64 + n0;
            ur[rr] = *(const GAS v4u*)cr; uk[rr] = *(const GAS v4u*)(cr + 512); uv[rr] = *(const GAS v4u*)(cr + 1024);
            pr_[rr] = *(const GAS v4u*)pr; pk_[rr] = *(const GAS v4u*)(pr + 512); pv_[rr] = *(const GAS v4u*)(pr + 1024);
            ua[rr] = *(const GAS v4u*)(REC + 4 * SL + ri); }
#pragma unroll
        for (int rr = 0; rr < 2; ++rr) { const int m = m0 + rr * NGW, b = m >> 12, t = m & (T - 1); const bool hp = t != 0;
            const size_t ri = ((size_t)(b * 8 + h) * T + t) * 64 + n0;
            float r[8], k[8], v[8], rp[8], kp[8], vp[8], a[8];
            unpack8(ur[rr], r); unpack8(uk[rr], k); unpack8(uv[rr], v); unpack8(pr_[rr], rp); unpack8(pk_[rr], kp); unpack8(pv_[rr], vp); unpack8(ua[rr], a);
            float kk[8], ss = 0.f;
#pragma unroll
            for (int j = 0; j < 8; ++j) { const float rpj = hp ? rp[j] : 0.f, kpj = hp ? kp[j] : 0.f, vpj = hp ? vp[j] : 0.f;
                r[j] += (rpj - r[j]) * mur[j]; k[j] += (kpj - k[j]) * muk[j]; v[j] += (vpj - v[j]) * muv[j];
                kk[j] = k[j] * kkw[j]; ss += kk[j] * kk[j]; }
            const float inv = 1.0f / fmaxf(sqrtf(sum8(ss)), 1e-12f);
            float an[8], bn[8], kn[8];
#pragma unroll
            for (int j = 0; j < 8; ++j) { kk[j] *= inv; an[j] = -kk[j]; bn[j] = kk[j] * a[j]; kn[j] = k[j] * (1.0f + (a[j] - 1.0f) * kaw[j]); }
            const v4u oa = pack8u(an), orr = pack8u(r), ok = pack8u(kn), ob = pack8u(bn), ov = pack8u(v);
            float rq[8], kq[8], bq[8]; unpack8(orr, rq); unpack8(ok, kq); unpack8(ob, bq);
            float sb = 0.f, sk = 0.f, sbo = 0.f;
#pragma unroll
            for (int j = 0; j < 8; ++j) { sb += bq[j] * rq[j]; sk += kq[j] * rq[j]; sbo += rq[j] * kq[j] * rkw[j]; }
            sb = sum8(sb); sk = sum8(sk); sbo = sum8(sbo);
            *(GAS v4u*)(REC + 1 * SL + ri) = oa; *(GAS v4u*)(REC + 2 * SL + ri) = orr; *(GAS v4u*)(REC + 3 * SL + ri) = ok; *(GAS v4u*)(REC + 4 * SL + ri) = ob; *(GAS v4u*)(REC + 5 * SL + ri) = ov;
            if ((lane & 7) == 0) SC[(size_t)(b * 8 + h) * T + t] = (f32x4){sb, sk, sbo, 0.f}; }
    }
}
constexpr int KS_STRIDE = 144, VT_STRIDE = 528, ATT_KS_OFF = 0, ATT_VT_OFF = 256 * KS_STRIDE;
__device__ __forceinline__ void p6_attention(Frame& F) {
    bf16* ATTQ = (bf16*)(F.ws + WS_ATTQ); const bf16* ATTKV = (const bf16*)(F.ws + WS_ATTKV);
    const float* qn = F.in18; const float* kn = F.in19; const float* sinks = F.in20;
    LAS unsigned char* Ks = F.lds + ATT_KS_OFF; LAS unsigned char* Vt = F.lds + ATT_VT_OFF;
    const int tid = fresh_tid(), lane = tid & 63, w = F.wave, g = lane >> 4, n16 = lane & 15;
    for (int unit = F.vcu; unit < BATCH * 2 * 32; unit += F.G) {
        const int nb = unit & 31, kvh = (unit >> 5) & 1, b = unit >> 6; const int m0 = b * T + nb * 128;
#pragma unroll
        for (int i = 0; i < 4; ++i) { const int e = tid + 512 * i, key = e >> 3, dg = e & 7; const bool valid = nb > 0 || key >= 128;
            v4u ku = (v4u){0u, 0u, 0u, 0u}, vu = (v4u){0u, 0u, 0u, 0u};
            if (valid) { const bf16* src = ATTKV + (size_t)(m0 - 128 + key) * 256 + kvh * 64 + dg * 8; ku = *(const GAS v4u*)src; vu = *(const GAS v4u*)(src + 128); }
            float kf[8] = {bflo(ku.x), bfhi(ku.x), bflo(ku.y), bfhi(ku.y), bflo(ku.z), bfhi(ku.z), bflo(ku.w), bfhi(ku.w)};
            float ss = 0.f;
#pragma unroll
            for (int j = 0; j < 8; ++j) ss += kf[j] * kf[j];
            ss += __shfl_xor(ss, 1); ss += __shfl_xor(ss, 2); ss += __shfl_xor(ss, 4);
            const float rs = 1.0f / sqrtf(ss * (1.0f / 64.0f) + RMS_EPS);
#pragma unroll
            for (int j = 0; j < 8; ++j) kf[j] *= rs * kn[dg * 8 + j];
            *(LAS v4u*)(Ks + key * KS_STRIDE + dg * 16) = (v4u){pk2(kf[0], kf[1]), pk2(kf[2], kf[3]), pk2(kf[4], kf[5]), pk2(kf[6], kf[7])};
            const unsigned vv[4] = {vu.x, vu.y, vu.z, vu.w};
#pragma unroll
            for (int j = 0; j < 8; ++j) *(LAS bf16*)(Vt + (dg * 8 + j) * VT_STRIDE + key * 2) = (bf16)((vv[j >> 1] >> ((j & 1) * 16)) & 0xffffu);
        }
        __syncthreads();
        const int hq = kvh * 4 + (w >> 1), qbase = (w & 1) * 64; const float sink = sinks[hq];
        float qg[16];
#pragma unroll
        for (int j = 0; j < 16; ++j) qg[j] = qn[(j >> 3) * 32 + 8 * g + (j & 7)];
        bf16* qrow = ATTQ + (size_t)(m0 + qbase + n16) * 512 + hq * 64 + 8 * g;
        v4u qa_n = *(const GAS v4u*)qrow, qb_n = *(const GAS v4u*)(qrow + 32);
        for (int qt = 0; qt < 4; ++qt) {
            const int q0 = qbase + 16 * qt, qi = q0 + n16, kt0 = q0 >> 4;
            const v4u qa = qa_n, qb = qb_n;
            if (qt < 3) { const bf16* qp = qrow + (size_t)(qt + 1) * 16 * 512; qa_n = *(const GAS v4u*)qp; qb_n = *(const GAS v4u*)(qp + 32); }
            bf16x8 ka[10][2];
#pragma unroll
            for (int i = 0; i < 10; ++i) { const int kt = kt0 + i, ktc = kt < 16 ? kt : 15; const LAS unsigned char* kp = Ks + (16 * ktc + n16) * KS_STRIDE + 16 * g;
                ka[i][0] = *(const LAS bf16x8*)kp; ka[i][1] = *(const LAS bf16x8*)(kp + 64); }
            float q[16] = {bflo(qa.x), bfhi(qa.x), bflo(qa.y), bfhi(qa.y), bflo(qa.z), bfhi(qa.z), bflo(qa.w), bfhi(qa.w),
                           bflo(qb.x), bfhi(qb.x), bflo(qb.y), bfhi(qb.y), bflo(qb.z), bfhi(qb.z), bflo(qb.w), bfhi(qb.w)};
            float ss = 0.f;
#pragma unroll
            for (int j = 0; j < 16; ++j) ss += q[j] * q[j];
            ss += __shfl_xor(ss, 16); ss += __shfl_xor(ss, 32);
            const float rs = 0.125f / sqrtf(ss * (1.0f / 64.0f) + RMS_EPS);
#pragma unroll
            for (int j = 0; j < 16; ++j) q[j] *= rs * qg[j];
            const v4u qf0 = (v4u){pk2(q[0], q[1]), pk2(q[2], q[3]), pk2(q[4], q[5]), pk2(q[6], q[7])}, qf1 = (v4u){pk2(q[8], q[9]), pk2(q[10], q[11]), pk2(q[12], q[13]), pk2(q[14], q[15])};
            const bf16x8 bq0 = __builtin_bit_cast(bf16x8, qf0), bq1 = __builtin_bit_cast(bf16x8, qf1);
            __builtin_amdgcn_sched_barrier(0);
            f32x4 st[10];
#pragma unroll
            for (int i = 0; i < 10; ++i) { f32x4 acc = (f32x4){0.f, 0.f, 0.f, 0.f};
                acc = __builtin_amdgcn_mfma_f32_16x16x32_bf16(ka[i][0], bq0, acc, 0, 0, 0);
                st[i] = __builtin_amdgcn_mfma_f32_16x16x32_bf16(ka[i][1], bq1, acc, 0, 0, 0); }
            v2u vf[5][4][2];
#pragma unroll
            for (int j = 0; j < 5; ++j) { const int ka_ = kt0 + 2 * j, kb_ = ka_ + 1, kac = ka_ < 16 ? ka_ : 15, kbc = kb_ < 16 ? kb_ : 15;
#pragma unroll
                for (int dt = 0; dt < 4; ++dt) { const LAS unsigned char* vp = Vt + (16 * dt + n16) * VT_STRIDE;
                    vf[j][dt][0] = *(const LAS v2u*)(vp + (16 * kac + 4 * g) * 2); vf[j][dt][1] = *(const LAS v2u*)(vp + (16 * kbc + 4 * g) * 2); } }
            float mx = -INFINITY;
#pragma unroll
            for (int i = 0; i < 10; ++i)
#pragma unroll
                for (int r = 0; r < 4; ++r) { const int kj = 16 * (kt0 + i) + 4 * g + r; const bool ok = (kj > qi) && (kj <= qi + 128) && (nb > 0 || kj >= 128);
                    st[i][r] = ok ? st[i][r] : -INFINITY; mx = fmaxf(mx, st[i][r]); }
            mx = fmaxf(mx, __shfl_xor(mx, 16)); mx = fmaxf(mx, __shfl_xor(mx, 32)); mx = fmaxf(mx, sink);
            float den = 0.f;
#pragma unroll
            for (int i = 0; i < 10; ++i)
#pragma unroll
                for (int r = 0; r < 4; ++r) { const float p = __expf(st[i][r] - mx); st[i][r] = p; den += p; }
            den += __shfl_xor(den, 16); den += __shfl_xor(den, 32); den += __expf(sink - mx);
            const float inv = 1.0f / den;
            f32x4 o[4];
#pragma unroll
            for (int dt = 0; dt < 4; ++dt) o[dt] = (f32x4){0.f, 0.f, 0.f, 0.f};
#pragma unroll
            for (int j = 0; j < 5; ++j) {
                const v4u pu = (v4u){pk2(st[2 * j][0], st[2 * j][1]), pk2(st[2 * j][2], st[2 * j][3]), pk2(st[2 * j + 1][0], st[2 * j + 1][1]), pk2(st[2 * j + 1][2], st[2 * j + 1][3])};
                const bf16x8 pf = __builtin_bit_cast(bf16x8, pu);
#pragma unroll
                for (int dt = 0; dt < 4; ++dt) { const bf16x8 af = __builtin_bit_cast(bf16x8, (v4u){vf[j][dt][0].x, vf[j][dt][0].y, vf[j][dt][1].x, vf[j][dt][1].y});
                    o[dt] = __builtin_amdgcn_mfma_f32_16x16x32_bf16(af, pf, o[dt], 0, 0, 0); } }
            bf16* op = ATTQ + (size_t)(m0 + qi) * 512 + hq * 64 + 4 * g;
#pragma unroll
            for (int dt = 0; dt < 4; ++dt) *(GAS v2u*)(op + 16 * dt) = (v2u){pk2(o[dt][0] * inv, o[dt][1] * inv), pk2(o[dt][2] * inv, o[dt][3] * inv)};
        }
        __syncthreads();
    }
}
constexpr int SC_NS = 32, SC_NP = 16, SC_ARR = 4096, SC_SCL = 9 * SC_ARR, SC_VS = SC_SCL + 512, SC_YB = SC_VS + 4096, SC_BUF = SC_YB + 2048;
struct ScanPre { v2u lw1, a1, r1, k1, b1, lw2, a2, r2, k2, b2; unsigned short v1, v2; f32x4 sc1, sc2; };
__device__ __forceinline__ ScanPre scan_issue(Frame& F, int bh, int quarter, int t0, int lt) {
    const unsigned char* REC = F.ws + WS_REC; const f32x4* SC = (const f32x4*)(F.ws + WS_SC);
    const int pr = lt >> 4, q = lt & 15; const size_t st = (size_t)bh * T + t0 + 2 * pr;
    const size_t e1 = st * 128 + (size_t)q * 8, e2 = e1 + 128;
    ScanPre p;
    p.lw1 = *(const GAS v2u*)(REC + 0 * REC_SLOT + e1); p.a1 = *(const GAS v2u*)(REC + 1 * REC_SLOT + e1); p.r1 = *(const GAS v2u*)(REC + 2 * REC_SLOT + e1); p.k1 = *(const GAS v2u*)(REC + 3 * REC_SLOT + e1); p.b1 = *(const GAS v2u*)(REC + 4 * REC_SLOT + e1);
    p.lw2 = *(const GAS v2u*)(REC + 0 * REC_SLOT + e2); p.a2 = *(const GAS v2u*)(REC + 1 * REC_SLOT + e2); p.r2 = *(const GAS v2u*)(REC + 2 * REC_SLOT + e2); p.k2 = *(const GAS v2u*)(REC + 3 * REC_SLOT + e2); p.b2 = *(const GAS v2u*)(REC + 4 * REC_SLOT + e2);
    const bf16* RV = (const bf16*)(REC + 5 * REC_SLOT) + st * 64 + 16 * quarter + q;
    p.v1 = RV[0]; p.v2 = RV[64];
    p.sc1 = *(const GAS f32x4*)(SC + st); p.sc2 = *(const GAS f32x4*)(SC + st + 1);
    return p;
}
__device__ __forceinline__ void un4(const v2u u, float (&f)[4]) { f[0] = bflo(u.x); f[1] = bfhi(u.x); f[2] = bflo(u.y); f[3] = bfhi(u.y); }
__device__ __forceinline__ void scan_commit(const ScanPre& p, LAS unsigned char* buf, int lt) {
    const int pr = lt >> 4, q = lt & 15, idx = pr * 16 + q;
    float lw1[4], a1[4], r1[4], k1[4], b1[4], lw2[4], a2[4], r2[4], k2[4], b2[4];
    un4(p.lw1, lw1); un4(p.a1, a1); un4(p.r1, r1); un4(p.k1, k1); un4(p.b1, b1); un4(p.lw2, lw2); un4(p.a2, a2); un4(p.r2, r2); un4(p.k2, k2); un4(p.b2, b2);
    float w1[4], w2[4], z1[4], wa2[4], wz2[4], ww[4], bw[4], kw[4];
    float ba = 0.f, ka = 0.f, bz = 0.f, kz = 0.f;
#pragma unroll
    for (int j = 0; j < 4; ++j) { w1[j] = __expf(lw1[j]); w2[j] = __expf(lw2[j]); z1[j] = w1[j] * r1[j]; const float z2 = w2[j] * r2[j];
        wa2[j] = w1[j] * a2[j]; wz2[j] = w1[j] * z2; ww[j] = w1[j] * w2[j]; bw[j] = b1[j] * w2[j]; kw[j] = k1[j] * w2[j];
        ba += b1[j] * a2[j]; ka += k1[j] * a2[j]; bz += b1[j] * z2; kz += k1[j] * z2; }
    ba = row16_sum(ba); ka = row16_sum(ka); bz = row16_sum(bz); kz = row16_sum(kz);
    LAS f32x4* A = (LAS f32x4*)buf;
    A[0 * 256 + idx] = (f32x4){a1[0], z1[0], a1[1], z1[1]}; A[1 * 256 + idx] = (f32x4){a1[2], z1[2], a1[3], z1[3]};
    A[2 * 256 + idx] = (f32x4){wa2[0], wz2[0], wa2[1], wz2[1]}; A[3 * 256 + idx] = (f32x4){wa2[2], wz2[2], wa2[3], wz2[3]};
    A[4 * 256 + idx] = (f32x4){ww[0], ww[1], ww[2], ww[3]}; A[5 * 256 + idx] = (f32x4){bw[0], bw[1], bw[2], bw[3]}; A[6 * 256 + idx] = (f32x4){kw[0], kw[1], kw[2], kw[3]};
    A[7 * 256 + idx] = (f32x4){b2[0], b2[1], b2[2], b2[3]}; A[8 * 256 + idx] = (f32x4){k2[0], k2[1], k2[2], k2[3]};
    if (q == 0) { LAS f32x4* S4 = (LAS f32x4*)(buf + SC_SCL); S4[pr * 2] = (f32x4){ba, ka, bz, kz}; S4[pr * 2 + 1] = (f32x4){p.sc1.x, p.sc2.x, 0.f, 0.f}; }
    const float v1 = bf1(p.v1), v2 = bf1(p.v2);
    ((LAS f32x4*)(buf + SC_VS))[idx] = (f32x4){v1, v2, v1 * p.sc1.y, v2 * p.sc2.y};
}
__device__ __forceinline__ void scan_flush(Frame& F, int bh, int quarter, int t0, const LAS unsigned char* buf, int lt) {
    if (lt < 128) { const int s = lt >> 2, c4 = lt & 3; const int b = bh >> 3, h = bh & 7;
        float* yraw = (float*)(F.ws + WS_YRAW);
        const LAS float* yb = (const LAS float*)(buf + SC_YB) + ((s >> 1) * 16 + 4 * c4) * 2 + (s & 1);
        const f32x4 y = (f32x4){yb[0], yb[2], yb[4], yb[6]};
        *(GAS f32x4*)(yraw + (size_t)(b * T + t0 + s) * 512 + h * 64 + 16 * quarter + 4 * c4) = y; }
}
__device__ __forceinline__ void p7_scan(Frame& F) {
    const int w = F.wave, tid = fresh_tid(), lane = tid & 63, rl = lane >> 4, q = lane & 15, lt = tid - 256;
    constexpr int NBLK = T / SC_NS;
#define SCAN_BAR() do { asm volatile("s_waitcnt lgkmcnt(0)" ::: "memory"); __builtin_amdgcn_s_barrier(); asm volatile("" ::: "memory"); } while (0)
    for (int unit = F.vcu; unit < 256; unit += F.G) {
        const int bh = unit >> 2, quarter = unit & 3;
        ScanPre pre;
        if (w >= 4) { pre = scan_issue(F, bh, quarter, 0, lt); scan_commit(pre, F.lds, lt); pre = scan_issue(F, bh, quarter, SC_NS, lt); }
        SCAN_BAR();
        float S0 = 0.f, S1 = 0.f, S2 = 0.f, S3 = 0.f;
        for (int nb = 0; nb < NBLK; ++nb) {
            LAS unsigned char* cur = F.lds + (nb & 1) * SC_BUF; LAS unsigned char* oth = F.lds + ((nb + 1) & 1) * SC_BUF;
            if (w >= 4) {
                if (nb > 0) scan_flush(F, bh, quarter, (nb - 1) * SC_NS, oth, lt);
                if (nb + 1 < NBLK) scan_commit(pre, oth, lt);
                if (nb + 2 < NBLK) pre = scan_issue(F, bh, quarter, (nb + 2) * SC_NS, lt);
            } else {
                const LAS f32x4* A = (const LAS f32x4*)cur + q; const LAS f32x4* SCL = (const LAS f32x4*)(cur + SC_SCL);
                const int rowl = 4 * w + rl; const LAS f32x4* VS = (const LAS f32x4*)(cur + SC_VS) + rowl; LAS f32x2* YB = (LAS f32x2*)(cur + SC_YB) + rowl;
                f32x4 az1a = A[0], az1b = A[256], az2a = A[512], az2b = A[768], ww = A[1024], b1 = A[1280], k1 = A[1536], b2 = A[1792], k2 = A[2048], c0 = SCL[0], vs = VS[0]; f32x2 c1 = *(const LAS f32x2*)(SCL + 1);
#pragma unroll 4
                for (int pr = 0; pr < SC_NP; ++pr) {
                    const int pn = (pr + 1) * 16;
                    const f32x4 n_az1a = A[pn], n_az1b = A[256 + pn], n_az2a = A[512 + pn], n_az2b = A[768 + pn], n_ww = A[1024 + pn], n_b1 = A[1280 + pn], n_k1 = A[1536 + pn], n_b2 = A[1792 + pn], n_k2 = A[2048 + pn],
                                n_c0 = SCL[2 * pr + 2], n_vs = VS[pn]; const f32x2 n_c1 = *(const LAS f32x2*)(SCL + 2 * pr + 3);
                    __builtin_amdgcn_sched_barrier(0);
                    float sa1 = S0 * az1a.x; sa1 = fmaf(S1, az1a.z, sa1); sa1 = fmaf(S2, az1b.x, sa1); sa1 = fmaf(S3, az1b.z, sa1);
                    float z1 = S0 * az1a.y; z1 = fmaf(S1, az1a.w, z1); z1 = fmaf(S2, az1b.y, z1); z1 = fmaf(S3, az1b.w, z1);
                    float p2 = S0 * az2a.x; p2 = fmaf(S1, az2a.z, p2); p2 = fmaf(S2, az2b.x, p2); p2 = fmaf(S3, az2b.z, p2);
                    float q2 = S0 * az2a.y; q2 = fmaf(S1, az2a.w, q2); q2 = fmaf(S2, az2b.y, q2); q2 = fmaf(S3, az2b.w, q2);
                    float t0_ = fmaf(vs.x, k1.x, S0 * ww.x), t1_ = fmaf(vs.x, k1.y, S1 * ww.y), t2_ = fmaf(vs.x, k1.z, S2 * ww.z), t3_ = fmaf(vs.x, k1.w, S3 * ww.w);
                    t0_ = fmaf(vs.y, k2.x, t0_); t1_ = fmaf(vs.y, k2.y, t1_); t2_ = fmaf(vs.y, k2.z, t2_); t3_ = fmaf(vs.y, k2.w, t3_);
                    sa1 = row16_sum(sa1); z1 = row16_sum(z1); p2 = row16_sum(p2); q2 = row16_sum(q2);
                    const float sa2 = fmaf(sa1, c0.x, fmaf(vs.x, c0.y, p2)), z2 = fmaf(sa1, c0.z, fmaf(vs.x, c0.w, q2));
                    S0 = fmaf(sa2, b2.x, fmaf(sa1, b1.x, t0_)); S1 = fmaf(sa2, b2.y, fmaf(sa1, b1.y, t1_)); S2 = fmaf(sa2, b2.z, fmaf(sa1, b1.z, t2_)); S3 = fmaf(sa2, b2.w, fmaf(sa1, b1.w, t3_));
                    YB[pr * 16] = (f32x2){fmaf(sa1, c1.x, z1) + vs.z, fmaf(sa2, c1.y, z2) + vs.w};
                    az1a = n_az1a; az1b = n_az1b; az2a = n_az2a; az2b = n_az2b; ww = n_ww; b1 = n_b1; k1 = n_k1; b2 = n_b2; k2 = n_k2; c0 = n_c0; c1 = n_c1; vs = n_vs;
                }
            }
            SCAN_BAR();
        }
        if (w >= 4) scan_flush(F, bh, quarter, T - SC_NS, F.lds + ((NBLK - 1) & 1) * SC_BUF, lt);
        asm volatile("s_waitcnt vmcnt(0)" ::: "memory"); SCAN_BAR();
    }
#undef SCAN_BAR
}
__device__ __forceinline__ void p8_post(Frame& F) {
    const float* yraw = (const float*)(F.ws + WS_YRAW); const bf16* RV = (const bf16*)(F.ws + WS_REC + 5 * REC_SLOT); const f32x4* SC = (const f32x4*)(F.ws + WS_SC);
    const bf16* Gt = (const bf16*)(F.ws + WS_G); bf16* YR = (bf16*)(F.ws + WS_YR);
    const int gw = F.vcu * NWAVES + F.wave, NGW = F.G * NWAVES, lane = fresh_tid() & 63, h = lane >> 3, c0 = 8 * lane, n0 = 8 * (lane & 7);
    float lw[8], lb[8]; ld8f(F.in16 + c0, lw); ld8f(F.in17 + c0, lb);
    for (int m0 = gw; m0 < M; m0 += 2 * NGW) {
        float yv[2][8]; v4u uvv[2], ugg[2]; f32x4 scv[2];
#pragma unroll
        for (int rr = 0; rr < 2; ++rr) { const int m = m0 + rr * NGW, b = m >> 12, t = m & (T - 1); const size_t rt = (size_t)(b * 8 + h) * T + t;
            ld8f(yraw + (size_t)m * 512 + c0, yv[rr]); uvv[rr] = *(const GAS v4u*)(RV + rt * 64 + n0); ugg[rr] = *(const GAS v4u*)(Gt + (size_t)m * 512 + c0); scv[rr] = *(const GAS f32x4*)(SC + rt); }
#pragma unroll
        for (int rr = 0; rr < 2; ++rr) { const int m = m0 + rr * NGW; const float bonus = scv[rr].z;
            float v[8], g[8]; unpack8(uvv[rr], v); unpack8(ugg[rr], g);
            float s1 = 0.f;
#pragma unroll
            for (int j = 0; j < 8; ++j) s1 += yv[rr][j];
            const float mean = sum8(s1) * (1.0f / 64.0f); float s2 = 0.f;
#pragma unroll
            for (int j = 0; j < 8; ++j) { yv[rr][j] -= mean; s2 += yv[rr][j] * yv[rr][j]; }
            const float rstd = 1.0f / sqrtf(sum8(s2) * (1.0f / 64.0f) + GN_EPS);
            float o[8];
#pragma unroll
            for (int j = 0; j < 8; ++j) o[j] = (yv[rr][j] * rstd * lw[j] + lb[j] + bonus * v[j]) * g[j];
            *(GAS v4u*)(YR + (size_t)m * 512 + c0) = pack8u(o); }
    }
}
__device__ __forceinline__ void p13_final(Frame& F) {
    const float* part = (const float*)(F.ws + WS_PART + 3 * 2 * MiB); const float* gn = F.in28;
    const int gw = F.vcu * NWAVES + F.wave, NGW = F.G * NWAVES, lane = fresh_tid() & 63;
    f32x4 g4[4];
#pragma unroll
    for (int j = 0; j < 4; ++j) g4[j] = ((const GAS f32x4*)gn)[lane + 64 * j];
    for (int m0 = gw; m0 < M; m0 += 4 * NGW) { f32x4 v[4][4]; float ps[4];
#pragma unroll
        for (int r = 0; r < 4; ++r) { const int m = m0 + r * NGW; ps[r] = 0.f; if (m < M) { GAS f32x4* xr = (GAS f32x4*)(F.out + (size_t)m * D) + lane; ps[r] = lane < 16 ? part[(size_t)m * 16 + lane] : 0.f;
#pragma unroll
            for (int j = 0; j < 4; ++j) v[r][j] = xr[64 * j]; } }
#pragma unroll
        for (int r = 0; r < 4; ++r) { const int m = m0 + r * NGW; if (m < M) { const float rs = 1.0f / sqrtf(wave_sum(ps[r]) * (1.0f / 1024.0f) + RMS_EPS);
            GAS f32x4* xr = (GAS f32x4*)(F.out + (size_t)m * D) + lane;
#pragma unroll
            for (int j = 0; j < 4; ++j) xr[64 * j] = v[r][j] * rs * g4[j]; } }
    }
}
struct Args { const float* in[29]; float* out; unsigned char* ws; };
__global__ void __launch_bounds__(NWAVES * 64, 2) fwd_megakernel(Args args) {
    extern __shared__ __attribute__((aligned(16))) unsigned char lds[];
    cg::grid_group grid = cg::this_grid();
    Frame F;
    F.lds = (LAS unsigned char*)lds;
    F.tid = threadIdx.x; F.lane = F.tid & 63; F.wave = __builtin_amdgcn_readfirstlane(F.tid >> 6);
    F.G = gridDim.x; { const int bx = blockIdx.x; F.vcu = (F.G % 8 == 0) ? (bx % 8) * (F.G / 8) + bx / 8 : bx; }
F.in0 = args.in[0]; F.in1 = args.in[1]; F.in2 = args.in[2]; F.in3 = args.in[3]; F.in4 = args.in[4]; F.in5 = args.in[5]; F.in6 = args.in[6]; F.in7 = args.in[7]; F.in8 = args.in[8]; F.in9 = args.in[9]; F.in10 = args.in[10]; F.in11 = args.in[11]; F.in12 = args.in[12]; F.in13 = args.in[13]; F.in14 = args.in[14]; F.in15 = args.in[15]; F.in16 = args.in[16]; F.in17 = args.in[17]; F.in18 = args.in[18]; F.in19 = args.in[19]; F.in20 = args.in[20]; F.in21 = args.in[21]; F.in22 = args.in[22]; F.in23 = args.in[23]; F.in24 = args.in[24]; F.in25 = args.in[25]; F.in26 = args.in[26]; F.in27 = args.in[27]; F.in28 = args.in[28];
    F.out = args.out; F.ws = args.ws;
    unsigned char* ws = args.ws;
    bf16* XB = (bf16*)(ws + WS_XB); bf16* HB = (bf16*)(ws + WS_H);
    float* PA = (float*)(ws + WS_PART); float* PB = PA + (size_t)M * 16; float* PC = PB + (size_t)M * 16; float* PD = PC + (size_t)M * 16;
    using pg8::gemm_phase; using pg8::StaticOrder; using pg8::Gemm;
    volatile LAS unsigned* bst = (volatile LAS unsigned*)(F.lds + RING_BYTES);
    if (F.tid == 0) { bst[0] = 0u; bst[1] = 0u; }
    __syncthreads();
    XcdBarrier bar = xcd_barrier_post((unsigned*)ws, bst);
#define SYNC() xcd_barrier(bar)
#define RUN_GEMM(EPI, Aptr, Bptr, NN, KK, ...) do { Gemm g_{(const pg8::bf16_t*)(Aptr), (const pg8::bf16_t*)(Bptr), M, (NN), (KK)}; StaticOrder S_; S_.init(M, (NN), F.G, (int)blockIdx.x); \
        pg8::EPI E_{__VA_ARGS__}; gemm_phase<pg8::EPI, StaticOrder, true, true>(F.lds, g_, S_, E_); } while (0)

    p0_prologue(F); grid.sync();
    { const pg8::RsTab tb = fill_rstd(F, PA, 2 * FF); RUN_GEMM(EpiGU, XB, ws + WS_WGU1, 2 * FF, D, tb, F.lds, HB, PA); } SYNC();
    RUN_GEMM(EpiRes, HB, ws + WS_WDN1, D, FF, F.in0, F.out, XB, PB, 0.5f); SYNC();
    { const pg8::RsTab tb = fill_rstd(F, PB, 2560); RUN_GEMM(EpiProj, XB, ws + WS_WIN, 2560, D, tb, F.lds, (bf16*)(ws + WS_RKVL), (bf16*)(ws + WS_ATTQ), (bf16*)(ws + WS_ATTKV), PB); } SYNC();
    p4_lora_in(F); SYNC();
    RUN_GEMM(EpiLora, ws + WS_LA, ws + WS_WLO, 1536, 256, (bf16*)(ws + WS_REC), (bf16*)(ws + WS_REC + 4 * REC_SLOT), (bf16*)(ws + WS_G), F.in8, F.in10); SYNC();
    p6_prep(F); p6_attention(F); SYNC();
    p7_scan(F); SYNC();
    p8_post(F); SYNC();
    { const pg8::RsTab tb = fill_rstd(F, PB, 2048); RUN_GEMM(EpiGate, XB, ws + WS_WGT, 2048, D, tb, F.lds, (bf16*)(ws + WS_GATES), PB); } SYNC();
    RUN_GEMM(EpiBranch, ws + WS_YR, ws + WS_WBR, D, 512, (const bf16*)(ws + WS_GATES), (bf16*)(ws + WS_MERGED), 0, 0);
    RUN_GEMM(EpiBranch, ws + WS_ATTQ, ws + WS_WBA, D, 512, (const bf16*)(ws + WS_GATES), (bf16*)(ws + WS_MERGED), 1024, 1); SYNC();
    RUN_GEMM(EpiRes, ws + WS_MERGED, ws + WS_WOUT, D, D, F.out, F.out, XB, PC, 1.0f); SYNC();
    { const pg8::RsTab tb = fill_rstd(F, PC, 2 * FF); RUN_GEMM(EpiGU, XB, ws + WS_WGU2, 2 * FF, D, tb, F.lds, HB, PC); } SYNC();
    RUN_GEMM(EpiRes, HB, ws + WS_WDN2, D, FF, F.out, F.out, (bf16*)nullptr, PD, 0.5f); SYNC();
    p13_final(F);
}

extern "C" void kernel_launch(void* const* d_in, const int* in_sizes, int n_in, void* d_out, int out_size, void* d_ws, size_t ws_size, hipStream_t stream) {
    static int grid = 0;
    if (grid == 0) {
        if (n_in != 29 || in_sizes[0] != M * D || out_size != M * D || ws_size < WS_END) { fprintf(stderr, "kernel_launch: unexpected shapes (n_in %d, ws %zu)\n", n_in, ws_size); grid = -1; return; }
        int dev = 0, cus = 0, per_cu = 0;
        hipGetDevice(&dev); hipDeviceGetAttribute(&cus, hipDeviceAttributeMultiprocessorCount, dev);
        if (hipFuncSetAttribute((const void*)fwd_megakernel, hipFuncAttributeMaxDynamicSharedMemorySize, LDS_BYTES) != hipSuccess) { fprintf(stderr, "kernel_launch: hipFuncSetAttribute failed\n"); grid = -1; return; }
        hipOccupancyMaxActiveBlocksPerMultiprocessor(&per_cu, (const void*)fwd_megakernel, NWAVES * 64, LDS_BYTES);
        (void)hipGetLastError();
        if (per_cu < 1) fprintf(stderr, "kernel_launch: occupancy query says %d blocks/CU\n", per_cu);
        grid = cus;
    }
    if (grid < 0) return;
    if (hipMemsetAsync(d_ws, 0, 16384, stream) != hipSuccess) { fprintf(stderr, "kernel_launch: memset failed\n"); return; }
    Args a{};
    for (int i = 0; i < 29; ++i) a.in[i] = (const float*)d_in[i];
    a.out = (float*)d_out; a.ws = (unsigned char*)d_ws;
    void* kargs[] = {&a};
    hipError_t e = hipLaunchCooperativeKernel((const void*)fwd_megakernel, dim3(grid), dim3(NWAVES * 64), kargs, LDS_BYTES, stream);
    if (e != hipSuccess) fprintf(stderr, "kernel_launch: cooperative launch failed: %s (grid %d)\n", hipGetErrorString(e), grid);
}
```

```cpp
#include <hip/hip_runtime.h>
#include <hip/hip_cooperative_groups.h>
#include <cstdio>
#include <cstdint>
namespace cg = cooperative_groups;
namespace pg8 {
#define PG8_LAS __attribute__((address_space(3)))
typedef unsigned short bf16_t;
typedef short bf16x8 __attribute__((ext_vector_type(8)));
typedef float f32x4 __attribute__((ext_vector_type(4)));
typedef unsigned u32x4 __attribute__((ext_vector_type(4)));
constexpr int BM = 256, BK = 64, HALF = 128, HTB = HALF * BK * 2  , STAGE_BYTES = 8 * HTB, NXCD = 8, WGM = 8;

__host__ __device__ __forceinline__ int lds_byte(int r, int c) { const int st = (r >> 4) * 2 + (c >> 5), rr = r & 15, cc = c & 31, ob = rr * 64 + cc * 2; return st * 1024 + (ob ^ (((ob >> 9) & 1) << 5)); }
__host__ __device__ __forceinline__ void stage_rc(int b, int& R, int& C) { const int st = b / 1024, sb = b % 1024, swz = sb ^ (((sb >> 9) & 1) << 5); R = (st >> 1) * 16 + swz / 64; C = (st & 1) * 32 + (swz % 64) / 2; }
__host__ __device__ __forceinline__ int perm32(int rho) { const int n = rho >> 4, i = rho & 15; return 8 * (i >> 2) + 4 * n + (i & 3); }

struct Unit { int pm, pn; };
struct Gemm { const bf16_t* A; const bf16_t* Bt; int M, N, K; };

struct StaticOrder {
    int nM, nN, nwg, G, c;
    __host__ __device__ void init(int M, int N, int G_, int c_) { nM = M / BM; nN = N / BM; nwg = nM * nN; G = G_; c = c_; }
    __host__ __device__ bool next(int i, Unit& u) const {
        const long L = (long)i * G + c; if (L >= nwg) return false;
        int wgid = (int)L; { const int q = nwg / NXCD, r = nwg % NXCD, xcd = wgid % NXCD, off = wgid / NXCD; wgid = (xcd < r ? xcd * (q + 1) : r * (q + 1) + (xcd - r) * q) + off; }
        const int nig = WGM * nN, gid = wgid / nig, fm = gid * WGM, gsz = (nM - fm) < WGM ? (nM - fm) : WGM;
        u.pm = fm + ((wgid % nig) % gsz); u.pn = (wgid % nig) / gsz; return true;
    }
    __device__ __forceinline__ void a_ready(const Unit&) const {}
    __device__ __forceinline__ void done(const Unit&) const {}
};

__device__ __forceinline__ unsigned cvt_pk_bf16(float lo, float hi) { unsigned r; asm volatile("v_cvt_pk_bf16_f32 %0, %1, %2" : "=v"(r) : "v"(lo), "v"(hi)); return r; }
__device__ __forceinline__ u32x4 pack8(f32x4 v0, f32x4 v1) {
    u32x4 w;
    asm volatile("s_nop 1\n\tv_cvt_pk_bf16_f32 %0, %4, %5\n\tv_cvt_pk_bf16_f32 %1, %6, %7\n\tv_cvt_pk_bf16_f32 %2, %8, %9\n\tv_cvt_pk_bf16_f32 %3, %10, %11"
                 : "=&v"(w.x), "=&v"(w.y), "=&v"(w.z), "=&v"(w.w)
                 : "v"(v0[0]), "v"(v0[1]), "v"(v0[2]), "v"(v0[3]), "v"(v1[0]), "v"(v1[1]), "v"(v1[2]), "v"(v1[3]));
    return w;
}
__device__ __forceinline__ float bf_lo(unsigned u) { return __uint_as_float(u << 16); }
__device__ __forceinline__ float bf_hi(unsigned u) { return __uint_as_float(u & 0xffff0000u); }
constexpr int RS_TAB_OFF = 131072 + 64;
struct RsTab { int pm[4]; };
__device__ __forceinline__ void rows_rstd(const RsTab& tb, PG8_LAS unsigned char* lds, const Unit& u, int wr, int fr, float (&rs)[2][4]) {
    const int slot = u.pm == tb.pm[0] ? 0 : (u.pm == tb.pm[1] ? 1 : (u.pm == tb.pm[2] ? 2 : 3));
    const PG8_LAS float* t = (const PG8_LAS float*)(lds + RS_TAB_OFF) + slot * 256 + wr * 64 + fr;
#pragma unroll
    for (int ai = 0; ai < 2; ++ai)
#pragma unroll
        for (int m = 0; m < 4; ++m) rs[ai][m] = t[ai * HALF + m * 16];
}
__device__ __forceinline__ float fexp_(float x) { return __builtin_amdgcn_exp2f(x * 1.44269504089f); }
__device__ __forceinline__ float sigmoidf_(float x) { return __builtin_amdgcn_rcpf(1.0f + fexp_(-x)); }

struct EpiGU {
    static constexpr bool PERM = true, AFTER_DRAIN = false;
    RsTab tb; PG8_LAS unsigned char* lds;
    bf16_t* H; const float* part;
    __device__ __forceinline__ void operator()(const f32x4 (&acc)[2][2][4][2], const Unit& u, int wr, int wc, int fr, int fq) const {
        const int row0 = u.pm * BM + wr * 64 + fr, col0 = u.pn * 128 + wc * 32 + 8 * fq;
        float rsv[2][4]; rows_rstd(tb, lds, u, wr, fr, rsv);
#pragma unroll
        for (int ai = 0; ai < 2; ++ai)
#pragma unroll
            for (int m = 0; m < 4; ++m) { const int row = row0 + ai * HALF + m * 16; const float rs = rsv[ai][m];
                f32x4 h0, h1;
#pragma unroll
                for (int j = 0; j < 4; ++j) { const float g0 = acc[ai][0][m][0][j] * rs, u0 = acc[ai][1][m][0][j] * rs, g1 = acc[ai][0][m][1][j] * rs, u1 = acc[ai][1][m][1][j] * rs;
                    h0[j] = g0 * u0 * __builtin_amdgcn_rcpf(1.0f + fexp_(-g0)); h1[j] = g1 * u1 * __builtin_amdgcn_rcpf(1.0f + fexp_(-g1)); }
                *(u32x4*)(H + (size_t)row * 2816 + col0) = pack8(h0, h1); asm volatile("" ::: "memory"); }
    }
};
struct EpiRes {
    static constexpr bool PERM = true, AFTER_DRAIN = false;
    const float* xin; float* xout; bf16_t* xb; float* part; float alpha;
    __device__ __forceinline__ void operator()(const f32x4 (&acc)[2][2][4][2], const Unit& u, int wr, int wc, int fr, int fq) const {
        const int row0 = u.pm * BM + wr * 64 + fr, col0 = u.pn * BM + wc * 32 + 8 * fq;
#pragma unroll
        for (int ai = 0; ai < 2; ++ai) {
            f32x4 rv[4][2][2];
#pragma unroll
            for (int m = 0; m < 4; ++m)
#pragma unroll
                for (int bj = 0; bj < 2; ++bj) { const size_t off = (size_t)(row0 + ai * HALF + m * 16) * 1024 + col0 + bj * HALF; rv[m][bj][0] = *(const f32x4*)(xin + off); rv[m][bj][1] = *(const f32x4*)(xin + off + 4); }
            asm volatile("" ::: "memory");
#pragma unroll
            for (int m = 0; m < 4; ++m) { const int row = row0 + ai * HALF + m * 16; float ss = 0.f;
#pragma unroll
                for (int bj = 0; bj < 2; ++bj) { const size_t off = (size_t)row * 1024 + col0 + bj * HALF;
                    const f32x4 v0 = rv[m][bj][0] + acc[ai][bj][m][0] * alpha, v1 = rv[m][bj][1] + acc[ai][bj][m][1] * alpha;
                    *(f32x4*)(xout + off) = v0; *(f32x4*)(xout + off + 4) = v1;
                    if (xb) *(u32x4*)(xb + off) = pack8(v0, v1);
                    ss += (v0[0] * v0[0] + v0[1] * v0[1]) + (v0[2] * v0[2] + v0[3] * v0[3]) + (v1[0] * v1[0] + v1[1] * v1[1]) + (v1[2] * v1[2] + v1[3] * v1[3]); }
                ss += __shfl_xor(ss, 16); ss += __shfl_xor(ss, 32);
                if (fq == 0) part[(size_t)row * 16 + u.pn * 4 + wc] = ss; }
            asm volatile("" ::: "memory"); }
    }
};
constexpr int XT_OFF = 131072 + 64 + 4096;
struct EpiResNorm {
    static constexpr bool PERM = true, AFTER_DRAIN = false;
    const float* xin; float* xout; const float* gain; float* xslot; unsigned* cnt; PG8_LAS unsigned char* lds; float alpha;
    __device__ __forceinline__ void operator()(const f32x4 (&acc_)[2][2][4][2], const Unit& u, int wr, int wc, int fr, int fq) const {
        f32x4 (&acc)[2][2][4][2] = const_cast<f32x4 (&)[2][2][4][2]>(acc_);
        PG8_LAS float* Pt = (PG8_LAS float*)(lds + XT_OFF); PG8_LAS float* St = Pt + 1024;
        const int tid = threadIdx.x, lane = tid & 63, wid = tid >> 6;
        const int row0 = u.pm * BM + wr * 64 + fr, col0 = u.pn * BM + wc * 32 + 8 * fq;
#pragma unroll
        for (int ai = 0; ai < 2; ++ai) {
            f32x4 rv[4][2][2];
#pragma unroll
            for (int m = 0; m < 4; ++m)
#pragma unroll
                for (int bj = 0; bj < 2; ++bj) { const size_t off = (size_t)(row0 + ai * HALF + m * 16) * 1024 + col0 + bj * HALF; rv[m][bj][0] = *(const f32x4*)(xin + off); rv[m][bj][1] = *(const f32x4*)(xin + off + 4); }
            asm volatile("" ::: "memory");
#pragma unroll
            for (int m = 0; m < 4; ++m) { float ss = 0.f;
#pragma unroll
                for (int bj = 0; bj < 2; ++bj) {
                    const f32x4 v0 = rv[m][bj][0] + acc[ai][bj][m][0] * alpha, v1 = rv[m][bj][1] + acc[ai][bj][m][1] * alpha;
                    acc[ai][bj][m][0] = v0; acc[ai][bj][m][1] = v1;
                    ss += (v0[0] * v0[0] + v0[1] * v0[1]) + (v0[2] * v0[2] + v0[3] * v0[3]) + (v1[0] * v1[0] + v1[1] * v1[1]) + (v1[2] * v1[2] + v1[3] * v1[3]); }
                ss += __shfl_xor(ss, 16); ss += __shfl_xor(ss, 32);
                if (fq == 0) Pt[(ai * HALF + wr * 64 + m * 16 + fr) * 4 + wc] = ss; }
            asm volatile("" ::: "memory"); }
        asm volatile("s_waitcnt lgkmcnt(0)" ::: "memory"); __builtin_amdgcn_s_barrier(); asm volatile("" ::: "memory");
        if (tid < 256) { const float ts = (Pt[tid * 4 + 0] + Pt[tid * 4 + 1]) + (Pt[tid * 4 + 2] + Pt[tid * 4 + 3]);
            __hip_atomic_store(xslot + ((size_t)(u.pm * BM + tid) * 4 + u.pn), ts, __ATOMIC_RELAXED, __HIP_MEMORY_SCOPE_AGENT); }
        asm volatile("s_waitcnt vmcnt(0)" ::: "memory");
        if (lane == 0) __hip_atomic_fetch_add(cnt + 64 * u.pm, 1u, __ATOMIC_RELAXED, __HIP_MEMORY_SCOPE_AGENT);
        if (wid == 0) { unsigned sp = 0;
            while ((unsigned)__builtin_amdgcn_readfirstlane(__hip_atomic_load(cnt + 64 * u.pm, __ATOMIC_RELAXED, __HIP_MEMORY_SCOPE_AGENT)) < 32u) { __builtin_amdgcn_s_sleep(2); if (++sp > (1u << 18)) break; }
            __builtin_amdgcn_fence(__ATOMIC_ACQUIRE, "agent"); }
        asm volatile("s_waitcnt vmcnt(0) lgkmcnt(0)" ::: "memory"); __builtin_amdgcn_s_barrier(); asm volatile("" ::: "memory");
        if (tid < 256) { const float* sl = xslot + (size_t)(u.pm * BM + tid) * 4; float tot = 0.f;
#pragma unroll
            for (int t = 0; t < 4; ++t) tot += __hip_atomic_load(sl + t, __ATOMIC_RELAXED, __HIP_MEMORY_SCOPE_AGENT);
            St[tid] = __builtin_amdgcn_rsqf(tot * (1.0f / 1024.0f) + 1e-6f); }
        asm volatile("s_waitcnt vmcnt(0) lgkmcnt(0)" ::: "memory"); __builtin_amdgcn_s_barrier(); asm volatile("" ::: "memory");
        f32x4 g[2][2];
#pragma unroll
        for (int bj = 0; bj < 2; ++bj) { g[bj][0] = *(const f32x4*)(gain + col0 + bj * HALF); g[bj][1] = *(const f32x4*)(gain + col0 + bj * HALF + 4); }
#pragma unroll
        for (int ai = 0; ai < 2; ++ai)
#pragma unroll
            for (int m = 0; m < 4; ++m) { const int rl = ai * HALF + wr * 64 + m * 16 + fr; const float rs = St[rl];
#pragma unroll
                for (int bj = 0; bj < 2; ++bj) { const size_t off = (size_t)(u.pm * BM + rl) * 1024 + col0 + bj * HALF;
                    *(f32x4*)(xout + off) = acc[ai][bj][m][0] * rs * g[bj][0]; *(f32x4*)(xout + off + 4) = acc[ai][bj][m][1] * rs * g[bj][1]; } }
    }
};
struct EpiProj {
    static constexpr bool PERM = true, AFTER_DRAIN = false;
    RsTab tb; PG8_LAS unsigned char* lds;
    bf16_t* rkvl; bf16_t* attq; bf16_t* attkv; const float* part;
    __device__ __forceinline__ void operator()(const f32x4 (&acc)[2][2][4][2], const Unit& u, int wr, int wc, int fr, int fq) const {
        bf16_t* base; int ldc, colt;
        if (u.pn < 7) { base = rkvl; ldc = 1792; colt = u.pn * BM; } else if (u.pn < 9) { base = attq; ldc = 512; colt = (u.pn - 7) * BM; } else { base = attkv; ldc = 256; colt = 0; }
        const int row0 = u.pm * BM + wr * 64 + fr, col0 = colt + wc * 32 + 8 * fq;
        float rsv[2][4]; rows_rstd(tb, lds, u, wr, fr, rsv);
#pragma unroll
        for (int ai = 0; ai < 2; ++ai)
#pragma unroll
            for (int m = 0; m < 4; ++m) { const int row = row0 + ai * HALF + m * 16; const float rs = rsv[ai][m];
#pragma unroll
                for (int bj = 0; bj < 2; ++bj) *(u32x4*)(base + (size_t)row * ldc + col0 + bj * HALF) = pack8(acc[ai][bj][m][0] * rs, acc[ai][bj][m][1] * rs); }
    }
};
struct EpiGate {
    static constexpr bool PERM = true, AFTER_DRAIN = false;
    RsTab tb; PG8_LAS unsigned char* lds;
    bf16_t* gates; const float* part;
    __device__ __forceinline__ void operator()(const f32x4 (&acc)[2][2][4][2], const Unit& u, int wr, int wc, int fr, int fq) const {
        const int row0 = u.pm * BM + wr * 64 + fr, col0 = u.pn * BM + wc * 32 + 8 * fq;
        float rsv[2][4]; rows_rstd(tb, lds, u, wr, fr, rsv);
#pragma unroll
        for (int ai = 0; ai < 2; ++ai)
#pragma unroll
            for (int m = 0; m < 4; ++m) { const int row = row0 + ai * HALF + m * 16; const float rs = rsv[ai][m];
#pragma unroll
                for (int bj = 0; bj < 2; ++bj) { f32x4 v0, v1;
#pragma unroll
                    for (int j = 0; j < 4; ++j) { v0[j] = sigmoidf_(acc[ai][bj][m][0][j] * rs); v1[j] = sigmoidf_(acc[ai][bj][m][1][j] * rs); }
                    *(u32x4*)(gates + (size_t)row * 2048 + col0 + bj * HALF) = pack8(v0, v1); } }
    }
};
struct EpiLora {
    static constexpr bool PERM = true, AFTER_DRAIN = false;
    bf16_t* rec_lw; bf16_t* rec_a; bf16_t* g; const float* w0; const float* a0; int kind_base;
    template <int KIND> __device__ __forceinline__ void body(const f32x4 (&acc)[2][2][4][2], const Unit& u, int wr, int wc, int fr, int fq) const {
        const int row0 = u.pm * BM + wr * 64 + fr, col0 = (u.pn & 1) * BM + wc * 32 + 8 * fq;
#pragma unroll
        for (int ai = 0; ai < 2; ++ai)
#pragma unroll
            for (int m = 0; m < 4; ++m) { const int row = row0 + ai * HALF + m * 16; const int b = row >> 12, t = row & 4095;
#pragma unroll
                for (int bj = 0; bj < 2; ++bj) { const int c = col0 + bj * HALF; f32x4 v0 = acc[ai][bj][m][0], v1 = acc[ai][bj][m][1];
                    if (KIND != 2) { const float* bias = (KIND == 0 ? w0 : a0) + c; v0 = v0 + *(const f32x4*)bias; v1 = v1 + *(const f32x4*)(bias + 4); }
                    if (KIND == 2) { *(u32x4*)(g + (size_t)row * 512 + c) = pack8(v0, v1); }
                    else {
#pragma unroll
                        for (int j = 0; j < 4; ++j) {
                            if (KIND == 0) { v0[j] = -0.60653065971263342f * sigmoidf_(v0[j]); v1[j] = -0.60653065971263342f * sigmoidf_(v1[j]); }
                            else { v0[j] = sigmoidf_(v0[j]); v1[j] = sigmoidf_(v1[j]); } }
                        bf16_t* dst = (KIND == 0 ? rec_lw : rec_a) + ((size_t)((b * 8 + (c >> 6)) * 4096 + t)) * 64 + (c & 63);
                        *(u32x4*)dst = pack8(v0, v1); } }
                asm volatile("" ::: "memory"); }
    }
    __device__ __forceinline__ void operator()(const f32x4 (&acc)[2][2][4][2], const Unit& u, int wr, int wc, int fr, int fq) const {
        const int kind = kind_base + (u.pn >> 1);
        if (kind == 0) body<0>(acc, u, wr, wc, fr, fq); else if (kind == 1) body<1>(acc, u, wr, wc, fr, fq); else body<2>(acc, u, wr, wc, fr, fq);
    }
};
struct EpiBranch {
    static constexpr bool PERM = true, AFTER_DRAIN = false;
    const bf16_t* gates; bf16_t* merged; int goff; int accum;
    __device__ __forceinline__ void operator()(const f32x4 (&acc)[2][2][4][2], const Unit& u, int wr, int wc, int fr, int fq) const {
        const int row0 = u.pm * BM + wr * 64 + fr, col0 = u.pn * BM + wc * 32 + 8 * fq;
#pragma unroll
        for (int ai = 0; ai < 2; ++ai) {
            u32x4 gq[4][2], pq[4][2];
#pragma unroll
            for (int m = 0; m < 4; ++m)
#pragma unroll
                for (int bj = 0; bj < 2; ++bj) { const int row = row0 + ai * HALF + m * 16, c = col0 + bj * HALF;
                    gq[m][bj] = *(const u32x4*)(gates + (size_t)row * 2048 + goff + c);
                    pq[m][bj] = accum ? *(const u32x4*)(merged + (size_t)row * 1024 + c) : (u32x4){0u, 0u, 0u, 0u}; }
            asm volatile("" ::: "memory");
#pragma unroll
            for (int m = 0; m < 4; ++m)
#pragma unroll
                for (int bj = 0; bj < 2; ++bj) { const int row = row0 + ai * HALF + m * 16, c = col0 + bj * HALF; const u32x4 g4 = gq[m][bj], p4 = pq[m][bj];
                    f32x4 v0 = acc[ai][bj][m][0], v1 = acc[ai][bj][m][1];
                    v0[0] = v0[0] * bf_lo(g4.x) + bf_lo(p4.x); v0[1] = v0[1] * bf_hi(g4.x) + bf_hi(p4.x); v0[2] = v0[2] * bf_lo(g4.y) + bf_lo(p4.y); v0[3] = v0[3] * bf_hi(g4.y) + bf_hi(p4.y);
                    v1[0] = v1[0] * bf_lo(g4.z) + bf_lo(p4.z); v1[1] = v1[1] * bf_hi(g4.z) + bf_hi(p4.z); v1[2] = v1[2] * bf_lo(g4.w) + bf_lo(p4.w); v1[3] = v1[3] * bf_hi(g4.w) + bf_hi(p4.w);
                    *(u32x4*)(merged + (size_t)row * 1024 + c) = pack8(v0, v1); }
            asm volatile("" ::: "memory"); }
    }
};

template <class Epi, class Sched, bool ALIGN_EPI = false, bool SP2 = false>
__device__ __forceinline__ void gemm_phase(PG8_LAS unsigned char* lds, const Gemm g, const Sched& S, const Epi& E) {
    int tid_ = threadIdx.x; asm volatile("" : "+v"(tid_));
    const int tid = tid_, wid = __builtin_amdgcn_readfirstlane(tid >> 6), lane = tid & 63, wr = wid >> 2, wc = wid & 3, fr = lane & 15, fq = lane >> 4;
    const int K = g.K, nt = K / BK;
    unsigned voffA[2], voffB[2];
#pragma unroll
    for (int i = 0; i < 2; ++i) { int R, C; stage_rc(tid * 16 + i * 8192, R, C); const int Rb = Epi::PERM ? ((R & ~31) + perm32(R & 31)) : R;
        voffA[i] = (unsigned)(R * K + C) * 2u; voffB[i] = (unsigned)(Rb * K + C) * 2u; }
    const size_t kstep = (size_t)(BK * 2);
    const size_t hstep = (size_t)HALF * K * 2;
    const size_t tstep = 2 * hstep;
    const unsigned ldsw = (unsigned)wid * 1024u;
    const int aoff = lds_byte(wr * 64 + fr, fq * 8), boff = lds_byte(wc * 32 + fr, fq * 8);
#define PG8_SA(b, h) (((b) * 2 + (h)) * HTB)
#define PG8_SB(b, h) ((4 + (b) * 2 + (h)) * HTB)
#define PG8_STAGE(bufoff, gbase, voff) do { _Pragma("unroll") for (int _i = 0; _i < 2; ++_i) \
        __builtin_amdgcn_global_load_lds((const unsigned*)((const char*)(gbase) + (voff)[_i]), (PG8_LAS unsigned*)(lds + (bufoff) + ldsw + _i * 8192), 16, 0, 0); } while (0)
#define PG8_LDA(dst, b, h) do { _Pragma("unroll") for (int m = 0; m < 4; ++m) _Pragma("unroll") for (int k = 0; k < 2; ++k) dst[m][k] = *(const PG8_LAS bf16x8*)(lds + PG8_SA(b, h) + aoff + m * 2048 + k * 1024); } while (0)
#define PG8_LDB(dst, b, h) do { _Pragma("unroll") for (int n = 0; n < 2; ++n) _Pragma("unroll") for (int k = 0; k < 2; ++k) dst[n][k] = *(const PG8_LAS bf16x8*)(lds + PG8_SB(b, h) + boff + n * 2048 + k * 1024); } while (0)
#define PG8_MMA(ai, bj, At, Bt) do { __builtin_amdgcn_s_setprio(1); _Pragma("unroll") for (int m = 0; m < 4; ++m) _Pragma("unroll") for (int n = 0; n < 2; ++n) _Pragma("unroll") for (int k = 0; k < 2; ++k) \
        acc[ai][bj][m][n] = __builtin_amdgcn_mfma_f32_16x16x32_bf16(Bt[n][k], At[m][k], acc[ai][bj][m][n], 0, 0, 0); __builtin_amdgcn_s_setprio(0); } while (0)
#define PG8_WAIT_V(n) asm volatile("s_waitcnt vmcnt(" #n ")" ::: "memory")
#define PG8_WAIT_L(n) asm volatile("s_waitcnt lgkmcnt(" #n ")" ::: "memory")
#define PG8_BAR __builtin_amdgcn_s_barrier()
#define PG8_SCHED __builtin_amdgcn_sched_barrier(0)
    Unit cur, nxt; int ui = 0;
    if (!S.next(0, cur)) return;
    f32x4 acc[2][2][4][2];
#pragma unroll
    for (int a = 0; a < 2; ++a)
#pragma unroll
        for (int b = 0; b < 2; ++b)
#pragma unroll
            for (int m = 0; m < 4; ++m)
#pragma unroll
                for (int n = 0; n < 2; ++n) acc[a][b][m][n] = (f32x4){0.f, 0.f, 0.f, 0.f};
    bf16x8 At[4][2], B0[2][2], B1[2][2];
    const char* cA = (const char*)g.A + (size_t)cur.pm * tstep; const char* cB = (const char*)g.Bt + (size_t)cur.pn * tstep;
    S.a_ready(cur);
    if constexpr (SP2) {
        PG8_STAGE(PG8_SB(0, 0), cB, voffB); PG8_STAGE(PG8_SB(0, 1), cB + hstep, voffB); PG8_STAGE(PG8_SA(0, 0), cA, voffA); PG8_STAGE(PG8_SA(0, 1), cA + hstep, voffA);
        if (wr == 1) PG8_BAR;
        PG8_WAIT_V(2); PG8_BAR;
        PG8_STAGE(PG8_SB(1, 0), cB + kstep, voffB); PG8_STAGE(PG8_SA(1, 0), cA + kstep, voffA); PG8_STAGE(PG8_SB(1, 1), cB + hstep + kstep, voffB);
        PG8_WAIT_V(6); PG8_BAR;
    } else {
        PG8_STAGE(PG8_SB(0, 0), cB, voffB); PG8_STAGE(PG8_SA(0, 0), cA, voffA); PG8_STAGE(PG8_SB(0, 1), cB + hstep, voffB); PG8_STAGE(PG8_SA(0, 1), cA + hstep, voffA);
        if (wr == 1) PG8_BAR;
        PG8_WAIT_V(4); PG8_BAR;
        PG8_STAGE(PG8_SB(1, 0), cB + kstep, voffB); PG8_STAGE(PG8_SA(1, 0), cA + kstep, voffA); PG8_STAGE(PG8_SB(1, 1), cB + hstep + kstep, voffB);
        PG8_WAIT_V(6); PG8_BAR;
    }
    for (;;) {
        const bool has_next = S.next(ui + 1, nxt);
        const char* nA = has_next ? (const char*)g.A + (size_t)nxt.pm * tstep : cA; const char* nB = has_next ? (const char*)g.Bt + (size_t)nxt.pn * tstep : cB;
        for (int t = 0; t < nt; t += 2) {
            const bool last = (t == nt - 2);
            const char* a1 = cA + (size_t)(t + 1) * kstep;
            const char* a2 = last ? nA : cA + (size_t)(t + 2) * kstep; const char* b2 = last ? nB : cB + (size_t)(t + 2) * kstep;
            const char* a3 = a2 + kstep; const char* b3 = b2 + kstep;
            if (last && has_next) S.a_ready(nxt);
            if constexpr (SP2) {
            PG8_LDB(B0, 0, 0); PG8_LDB(B1, 0, 1); PG8_SCHED; PG8_LDA(At, 0, 0); PG8_STAGE(PG8_SA(1, 1), a1 + hstep, voffA);
            PG8_WAIT_V(8); PG8_WAIT_L(0); PG8_BAR; PG8_MMA(0, 0, At, B0); PG8_MMA(0, 1, At, B1); PG8_BAR; PG8_SCHED;
            PG8_LDA(At, 0, 1); PG8_STAGE(PG8_SB(0, 0), b2, voffB); PG8_STAGE(PG8_SB(0, 1), b2 + hstep, voffB); PG8_STAGE(PG8_SA(0, 0), a2, voffA);
            PG8_WAIT_V(8); PG8_WAIT_L(0); PG8_BAR; PG8_MMA(1, 0, At, B0); PG8_MMA(1, 1, At, B1); PG8_BAR; PG8_SCHED;
            PG8_LDB(B0, 1, 0); PG8_LDB(B1, 1, 1); PG8_SCHED; PG8_LDA(At, 1, 0); PG8_STAGE(PG8_SA(0, 1), a2 + hstep, voffA);
            PG8_WAIT_V(8); PG8_WAIT_L(0); PG8_BAR; PG8_MMA(0, 0, At, B0); PG8_MMA(0, 1, At, B1); PG8_BAR; PG8_SCHED;
            PG8_LDA(At, 1, 1); PG8_STAGE(PG8_SB(1, 0), b3, voffB); PG8_STAGE(PG8_SB(1, 1), b3 + hstep, voffB); PG8_STAGE(PG8_SA(1, 0), a3, voffA);
            PG8_WAIT_V(8); PG8_WAIT_L(0); PG8_BAR; PG8_MMA(1, 0, At, B0); PG8_MMA(1, 1, At, B1); PG8_BAR; PG8_SCHED;
            } else {
            PG8_LDB(B0, 0, 0); PG8_SCHED; PG8_LDA(At, 0, 0); PG8_STAGE(PG8_SA(1, 1), a1 + hstep, voffA);
            PG8_WAIT_L(8); PG8_BAR; PG8_WAIT_L(0); PG8_MMA(0, 0, At, B0); PG8_BAR; PG8_SCHED;
            PG8_LDB(B1, 0, 1); PG8_STAGE(PG8_SB(0, 0), b2, voffB);
            PG8_BAR; PG8_WAIT_L(0); PG8_MMA(0, 1, At, B1); PG8_BAR;
            PG8_LDA(At, 0, 1); PG8_STAGE(PG8_SA(0, 0), a2, voffA);
            PG8_BAR; PG8_WAIT_L(0); PG8_MMA(1, 0, At, B0); PG8_BAR; PG8_SCHED;
            PG8_STAGE(PG8_SB(0, 1), b2 + hstep, voffB);
            PG8_WAIT_V(6); PG8_BAR; PG8_MMA(1, 1, At, B1); PG8_BAR;
            PG8_LDB(B0, 1, 0); PG8_SCHED; PG8_LDA(At, 1, 0); PG8_STAGE(PG8_SA(0, 1), a2 + hstep, voffA);
            PG8_WAIT_L(8); PG8_BAR; PG8_WAIT_L(0); PG8_MMA(0, 0, At, B0); PG8_BAR; PG8_SCHED;
            PG8_LDB(B1, 1, 1); PG8_STAGE(PG8_SB(1, 0), b3, voffB);
            PG8_BAR; PG8_WAIT_L(0); PG8_MMA(0, 1, At, B1); PG8_BAR;
            PG8_LDA(At, 1, 1); PG8_STAGE(PG8_SA(1, 0), a3, voffA);
            PG8_BAR; PG8_WAIT_L(0); PG8_MMA(1, 0, At, B0); PG8_BAR; PG8_SCHED;
            PG8_STAGE(PG8_SB(1, 1), b3 + hstep, voffB);
            PG8_WAIT_V(6); PG8_BAR; PG8_MMA(1, 1, At, B1); PG8_BAR;
            }
        }
        if constexpr (ALIGN_EPI) { if (wr == 0) PG8_BAR; }
        if constexpr (!Epi::AFTER_DRAIN) { E(acc, cur, wr, wc, fr, fq); S.done(cur); }
        if (!has_next) break;
#pragma unroll
        for (int a = 0; a < 2; ++a)
#pragma unroll
            for (int b = 0; b < 2; ++b)
#pragma unroll
                for (int m = 0; m < 4; ++m)
#pragma unroll
                    for (int n = 0; n < 2; ++n) acc[a][b][m][n] = (f32x4){0.f, 0.f, 0.f, 0.f};
        cur = nxt; cA = nA; cB = nB; ++ui;
        if constexpr (ALIGN_EPI) { if (wr == 1) PG8_BAR; }
    }
    PG8_WAIT_V(0);
    if constexpr (!ALIGN_EPI) { if (wr == 0) PG8_BAR; }
    PG8_BAR;
    if constexpr (Epi::AFTER_DRAIN) { E.fused(acc, cur, wr, wc, fr, fq, lds, wid, lane); S.done(cur); }
#undef PG8_SA
#undef PG8_SB
#undef PG8_STAGE
#undef PG8_LDA
#undef PG8_LDB
#undef PG8_MMA
#undef PG8_WAIT_V
#undef PG8_WAIT_L
#undef PG8_BAR
#undef PG8_SCHED
}
}
constexpr int NWAVES = 8;
constexpr int BATCH = 8, T = 4096, D = 1024, M = BATCH * T, FF = 2816, NH = 8, HD = 64, INC = 4512;
constexpr float RMS_EPS = 1e-6f, GN_EPS = 64e-5f;
constexpr size_t MiB = 1u << 20;
constexpr size_t WS_PART = 1 * MiB;
constexpr size_t WS_SC = 9 * MiB;
constexpr size_t WS_WGU1 = 13 * MiB, WS_WDN1 = WS_WGU1 + 11 * MiB, WS_WGU2 = WS_WDN1 + 5632 * 1024, WS_WDN2 = WS_WGU2 + 11 * MiB;
constexpr size_t WS_WIN = WS_WDN2 + 5632 * 1024, WS_WGT = WS_WIN + 5 * MiB, WS_WLO = WS_WGT + 4 * MiB, WS_WBR = WS_WLO + 768 * 1024, WS_WBA = WS_WBR + 1 * MiB, WS_WOUT = WS_WBA + 1 * MiB;
constexpr size_t WS_XB = 62 * MiB;
constexpr size_t WS_ATTQ = 126 * MiB;
constexpr size_t WS_ATTKV = 158 * MiB;
constexpr size_t WS_RKVL = 174 * MiB;
constexpr size_t WS_G = 286 * MiB;
constexpr size_t WS_REC = 318 * MiB, REC_SLOT = 32 * MiB;
constexpr size_t WS_H = 126 * MiB;
constexpr size_t WS_YRAW = WS_REC + 1 * REC_SLOT;
constexpr size_t WS_MERGED = WS_REC + 1 * REC_SLOT;
constexpr size_t WS_VB = WS_REC + 3 * REC_SLOT;
constexpr size_t WS_GATES = WS_ATTKV;
constexpr size_t WS_YR = WS_REC + 4 * REC_SLOT;
constexpr size_t WS_LA = WS_REC + 5 * REC_SLOT;
constexpr size_t WS_END = WS_REC + 6 * REC_SLOT;
static_assert(WS_WOUT + 4 * MiB <= WS_XB && WS_H + (size_t)M * FF * 2 <= WS_REC && WS_GATES + (size_t)M * 2048 * 2 <= WS_G, "ws map");
constexpr int RING_BYTES = 131072, LDS_BYTES = 147456;

#define GAS __attribute__((address_space(1)))
#define LAS __attribute__((address_space(3)))
typedef unsigned short bf16;
typedef unsigned v4u __attribute__((ext_vector_type(4)));
typedef unsigned v2u __attribute__((ext_vector_type(2)));
typedef float f32x4 __attribute__((ext_vector_type(4)));
typedef float f32x2 __attribute__((ext_vector_type(2)));
typedef short bf16x8 __attribute__((ext_vector_type(8)));
#define LDS_WAIT() asm volatile("s_waitcnt lgkmcnt(0)" ::: "memory")
__device__ __forceinline__ unsigned f2bf(float f) { unsigned u = __builtin_bit_cast(unsigned, f); return (u + 0x7fffu + ((u >> 16) & 1u)) >> 16; }
__device__ __forceinline__ unsigned pk2(float lo, float hi) { return f2bf(lo) | (f2bf(hi) << 16); }
__device__ __forceinline__ float bflo(unsigned u) { return __uint_as_float(u << 16); }
__device__ __forceinline__ float bfhi(unsigned u) { return __uint_as_float(u & 0xffff0000u); }
__device__ __forceinline__ float bf1(bf16 h) { return __uint_as_float((unsigned)h << 16); }
__device__ __forceinline__ float wave_sum(float v) {
#pragma unroll
    for (int o = 1; o < 64; o <<= 1) v += __shfl_xor(v, o);
    return v;
}
template <int CTRL> __device__ __forceinline__ float dppf(float x) { return __builtin_bit_cast(float, __builtin_amdgcn_update_dpp(0, __builtin_bit_cast(int, x), CTRL, 0xf, 0xf, false)); }
__device__ __forceinline__ float row16_sum(float x) { x += dppf<0xB1>(x); x += dppf<0x4E>(x); x += dppf<0x141>(x); x += dppf<0x140>(x); return x; }

#define RLX_AGENT __ATOMIC_RELAXED, __HIP_MEMORY_SCOPE_AGENT
#define XB_TMO      128
#define XB_XCNT(j)  (256  + 64 * (j))
#define XB_XSUB(j)  (1280 + 64 * (j))
#define XB_XGEN(j)  (2304 + 64 * (j))
#define XB_TOP      3328
#define XB_TOPGEN   3392
#define XCD_BAR_WORDS 3456
#define XB_SPIN_CAP (1u << 18)

__device__ __forceinline__ unsigned xb_ld(unsigned* p)              { return __hip_atomic_load(p, __ATOMIC_RELAXED, __HIP_MEMORY_SCOPE_AGENT); }
__device__ __forceinline__ unsigned xb_add(unsigned* p, unsigned v) { return __hip_atomic_fetch_add(p, v, __ATOMIC_RELAXED, __HIP_MEMORY_SCOPE_AGENT); }
__device__ __forceinline__ unsigned xb_xcc_id() { return (unsigned)__builtin_amdgcn_s_getreg((3 << 11) | 20) & 0xFu; }
#define XB_SPIN(cond, bar) do { unsigned _sp = 0; while (cond) { __builtin_amdgcn_s_sleep(1); \
    if ((++_sp & 255u) == 0u) { if (xb_ld(&(bar)[XB_TMO])) break; if (_sp > XB_SPIN_CAP) { atomicAdd(&(bar)[XB_TMO], 1u); break; } } } } while (0)

struct XcdBarrier {
    unsigned* bar; unsigned x;
    volatile LAS unsigned* st;
};

__device__ __forceinline__ XcdBarrier xcd_barrier_post(unsigned* bar, volatile LAS unsigned* st) {
    XcdBarrier b; b.bar = bar; b.x = xb_xcc_id(); b.st = st;
    if (threadIdx.x == 0) (void)xb_add(&bar[XB_XCNT(b.x)], 1u);
    return b;
}
__device__ __forceinline__ void xcd_barrier_complete(unsigned* bar, unsigned x, unsigned& nloc, unsigned& nx) {
    const unsigned G = gridDim.x * gridDim.y * gridDim.z;
    unsigned sum, cnt, mine, sp = 0u;
    for (;;) {
        sum = 0u; cnt = 0u; mine = 0u;
#pragma unroll
        for (unsigned j = 0; j < 16; ++j) { const unsigned c = xb_ld(&bar[XB_XCNT(j)]); sum += c; cnt += (c > 0u) ? 1u : 0u; mine = (j == x) ? c : mine; }
        if (sum == G) break;
        __builtin_amdgcn_s_sleep(1);
        if ((++sp & 255u) == 0u) { if (xb_ld(&bar[XB_TMO])) break; if (sp > XB_SPIN_CAP) { atomicAdd(&bar[XB_TMO], 1u); break; } }
    }
    nloc = mine > 0u ? mine : 1u; nx = cnt > 0u ? cnt : 1u;
}

__device__ __forceinline__ void xcd_barrier(const XcdBarrier& b) {
    asm volatile("s_waitcnt vmcnt(0)" ::: "memory");
    __syncthreads();
    if (threadIdx.x == 0) {
        unsigned* bar = b.bar;
        __builtin_amdgcn_s_waitcnt(0);
        unsigned nloc = b.st[0], nx = b.st[1];
        if (nloc == 0u) { xcd_barrier_complete(bar, b.x, nloc, nx); b.st[0] = nloc; b.st[1] = nx; }
        const unsigned old = xb_add(&bar[XB_XSUB(b.x)], 1u);
        const unsigned gen = old / nloc;
        if (old + 1u == (gen + 1u) * nloc) {
            __builtin_amdgcn_fence(__ATOMIC_RELEASE, "agent");
            asm volatile("s_waitcnt vmcnt(0)" ::: "memory");
            const unsigned og = xb_add(&bar[XB_TOP], 1u);
            const unsigned tg = og / nx;
            if (og + 1u == (tg + 1u) * nx) xb_add(&bar[XB_TOPGEN], 1u);
            else XB_SPIN(xb_ld(&bar[XB_TOPGEN]) == tg, bar);
            __builtin_amdgcn_fence(__ATOMIC_ACQUIRE, "agent");
            xb_add(&bar[XB_XGEN(b.x)], 1u);
            asm volatile("s_waitcnt vmcnt(0)" ::: "memory");
        } else {
            XB_SPIN(xb_ld(&bar[XB_XGEN(b.x)]) == gen, bar);
            __builtin_amdgcn_fence(__ATOMIC_ACQUIRE, "agent");
            asm volatile("s_waitcnt vmcnt(0)" ::: "memory");
        }
    }
    __syncthreads();
}

__device__ __forceinline__ int fresh_tid() { int t = threadIdx.x; asm volatile("" : "+v"(t)); return t; }
struct Frame {
    LAS unsigned char* lds;
    int tid, lane, wave, vcu, G;
    const float *in0, *in1, *in2, *in3, *in4, *in5, *in6, *in7, *in8, *in9, *in10, *in11, *in12, *in13, *in14, *in15, *in16, *in17, *in18, *in19, *in20, *in21, *in22, *in23, *in24, *in25, *in26, *in27, *in28; float* out; unsigned char* ws;
};

__device__ __forceinline__ pg8::RsTab fill_rstd(Frame& F, const float* part, int N) {
    pg8::StaticOrder S; S.init(M, N, F.G, (int)blockIdx.x); pg8::Unit u; pg8::RsTab tb; tb.pm[0] = tb.pm[1] = tb.pm[2] = tb.pm[3] = -1;
    for (int i = 0; S.next(i, u); ++i) { if (u.pm == tb.pm[0] || u.pm == tb.pm[1] || u.pm == tb.pm[2] || u.pm == tb.pm[3]) continue;
        if (tb.pm[0] < 0) tb.pm[0] = u.pm; else if (tb.pm[1] < 0) tb.pm[1] = u.pm; else if (tb.pm[2] < 0) tb.pm[2] = u.pm; else tb.pm[3] = u.pm; }
    const int tid = fresh_tid(); LAS float* t = (LAS float*)(F.lds + pg8::RS_TAB_OFF);
#pragma unroll
    for (int h = 0; h < 2; ++h) { const int e = tid + 512 * h, slot = e >> 8, r = e & 255; const int pm = slot == 0 ? tb.pm[0] : slot == 1 ? tb.pm[1] : slot == 2 ? tb.pm[2] : tb.pm[3];
        if (pm >= 0) { const GAS f32x4* p = (const GAS f32x4*)(part + ((size_t)pm * 256 + r) * 16); const f32x4 a = p[0], b = p[1], c = p[2], d = p[3];
            const float sm = ((a[0] + a[1]) + (a[2] + a[3])) + ((b[0] + b[1]) + (b[2] + b[3])) + ((c[0] + c[1]) + (c[2] + c[3])) + ((d[0] + d[1]) + (d[2] + d[3]));
            t[e] = __builtin_amdgcn_rsqf(sm * (1.0f / 1024.0f) + RMS_EPS); } }
    __syncthreads();
    return tb;
}
__device__ __forceinline__ void tr_item(const float* W, int ldn, int k0, int n0, bf16* WT, int ldk, int drow0, int dk0, const float* scale, int dup, LAS float* scr, int lane) {
    float tv[32], ts[32];
#pragma unroll
    for (int i = 0; i < 32; ++i) { const int kk = 2 * i + (lane >> 5); tv[i] = W[(size_t)(k0 + kk) * ldn + n0 + (lane & 31)]; ts[i] = scale ? scale[k0 + kk] : 1.0f; }
#pragma unroll
    for (int i = 0; i < 32; ++i) { const int kk = 2 * i + (lane >> 5); scr[kk * 33 + (lane & 31)] = tv[i] * ts[i]; }
    LDS_WAIT(); asm volatile("" ::: "memory");
    const int c = lane & 7;
#pragma unroll
    for (int j = 0; j < 4; ++j) { const int n = (lane >> 3) + 8 * j; const LAS float* s = scr + (8 * c) * 33 + n;
        v4u o; o.x = pk2(s[0 * 33], s[1 * 33]); o.y = pk2(s[2 * 33], s[3 * 33]); o.z = pk2(s[4 * 33], s[5 * 33]); o.w = pk2(s[6 * 33], s[7 * 33]);
        bf16* dp = WT + (size_t)(drow0 + n0 + n) * ldk + dk0 + k0 + 8 * c;
        *(GAS v4u*)dp = o; if (dup) *(GAS v4u*)(dp + dup) = o; }
    LDS_WAIT(); asm volatile("" ::: "memory");
}
__device__ __forceinline__ void p0_prologue(Frame& F) {
    LAS float* scr = (LAS float*)(F.lds + F.wave * 16384);
    unsigned char* ws = F.ws;
    const int gw = F.vcu * NWAVES + F.wave, NGW = F.G * NWAVES, lane = fresh_tid() & 63;
    constexpr int I_GU = 16 * 88, I_DN = 44 * 32, I_IN = 16 * 77, I_GT = 16 * 64, I_BR = 8 * 32, I_OUT = 16 * 32;
    constexpr int NITEMS = 4 * I_GU + 2 * I_DN + I_IN + I_GT + 2 * I_BR + I_OUT;
    for (int it = gw; it < NITEMS; it += NGW) {
        int r = it;
        if (r < 4 * I_GU) {
            const int which = r / I_GU; r -= which * I_GU; const int kb = r / 88, nb = r % 88, n0 = nb * 32;
            const float* W = which == 0 ? F.in2 : which == 1 ? F.in3 : which == 2 ? F.in25 : F.in26;
            tr_item(W, FF, kb * 64, n0, (bf16*)(ws + (which < 2 ? WS_WGU1 : WS_WGU2)), D, (n0 >> 7) * 256 + (which & 1) * 128 + (n0 & 127) - n0, 0, which < 2 ? F.in1 : F.in24, 0, scr, lane);
            continue; }
        r -= 4 * I_GU;
        if (r < 2 * I_DN) { const int which = r / I_DN; r -= which * I_DN; const int kb = r / 32, nb = r % 32;
            tr_item(which ? F.in27 : F.in4, D, kb * 64, nb * 32, (bf16*)(ws + (which ? WS_WDN2 : WS_WDN1)), FF, 0, 0, nullptr, 0, scr, lane); continue; }
        r -= 2 * I_DN;
        if (r < I_IN) { const int kb = r / 77, nb = r % 77, n0 = nb * 32;
            tr_item(F.in6, INC, kb * 64, n0, (bf16*)(ws + WS_WIN), D, n0 < 1696 ? 0 : 96, 0, F.in5, 0, scr, lane); continue; }
        r -= I_IN;
        if (r < I_GT) { const int kb = r / 64, nb = r % 64;
            tr_item(F.in6, INC, kb * 64, 2464 + nb * 32, (bf16*)(ws + WS_WGT), D, -2464, 0, F.in5, 0, scr, lane); continue; }
        r -= I_GT;
        if (r < 2 * I_BR) { const int which = r / I_BR; r -= which * I_BR; const int kb = r / 32, nb = r % 32;
            tr_item(which ? F.in22 : F.in21, D, kb * 64, nb * 32, (bf16*)(ws + (which ? WS_WBA : WS_WBR)), 512, 0, 0, nullptr, 0, scr, lane); continue; }
        r -= 2 * I_BR;
        { const int kb = r / 32, nb = r % 32; tr_item(F.in23, D, kb * 64, nb * 32, (bf16*)(ws + WS_WOUT), D, 0, 0, nullptr, 0, scr, lane); }
    }
    { GAS v4u* z = (GAS v4u*)(ws + WS_WIN + (size_t)1696 * D * 2); for (int i = gw * 64 + lane; i < 12288; i += NGW * 64) z[i] = (v4u){0u, 0u, 0u, 0u}; }
    { bf16* WL = (bf16*)(ws + WS_WLO);
      for (int i = gw * 64 + lane; i < 1536 * 128; i += NGW * 64) { const int n = i >> 7, k = i & 127, grp = n >> 9, nn = n & 511; float v = 0.f;
          if (grp == 0) { if (k < 32) v = F.in9[k * 512 + nn]; } else if (grp == 1) { if (k >= 32 && k < 64) v = F.in11[(k - 32) * 512 + nn]; } else { if (k < 96) v = F.in12[k * 512 + nn]; }
          WL[i] = (bf16)f2bf(v); } }
    { const float* x = F.in0; bf16* XB = (bf16*)(ws + WS_XB); float* part = (float*)(ws + WS_PART);
      for (int m0 = gw; m0 < M; m0 += 4 * NGW) { f32x4 v[4][4];
#pragma unroll
          for (int r = 0; r < 4; ++r) { const int m = m0 + r * NGW; if (m < M) { const GAS f32x4* xr = (const GAS f32x4*)(x + (size_t)m * D) + lane;
#pragma unroll
              for (int j = 0; j < 4; ++j) v[r][j] = xr[64 * j]; } }
#pragma unroll
          for (int r = 0; r < 4; ++r) { const int m = m0 + r * NGW; if (m < M) { float s = 0.f;
#pragma unroll
              for (int j = 0; j < 4; ++j) s += (v[r][j].x * v[r][j].x + v[r][j].y * v[r][j].y) + (v[r][j].z * v[r][j].z + v[r][j].w * v[r][j].w);
              s = wave_sum(s);
              GAS unsigned long long* o8 = (GAS unsigned long long*)(XB + (size_t)m * D) + lane;
#pragma unroll
              for (int j = 0; j < 4; ++j) o8[64 * j] = (unsigned long long)pk2(v[r][j].x, v[r][j].y) | ((unsigned long long)pk2(v[r][j].z, v[r][j].w) << 32);
              if (lane < 16) part[(size_t)m * 16 + lane] = lane == 0 ? s : 0.f; } } } }
}
__device__ __forceinline__ void p4_lora_in(Frame& F) {
    const bf16* RKVL = (const bf16*)(F.ws + WS_RKVL); const float* mu = F.in7 + 1536;
    const int gw = F.vcu * NWAVES + F.wave, NGW = F.G * NWAVES, lane = fresh_tid() & 63, second = lane >> 5, c0 = 4 * (lane & 31);
    bf16* LA = (bf16*)(F.ws + WS_LA) + (second ? (size_t)M * 128 : 0);
    const int sc0 = second ? 64 + c0 : c0;
    const bool act = second ? c0 < 96 : c0 < 64; f32x4 mv = (f32x4){0.f, 0.f, 0.f, 0.f}; if (act) mv = *(const GAS f32x4*)(mu + sc0);
    for (int m0 = gw; m0 < M; m0 += 4 * NGW) {
        v2u cu[4], pu[4];
#pragma unroll
        for (int rr = 0; rr < 4; ++rr) { const int m = m0 + rr * NGW; cu[rr] = (v2u){0u, 0u}; pu[rr] = (v2u){0u, 0u};
            if (act) { cu[rr] = *(const GAS v2u*)(RKVL + (size_t)m * 1792 + 1536 + sc0); if ((m & (T - 1)) != 0) pu[rr] = *(const GAS v2u*)(RKVL + (size_t)(m - 1) * 1792 + 1536 + sc0); } }
#pragma unroll
        for (int rr = 0; rr < 4; ++rr) { const int m = m0 + rr * NGW; float o[4] = {0.f, 0.f, 0.f, 0.f};
            if (act) { const float cur[4] = {bflo(cu[rr].x), bfhi(cu[rr].x), bflo(cu[rr].y), bfhi(cu[rr].y)}, prv[4] = {bflo(pu[rr].x), bfhi(pu[rr].x), bflo(pu[rr].y), bfhi(pu[rr].y)};
#pragma unroll
                for (int j = 0; j < 4; ++j) { const float p = cur[j] + (prv[j] - cur[j]) * mv[j]; const int c = sc0 + j;
                    const float e = __builtin_amdgcn_exp2f((c < 32 ? 2.0f : -1.0f) * 1.44269504089f * p), rc = __builtin_amdgcn_rcpf(1.0f + e);
                    o[j] = c < 32 ? 1.0f - 2.0f * rc : (c < 64 ? p : rc); } }
            *(GAS v2u*)(LA + (size_t)m * 128 + c0) = (v2u){pk2(o[0], o[1]), pk2(o[2], o[3])}; }
    }
}
__device__ __forceinline__ float sum8(float v) { v += __shfl_xor(v, 1); v += __shfl_xor(v, 2); v += __shfl_xor(v, 4); return v; }
__device__ __forceinline__ void unpack8(const v4u u, float (&f)[8]) { f[0] = bflo(u.x); f[1] = bfhi(u.x); f[2] = bflo(u.y); f[3] = bfhi(u.y); f[4] = bflo(u.z); f[5] = bfhi(u.z); f[6] = bflo(u.w); f[7] = bfhi(u.w); }
__device__ __forceinline__ v4u pack8u(const float (&f)[8]) { return (v4u){pk2(f[0], f[1]), pk2(f[2], f[3]), pk2(f[4], f[5]), pk2(f[6], f[7])}; }
__device__ __forceinline__ void ld8f(const float* p, float (&f)[8]) { const f32x4 a = *(const GAS f32x4*)p, b = *(const GAS f32x4*)(p + 4); f[0] = a.x; f[1] = a.y; f[2] = a.z; f[3] = a.w; f[4] = b.x; f[5] = b.y; f[6] = b.z; f[7] = b.w; }
constexpr int KS_STRIDE = 144, VT_STRIDE = 528, ATT_KS_OFF = 0, ATT_VT_OFF = 256 * KS_STRIDE;
__device__ __forceinline__ void p6_attention(Frame& F) {
    bf16* ATTQ = (bf16*)(F.ws + WS_ATTQ); const bf16* ATTKV = (const bf16*)(F.ws + WS_ATTKV);
    const float* qn = F.in18; const float* kn = F.in19; const float* sinks = F.in20;
    LAS unsigned char* Ks = F.lds + ATT_KS_OFF; LAS unsigned char* Vt = F.lds + ATT_VT_OFF;
    const int tid = fresh_tid(), lane = tid & 63, w = F.wave, g = lane >> 4, n16 = lane & 15;
    for (int unit = F.vcu; unit < BATCH * 2 * 32; unit += F.G) {
        const int nb = unit & 31, kvh = (unit >> 5) & 1, b = unit >> 6; const int m0 = b * T + nb * 128;
#pragma unroll
        for (int i = 0; i < 4; ++i) { const int e = tid + 512 * i, key = e >> 3, dg = e & 7; const bool valid = nb > 0 || key >= 128;
            v4u ku = (v4u){0u, 0u, 0u, 0u}, vu = (v4u){0u, 0u, 0u, 0u};
            if (valid) { const bf16* src = ATTKV + (size_t)(m0 - 128 + key) * 256 + kvh * 64 + dg * 8; ku = *(const GAS v4u*)src; vu = *(const GAS v4u*)(src + 128); }
            float kf[8] = {bflo(ku.x), bfhi(ku.x), bflo(ku.y), bfhi(ku.y), bflo(ku.z), bfhi(ku.z), bflo(ku.w), bfhi(ku.w)};
            float ss = 0.f;
#pragma unroll
            for (int j = 0; j < 8; ++j) ss += kf[j] * kf[j];
            ss += __shfl_xor(ss, 1); ss += __shfl_xor(ss, 2); ss += __shfl_xor(ss, 4);
            const float rs = __builtin_amdgcn_rsqf(ss * (1.0f / 64.0f) + RMS_EPS);
#pragma unroll
            for (int j = 0; j < 8; ++j) kf[j] *= rs * kn[dg * 8 + j];
            *(LAS v4u*)(Ks + key * KS_STRIDE + dg * 16) = (v4u){pk2(kf[0], kf[1]), pk2(kf[2], kf[3]), pk2(kf[4], kf[5]), pk2(kf[6], kf[7])};
            const unsigned vv[4] = {vu.x, vu.y, vu.z, vu.w};
#pragma unroll
            for (int j = 0; j < 8; ++j) *(LAS bf16*)(Vt + (dg * 8 + j) * VT_STRIDE + key * 2) = (bf16)((vv[j >> 1] >> ((j & 1) * 16)) & 0xffffu);
        }
        __syncthreads();
        const int hq = kvh * 4 + (w >> 1), qbase = (w & 1) * 64; const float sink = sinks[hq];
        float qg[16];
#pragma unroll
        for (int j = 0; j < 16; ++j) qg[j] = qn[(j >> 3) * 32 + 8 * g + (j & 7)];
        bf16* qrow = ATTQ + (size_t)(m0 + qbase + n16) * 512 + hq * 64 + 8 * g;
        v4u qa_n = *(const GAS v4u*)qrow, qb_n = *(const GAS v4u*)(qrow + 32);
        for (int qt = 0; qt < 4; ++qt) {
            const int q0 = qbase + 16 * qt, qi = q0 + n16, kt0 = q0 >> 4;
            const v4u qa = qa_n, qb = qb_n;
            if (qt < 3) { const bf16* qp = qrow + (size_t)(qt + 1) * 16 * 512; qa_n = *(const GAS v4u*)qp; qb_n = *(const GAS v4u*)(qp + 32); }
            bf16x8 ka[9][2];
#pragma unroll
            for (int i = 0; i < 9; ++i) { const int kt = kt0 + i, ktc = kt < 16 ? kt : 15; const LAS unsigned char* kp = Ks + (16 * ktc + n16) * KS_STRIDE + 16 * g;
                ka[i][0] = *(const LAS bf16x8*)kp; ka[i][1] = *(const LAS bf16x8*)(kp + 64); }
            float q[16] = {bflo(qa.x), bfhi(qa.x), bflo(qa.y), bfhi(qa.y), bflo(qa.z), bfhi(qa.z), bflo(qa.w), bfhi(qa.w),
                           bflo(qb.x), bfhi(qb.x), bflo(qb.y), bfhi(qb.y), bflo(qb.z), bfhi(qb.z), bflo(qb.w), bfhi(qb.w)};
            float ss = 0.f;
#pragma unroll
            for (int j = 0; j < 16; ++j) ss += q[j] * q[j];
            ss += __shfl_xor(ss, 16); ss += __shfl_xor(ss, 32);
            const float rs = 0.125f * __builtin_amdgcn_rsqf(ss * (1.0f / 64.0f) + RMS_EPS);
#pragma unroll
            for (int j = 0; j < 16; ++j) q[j] *= rs * qg[j];
            const v4u qf0 = (v4u){pk2(q[0], q[1]), pk2(q[2], q[3]), pk2(q[4], q[5]), pk2(q[6], q[7])}, qf1 = (v4u){pk2(q[8], q[9]), pk2(q[10], q[11]), pk2(q[12], q[13]), pk2(q[14], q[15])};
            const bf16x8 bq0 = __builtin_bit_cast(bf16x8, qf0), bq1 = __builtin_bit_cast(bf16x8, qf1);
            __builtin_amdgcn_sched_barrier(0);
            f32x4 st[10]; st[9] = (f32x4){0.f, 0.f, 0.f, 0.f};
#pragma unroll
            for (int i = 0; i < 9; ++i) { f32x4 acc = (f32x4){0.f, 0.f, 0.f, 0.f};
                acc = __builtin_amdgcn_mfma_f32_16x16x32_bf16(ka[i][0], bq0, acc, 0, 0, 0);
                st[i] = __builtin_amdgcn_mfma_f32_16x16x32_bf16(ka[i][1], bq1, acc, 0, 0, 0); }
            v2u vf[5][4][2];
#pragma unroll
            for (int j = 0; j < 5; ++j) { const int ka_ = kt0 + 2 * j, kb_ = ka_ + 1, kac = ka_ < 16 ? ka_ : 15, kbc = kb_ < 16 ? kb_ : 15;
#pragma unroll
                for (int dt = 0; dt < 4; ++dt) { const LAS unsigned char* vp = Vt + (16 * dt + n16) * VT_STRIDE;
                    vf[j][dt][0] = *(const LAS v2u*)(vp + (16 * kac + 4 * g) * 2); vf[j][dt][1] = *(const LAS v2u*)(vp + (16 * kbc + 4 * g) * 2); } }
            float mx = -INFINITY;
#pragma unroll
            for (int i = 0; i < 9; ++i)
#pragma unroll
                for (int r = 0; r < 4; ++r) { const int kj = 16 * (kt0 + i) + 4 * g + r; const bool ok = (kj > qi) && (kj <= qi + 128) && (nb > 0 || kj >= 128);
                    st[i][r] = ok ? st[i][r] : -INFINITY; mx = fmaxf(mx, st[i][r]); }
            mx = fmaxf(mx, __shfl_xor(mx, 16)); mx = fmaxf(mx, __shfl_xor(mx, 32)); mx = fmaxf(mx, sink);
            float den = 0.f;
#pragma unroll
            for (int i = 0; i < 9; ++i)
#pragma unroll
                for (int r = 0; r < 4; ++r) { const float p = __expf(st[i][r] - mx); st[i][r] = p; den += p; }
            den += __shfl_xor(den, 16); den += __shfl_xor(den, 32); den += __expf(sink - mx);
            const float inv = __builtin_amdgcn_rcpf(den);
            f32x4 o[4];
#pragma unroll
            for (int dt = 0; dt < 4; ++dt) o[dt] = (f32x4){0.f, 0.f, 0.f, 0.f};
#pragma unroll
            for (int j = 0; j < 5; ++j) {
                const v4u pu = (v4u){pk2(st[2 * j][0], st[2 * j][1]), pk2(st[2 * j][2], st[2 * j][3]), pk2(st[2 * j + 1][0], st[2 * j + 1][1]), pk2(st[2 * j + 1][2], st[2 * j + 1][3])};
                const bf16x8 pf = __builtin_bit_cast(bf16x8, pu);
#pragma unroll
                for (int dt = 0; dt < 4; ++dt) { const bf16x8 af = __builtin_bit_cast(bf16x8, (v4u){vf[j][dt][0].x, vf[j][dt][0].y, vf[j][dt][1].x, vf[j][dt][1].y});
                    o[dt] = __builtin_amdgcn_mfma_f32_16x16x32_bf16(af, pf, o[dt], 0, 0, 0); } }
            bf16* op = ATTQ + (size_t)(m0 + qi) * 512 + hq * 64 + 4 * g;
#pragma unroll
            for (int dt = 0; dt < 4; ++dt) *(GAS v2u*)(op + 16 * dt) = (v2u){pk2(o[dt][0] * inv, o[dt][1] * inv), pk2(o[dt][2] * inv, o[dt][3] * inv)};
        }
        __syncthreads();
    }
}
constexpr int SC_NS = 32, SC_NP = 16, SC_ARR = 4096, SC_SCL = 9 * SC_ARR, SC_VS = SC_SCL + 512, SC_YB = SC_VS + 4096, SC_BUF = SC_YB + 2048;
struct ScanPre { v2u r0, r1, r2, k0, k1, k2, lw1, lw2, a1, a2; unsigned short vr0, vr1, vr2; };
struct ScanPar { f32x4 mur, muk, kkw, kaw, rkw; float muvr; };
__device__ __forceinline__ ScanPre scan_issue(Frame& F, int bh, int quarter, int t0, int lt) {
    const unsigned char* REC = F.ws + WS_REC; const bf16* RKVL = (const bf16*)(F.ws + WS_RKVL);
    const int pr = lt >> 4, q = lt & 15, b = bh >> 3, h = bh & 7, t1 = t0 + 2 * pr;
    const bf16* row1 = RKVL + (size_t)(b * T + t1) * 1792 + h * 64; const bf16* rowp = row1 - (t1 > 0 ? 1792 : 0); const bf16* row2 = row1 + 1792;
    ScanPre p;
    p.r0 = *(const GAS v2u*)(rowp + 4 * q); p.r1 = *(const GAS v2u*)(row1 + 4 * q); p.r2 = *(const GAS v2u*)(row2 + 4 * q);
    p.k0 = *(const GAS v2u*)(rowp + 512 + 4 * q); p.k1 = *(const GAS v2u*)(row1 + 512 + 4 * q); p.k2 = *(const GAS v2u*)(row2 + 512 + 4 * q);
    const size_t e1 = ((size_t)bh * T + t1) * 128 + (size_t)q * 8;
    p.lw1 = *(const GAS v2u*)(REC + 0 * REC_SLOT + e1); p.lw2 = *(const GAS v2u*)(REC + 0 * REC_SLOT + e1 + 128);
    p.a1 = *(const GAS v2u*)(REC + 4 * REC_SLOT + e1); p.a2 = *(const GAS v2u*)(REC + 4 * REC_SLOT + e1 + 128);
    const int vc = 1024 + 16 * quarter + q; p.vr0 = rowp[vc]; p.vr1 = row1[vc]; p.vr2 = row2[vc];
    if (t1 == 0) { p.r0 = (v2u){0u, 0u}; p.k0 = (v2u){0u, 0u}; p.vr0 = 0; }
    return p;
}
__device__ __forceinline__ void un4(const v2u u, float (&f)[4]) { f[0] = bflo(u.x); f[1] = bfhi(u.x); f[2] = bflo(u.y); f[3] = bfhi(u.y); }
__device__ __forceinline__ void scan_commit(Frame& F, const ScanPre& p, const ScanPar& c, int bh, int quarter, int t0, LAS unsigned char* buf, int lt) {
    const int pr = lt >> 4, q = lt & 15, idx = pr * 16 + q, t1 = t0 + 2 * pr;
    float rA[4], rB[4], rC[4], kA[4], kB[4], kC[4], lw1[4], lw2[4], s1[4], s2[4];
    un4(p.r0, rA); un4(p.r1, rB); un4(p.r2, rC); un4(p.k0, kA); un4(p.k1, kB); un4(p.k2, kC); un4(p.lw1, lw1); un4(p.lw2, lw2); un4(p.a1, s1); un4(p.a2, s2);
    float r1[4], r2[4], k1[4], k2[4], kk1[4], kk2[4]; float n1 = 0.f, n2 = 0.f;
#pragma unroll
    for (int j = 0; j < 4; ++j) { r1[j] = rB[j] + (rA[j] - rB[j]) * c.mur[j]; r2[j] = rC[j] + (rB[j] - rC[j]) * c.mur[j]; k1[j] = kB[j] + (kA[j] - kB[j]) * c.muk[j]; k2[j] = kC[j] + (kB[j] - kC[j]) * c.muk[j];
        kk1[j] = k1[j] * c.kkw[j]; kk2[j] = k2[j] * c.kkw[j]; n1 += kk1[j] * kk1[j]; n2 += kk2[j] * kk2[j]; }
    n1 = row16_sum(n1); n2 = row16_sum(n2);
    const float i1 = __builtin_amdgcn_rsqf(fmaxf(n1, 1e-24f)), i2 = __builtin_amdgcn_rsqf(fmaxf(n2, 1e-24f));
    float a1[4], a2[4], b1[4], b2[4], w1[4], w2[4], z1[4], wa2[4], wz2[4], ww[4], bw[4], kw[4];
    float be1 = 0.f, ka1 = 0.f, bo1 = 0.f, be2 = 0.f, ka2 = 0.f, bo2 = 0.f, ba = 0.f, ka = 0.f, bz = 0.f, kz = 0.f;
#pragma unroll
    for (int j = 0; j < 4; ++j) { kk1[j] *= i1; kk2[j] *= i2; a1[j] = -kk1[j]; a2[j] = -kk2[j]; b1[j] = kk1[j] * s1[j]; b2[j] = kk2[j] * s2[j];
        k1[j] *= 1.0f + (s1[j] - 1.0f) * c.kaw[j]; k2[j] *= 1.0f + (s2[j] - 1.0f) * c.kaw[j];
        w1[j] = __expf(lw1[j]); w2[j] = __expf(lw2[j]); z1[j] = w1[j] * r1[j]; const float z2 = w2[j] * r2[j];
        be1 += b1[j] * r1[j]; ka1 += k1[j] * r1[j]; bo1 += r1[j] * k1[j] * c.rkw[j]; be2 += b2[j] * r2[j]; ka2 += k2[j] * r2[j]; bo2 += r2[j] * k2[j] * c.rkw[j];
        wa2[j] = w1[j] * a2[j]; wz2[j] = w1[j] * z2; ww[j] = w1[j] * w2[j]; bw[j] = b1[j] * w2[j]; kw[j] = k1[j] * w2[j];
        ba += b1[j] * a2[j]; ka += k1[j] * a2[j]; bz += b1[j] * z2; kz += k1[j] * z2; }
    be1 = row16_sum(be1); ka1 = row16_sum(ka1); bo1 = row16_sum(bo1); be2 = row16_sum(be2); ka2 = row16_sum(ka2); bo2 = row16_sum(bo2);
    ba = row16_sum(ba); ka = row16_sum(ka); bz = row16_sum(bz); kz = row16_sum(kz);
    LAS f32x4* A = (LAS f32x4*)buf;
    A[0 * 256 + idx] = (f32x4){a1[0], z1[0], a1[1], z1[1]}; A[1 * 256 + idx] = (f32x4){a1[2], z1[2], a1[3], z1[3]};
    A[2 * 256 + idx] = (f32x4){wa2[0], wz2[0], wa2[1], wz2[1]}; A[3 * 256 + idx] = (f32x4){wa2[2], wz2[2], wa2[3], wz2[3]};
    A[4 * 256 + idx] = (f32x4){ww[0], ww[1], ww[2], ww[3]}; A[5 * 256 + idx] = (f32x4){bw[0], bw[1], bw[2], bw[3]}; A[6 * 256 + idx] = (f32x4){kw[0], kw[1], kw[2], kw[3]};
    A[7 * 256 + idx] = (f32x4){b2[0], b2[1], b2[2], b2[3]}; A[8 * 256 + idx] = (f32x4){k2[0], k2[1], k2[2], k2[3]};
    if (q == 0) { LAS f32x4* S4 = (LAS f32x4*)(buf + SC_SCL); S4[pr * 2] = (f32x4){ba, bz, ka, kz}; S4[pr * 2 + 1] = (f32x4){be1, be2, 0.f, 0.f};
        if (quarter == 0) { f32x4* SC = (f32x4*)(F.ws + WS_SC) + (size_t)bh * T + t1; SC[0] = (f32x4){be1, ka1, bo1, 0.f}; SC[1] = (f32x4){be2, ka2, bo2, 0.f}; } }
    const float vA = bf1(p.vr0), vB = bf1(p.vr1), vC = bf1(p.vr2); const float v1 = vB + (vA - vB) * c.muvr, v2 = vC + (vB - vC) * c.muvr;
    ((LAS f32x4*)(buf + SC_VS))[idx] = (f32x4){v1, v2, v1 * ka1, v2 * ka2};
    bf16* VB = (bf16*)(F.ws + WS_VB) + ((size_t)bh * T + t1) * 64 + 16 * quarter + q; VB[0] = (bf16)f2bf(v1); VB[64] = (bf16)f2bf(v2);
}
__device__ __forceinline__ void scan_flush(Frame& F, int bh, int quarter, int t0, const LAS unsigned char* buf, int lt) {
    if (lt < 128) { const int s = lt >> 2, c4 = lt & 3; const int b = bh >> 3, h = bh & 7;
        float* yraw = (float*)(F.ws + WS_YRAW);
        const LAS float* yb = (const LAS float*)(buf + SC_YB) + ((s >> 1) * 16 + 4 * c4) * 2 + (s & 1);
        const f32x4 y = (f32x4){yb[0], yb[2], yb[4], yb[6]};
        *(GAS f32x4*)(yraw + (size_t)(b * T + t0 + s) * 512 + h * 64 + 16 * quarter + 4 * c4) = y; }
}
__device__ __forceinline__ void p7_scan(Frame& F) {
    const int w = F.wave, tid = fresh_tid(), lane = tid & 63, rl = lane >> 4, q = lane & 15, lt = tid - 256;
    constexpr int NBLK = T / SC_NS;
#define SCAN_BAR() do { asm volatile("s_waitcnt lgkmcnt(0)" ::: "memory"); __builtin_amdgcn_s_barrier(); asm volatile("" ::: "memory"); } while (0)
    for (int unit = F.vcu; unit < 256; unit += F.G) {
        const int bh = unit >> 2, quarter = unit & 3;
        ScanPre pre; ScanPar par;
        if (w >= 4) { const int h = bh & 7, q4 = h * 64 + 4 * (lt & 15);
            par.mur = *(const GAS f32x4*)(F.in7 + q4); par.muk = *(const GAS f32x4*)(F.in7 + 512 + q4); par.kkw = *(const GAS f32x4*)(F.in13 + q4); par.kaw = *(const GAS f32x4*)(F.in14 + q4); par.rkw = *(const GAS f32x4*)(F.in15 + q4);
            par.muvr = F.in7[1024 + h * 64 + 16 * quarter + (lt & 15)];
            pre = scan_issue(F, bh, quarter, 0, lt); scan_commit(F, pre, par, bh, quarter, 0, F.lds, lt); pre = scan_issue(F, bh, quarter, SC_NS, lt); }
        SCAN_BAR();
        f32x2 S01 = (f32x2){0.f, 0.f}, S23 = (f32x2){0.f, 0.f};
        for (int nb = 0; nb < NBLK; ++nb) {
            LAS unsigned char* cur = F.lds + (nb & 1) * SC_BUF; LAS unsigned char* oth = F.lds + ((nb + 1) & 1) * SC_BUF;
            if (w >= 4) {
                if (nb > 0) scan_flush(F, bh, quarter, (nb - 1) * SC_NS, oth, lt);
                if (nb + 1 < NBLK) scan_commit(F, pre, par, bh, quarter, (nb + 1) * SC_NS, oth, lt);
                if (nb + 2 < NBLK) pre = scan_issue(F, bh, quarter, (nb + 2) * SC_NS, lt);
            } else {
                const LAS f32x4* A = (const LAS f32x4*)cur + q; const LAS f32x4* SCL = (const LAS f32x4*)(cur + SC_SCL);
                const int rowl = 4 * w + rl; const LAS f32x4* VS = (const LAS f32x4*)(cur + SC_VS) + rowl; LAS f32x2* YB = (LAS f32x2*)(cur + SC_YB) + rowl;
                f32x4 az1a = A[0], az1b = A[256], az2a = A[512], az2b = A[768], ww = A[1024], b1 = A[1280], k1 = A[1536], b2 = A[1792], k2 = A[2048], c0 = SCL[0], vs = VS[0]; f32x2 c1 = *(const LAS f32x2*)(SCL + 1);
#pragma unroll 4
                for (int pr = 0; pr < SC_NP; ++pr) {
                    const int pn = (pr + 1) * 16;
                    const f32x4 n_az1a = A[pn], n_az1b = A[256 + pn], n_az2a = A[512 + pn], n_az2b = A[768 + pn], n_ww = A[1024 + pn], n_b1 = A[1280 + pn], n_k1 = A[1536 + pn], n_b2 = A[1792 + pn], n_k2 = A[2048 + pn],
                                n_c0 = SCL[2 * pr + 2], n_vs = VS[pn]; const f32x2 n_c1 = *(const LAS f32x2*)(SCL + 2 * pr + 3);
                    __builtin_amdgcn_sched_barrier(0);
                    f32x2 d1 = S01.xx * az1a.xy; d1 = S01.yy * az1a.zw + d1; d1 = S23.xx * az1b.xy + d1; d1 = S23.yy * az1b.zw + d1;
                    f32x2 d2 = S01.xx * az2a.xy; d2 = S01.yy * az2a.zw + d2; d2 = S23.xx * az2b.xy + d2; d2 = S23.yy * az2b.zw + d2;
                    f32x2 t01 = S01 * ww.xy; t01 = vs.xx * k1.xy + t01; t01 = vs.yy * k2.xy + t01;
                    f32x2 t23 = S23 * ww.zw; t23 = vs.xx * k1.zw + t23; t23 = vs.yy * k2.zw + t23;
                    float e0 = d1.x, e1 = d1.y, e2 = d2.x, e3 = d2.y;
#define SCAN_DPP4(ctrl) "v_add_f32_dpp %0, %0, %0 " ctrl " row_mask:0xf bank_mask:0xf\n\tv_add_f32_dpp %1, %1, %1 " ctrl " row_mask:0xf bank_mask:0xf\n\tv_add_f32_dpp %2, %2, %2 " ctrl " row_mask:0xf bank_mask:0xf\n\tv_add_f32_dpp %3, %3, %3 " ctrl " row_mask:0xf bank_mask:0xf\n\t"
                    asm volatile("s_nop 1\n\t" SCAN_DPP4("quad_perm:[1,0,3,2]") SCAN_DPP4("quad_perm:[2,3,0,1]") SCAN_DPP4("row_half_mirror") SCAN_DPP4("row_mirror") : "+v"(e0), "+v"(e1), "+v"(e2), "+v"(e3));
#undef SCAN_DPP4
                    const float sa1 = e0, z1 = e1, p2 = e2, q2 = e3;
                    f32x2 r2 = (f32x2){p2, q2}; r2 = (f32x2){sa1, sa1} * c0.xy + r2; r2 = vs.xx * c0.zw + r2;
                    const f32x2 sa12 = (f32x2){sa1, r2.x};
                    S01 = sa12.xx * b1.xy + t01; S01 = sa12.yy * b2.xy + S01;
                    S23 = sa12.xx * b1.zw + t23; S23 = sa12.yy * b2.zw + S23;
                    YB[pr * 16] = sa12 * c1 + ((f32x2){z1, r2.y} + vs.zw);
                    az1a = n_az1a; az1b = n_az1b; az2a = n_az2a; az2b = n_az2b; ww = n_ww; b1 = n_b1; k1 = n_k1; b2 = n_b2; k2 = n_k2; c0 = n_c0; c1 = n_c1; vs = n_vs;
                }
            }
            SCAN_BAR();
        }
        if (w >= 4) scan_flush(F, bh, quarter, T - SC_NS, F.lds + ((NBLK - 1) & 1) * SC_BUF, lt);
        asm volatile("s_waitcnt vmcnt(0)" ::: "memory"); SCAN_BAR();
    }
#undef SCAN_BAR
}
__device__ __forceinline__ void p8_post(Frame& F) {
    const float* yraw = (const float*)(F.ws + WS_YRAW); const bf16* RV = (const bf16*)(F.ws + WS_VB); const f32x4* SC = (const f32x4*)(F.ws + WS_SC);
    const bf16* Gt = (const bf16*)(F.ws + WS_G); bf16* YR = (bf16*)(F.ws + WS_YR);
    const int gw = F.vcu * NWAVES + F.wave, NGW = F.G * NWAVES, lane = fresh_tid() & 63, h = lane >> 3, c0 = 8 * lane, n0 = 8 * (lane & 7);
    float lw[8], lb[8]; ld8f(F.in16 + c0, lw); ld8f(F.in17 + c0, lb);
    for (int m0 = gw; m0 < M; m0 += 2 * NGW) {
        float yv[2][8]; v4u uvv[2], ugg[2]; f32x4 scv[2];
#pragma unroll
        for (int rr = 0; rr < 2; ++rr) { const int m = m0 + rr * NGW, b = m >> 12, t = m & (T - 1); const size_t rt = (size_t)(b * 8 + h) * T + t;
            ld8f(yraw + (size_t)m * 512 + c0, yv[rr]); uvv[rr] = *(const GAS v4u*)(RV + rt * 64 + n0); ugg[rr] = *(const GAS v4u*)(Gt + (size_t)m * 512 + c0); scv[rr] = *(const GAS f32x4*)(SC + rt); }
#pragma unroll
        for (int rr = 0; rr < 2; ++rr) { const int m = m0 + rr * NGW; const float bonus = scv[rr].z;
            float v[8], g[8]; unpack8(uvv[rr], v); unpack8(ugg[rr], g);
            float s1 = 0.f;
#pragma unroll
            for (int j = 0; j < 8; ++j) s1 += yv[rr][j];
            const float mean = sum8(s1) * (1.0f / 64.0f); float s2 = 0.f;
#pragma unroll
            for (int j = 0; j < 8; ++j) { yv[rr][j] -= mean; s2 += yv[rr][j] * yv[rr][j]; }
            const float rstd = __builtin_amdgcn_rsqf(sum8(s2) * (1.0f / 64.0f) + GN_EPS);
            float o[8];
#pragma unroll
            for (int j = 0; j < 8; ++j) o[j] = (yv[rr][j] * rstd * lw[j] + lb[j] + bonus * v[j]) * g[j];
            *(GAS v4u*)(YR + (size_t)m * 512 + c0) = pack8u(o); }
    }
}
__device__ __forceinline__ void p13_final(Frame& F) {
    const float* part = (const float*)(F.ws + WS_PART + 3 * 2 * MiB); const float* gn = F.in28;
    const int gw = F.vcu * NWAVES + F.wave, NGW = F.G * NWAVES, lane = fresh_tid() & 63;
    f32x4 g4[4];
#pragma unroll
    for (int j = 0; j < 4; ++j) g4[j] = ((const GAS f32x4*)gn)[lane + 64 * j];
    for (int m0 = gw; m0 < M; m0 += 4 * NGW) { f32x4 v[4][4]; float ps[4];
#pragma unroll
        for (int r = 0; r < 4; ++r) { const int m = m0 + r * NGW; ps[r] = 0.f; if (m < M) { GAS f32x4* xr = (GAS f32x4*)(F.out + (size_t)m * D) + lane; ps[r] = lane < 16 ? part[(size_t)m * 16 + lane] : 0.f;
#pragma unroll
            for (int j = 0; j < 4; ++j) v[r][j] = xr[64 * j]; } }
#pragma unroll
        for (int r = 0; r < 4; ++r) { const int m = m0 + r * NGW; if (m < M) { const float rs = 1.0f / sqrtf(wave_sum(ps[r]) * (1.0f / 1024.0f) + RMS_EPS);
            GAS f32x4* xr = (GAS f32x4*)(F.out + (size_t)m * D) + lane;
#pragma unroll
            for (int j = 0; j < 4; ++j) xr[64 * j] = v[r][j] * rs * g4[j]; } }
    }
}
struct Args { const float* in[29]; float* out; unsigned char* ws; };
__global__ void __launch_bounds__(NWAVES * 64, 2) fwd_megakernel(Args args) {
    extern __shared__ __attribute__((aligned(16))) unsigned char lds[];
    cg::grid_group grid = cg::this_grid();
    Frame F;
    F.lds = (LAS unsigned char*)lds;
    F.tid = threadIdx.x; F.lane = F.tid & 63; F.wave = __builtin_amdgcn_readfirstlane(F.tid >> 6);
    F.G = gridDim.x; { const int bx = blockIdx.x; F.vcu = (F.G % 8 == 0) ? (bx % 8) * (F.G / 8) + bx / 8 : bx; }
F.in0 = args.in[0]; F.in1 = args.in[1]; F.in2 = args.in[2]; F.in3 = args.in[3]; F.in4 = args.in[4]; F.in5 = args.in[5]; F.in6 = args.in[6]; F.in7 = args.in[7]; F.in8 = args.in[8]; F.in9 = args.in[9]; F.in10 = args.in[10]; F.in11 = args.in[11]; F.in12 = args.in[12]; F.in13 = args.in[13]; F.in14 = args.in[14]; F.in15 = args.in[15]; F.in16 = args.in[16]; F.in17 = args.in[17]; F.in18 = args.in[18]; F.in19 = args.in[19]; F.in20 = args.in[20]; F.in21 = args.in[21]; F.in22 = args.in[22]; F.in23 = args.in[23]; F.in24 = args.in[24]; F.in25 = args.in[25]; F.in26 = args.in[26]; F.in27 = args.in[27]; F.in28 = args.in[28];
    F.out = args.out; F.ws = args.ws;
    unsigned char* ws = args.ws;
    bf16* XB = (bf16*)(ws + WS_XB); bf16* HB = (bf16*)(ws + WS_H);
    float* PA = (float*)(ws + WS_PART); float* PB = PA + (size_t)M * 16; float* PC = PB + (size_t)M * 16; float* PD = PC + (size_t)M * 16;
    using pg8::gemm_phase; using pg8::StaticOrder; using pg8::Gemm;
    volatile LAS unsigned* bst = (volatile LAS unsigned*)(F.lds + RING_BYTES);
    if (F.tid == 0) { bst[0] = 0u; bst[1] = 0u; }
    __syncthreads();
    XcdBarrier bar = xcd_barrier_post((unsigned*)ws, bst);
#define SYNC() xcd_barrier(bar)
#define RUN_GEMM(EPI, Aptr, Bptr, NN, KK, ...) do { Gemm g_{(const pg8::bf16_t*)(Aptr), (const pg8::bf16_t*)(Bptr), M, (NN), (KK)}; StaticOrder S_; S_.init(M, (NN), F.G, (int)blockIdx.x); \
        pg8::EPI E_{__VA_ARGS__}; gemm_phase<pg8::EPI, StaticOrder, true, true>(F.lds, g_, S_, E_); } while (0)

    p0_prologue(F); SYNC();
    { const pg8::RsTab tb = fill_rstd(F, PA, 2 * FF); RUN_GEMM(EpiGU, XB, ws + WS_WGU1, 2 * FF, D, tb, F.lds, HB, PA); } grid.sync();
    RUN_GEMM(EpiRes, HB, ws + WS_WDN1, D, FF, F.in0, F.out, XB, PB, 0.5f); SYNC();
    { const pg8::RsTab tb = fill_rstd(F, PB, 2560); RUN_GEMM(EpiProj, XB, ws + WS_WIN, 2560, D, tb, F.lds, (bf16*)(ws + WS_RKVL), (bf16*)(ws + WS_ATTQ), (bf16*)(ws + WS_ATTKV), PB); } SYNC();
    p4_lora_in(F); p6_attention(F); SYNC();
    RUN_GEMM(EpiLora, ws + WS_LA, ws + WS_WLO, 1024, 128, (bf16*)(ws + WS_REC), (bf16*)(ws + WS_REC + 4 * REC_SLOT), (bf16*)(ws + WS_G), F.in8, F.in10, 0);
    RUN_GEMM(EpiLora, ws + WS_LA + (size_t)M * 128 * 2, ws + WS_WLO + 1024 * 128 * 2, 512, 128, (bf16*)(ws + WS_REC), (bf16*)(ws + WS_REC + 4 * REC_SLOT), (bf16*)(ws + WS_G), F.in8, F.in10, 2); SYNC();
    p7_scan(F); SYNC();
    p8_post(F);
    { const pg8::RsTab tb = fill_rstd(F, PB, 2048); RUN_GEMM(EpiGate, XB, ws + WS_WGT, 2048, D, tb, F.lds, (bf16*)(ws + WS_GATES), PB); } SYNC();
    RUN_GEMM(EpiBranch, ws + WS_YR, ws + WS_WBR, D, 512, (const bf16*)(ws + WS_GATES), (bf16*)(ws + WS_MERGED), 0, 0);
    RUN_GEMM(EpiBranch, ws + WS_ATTQ, ws + WS_WBA, D, 512, (const bf16*)(ws + WS_GATES), (bf16*)(ws + WS_MERGED), 1024, 1); SYNC();
    RUN_GEMM(EpiRes, ws + WS_MERGED, ws + WS_WOUT, D, D, F.out, F.out, XB, PC, 1.0f); SYNC();
    { const pg8::RsTab tb = fill_rstd(F, PC, 2 * FF); RUN_GEMM(EpiGU, XB, ws + WS_WGU2, 2 * FF, D, tb, F.lds, HB, PC); } SYNC();
    RUN_GEMM(EpiResNorm, HB, ws + WS_WDN2, D, FF, F.out, F.out, F.in28, (float*)(ws + WS_SC), (unsigned*)(ws + 32768), F.lds, 0.5f);
}

extern "C" void kernel_launch(void* const* d_in, const int* in_sizes, int n_in, void* d_out, int out_size, void* d_ws, size_t ws_size, hipStream_t stream) {
    static int grid = 0;
    if (grid == 0) {
        if (n_in != 29 || in_sizes[0] != M * D || out_size != M * D || ws_size < WS_END) { fprintf(stderr, "kernel_launch: unexpected shapes (n_in %d, ws %zu)\n", n_in, ws_size); grid = -1; return; }
        int dev = 0, cus = 0, per_cu = 0;
        hipGetDevice(&dev); hipDeviceGetAttribute(&cus, hipDeviceAttributeMultiprocessorCount, dev);
        if (hipFuncSetAttribute((const void*)fwd_megakernel, hipFuncAttributeMaxDynamicSharedMemorySize, LDS_BYTES) != hipSuccess) { fprintf(stderr, "kernel_launch: hipFuncSetAttribute failed\n"); grid = -1; return; }
        hipOccupancyMaxActiveBlocksPerMultiprocessor(&per_cu, (const void*)fwd_megakernel, NWAVES * 64, LDS_BYTES);
        (void)hipGetLastError();
        if (per_cu < 1) fprintf(stderr, "kernel_launch: occupancy query says %d blocks/CU\n", per_cu);
        grid = cus;
    }
    if (grid < 0) return;
    if (hipMemsetAsync(d_ws, 0, 65536, stream) != hipSuccess) { fprintf(stderr, "kernel_launch: memset failed\n"); return; }
    Args a{};
    for (int i = 0; i < 29; ++i) a.in[i] = (const float*)d_in[i];
    a.out = (float*)d_out; a.ws = (unsigned char*)d_ws;
    void* kargs[] = {&a};
    hipError_t e = hipLaunchCooperativeKernel((const void*)fwd_megakernel, dim3(grid), dim3(NWAVES * 64), kargs, LDS_BYTES, stream);
    if (e != hipSuccess) fprintf(stderr, "kernel_launch: cooperative launch failed: %s (grid %d)\n", hipGetErrorString(e), grid);
}
```

```cpp
#include <hip/hip_runtime.h>
#include <hip/hip_cooperative_groups.h>
#include <cstdio>
#include <cstdint>
namespace cg = cooperative_groups;
namespace pg8 {
#define PG8_LAS __attribute__((address_space(3)))
typedef unsigned short bf16_t;
typedef short bf16x8 __attribute__((ext_vector_type(8)));
typedef float f32x4 __attribute__((ext_vector_type(4)));
typedef unsigned u32x4 __attribute__((ext_vector_type(4)));
constexpr int BM = 256, BK = 64, HALF = 128, HTB = HALF * BK * 2  , STAGE_BYTES = 8 * HTB, NXCD = 8, WGM = 8;

__host__ __device__ __forceinline__ int lds_byte(int r, int c) { const int st = (r >> 4) * 2 + (c >> 5), rr = r & 15, cc = c & 31, ob = rr * 64 + cc * 2; return st * 1024 + (ob ^ (((ob >> 9) & 1) << 5)); }
__host__ __device__ __forceinline__ void stage_rc(int b, int& R, int& C) { const int st = b / 1024, sb = b % 1024, swz = sb ^ (((sb >> 9) & 1) << 5); R = (st >> 1) * 16 + swz / 64; C = (st & 1) * 32 + (swz % 64) / 2; }
__host__ __device__ __forceinline__ int perm32(int rho) { const int n = rho >> 4, i = rho & 15; return 8 * (i >> 2) + 4 * n + (i & 3); }

struct Unit { int pm, pn; };
struct Gemm { const bf16_t* A; const bf16_t* Bt; int M, N, K; };

struct StaticOrder {
    int nM, nN, nwg, G, c;
    __host__ __device__ void init(int M, int N, int G_, int c_) { nM = M / BM; nN = N / BM; nwg = nM * nN; G = G_; c = c_; }
    __host__ __device__ bool next(int i, Unit& u) const {
        const long L = (long)i * G + c; if (L >= nwg) return false;
        int wgid = (int)L; { const int q = nwg / NXCD, r = nwg % NXCD, xcd = wgid % NXCD, off = wgid / NXCD; wgid = (xcd < r ? xcd * (q + 1) : r * (q + 1) + (xcd - r) * q) + off; }
        const int nig = WGM * nN, gid = wgid / nig, fm = gid * WGM, gsz = (nM - fm) < WGM ? (nM - fm) : WGM;
        u.pm = fm + ((wgid % nig) % gsz); u.pn = (wgid % nig) / gsz; return true;
    }
    __device__ __forceinline__ void a_ready(const Unit&) const {}
    __device__ __forceinline__ void done(const Unit&) const {}
};

__device__ __forceinline__ unsigned cvt_pk_bf16(float lo, float hi) { unsigned r; asm volatile("v_cvt_pk_bf16_f32 %0, %1, %2" : "=v"(r) : "v"(lo), "v"(hi)); return r; }
__device__ __forceinline__ u32x4 pack8(f32x4 v0, f32x4 v1) {
    u32x4 w;
    asm volatile("s_nop 1\n\tv_cvt_pk_bf16_f32 %0, %4, %5\n\tv_cvt_pk_bf16_f32 %1, %6, %7\n\tv_cvt_pk_bf16_f32 %2, %8, %9\n\tv_cvt_pk_bf16_f32 %3, %10, %11"
                 : "=&v"(w.x), "=&v"(w.y), "=&v"(w.z), "=&v"(w.w)
                 : "v"(v0[0]), "v"(v0[1]), "v"(v0[2]), "v"(v0[3]), "v"(v1[0]), "v"(v1[1]), "v"(v1[2]), "v"(v1[3]));
    return w;
}
__device__ __forceinline__ float bf_lo(unsigned u) { return __uint_as_float(u << 16); }
__device__ __forceinline__ float bf_hi(unsigned u) { return __uint_as_float(u & 0xffff0000u); }
constexpr int RS_TAB_OFF = 131072 + 64;
struct RsTab { int pm[4]; };
__device__ __forceinline__ void rows_rstd(const RsTab& tb, PG8_LAS unsigned char* lds, const Unit& u, int wr, int fr, float (&rs)[2][4]) {
    const int slot = u.pm == tb.pm[0] ? 0 : (u.pm == tb.pm[1] ? 1 : (u.pm == tb.pm[2] ? 2 : 3));
    const PG8_LAS float* t = (const PG8_LAS float*)(lds + RS_TAB_OFF) + slot * 256 + wr * 64 + fr;
#pragma unroll
    for (int ai = 0; ai < 2; ++ai)
#pragma unroll
        for (int m = 0; m < 4; ++m) rs[ai][m] = t[ai * HALF + m * 16];
}
__device__ __forceinline__ float fexp_(float x) { return __builtin_amdgcn_exp2f(x * 1.44269504089f); }
__device__ __forceinline__ float sigmoidf_(float x) { return __builtin_amdgcn_rcpf(1.0f + fexp_(-x)); }

struct EpiGU {
    static constexpr bool PERM = true, AFTER_DRAIN = false;
    RsTab tb; PG8_LAS unsigned char* lds;
    bf16_t* H; const float* part;
    __device__ __forceinline__ void operator()(const f32x4 (&acc)[2][2][4][2], const Unit& u, int wr, int wc, int fr, int fq) const {
        const int row0 = u.pm * BM + wr * 64 + fr, col0 = u.pn * 128 + wc * 32 + 8 * fq;
        float rsv[2][4]; rows_rstd(tb, lds, u, wr, fr, rsv);
#pragma unroll
        for (int ai = 0; ai < 2; ++ai)
#pragma unroll
            for (int m = 0; m < 4; ++m) { const int row = row0 + ai * HALF + m * 16; const float rs = rsv[ai][m];
                f32x4 h0, h1;
#pragma unroll
                for (int j = 0; j < 4; ++j) { const float g0 = acc[ai][0][m][0][j] * rs, u0 = acc[ai][1][m][0][j] * rs, g1 = acc[ai][0][m][1][j] * rs, u1 = acc[ai][1][m][1][j] * rs;
                    h0[j] = g0 * u0 * __builtin_amdgcn_rcpf(1.0f + fexp_(-g0)); h1[j] = g1 * u1 * __builtin_amdgcn_rcpf(1.0f + fexp_(-g1)); }
                *(u32x4*)(H + (size_t)row * 2816 + col0) = pack8(h0, h1); asm volatile("" ::: "memory"); }
    }
};
struct EpiRes {
    static constexpr bool PERM = true, AFTER_DRAIN = false;
    const float* xin; float* xout; bf16_t* xb; float* part; float alpha;
    __device__ __forceinline__ void operator()(const f32x4 (&acc)[2][2][4][2], const Unit& u, int wr, int wc, int fr, int fq) const {
        const int row0 = u.pm * BM + wr * 64 + fr, col0 = u.pn * BM + wc * 32 + 8 * fq;
#pragma unroll
        for (int ai = 0; ai < 2; ++ai) {
            f32x4 rv[4][2][2];
#pragma unroll
            for (int m = 0; m < 4; ++m)
#pragma unroll
                for (int bj = 0; bj < 2; ++bj) { const size_t off = (size_t)(row0 + ai * HALF + m * 16) * 1024 + col0 + bj * HALF; rv[m][bj][0] = *(const f32x4*)(xin + off); rv[m][bj][1] = *(const f32x4*)(xin + off + 4); }
            asm volatile("" ::: "memory");
#pragma unroll
            for (int m = 0; m < 4; ++m) { const int row = row0 + ai * HALF + m * 16; float ss = 0.f;
#pragma unroll
                for (int bj = 0; bj < 2; ++bj) { const size_t off = (size_t)row * 1024 + col0 + bj * HALF;
                    const f32x4 v0 = rv[m][bj][0] + acc[ai][bj][m][0] * alpha, v1 = rv[m][bj][1] + acc[ai][bj][m][1] * alpha;
                    *(f32x4*)(xout + off) = v0; *(f32x4*)(xout + off + 4) = v1;
                    if (xb) *(u32x4*)(xb + off) = pack8(v0, v1);
                    ss += (v0[0] * v0[0] + v0[1] * v0[1]) + (v0[2] * v0[2] + v0[3] * v0[3]) + (v1[0] * v1[0] + v1[1] * v1[1]) + (v1[2] * v1[2] + v1[3] * v1[3]); }
                ss += __shfl_xor(ss, 16); ss += __shfl_xor(ss, 32);
                if (fq == 0) part[(size_t)row * 16 + u.pn * 4 + wc] = ss; }
            asm volatile("" ::: "memory"); }
    }
};
constexpr int XT_OFF = 131072 + 64 + 4096;
struct EpiResNorm {
    static constexpr bool PERM = true, AFTER_DRAIN = false;
    const float* xin; float* xout; const float* gain; float* xslot; unsigned* cnt; PG8_LAS unsigned char* lds; float alpha;
    __device__ __forceinline__ void operator()(const f32x4 (&acc_)[2][2][4][2], const Unit& u, int wr, int wc, int fr, int fq) const {
        f32x4 (&acc)[2][2][4][2] = const_cast<f32x4 (&)[2][2][4][2]>(acc_);
        PG8_LAS float* Pt = (PG8_LAS float*)(lds + XT_OFF); PG8_LAS float* St = Pt + 1024;
        const int tid = threadIdx.x, lane = tid & 63, wid = tid >> 6;
        const int row0 = u.pm * BM + wr * 64 + fr, col0 = u.pn * BM + wc * 32 + 8 * fq;
#pragma unroll
        for (int ai = 0; ai < 2; ++ai) {
            f32x4 rv[4][2][2];
#pragma unroll
            for (int m = 0; m < 4; ++m)
#pragma unroll
                for (int bj = 0; bj < 2; ++bj) { const size_t off = (size_t)(row0 + ai * HALF + m * 16) * 1024 + col0 + bj * HALF; rv[m][bj][0] = *(const f32x4*)(xin + off); rv[m][bj][1] = *(const f32x4*)(xin + off + 4); }
            asm volatile("" ::: "memory");
#pragma unroll
            for (int m = 0; m < 4; ++m) { float ss = 0.f;
#pragma unroll
                for (int bj = 0; bj < 2; ++bj) {
                    const f32x4 v0 = rv[m][bj][0] + acc[ai][bj][m][0] * alpha, v1 = rv[m][bj][1] + acc[ai][bj][m][1] * alpha;
                    acc[ai][bj][m][0] = v0; acc[ai][bj][m][1] = v1;
                    ss += (v0[0] * v0[0] + v0[1] * v0[1]) + (v0[2] * v0[2] + v0[3] * v0[3]) + (v1[0] * v1[0] + v1[1] * v1[1]) + (v1[2] * v1[2] + v1[3] * v1[3]); }
                ss += __shfl_xor(ss, 16); ss += __shfl_xor(ss, 32);
                if (fq == 0) Pt[(ai * HALF + wr * 64 + m * 16 + fr) * 4 + wc] = ss; }
            asm volatile("" ::: "memory"); }
        asm volatile("s_waitcnt lgkmcnt(0)" ::: "memory"); __builtin_amdgcn_s_barrier(); asm volatile("" ::: "memory");
        if (tid < 256) { const float ts = (Pt[tid * 4 + 0] + Pt[tid * 4 + 1]) + (Pt[tid * 4 + 2] + Pt[tid * 4 + 3]);
            __hip_atomic_store(xslot + ((size_t)(u.pm * BM + tid) * 4 + u.pn), ts, __ATOMIC_RELAXED, __HIP_MEMORY_SCOPE_AGENT); }
        asm volatile("s_waitcnt vmcnt(0)" ::: "memory");
        if (lane == 0) __hip_atomic_fetch_add(cnt + 64 * u.pm, 1u, __ATOMIC_RELAXED, __HIP_MEMORY_SCOPE_AGENT);
        if (wid == 0) { unsigned sp = 0;
            while ((unsigned)__builtin_amdgcn_readfirstlane(__hip_atomic_load(cnt + 64 * u.pm, __ATOMIC_RELAXED, __HIP_MEMORY_SCOPE_AGENT)) < 32u) { __builtin_amdgcn_s_sleep(2); if (++sp > (1u << 18)) break; }
            __builtin_amdgcn_fence(__ATOMIC_ACQUIRE, "agent"); }
        asm volatile("s_waitcnt vmcnt(0) lgkmcnt(0)" ::: "memory"); __builtin_amdgcn_s_barrier(); asm volatile("" ::: "memory");
        if (tid < 256) { const float* sl = xslot + (size_t)(u.pm * BM + tid) * 4; float tot = 0.f;
#pragma unroll
            for (int t = 0; t < 4; ++t) tot += __hip_atomic_load(sl + t, __ATOMIC_RELAXED, __HIP_MEMORY_SCOPE_AGENT);
            St[tid] = __builtin_amdgcn_rsqf(tot * (1.0f / 1024.0f) + 1e-6f); }
        asm volatile("s_waitcnt vmcnt(0) lgkmcnt(0)" ::: "memory"); __builtin_amdgcn_s_barrier(); asm volatile("" ::: "memory");
        f32x4 g[2][2];
#pragma unroll
        for (int bj = 0; bj < 2; ++bj) { g[bj][0] = *(const f32x4*)(gain + col0 + bj * HALF); g[bj][1] = *(const f32x4*)(gain + col0 + bj * HALF + 4); }
#pragma unroll
        for (int ai = 0; ai < 2; ++ai)
#pragma unroll
            for (int m = 0; m < 4; ++m) { const int rl = ai * HALF + wr * 64 + m * 16 + fr; const float rs = St[rl];
#pragma unroll
                for (int bj = 0; bj < 2; ++bj) { const size_t off = (size_t)(u.pm * BM + rl) * 1024 + col0 + bj * HALF;
                    *(f32x4*)(xout + off) = acc[ai][bj][m][0] * rs * g[bj][0]; *(f32x4*)(xout + off + 4) = acc[ai][bj][m][1] * rs * g[bj][1]; } }
    }
};
struct EpiProj {
    static constexpr bool PERM = true, AFTER_DRAIN = false;
    RsTab tb; PG8_LAS unsigned char* lds;
    bf16_t* rkvl; bf16_t* attq; bf16_t* attkv; const float* part;
    __device__ __forceinline__ void operator()(const f32x4 (&acc)[2][2][4][2], const Unit& u, int wr, int wc, int fr, int fq) const {
        bf16_t* base; int ldc, colt;
        if (u.pn < 7) { base = rkvl; ldc = 1792; colt = u.pn * BM; } else if (u.pn < 9) { base = attq; ldc = 512; colt = (u.pn - 7) * BM; } else { base = attkv; ldc = 256; colt = 0; }
        const int row0 = u.pm * BM + wr * 64 + fr, col0 = colt + wc * 32 + 8 * fq;
        float rsv[2][4]; rows_rstd(tb, lds, u, wr, fr, rsv);
#pragma unroll
        for (int ai = 0; ai < 2; ++ai)
#pragma unroll
            for (int m = 0; m < 4; ++m) { const int row = row0 + ai * HALF + m * 16; const float rs = rsv[ai][m];
#pragma unroll
                for (int bj = 0; bj < 2; ++bj) *(u32x4*)(base + (size_t)row * ldc + col0 + bj * HALF) = pack8(acc[ai][bj][m][0] * rs, acc[ai][bj][m][1] * rs); }
    }
};
struct EpiGate {
    static constexpr bool PERM = true, AFTER_DRAIN = false;
    RsTab tb; PG8_LAS unsigned char* lds;
    bf16_t* gates; const float* part;
    __device__ __forceinline__ void operator()(const f32x4 (&acc)[2][2][4][2], const Unit& u, int wr, int wc, int fr, int fq) const {
        const int row0 = u.pm * BM + wr * 64 + fr, col0 = u.pn * BM + wc * 32 + 8 * fq;
        float rsv[2][4]; rows_rstd(tb, lds, u, wr, fr, rsv);
#pragma unroll
        for (int ai = 0; ai < 2; ++ai)
#pragma unroll
            for (int m = 0; m < 4; ++m) { const int row = row0 + ai * HALF + m * 16; const float rs = rsv[ai][m];
#pragma unroll
                for (int bj = 0; bj < 2; ++bj) { f32x4 v0, v1;
#pragma unroll
                    for (int j = 0; j < 4; ++j) { v0[j] = sigmoidf_(acc[ai][bj][m][0][j] * rs); v1[j] = sigmoidf_(acc[ai][bj][m][1][j] * rs); }
                    *(u32x4*)(gates + (size_t)row * 2048 + col0 + bj * HALF) = pack8(v0, v1); } }
    }
};
struct EpiLora {
    static constexpr bool PERM = true, AFTER_DRAIN = false;
    bf16_t* rec_lw; bf16_t* rec_a; bf16_t* g; const float* w0; const float* a0; int kind_base;
    template <int KIND> __device__ __forceinline__ void body(const f32x4 (&acc)[2][2][4][2], const Unit& u, int wr, int wc, int fr, int fq) const {
        const int row0 = u.pm * BM + wr * 64 + fr, col0 = (u.pn & 1) * BM + wc * 32 + 8 * fq;
#pragma unroll
        for (int ai = 0; ai < 2; ++ai)
#pragma unroll
            for (int m = 0; m < 4; ++m) { const int row = row0 + ai * HALF + m * 16; const int b = row >> 12, t = row & 4095;
#pragma unroll
                for (int bj = 0; bj < 2; ++bj) { const int c = col0 + bj * HALF; f32x4 v0 = acc[ai][bj][m][0], v1 = acc[ai][bj][m][1];
                    if (KIND != 2) { const float* bias = (KIND == 0 ? w0 : a0) + c; v0 = v0 + *(const f32x4*)bias; v1 = v1 + *(const f32x4*)(bias + 4); }
                    if (KIND == 2) { *(u32x4*)(g + (size_t)row * 512 + c) = pack8(v0, v1); }
                    else {
#pragma unroll
                        for (int j = 0; j < 4; ++j) {
                            if (KIND == 0) { v0[j] = -0.60653065971263342f * sigmoidf_(v0[j]); v1[j] = -0.60653065971263342f * sigmoidf_(v1[j]); }
                            else { v0[j] = sigmoidf_(v0[j]); v1[j] = sigmoidf_(v1[j]); } }
                        bf16_t* dst = (KIND == 0 ? rec_lw : rec_a) + ((size_t)((b * 8 + (c >> 6)) * 4096 + t)) * 64 + (c & 63);
                        *(u32x4*)dst = pack8(v0, v1); } }
                asm volatile("" ::: "memory"); }
    }
    __device__ __forceinline__ void operator()(const f32x4 (&acc)[2][2][4][2], const Unit& u, int wr, int wc, int fr, int fq) const {
        const int kind = kind_base + (u.pn >> 1);
        if (kind == 0) body<0>(acc, u, wr, wc, fr, fq); else if (kind == 1) body<1>(acc, u, wr, wc, fr, fq); else body<2>(acc, u, wr, wc, fr, fq);
    }
};
struct EpiBranch {
    static constexpr bool PERM = true, AFTER_DRAIN = false;
    const bf16_t* gates; bf16_t* merged; int goff; int accum;
    __device__ __forceinline__ void operator()(const f32x4 (&acc)[2][2][4][2], const Unit& u, int wr, int wc, int fr, int fq) const {
        const int row0 = u.pm * BM + wr * 64 + fr, col0 = u.pn * BM + wc * 32 + 8 * fq;
#pragma unroll
        for (int ai = 0; ai < 2; ++ai) {
            u32x4 gq[4][2], pq[4][2];
#pragma unroll
            for (int m = 0; m < 4; ++m)
#pragma unroll
                for (int bj = 0; bj < 2; ++bj) { const int row = row0 + ai * HALF + m * 16, c = col0 + bj * HALF;
                    gq[m][bj] = *(const u32x4*)(gates + (size_t)row * 2048 + goff + c);
                    pq[m][bj] = accum ? *(const u32x4*)(merged + (size_t)row * 1024 + c) : (u32x4){0u, 0u, 0u, 0u}; }
            asm volatile("" ::: "memory");
#pragma unroll
            for (int m = 0; m < 4; ++m)
#pragma unroll
                for (int bj = 0; bj < 2; ++bj) { const int row = row0 + ai * HALF + m * 16, c = col0 + bj * HALF; const u32x4 g4 = gq[m][bj], p4 = pq[m][bj];
                    f32x4 v0 = acc[ai][bj][m][0], v1 = acc[ai][bj][m][1];
                    v0[0] = v0[0] * bf_lo(g4.x) + bf_lo(p4.x); v0[1] = v0[1] * bf_hi(g4.x) + bf_hi(p4.x); v0[2] = v0[2] * bf_lo(g4.y) + bf_lo(p4.y); v0[3] = v0[3] * bf_hi(g4.y) + bf_hi(p4.y);
                    v1[0] = v1[0] * bf_lo(g4.z) + bf_lo(p4.z); v1[1] = v1[1] * bf_hi(g4.z) + bf_hi(p4.z); v1[2] = v1[2] * bf_lo(g4.w) + bf_lo(p4.w); v1[3] = v1[3] * bf_hi(g4.w) + bf_hi(p4.w);
                    *(u32x4*)(merged + (size_t)row * 1024 + c) = pack8(v0, v1); }
            asm volatile("" ::: "memory"); }
    }
};

template <class Epi, class Sched, bool ALIGN_EPI = false, bool SP2 = false>
__device__ __forceinline__ void gemm_phase(PG8_LAS unsigned char* lds, const Gemm g, const Sched& S, const Epi& E) {
    int tid_ = threadIdx.x; asm volatile("" : "+v"(tid_));
    const int tid = tid_, wid = __builtin_amdgcn_readfirstlane(tid >> 6), lane = tid & 63, wr = wid >> 2, wc = wid & 3, fr = lane & 15, fq = lane >> 4;
    const int K = g.K, nt = K / BK;
    unsigned voffA[2], voffB[2];
#pragma unroll
    for (int i = 0; i < 2; ++i) { int R, C; stage_rc(tid * 16 + i * 8192, R, C); const int Rb = Epi::PERM ? ((R & ~31) + perm32(R & 31)) : R;
        voffA[i] = (unsigned)(R * K + C) * 2u; voffB[i] = (unsigned)(Rb * K + C) * 2u; }
    const size_t kstep = (size_t)(BK * 2);
    const size_t hstep = (size_t)HALF * K * 2;
    const size_t tstep = 2 * hstep;
    const unsigned ldsw = (unsigned)wid * 1024u;
    const int aoff = lds_byte(wr * 64 + fr, fq * 8), boff = lds_byte(wc * 32 + fr, fq * 8);
#define PG8_SA(b, h) (((b) * 2 + (h)) * HTB)
#define PG8_SB(b, h) ((4 + (b) * 2 + (h)) * HTB)
#define PG8_STAGE(bufoff, gbase, voff) do { _Pragma("unroll") for (int _i = 0; _i < 2; ++_i) \
        __builtin_amdgcn_global_load_lds((const unsigned*)((const char*)(gbase) + (voff)[_i]), (PG8_LAS unsigned*)(lds + (bufoff) + ldsw + _i * 8192), 16, 0, 0); } while (0)
#define PG8_LDA(dst, b, h) do { _Pragma("unroll") for (int m = 0; m < 4; ++m) _Pragma("unroll") for (int k = 0; k < 2; ++k) dst[m][k] = *(const PG8_LAS bf16x8*)(lds + PG8_SA(b, h) + aoff + m * 2048 + k * 1024); } while (0)
#define PG8_LDB(dst, b, h) do { _Pragma("unroll") for (int n = 0; n < 2; ++n) _Pragma("unroll") for (int k = 0; k < 2; ++k) dst[n][k] = *(const PG8_LAS bf16x8*)(lds + PG8_SB(b, h) + boff + n * 2048 + k * 1024); } while (0)
#define PG8_MMA(ai, bj, At, Bt) do { __builtin_amdgcn_s_setprio(1); _Pragma("unroll") for (int m = 0; m < 4; ++m) _Pragma("unroll") for (int n = 0; n < 2; ++n) _Pragma("unroll") for (int k = 0; k < 2; ++k) \
        acc[ai][bj][m][n] = __builtin_amdgcn_mfma_f32_16x16x32_bf16(Bt[n][k], At[m][k], acc[ai][bj][m][n], 0, 0, 0); __builtin_amdgcn_s_setprio(0); } while (0)
#define PG8_WAIT_V(n) asm volatile("s_waitcnt vmcnt(" #n ")" ::: "memory")
#define PG8_WAIT_L(n) asm volatile("s_waitcnt lgkmcnt(" #n ")" ::: "memory")
#define PG8_BAR __builtin_amdgcn_s_barrier()
#define PG8_SCHED __builtin_amdgcn_sched_barrier(0)
    Unit cur, nxt; int ui = 0;
    if (!S.next(0, cur)) return;
    f32x4 acc[2][2][4][2];
#pragma unroll
    for (int a = 0; a < 2; ++a)
#pragma unroll
        for (int b = 0; b < 2; ++b)
#pragma unroll
            for (int m = 0; m < 4; ++m)
#pragma unroll
                for (int n = 0; n < 2; ++n) acc[a][b][m][n] = (f32x4){0.f, 0.f, 0.f, 0.f};
    bf16x8 At[4][2], B0[2][2], B1[2][2];
    const char* cA = (const char*)g.A + (size_t)cur.pm * tstep; const char* cB = (const char*)g.Bt + (size_t)cur.pn * tstep;
    S.a_ready(cur);
    if constexpr (SP2) {
        PG8_STAGE(PG8_SB(0, 0), cB, voffB); PG8_STAGE(PG8_SB(0, 1), cB + hstep, voffB); PG8_STAGE(PG8_SA(0, 0), cA, voffA); PG8_STAGE(PG8_SA(0, 1), cA + hstep, voffA);
        if (wr == 1) PG8_BAR;
        PG8_WAIT_V(2); PG8_BAR;
        PG8_STAGE(PG8_SB(1, 0), cB + kstep, voffB); PG8_STAGE(PG8_SA(1, 0), cA + kstep, voffA); PG8_STAGE(PG8_SB(1, 1), cB + hstep + kstep, voffB);
        PG8_WAIT_V(6); PG8_BAR;
    } else {
        PG8_STAGE(PG8_SB(0, 0), cB, voffB); PG8_STAGE(PG8_SA(0, 0), cA, voffA); PG8_STAGE(PG8_SB(0, 1), cB + hstep, voffB); PG8_STAGE(PG8_SA(0, 1), cA + hstep, voffA);
        if (wr == 1) PG8_BAR;
        PG8_WAIT_V(4); PG8_BAR;
        PG8_STAGE(PG8_SB(1, 0), cB + kstep, voffB); PG8_STAGE(PG8_SA(1, 0), cA + kstep, voffA); PG8_STAGE(PG8_SB(1, 1), cB + hstep + kstep, voffB);
        PG8_WAIT_V(6); PG8_BAR;
    }
    for (;;) {
        const bool has_next = S.next(ui + 1, nxt);
        const char* nA = has_next ? (const char*)g.A + (size_t)nxt.pm * tstep : cA; const char* nB = has_next ? (const char*)g.Bt + (size_t)nxt.pn * tstep : cB;
        for (int t = 0; t < nt; t += 2) {
            const bool last = (t == nt - 2);
            const char* a1 = cA + (size_t)(t + 1) * kstep;
            const char* a2 = last ? nA : cA + (size_t)(t + 2) * kstep; const char* b2 = last ? nB : cB + (size_t)(t + 2) * kstep;
            const char* a3 = a2 + kstep; const char* b3 = b2 + kstep;
            if (last && has_next) S.a_ready(nxt);
            if constexpr (SP2) {
            PG8_LDB(B0, 0, 0); PG8_LDB(B1, 0, 1); PG8_SCHED; PG8_LDA(At, 0, 0); PG8_STAGE(PG8_SA(1, 1), a1 + hstep, voffA);
            PG8_WAIT_V(8); PG8_WAIT_L(0); PG8_BAR; PG8_MMA(0, 0, At, B0); PG8_MMA(0, 1, At, B1); PG8_BAR; PG8_SCHED;
            PG8_LDA(At, 0, 1); PG8_STAGE(PG8_SB(0, 0), b2, voffB); PG8_STAGE(PG8_SB(0, 1), b2 + hstep, voffB); PG8_STAGE(PG8_SA(0, 0), a2, voffA);
            PG8_WAIT_V(8); PG8_WAIT_L(0); PG8_BAR; PG8_MMA(1, 0, At, B0); PG8_MMA(1, 1, At, B1); PG8_BAR; PG8_SCHED;
            PG8_LDB(B0, 1, 0); PG8_LDB(B1, 1, 1); PG8_SCHED; PG8_LDA(At, 1, 0); PG8_STAGE(PG8_SA(0, 1), a2 + hstep, voffA);
            PG8_WAIT_V(8); PG8_WAIT_L(0); PG8_BAR; PG8_MMA(0, 0, At, B0); PG8_MMA(0, 1, At, B1); PG8_BAR; PG8_SCHED;
            PG8_LDA(At, 1, 1); PG8_STAGE(PG8_SB(1, 0), b3, voffB); PG8_STAGE(PG8_SB(1, 1), b3 + hstep, voffB); PG8_STAGE(PG8_SA(1, 0), a3, voffA);
            PG8_WAIT_V(8); PG8_WAIT_L(0); PG8_BAR; PG8_MMA(1, 0, At, B0); PG8_MMA(1, 1, At, B1); PG8_BAR; PG8_SCHED;
            } else {
            PG8_LDB(B0, 0, 0); PG8_SCHED; PG8_LDA(At, 0, 0); PG8_STAGE(PG8_SA(1, 1), a1 + hstep, voffA);
            PG8_WAIT_L(8); PG8_BAR; PG8_WAIT_L(0); PG8_MMA(0, 0, At, B0); PG8_BAR; PG8_SCHED;
            PG8_LDB(B1, 0, 1); PG8_STAGE(PG8_SB(0, 0), b2, voffB);
            PG8_BAR; PG8_WAIT_L(0); PG8_MMA(0, 1, At, B1); PG8_BAR;
            PG8_LDA(At, 0, 1); PG8_STAGE(PG8_SA(0, 0), a2, voffA);
            PG8_BAR; PG8_WAIT_L(0); PG8_MMA(1, 0, At, B0); PG8_BAR; PG8_SCHED;
            PG8_STAGE(PG8_SB(0, 1), b2 + hstep, voffB);
            PG8_WAIT_V(6); PG8_BAR; PG8_MMA(1, 1, At, B1); PG8_BAR;
            PG8_LDB(B0, 1, 0); PG8_SCHED; PG8_LDA(At, 1, 0); PG8_STAGE(PG8_SA(0, 1), a2 + hstep, voffA);
            PG8_WAIT_L(8); PG8_BAR; PG8_WAIT_L(0); PG8_MMA(0, 0, At, B0); PG8_BAR; PG8_SCHED;
            PG8_LDB(B1, 1, 1); PG8_STAGE(PG8_SB(1, 0), b3, voffB);
            PG8_BAR; PG8_WAIT_L(0); PG8_MMA(0, 1, At, B1); PG8_BAR;
            PG8_LDA(At, 1, 1); PG8_STAGE(PG8_SA(1, 0), a3, voffA);
            PG8_BAR; PG8_WAIT_L(0); PG8_MMA(1, 0, At, B0); PG8_BAR; PG8_SCHED;
            PG8_STAGE(PG8_SB(1, 1), b3 + hstep, voffB);
            PG8_WAIT_V(6); PG8_BAR; PG8_MMA(1, 1, At, B1); PG8_BAR;
            }
        }
        if constexpr (ALIGN_EPI) { if (wr == 0) PG8_BAR; }
        if constexpr (!Epi::AFTER_DRAIN) { E(acc, cur, wr, wc, fr, fq); S.done(cur); }
        if (!has_next) break;
#pragma unroll
        for (int a = 0; a < 2; ++a)
#pragma unroll
            for (int b = 0; b < 2; ++b)
#pragma unroll
                for (int m = 0; m < 4; ++m)
#pragma unroll
                    for (int n = 0; n < 2; ++n) acc[a][b][m][n] = (f32x4){0.f, 0.f, 0.f, 0.f};
        cur = nxt; cA = nA; cB = nB; ++ui;
        if constexpr (ALIGN_EPI) { if (wr == 1) PG8_BAR; }
    }
    PG8_WAIT_V(0);
    if constexpr (!ALIGN_EPI) { if (wr == 0) PG8_BAR; }
    PG8_BAR;
    if constexpr (Epi::AFTER_DRAIN) { E.fused(acc, cur, wr, wc, fr, fq, lds, wid, lane); S.done(cur); }
#undef PG8_SA
#undef PG8_SB
#undef PG8_STAGE
#undef PG8_LDA
#undef PG8_LDB
#undef PG8_MMA
#undef PG8_WAIT_V
#undef PG8_WAIT_L
#undef PG8_BAR
#undef PG8_SCHED
}
}
constexpr int NWAVES = 8;
constexpr int BATCH = 8, T = 4096, D = 1024, M = BATCH * T, FF = 2816, NH = 8, HD = 64, INC = 4512;
constexpr float RMS_EPS = 1e-6f, GN_EPS = 64e-5f;
constexpr size_t MiB = 1u << 20;
constexpr size_t WS_PART = 1 * MiB;
constexpr size_t WS_SC = 9 * MiB;
constexpr size_t WS_WGU1 = 13 * MiB, WS_WDN1 = WS_WGU1 + 11 * MiB, WS_WGU2 = WS_WDN1 + 5632 * 1024, WS_WDN2 = WS_WGU2 + 11 * MiB;
constexpr size_t WS_WIN = WS_WDN2 + 5632 * 1024, WS_WGT = WS_WIN + 5 * MiB, WS_WLO = WS_WGT + 4 * MiB, WS_WBR = WS_WLO + 768 * 1024, WS_WBA = WS_WBR + 1 * MiB, WS_WOUT = WS_WBA + 1 * MiB;
constexpr size_t WS_XB = 62 * MiB;
constexpr size_t WS_ATTQ = 126 * MiB;
constexpr size_t WS_ATTKV = 158 * MiB;
constexpr size_t WS_RKVL = 174 * MiB;
constexpr size_t WS_G = 286 * MiB;
constexpr size_t WS_REC = 318 * MiB, REC_SLOT = 32 * MiB;
constexpr size_t WS_H = 126 * MiB;
constexpr size_t WS_YRAW = WS_REC + 1 * REC_SLOT;
constexpr size_t WS_MERGED = WS_REC + 1 * REC_SLOT;
constexpr size_t WS_VB = WS_REC + 3 * REC_SLOT;
constexpr size_t WS_GATES = WS_ATTKV;
constexpr size_t WS_YR = WS_REC + 4 * REC_SLOT;
constexpr size_t WS_LA = WS_REC + 5 * REC_SLOT;
constexpr size_t WS_END = WS_REC + 6 * REC_SLOT;
static_assert(WS_WOUT + 4 * MiB <= WS_XB && WS_H + (size_t)M * FF * 2 <= WS_REC && WS_GATES + (size_t)M * 2048 * 2 <= WS_G, "ws map");
constexpr int RING_BYTES = 131072, LDS_BYTES = 147456;

#define GAS __attribute__((address_space(1)))
#define LAS __attribute__((address_space(3)))
typedef unsigned short bf16;
typedef unsigned v4u __attribute__((ext_vector_type(4)));
typedef unsigned v2u __attribute__((ext_vector_type(2)));
typedef float f32x4 __attribute__((ext_vector_type(4)));
typedef float f32x2 __attribute__((ext_vector_type(2)));
typedef short bf16x8 __attribute__((ext_vector_type(8)));
#define LDS_WAIT() asm volatile("s_waitcnt lgkmcnt(0)" ::: "memory")
__device__ __forceinline__ unsigned f2bf(float f) { unsigned u = __builtin_bit_cast(unsigned, f); return (u + 0x7fffu + ((u >> 16) & 1u)) >> 16; }
__device__ __forceinline__ unsigned pk2(float lo, float hi) { return f2bf(lo) | (f2bf(hi) << 16); }
__device__ __forceinline__ float bflo(unsigned u) { return __uint_as_float(u << 16); }
__device__ __forceinline__ float bfhi(unsigned u) { return __uint_as_float(u & 0xffff0000u); }
__device__ __forceinline__ float bf1(bf16 h) { return __uint_as_float((unsigned)h << 16); }
__device__ __forceinline__ float wave_sum(float v) {
#pragma unroll
    for (int o = 1; o < 64; o <<= 1) v += __shfl_xor(v, o);
    return v;
}
template <int CTRL> __device__ __forceinline__ float dppf(float x) { return __builtin_bit_cast(float, __builtin_amdgcn_update_dpp(0, __builtin_bit_cast(int, x), CTRL, 0xf, 0xf, false)); }
__device__ __forceinline__ float row16_sum(float x) { x += dppf<0xB1>(x); x += dppf<0x4E>(x); x += dppf<0x141>(x); x += dppf<0x140>(x); return x; }

#define RLX_AGENT __ATOMIC_RELAXED, __HIP_MEMORY_SCOPE_AGENT
#define XB_TMO      128
#define XB_XCNT(j)  (256  + 64 * (j))
#define XB_XSUB(j)  (1280 + 64 * (j))
#define XB_XGEN(j)  (2304 + 64 * (j))
#define XB_TOP      3328
#define XB_TOPGEN   3392
#define XCD_BAR_WORDS 3456
#define XB_SPIN_CAP (1u << 18)

__device__ __forceinline__ unsigned xb_ld(unsigned* p)              { return __hip_atomic_load(p, __ATOMIC_RELAXED, __HIP_MEMORY_SCOPE_AGENT); }
__device__ __forceinline__ unsigned xb_add(unsigned* p, unsigned v) { return __hip_atomic_fetch_add(p, v, __ATOMIC_RELAXED, __HIP_MEMORY_SCOPE_AGENT); }
__device__ __forceinline__ unsigned xb_xcc_id() { return (unsigned)__builtin_amdgcn_s_getreg((3 << 11) | 20) & 0xFu; }
#define XB_SPIN(cond, bar) do { unsigned _sp = 0; while (cond) { __builtin_amdgcn_s_sleep(1); \
    if ((++_sp & 255u) == 0u) { if (xb_ld(&(bar)[XB_TMO])) break; if (_sp > XB_SPIN_CAP) { atomicAdd(&(bar)[XB_TMO], 1u); break; } } } } while (0)

struct XcdBarrier {
    unsigned* bar; unsigned x;
    volatile LAS unsigned* st;
};

__device__ __forceinline__ XcdBarrier xcd_barrier_post(unsigned* bar, volatile LAS unsigned* st) {
    XcdBarrier b; b.bar = bar; b.x = xb_xcc_id(); b.st = st;
    if (threadIdx.x == 0) (void)xb_add(&bar[XB_XCNT(b.x)], 1u);
    return b;
}
__device__ __forceinline__ void xcd_barrier_complete(unsigned* bar, unsigned x, unsigned& nloc, unsigned& nx) {
    const unsigned G = gridDim.x * gridDim.y * gridDim.z;
    unsigned sum, cnt, mine, sp = 0u;
    for (;;) {
        sum = 0u; cnt = 0u; mine = 0u;
#pragma unroll
        for (unsigned j = 0; j < 16; ++j) { const unsigned c = xb_ld(&bar[XB_XCNT(j)]); sum += c; cnt += (c > 0u) ? 1u : 0u; mine = (j == x) ? c : mine; }
        if (sum == G) break;
        __builtin_amdgcn_s_sleep(1);
        if ((++sp & 255u) == 0u) { if (xb_ld(&bar[XB_TMO])) break; if (sp > XB_SPIN_CAP) { atomicAdd(&bar[XB_TMO], 1u); break; } }
    }
    nloc = mine > 0u ? mine : 1u; nx = cnt > 0u ? cnt : 1u;
}

__device__ __forceinline__ void xcd_barrier(const XcdBarrier& b) {
    asm volatile("s_waitcnt vmcnt(0)" ::: "memory");
    __syncthreads();
    if (threadIdx.x == 0) {
        unsigned* bar = b.bar;
        __builtin_amdgcn_s_waitcnt(0);
        unsigned nloc = b.st[0], nx = b.st[1];
        if (nloc == 0u) { xcd_barrier_complete(bar, b.x, nloc, nx); b.st[0] = nloc; b.st[1] = nx; }
        const unsigned old = xb_add(&bar[XB_XSUB(b.x)], 1u);
        const unsigned gen = old / nloc;
        if (old + 1u == (gen + 1u) * nloc) {
            __builtin_amdgcn_fence(__ATOMIC_RELEASE, "agent");
            asm volatile("s_waitcnt vmcnt(0)" ::: "memory");
            const unsigned og = xb_add(&bar[XB_TOP], 1u);
            const unsigned tg = og / nx;
            if (og + 1u == (tg + 1u) * nx) xb_add(&bar[XB_TOPGEN], 1u);
            else XB_SPIN(xb_ld(&bar[XB_TOPGEN]) == tg, bar);
            __builtin_amdgcn_fence(__ATOMIC_ACQUIRE, "agent");
            xb_add(&bar[XB_XGEN(b.x)], 1u);
            asm volatile("s_waitcnt vmcnt(0)" ::: "memory");
        } else {
            XB_SPIN(xb_ld(&bar[XB_XGEN(b.x)]) == gen, bar);
            __builtin_amdgcn_fence(__ATOMIC_ACQUIRE, "agent");
            asm volatile("s_waitcnt vmcnt(0)" ::: "memory");
        }
    }
    __syncthreads();
}

__device__ __forceinline__ int fresh_tid() { int t = threadIdx.x; asm volatile("" : "+v"(t)); return t; }
struct Frame {
    LAS unsigned char* lds;
    int tid, lane, wave, vcu, G;
    const float *in0, *in1, *in2, *in3, *in4, *in5, *in6, *in7, *in8, *in9, *in10, *in11, *in12, *in13, *in14, *in15, *in16, *in17, *in18, *in19, *in20, *in21, *in22, *in23, *in24, *in25, *in26, *in27, *in28; float* out; unsigned char* ws;
};

__device__ __forceinline__ pg8::RsTab fill_rstd(Frame& F, const float* part, int N) {
    pg8::StaticOrder S; S.init(M, N, F.G, (int)blockIdx.x); pg8::Unit u; pg8::RsTab tb; tb.pm[0] = tb.pm[1] = tb.pm[2] = tb.pm[3] = -1;
    for (int i = 0; S.next(i, u); ++i) { if (u.pm == tb.pm[0] || u.pm == tb.pm[1] || u.pm == tb.pm[2] || u.pm == tb.pm[3]) continue;
        if (tb.pm[0] < 0) tb.pm[0] = u.pm; else if (tb.pm[1] < 0) tb.pm[1] = u.pm; else if (tb.pm[2] < 0) tb.pm[2] = u.pm; else tb.pm[3] = u.pm; }
    const int tid = fresh_tid(); LAS float* t = (LAS float*)(F.lds + pg8::RS_TAB_OFF);
#pragma unroll
    for (int h = 0; h < 2; ++h) { const int e = tid + 512 * h, slot = e >> 8, r = e & 255; const int pm = slot == 0 ? tb.pm[0] : slot == 1 ? tb.pm[1] : slot == 2 ? tb.pm[2] : tb.pm[3];
        if (pm >= 0) { const GAS f32x4* p = (const GAS f32x4*)(part + ((size_t)pm * 256 + r) * 16); const f32x4 a = p[0], b = p[1], c = p[2], d = p[3];
            const float sm = ((a[0] + a[1]) + (a[2] + a[3])) + ((b[0] + b[1]) + (b[2] + b[3])) + ((c[0] + c[1]) + (c[2] + c[3])) + ((d[0] + d[1]) + (d[2] + d[3]));
            t[e] = __builtin_amdgcn_rsqf(sm * (1.0f / 1024.0f) + RMS_EPS); } }
    __syncthreads();
    return tb;
}
__device__ __forceinline__ void tr_item(const float* W, int ldn, int k0, int n0, bf16* WT, int ldk, int drow0, int dk0, const float* scale, int dup, LAS float* scr, int lane) {
    float tv[32], ts[32];
#pragma unroll
    for (int i = 0; i < 32; ++i) { const int kk = 2 * i + (lane >> 5); tv[i] = W[(size_t)(k0 + kk) * ldn + n0 + (lane & 31)]; ts[i] = scale ? scale[k0 + kk] : 1.0f; }
#pragma unroll
    for (int i = 0; i < 32; ++i) { const int kk = 2 * i + (lane >> 5); scr[kk * 33 + (lane & 31)] = tv[i] * ts[i]; }
    LDS_WAIT(); asm volatile("" ::: "memory");
    const int c = lane & 7;
#pragma unroll
    for (int j = 0; j < 4; ++j) { const int n = (lane >> 3) + 8 * j; const LAS float* s = scr + (8 * c) * 33 + n;
        v4u o; o.x = pk2(s[0 * 33], s[1 * 33]); o.y = pk2(s[2 * 33], s[3 * 33]); o.z = pk2(s[4 * 33], s[5 * 33]); o.w = pk2(s[6 * 33], s[7 * 33]);
        bf16* dp = WT + (size_t)(drow0 + n0 + n) * ldk + dk0 + k0 + 8 * c;
        *(GAS v4u*)dp = o; if (dup) *(GAS v4u*)(dp + dup) = o; }
    LDS_WAIT(); asm volatile("" ::: "memory");
}
__device__ __forceinline__ void p0_prologue(Frame& F) {
    LAS float* scr = (LAS float*)(F.lds + F.wave * 16384);
    unsigned char* ws = F.ws;
    const int gw = F.vcu * NWAVES + F.wave, NGW = F.G * NWAVES, lane = fresh_tid() & 63;
    constexpr int I_GU = 16 * 88, I_DN = 44 * 32, I_IN = 16 * 77, I_GT = 16 * 64, I_BR = 8 * 32, I_OUT = 16 * 32;
    constexpr int NITEMS = 4 * I_GU + 2 * I_DN + I_IN + I_GT + 2 * I_BR + I_OUT;
    for (int it = gw; it < NITEMS; it += NGW) {
        int r = it;
        if (r < 4 * I_GU) {
            const int which = r / I_GU; r -= which * I_GU; const int kb = r / 88, nb = r % 88, n0 = nb * 32;
            const float* W = which == 0 ? F.in2 : which == 1 ? F.in3 : which == 2 ? F.in25 : F.in26;
            tr_item(W, FF, kb * 64, n0, (bf16*)(ws + (which < 2 ? WS_WGU1 : WS_WGU2)), D, (n0 >> 7) * 256 + (which & 1) * 128 + (n0 & 127) - n0, 0, which < 2 ? F.in1 : F.in24, 0, scr, lane);
            continue; }
        r -= 4 * I_GU;
        if (r < 2 * I_DN) { const int which = r / I_DN; r -= which * I_DN; const int kb = r / 32, nb = r % 32;
            tr_item(which ? F.in27 : F.in4, D, kb * 64, nb * 32, (bf16*)(ws + (which ? WS_WDN2 : WS_WDN1)), FF, 0, 0, nullptr, 0, scr, lane); continue; }
        r -= 2 * I_DN;
        if (r < I_IN) { const int kb = r / 77, nb = r % 77, n0 = nb * 32;
            tr_item(F.in6, INC, kb * 64, n0, (bf16*)(ws + WS_WIN), D, n0 < 1696 ? 0 : 96, 0, F.in5, 0, scr, lane); continue; }
        r -= I_IN;
        if (r < I_GT) { const int kb = r / 64, nb = r % 64;
            tr_item(F.in6, INC, kb * 64, 2464 + nb * 32, (bf16*)(ws + WS_WGT), D, -2464, 0, F.in5, 0, scr, lane); continue; }
        r -= I_GT;
        if (r < 2 * I_BR) { const int which = r / I_BR; r -= which * I_BR; const int kb = r / 32, nb = r % 32;
            tr_item(which ? F.in22 : F.in21, D, kb * 64, nb * 32, (bf16*)(ws + (which ? WS_WBA : WS_WBR)), 512, 0, 0, nullptr, 0, scr, lane); continue; }
        r -= 2 * I_BR;
        { const int kb = r / 32, nb = r % 32; tr_item(F.in23, D, kb * 64, nb * 32, (bf16*)(ws + WS_WOUT), D, 0, 0, nullptr, 0, scr, lane); }
    }
    { GAS v4u* z = (GAS v4u*)(ws + WS_WIN + (size_t)1696 * D * 2); for (int i = gw * 64 + lane; i < 12288; i += NGW * 64) z[i] = (v4u){0u, 0u, 0u, 0u}; }
    { bf16* WL = (bf16*)(ws + WS_WLO);
      for (int i = gw * 64 + lane; i < 1536 * 128; i += NGW * 64) { const int n = i >> 7, k = i & 127, grp = n >> 9, nn = n & 511; float v = 0.f;
          if (grp == 0) { if (k < 32) v = F.in9[k * 512 + nn]; } else if (grp == 1) { if (k >= 32 && k < 64) v = F.in11[(k - 32) * 512 + nn]; } else { if (k < 96) v = F.in12[k * 512 + nn]; }
          WL[i] = (bf16)f2bf(v); } }
    { const float* x = F.in0; bf16* XB = (bf16*)(ws + WS_XB); float* part = (float*)(ws + WS_PART);
      for (int m0 = gw; m0 < M; m0 += 4 * NGW) { f32x4 v[4][4];
#pragma unroll
          for (int r = 0; r < 4; ++r) { const int m = m0 + r * NGW; if (m < M) { const GAS f32x4* xr = (const GAS f32x4*)(x + (size_t)m * D) + lane;
#pragma unroll
              for (int j = 0; j < 4; ++j) v[r][j] = xr[64 * j]; } }
#pragma unroll
          for (int r = 0; r < 4; ++r) { const int m = m0 + r * NGW; if (m < M) { float s = 0.f;
#pragma unroll
              for (int j = 0; j < 4; ++j) s += (v[r][j].x * v[r][j].x + v[r][j].y * v[r][j].y) + (v[r][j].z * v[r][j].z + v[r][j].w * v[r][j].w);
              s = wave_sum(s);
              GAS unsigned long long* o8 = (GAS unsigned long long*)(XB + (size_t)m * D) + lane;
#pragma unroll
              for (int j = 0; j < 4; ++j) o8[64 * j] = (unsigned long long)pk2(v[r][j].x, v[r][j].y) | ((unsigned long long)pk2(v[r][j].z, v[r][j].w) << 32);
              if (lane < 16) part[(size_t)m * 16 + lane] = lane == 0 ? s : 0.f; } } } }
}
__device__ __forceinline__ void p4_lora_in(Frame& F) {
    const bf16* RKVL = (const bf16*)(F.ws + WS_RKVL); const float* mu = F.in7 + 1536;
    const int gw = F.vcu * NWAVES + F.wave, NGW = F.G * NWAVES, lane = fresh_tid() & 63, second = lane >> 5, c0 = 4 * (lane & 31);
    bf16* LA = (bf16*)(F.ws + WS_LA) + (second ? (size_t)M * 128 : 0);
    const int sc0 = second ? 64 + c0 : c0;
    const bool act = second ? c0 < 96 : c0 < 64; f32x4 mv = (f32x4){0.f, 0.f, 0.f, 0.f}; if (act) mv = *(const GAS f32x4*)(mu + sc0);
    for (int m0 = gw; m0 < M; m0 += 4 * NGW) {
        v2u cu[4], pu[4];
#pragma unroll
        for (int rr = 0; rr < 4; ++rr) { const int m = m0 + rr * NGW; cu[rr] = (v2u){0u, 0u}; pu[rr] = (v2u){0u, 0u};
            if (act) { cu[rr] = *(const GAS v2u*)(RKVL + (size_t)m * 1792 + 1536 + sc0); if ((m & (T - 1)) != 0) pu[rr] = *(const GAS v2u*)(RKVL + (size_t)(m - 1) * 1792 + 1536 + sc0); } }
#pragma unroll
        for (int rr = 0; rr < 4; ++rr) { const int m = m0 + rr * NGW; float o[4] = {0.f, 0.f, 0.f, 0.f};
            if (act) { const float cur[4] = {bflo(cu[rr].x), bfhi(cu[rr].x), bflo(cu[rr].y), bfhi(cu[rr].y)}, prv[4] = {bflo(pu[rr].x), bfhi(pu[rr].x), bflo(pu[rr].y), bfhi(pu[rr].y)};
#pragma unroll
                for (int j = 0; j < 4; ++j) { const float p = cur[j] + (prv[j] - cur[j]) * mv[j]; const int c = sc0 + j;
                    const float e = __builtin_amdgcn_exp2f((c < 32 ? 2.0f : -1.0f) * 1.44269504089f * p), rc = __builtin_amdgcn_rcpf(1.0f + e);
                    o[j] = c < 32 ? 1.0f - 2.0f * rc : (c < 64 ? p : rc); } }
            *(GAS v2u*)(LA + (size_t)m * 128 + c0) = (v2u){pk2(o[0], o[1]), pk2(o[2], o[3])}; }
    }
}
__device__ __forceinline__ float sum8(float v) { v += __shfl_xor(v, 1); v += __shfl_xor(v, 2); v += __shfl_xor(v, 4); return v; }
__device__ __forceinline__ void unpack8(const v4u u, float (&f)[8]) { f[0] = bflo(u.x); f[1] = bfhi(u.x); f[2] = bflo(u.y); f[3] = bfhi(u.y); f[4] = bflo(u.z); f[5] = bfhi(u.z); f[6] = bflo(u.w); f[7] = bfhi(u.w); }
__device__ __forceinline__ v4u pack8u(const float (&f)[8]) { return (v4u){pk2(f[0], f[1]), pk2(f[2], f[3]), pk2(f[4], f[5]), pk2(f[6], f[7])}; }
__device__ __forceinline__ void ld8f(const float* p, float (&f)[8]) { const f32x4 a = *(const GAS f32x4*)p, b = *(const GAS f32x4*)(p + 4); f[0] = a.x; f[1] = a.y; f[2] = a.z; f[3] = a.w; f[4] = b.x; f[5] = b.y; f[6] = b.z; f[7] = b.w; }
constexpr int KS_STRIDE = 144, VT_STRIDE = 528, ATT_KS_OFF = 0, ATT_VT_OFF = 256 * KS_STRIDE;
__device__ __forceinline__ void p6_attention(Frame& F) {
    bf16* ATTQ = (bf16*)(F.ws + WS_ATTQ); const bf16* ATTKV = (const bf16*)(F.ws + WS_ATTKV);
    const float* qn = F.in18; const float* kn = F.in19; const float* sinks = F.in20;
    LAS unsigned char* Ks = F.lds + ATT_KS_OFF; LAS unsigned char* Vt = F.lds + ATT_VT_OFF;
    const int tid = fresh_tid(), lane = tid & 63, w = F.wave, g = lane >> 4, n16 = lane & 15;
    for (int unit = F.vcu; unit < BATCH * 2 * 32; unit += F.G) {
        const int nb = unit & 31, kvh = (unit >> 5) & 1, b = unit >> 6; const int m0 = b * T + nb * 128;
#pragma unroll
        for (int i = 0; i < 4; ++i) { const int e = tid + 512 * i, key = e >> 3, dg = e & 7; const bool valid = nb > 0 || key >= 128;
            v4u ku = (v4u){0u, 0u, 0u, 0u}, vu = (v4u){0u, 0u, 0u, 0u};
            if (valid) { const bf16* src = ATTKV + (size_t)(m0 - 128 + key) * 256 + kvh * 64 + dg * 8; ku = *(const GAS v4u*)src; vu = *(const GAS v4u*)(src + 128); }
            float kf[8] = {bflo(ku.x), bfhi(ku.x), bflo(ku.y), bfhi(ku.y), bflo(ku.z), bfhi(ku.z), bflo(ku.w), bfhi(ku.w)};
            float ss = 0.f;
#pragma unroll
            for (int j = 0; j < 8; ++j) ss += kf[j] * kf[j];
            ss += __shfl_xor(ss, 1); ss += __shfl_xor(ss, 2); ss += __shfl_xor(ss, 4);
            const float rs = __builtin_amdgcn_rsqf(ss * (1.0f / 64.0f) + RMS_EPS);
#pragma unroll
            for (int j = 0; j < 8; ++j) kf[j] *= rs * kn[dg * 8 + j];
            *(LAS v4u*)(Ks + key * KS_STRIDE + dg * 16) = (v4u){pk2(kf[0], kf[1]), pk2(kf[2], kf[3]), pk2(kf[4], kf[5]), pk2(kf[6], kf[7])};
            const unsigned vv[4] = {vu.x, vu.y, vu.z, vu.w};
#pragma unroll
            for (int j = 0; j < 8; ++j) *(LAS bf16*)(Vt + (dg * 8 + j) * VT_STRIDE + key * 2) = (bf16)((vv[j >> 1] >> ((j & 1) * 16)) & 0xffffu);
        }
        __syncthreads();
        const int hq = kvh * 4 + (w >> 1), qbase = (w & 1) * 64; const float sink = sinks[hq] * 1.44269504089f;
        float qg[16];
#pragma unroll
        for (int j = 0; j < 16; ++j) qg[j] = qn[(j >> 3) * 32 + 8 * g + (j & 7)];
        bf16* qrow = ATTQ + (size_t)(m0 + qbase + n16) * 512 + hq * 64 + 8 * g;
        v4u qa_n = *(const GAS v4u*)qrow, qb_n = *(const GAS v4u*)(qrow + 32);
        for (int qt = 0; qt < 4; ++qt) {
            const int q0 = qbase + 16 * qt, qi = q0 + n16, kt0 = q0 >> 4;
            const v4u qa = qa_n, qb = qb_n;
            if (qt < 3) { const bf16* qp = qrow + (size_t)(qt + 1) * 16 * 512; qa_n = *(const GAS v4u*)qp; qb_n = *(const GAS v4u*)(qp + 32); }
            bf16x8 ka[9][2];
#pragma unroll
            for (int i = 0; i < 9; ++i) { const int kt = kt0 + i, ktc = kt < 16 ? kt : 15; const LAS unsigned char* kp = Ks + (16 * ktc + n16) * KS_STRIDE + 16 * g;
                ka[i][0] = *(const LAS bf16x8*)kp; ka[i][1] = *(const LAS bf16x8*)(kp + 64); }
            float q[16] = {bflo(qa.x), bfhi(qa.x), bflo(qa.y), bfhi(qa.y), bflo(qa.z), bfhi(qa.z), bflo(qa.w), bfhi(qa.w),
                           bflo(qb.x), bfhi(qb.x), bflo(qb.y), bfhi(qb.y), bflo(qb.z), bfhi(qb.z), bflo(qb.w), bfhi(qb.w)};
            float ss = 0.f;
#pragma unroll
            for (int j = 0; j < 16; ++j) ss += q[j] * q[j];
            ss += __shfl_xor(ss, 16); ss += __shfl_xor(ss, 32);
            const float rs = (0.125f * 1.44269504089f) * __builtin_amdgcn_rsqf(ss * (1.0f / 64.0f) + RMS_EPS);
#pragma unroll
            for (int j = 0; j < 16; ++j) q[j] *= rs * qg[j];
            const v4u qf0 = (v4u){pk2(q[0], q[1]), pk2(q[2], q[3]), pk2(q[4], q[5]), pk2(q[6], q[7])}, qf1 = (v4u){pk2(q[8], q[9]), pk2(q[10], q[11]), pk2(q[12], q[13]), pk2(q[14], q[15])};
            const bf16x8 bq0 = __builtin_bit_cast(bf16x8, qf0), bq1 = __builtin_bit_cast(bf16x8, qf1);
            __builtin_amdgcn_sched_barrier(0);
            f32x4 st[10]; st[9] = (f32x4){0.f, 0.f, 0.f, 0.f};
#pragma unroll
            for (int i = 0; i < 9; ++i) { f32x4 acc = (f32x4){0.f, 0.f, 0.f, 0.f};
                acc = __builtin_amdgcn_mfma_f32_16x16x32_bf16(ka[i][0], bq0, acc, 0, 0, 0);
                st[i] = __builtin_amdgcn_mfma_f32_16x16x32_bf16(ka[i][1], bq1, acc, 0, 0, 0); }
            v2u vf[5][4][2];
#pragma unroll
            for (int j = 0; j < 5; ++j) { const int ka_ = kt0 + 2 * j, kb_ = ka_ + 1, kac = ka_ < 16 ? ka_ : 15, kbc = kb_ < 16 ? kb_ : 15;
#pragma unroll
                for (int dt = 0; dt < 4; ++dt) { const LAS unsigned char* vp = Vt + (16 * dt + n16) * VT_STRIDE;
                    vf[j][dt][0] = *(const LAS v2u*)(vp + (16 * kac + 4 * g) * 2); vf[j][dt][1] = *(const LAS v2u*)(vp + (16 * kbc + 4 * g) * 2); } }
            float mx = -INFINITY;
#pragma unroll
            for (int i = 0; i < 9; ++i)
#pragma unroll
                for (int r = 0; r < 4; ++r) { const int kj = 16 * (kt0 + i) + 4 * g + r; const bool ok = (i != 0 || kj > qi) && (i != 8 || kj <= qi + 128) && (nb > 0 || kj >= 128);
                    st[i][r] = ok ? st[i][r] : -INFINITY; mx = fmaxf(mx, st[i][r]); }
            mx = fmaxf(mx, __shfl_xor(mx, 16)); mx = fmaxf(mx, __shfl_xor(mx, 32)); mx = fmaxf(mx, sink);
            float den = 0.f;
#pragma unroll
            for (int i = 0; i < 9; ++i)
#pragma unroll
                for (int r = 0; r < 4; ++r) { const float p = __builtin_amdgcn_exp2f(st[i][r] - mx); st[i][r] = p; den += p; }
            den += __shfl_xor(den, 16); den += __shfl_xor(den, 32); den += __builtin_amdgcn_exp2f(sink - mx);
            const float inv = __builtin_amdgcn_rcpf(den);
            f32x4 o[4];
#pragma unroll
            for (int dt = 0; dt < 4; ++dt) o[dt] = (f32x4){0.f, 0.f, 0.f, 0.f};
#pragma unroll
            for (int j = 0; j < 5; ++j) {
                const v4u pu = (v4u){pk2(st[2 * j][0], st[2 * j][1]), pk2(st[2 * j][2], st[2 * j][3]), pk2(st[2 * j + 1][0], st[2 * j + 1][1]), pk2(st[2 * j + 1][2], st[2 * j + 1][3])};
                const bf16x8 pf = __builtin_bit_cast(bf16x8, pu);
#pragma unroll
                for (int dt = 0; dt < 4; ++dt) { const bf16x8 af = __builtin_bit_cast(bf16x8, (v4u){vf[j][dt][0].x, vf[j][dt][0].y, vf[j][dt][1].x, vf[j][dt][1].y});
                    o[dt] = __builtin_amdgcn_mfma_f32_16x16x32_bf16(af, pf, o[dt], 0, 0, 0); } }
            bf16* op = ATTQ + (size_t)(m0 + qi) * 512 + hq * 64 + 4 * g;
#pragma unroll
            for (int dt = 0; dt < 4; ++dt) *(GAS v2u*)(op + 16 * dt) = (v2u){pk2(o[dt][0] * inv, o[dt][1] * inv), pk2(o[dt][2] * inv, o[dt][3] * inv)};
        }
        __syncthreads();
    }
}
constexpr int SC_NS = 32, SC_NP = 16, SC_ARR = 4096, SC_SCL = 9 * SC_ARR, SC_VS = SC_SCL + 512, SC_YB = SC_VS + 4096, SC_BUF = SC_YB + 2048;
struct ScanPre { v2u r0, r1, r2, k0, k1, k2, lw1, lw2, a1, a2; unsigned short vr0, vr1, vr2; };
struct ScanPar { f32x4 mur, muk, kkw, kaw, rkw; float muvr; };
__device__ __forceinline__ ScanPre scan_issue(Frame& F, int bh, int quarter, int t0, int lt) {
    const unsigned char* REC = F.ws + WS_REC; const bf16* RKVL = (const bf16*)(F.ws + WS_RKVL);
    const int pr = lt >> 4, q = lt & 15, b = bh >> 3, h = bh & 7, t1 = t0 + 2 * pr;
    const bf16* row1 = RKVL + (size_t)(b * T + t1) * 1792 + h * 64; const bf16* rowp = row1 - (t1 > 0 ? 1792 : 0); const bf16* row2 = row1 + 1792;
    ScanPre p;
    p.r0 = *(const GAS v2u*)(rowp + 4 * q); p.r1 = *(const GAS v2u*)(row1 + 4 * q); p.r2 = *(const GAS v2u*)(row2 + 4 * q);
    p.k0 = *(const GAS v2u*)(rowp + 512 + 4 * q); p.k1 = *(const GAS v2u*)(row1 + 512 + 4 * q); p.k2 = *(const GAS v2u*)(row2 + 512 + 4 * q);
    const size_t e1 = ((size_t)bh * T + t1) * 128 + (size_t)q * 8;
    p.lw1 = *(const GAS v2u*)(REC + 0 * REC_SLOT + e1); p.lw2 = *(const GAS v2u*)(REC + 0 * REC_SLOT + e1 + 128);
    p.a1 = *(const GAS v2u*)(REC + 4 * REC_SLOT + e1); p.a2 = *(const GAS v2u*)(REC + 4 * REC_SLOT + e1 + 128);
    const int vc = 1024 + 16 * quarter + q; p.vr0 = rowp[vc]; p.vr1 = row1[vc]; p.vr2 = row2[vc];
    if (t1 == 0) { p.r0 = (v2u){0u, 0u}; p.k0 = (v2u){0u, 0u}; p.vr0 = 0; }
    return p;
}
__device__ __forceinline__ void un4(const v2u u, float (&f)[4]) { f[0] = bflo(u.x); f[1] = bfhi(u.x); f[2] = bflo(u.y); f[3] = bfhi(u.y); }
__device__ __forceinline__ void scan_commit(Frame& F, const ScanPre& p, const ScanPar& c, int bh, int quarter, int t0, LAS unsigned char* buf, int lt) {
    const int pr = lt >> 4, q = lt & 15, idx = pr * 16 + q, t1 = t0 + 2 * pr;
    float rA[4], rB[4], rC[4], kA[4], kB[4], kC[4], lw1[4], lw2[4], s1[4], s2[4];
    un4(p.r0, rA); un4(p.r1, rB); un4(p.r2, rC); un4(p.k0, kA); un4(p.k1, kB); un4(p.k2, kC); un4(p.lw1, lw1); un4(p.lw2, lw2); un4(p.a1, s1); un4(p.a2, s2);
    float r1[4], r2[4], k1[4], k2[4], kk1[4], kk2[4]; float n1 = 0.f, n2 = 0.f;
#pragma unroll
    for (int j = 0; j < 4; ++j) { r1[j] = rB[j] + (rA[j] - rB[j]) * c.mur[j]; r2[j] = rC[j] + (rB[j] - rC[j]) * c.mur[j]; k1[j] = kB[j] + (kA[j] - kB[j]) * c.muk[j]; k2[j] = kC[j] + (kB[j] - kC[j]) * c.muk[j];
        kk1[j] = k1[j] * c.kkw[j]; kk2[j] = k2[j] * c.kkw[j]; n1 += kk1[j] * kk1[j]; n2 += kk2[j] * kk2[j]; }
    n1 = row16_sum(n1); n2 = row16_sum(n2);
    const float i1 = __builtin_amdgcn_rsqf(fmaxf(n1, 1e-24f)), i2 = __builtin_amdgcn_rsqf(fmaxf(n2, 1e-24f));
    float a1[4], a2[4], b1[4], b2[4], w1[4], w2[4], z1[4], wa2[4], wz2[4], ww[4], bw[4], kw[4];
    float be1 = 0.f, ka1 = 0.f, bo1 = 0.f, be2 = 0.f, ka2 = 0.f, bo2 = 0.f, ba = 0.f, ka = 0.f, bz = 0.f, kz = 0.f;
#pragma unroll
    for (int j = 0; j < 4; ++j) { kk1[j] *= i1; kk2[j] *= i2; a1[j] = -kk1[j]; a2[j] = -kk2[j]; b1[j] = kk1[j] * s1[j]; b2[j] = kk2[j] * s2[j];
        k1[j] *= 1.0f + (s1[j] - 1.0f) * c.kaw[j]; k2[j] *= 1.0f + (s2[j] - 1.0f) * c.kaw[j];
        w1[j] = __expf(lw1[j]); w2[j] = __expf(lw2[j]); z1[j] = w1[j] * r1[j]; const float z2 = w2[j] * r2[j];
        be1 += b1[j] * r1[j]; ka1 += k1[j] * r1[j]; bo1 += r1[j] * k1[j] * c.rkw[j]; be2 += b2[j] * r2[j]; ka2 += k2[j] * r2[j]; bo2 += r2[j] * k2[j] * c.rkw[j];
        wa2[j] = w1[j] * a2[j]; wz2[j] = w1[j] * z2; ww[j] = w1[j] * w2[j]; bw[j] = b1[j] * w2[j]; kw[j] = k1[j] * w2[j];
        ba += b1[j] * a2[j]; ka += k1[j] * a2[j]; bz += b1[j] * z2; kz += k1[j] * z2; }
    be1 = row16_sum(be1); ka1 = row16_sum(ka1); bo1 = row16_sum(bo1); be2 = row16_sum(be2); ka2 = row16_sum(ka2); bo2 = row16_sum(bo2);
    ba = row16_sum(ba); ka = row16_sum(ka); bz = row16_sum(bz); kz = row16_sum(kz);
    LAS f32x4* A = (LAS f32x4*)buf;
    A[0 * 256 + idx] = (f32x4){a1[0], z1[0], a1[1], z1[1]}; A[1 * 256 + idx] = (f32x4){a1[2], z1[2], a1[3], z1[3]};
    A[2 * 256 + idx] = (f32x4){wa2[0], wz2[0], wa2[1], wz2[1]}; A[3 * 256 + idx] = (f32x4){wa2[2], wz2[2], wa2[3], wz2[3]};
    A[4 * 256 + idx] = (f32x4){ww[0], ww[1], ww[2], ww[3]}; A[5 * 256 + idx] = (f32x4){bw[0], bw[1], bw[2], bw[3]}; A[6 * 256 + idx] = (f32x4){kw[0], kw[1], kw[2], kw[3]};
    A[7 * 256 + idx] = (f32x4){b2[0], b2[1], b2[2], b2[3]}; A[8 * 256 + idx] = (f32x4){k2[0], k2[1], k2[2], k2[3]};
    if (q == 0) { LAS f32x4* S4 = (LAS f32x4*)(buf + SC_SCL); S4[pr * 2] = (f32x4){ba, bz, ka, kz}; S4[pr * 2 + 1] = (f32x4){be1, be2, 0.f, 0.f};
        if (quarter == 0) { f32x4* SC = (f32x4*)(F.ws + WS_SC) + (size_t)bh * T + t1; SC[0] = (f32x4){be1, ka1, bo1, 0.f}; SC[1] = (f32x4){be2, ka2, bo2, 0.f}; } }
    const float vA = bf1(p.vr0), vB = bf1(p.vr1), vC = bf1(p.vr2); const float v1 = vB + (vA - vB) * c.muvr, v2 = vC + (vB - vC) * c.muvr;
    ((LAS f32x4*)(buf + SC_VS))[idx] = (f32x4){v1, v2, v1 * ka1, v2 * ka2};
    bf16* VB = (bf16*)(F.ws + WS_VB) + ((size_t)bh * T + t1) * 64 + 16 * quarter + q; VB[0] = (bf16)f2bf(v1); VB[64] = (bf16)f2bf(v2);
}
__device__ __forceinline__ void scan_flush(Frame& F, int bh, int quarter, int t0, const LAS unsigned char* buf, int lt) {
    if (lt < 128) { const int s = lt >> 2, c4 = lt & 3; const int b = bh >> 3, h = bh & 7;
        float* yraw = (float*)(F.ws + WS_YRAW);
        const LAS float* yb = (const LAS float*)(buf + SC_YB) + ((s >> 1) * 16 + 4 * c4) * 2 + (s & 1);
        const f32x4 y = (f32x4){yb[0], yb[2], yb[4], yb[6]};
        *(GAS f32x4*)(yraw + (size_t)(b * T + t0 + s) * 512 + h * 64 + 16 * quarter + 4 * c4) = y; }
}
__device__ __forceinline__ void p7_scan(Frame& F) {
    const int w = F.wave, tid = fresh_tid(), lane = tid & 63, rl = lane >> 4, q = lane & 15, lt = tid - 256;
    constexpr int NBLK = T / SC_NS;
#define SCAN_BAR() do { asm volatile("s_waitcnt lgkmcnt(0)" ::: "memory"); __builtin_amdgcn_s_barrier(); asm volatile("" ::: "memory"); } while (0)
    for (int unit = F.vcu; unit < 256; unit += F.G) {
        const int bh = unit >> 2, quarter = unit & 3;
        ScanPre pre; ScanPar par;
        if (w >= 4) { const int h = bh & 7, q4 = h * 64 + 4 * (lt & 15);
            par.mur = *(const GAS f32x4*)(F.in7 + q4); par.muk = *(const GAS f32x4*)(F.in7 + 512 + q4); par.kkw = *(const GAS f32x4*)(F.in13 + q4); par.kaw = *(const GAS f32x4*)(F.in14 + q4); par.rkw = *(const GAS f32x4*)(F.in15 + q4);
            par.muvr = F.in7[1024 + h * 64 + 16 * quarter + (lt & 15)];
            pre = scan_issue(F, bh, quarter, 0, lt); scan_commit(F, pre, par, bh, quarter, 0, F.lds, lt); pre = scan_issue(F, bh, quarter, SC_NS, lt); }
        SCAN_BAR();
        f32x2 S01 = (f32x2){0.f, 0.f}, S23 = (f32x2){0.f, 0.f};
        for (int nb = 0; nb < NBLK; ++nb) {
            LAS unsigned char* cur = F.lds + (nb & 1) * SC_BUF; LAS unsigned char* oth = F.lds + ((nb + 1) & 1) * SC_BUF;
            if (w >= 4) {
                if (nb > 0) scan_flush(F, bh, quarter, (nb - 1) * SC_NS, oth, lt);
                if (nb + 1 < NBLK) scan_commit(F, pre, par, bh, quarter, (nb + 1) * SC_NS, oth, lt);
                if (nb + 2 < NBLK) pre = scan_issue(F, bh, quarter, (nb + 2) * SC_NS, lt);
            } else {
                const LAS f32x4* A = (const LAS f32x4*)cur + q; const LAS f32x4* SCL = (const LAS f32x4*)(cur + SC_SCL);
                const int rowl = 4 * w + rl; const LAS f32x4* VS = (const LAS f32x4*)(cur + SC_VS) + rowl; LAS f32x2* YB = (LAS f32x2*)(cur + SC_YB) + rowl;
                f32x4 az1a = A[0], az1b = A[256], az2a = A[512], az2b = A[768], ww = A[1024], b1 = A[1280], k1 = A[1536], b2 = A[1792], k2 = A[2048], c0 = SCL[0], vs = VS[0]; f32x2 c1 = *(const LAS f32x2*)(SCL + 1);
#pragma unroll 4
                for (int pr = 0; pr < SC_NP; ++pr) {
                    const int pn = (pr + 1) * 16;
                    const f32x4 n_az1a = A[pn], n_az1b = A[256 + pn], n_az2a = A[512 + pn], n_az2b = A[768 + pn], n_ww = A[1024 + pn], n_b1 = A[1280 + pn], n_k1 = A[1536 + pn], n_b2 = A[1792 + pn], n_k2 = A[2048 + pn],
                                n_c0 = SCL[2 * pr + 2], n_vs = VS[pn]; const f32x2 n_c1 = *(const LAS f32x2*)(SCL + 2 * pr + 3);
                    __builtin_amdgcn_sched_barrier(0);
                    f32x2 d1 = S01.xx * az1a.xy; d1 = S01.yy * az1a.zw + d1; d1 = S23.xx * az1b.xy + d1; d1 = S23.yy * az1b.zw + d1;
                    f32x2 d2 = S01.xx * az2a.xy; d2 = S01.yy * az2a.zw + d2; d2 = S23.xx * az2b.xy + d2; d2 = S23.yy * az2b.zw + d2;
                    f32x2 t01 = S01 * ww.xy; t01 = vs.xx * k1.xy + t01; t01 = vs.yy * k2.xy + t01;
                    f32x2 t23 = S23 * ww.zw; t23 = vs.xx * k1.zw + t23; t23 = vs.yy * k2.zw + t23;
                    float e0 = d1.x, e1 = d1.y, e2 = d2.x, e3 = d2.y;
#define SCAN_DPP4(ctrl) "v_add_f32_dpp %0, %0, %0 " ctrl " row_mask:0xf bank_mask:0xf\n\tv_add_f32_dpp %1, %1, %1 " ctrl " row_mask:0xf bank_mask:0xf\n\tv_add_f32_dpp %2, %2, %2 " ctrl " row_mask:0xf bank_mask:0xf\n\tv_add_f32_dpp %3, %3, %3 " ctrl " row_mask:0xf bank_mask:0xf\n\t"
                    asm volatile("s_nop 1\n\t" SCAN_DPP4("quad_perm:[1,0,3,2]") SCAN_DPP4("quad_perm:[2,3,0,1]") SCAN_DPP4("row_half_mirror") SCAN_DPP4("row_mirror") : "+v"(e0), "+v"(e1), "+v"(e2), "+v"(e3));
#undef SCAN_DPP4
                    const float sa1 = e0, z1 = e1, p2 = e2, q2 = e3;
                    f32x2 r2 = (f32x2){p2, q2}; r2 = (f32x2){sa1, sa1} * c0.xy + r2; r2 = vs.xx * c0.zw + r2;
                    const f32x2 sa12 = (f32x2){sa1, r2.x};
                    S01 = sa12.xx * b1.xy + t01; S01 = sa12.yy * b2.xy + S01;
                    S23 = sa12.xx * b1.zw + t23; S23 = sa12.yy * b2.zw + S23;
                    YB[pr * 16] = sa12 * c1 + ((f32x2){z1, r2.y} + vs.zw);
                    az1a = n_az1a; az1b = n_az1b; az2a = n_az2a; az2b = n_az2b; ww = n_ww; b1 = n_b1; k1 = n_k1; b2 = n_b2; k2 = n_k2; c0 = n_c0; c1 = n_c1; vs = n_vs;
                }
            }
            SCAN_BAR();
        }
        if (w >= 4) scan_flush(F, bh, quarter, T - SC_NS, F.lds + ((NBLK - 1) & 1) * SC_BUF, lt);
        asm volatile("s_waitcnt vmcnt(0)" ::: "memory"); SCAN_BAR();
    }
#undef SCAN_BAR
}
__device__ __forceinline__ void p8_post(Frame& F) {
    const float* yraw = (const float*)(F.ws + WS_YRAW); const bf16* RV = (const bf16*)(F.ws + WS_VB); const f32x4* SC = (const f32x4*)(F.ws + WS_SC);
    const bf16* Gt = (const bf16*)(F.ws + WS_G); bf16* YR = (bf16*)(F.ws + WS_YR);
    const int gw = F.vcu * NWAVES + F.wave, NGW = F.G * NWAVES, lane = fresh_tid() & 63, h = lane >> 3, c0 = 8 * lane, n0 = 8 * (lane & 7);
    float lw[8], lb[8]; ld8f(F.in16 + c0, lw); ld8f(F.in17 + c0, lb);
    for (int m0 = gw; m0 < M; m0 += 2 * NGW) {
        float yv[2][8]; v4u uvv[2], ugg[2]; f32x4 scv[2];
#pragma unroll
        for (int rr = 0; rr < 2; ++rr) { const int m = m0 + rr * NGW, b = m >> 12, t = m & (T - 1); const size_t rt = (size_t)(b * 8 + h) * T + t;
            ld8f(yraw + (size_t)m * 512 + c0, yv[rr]); uvv[rr] = *(const GAS v4u*)(RV + rt * 64 + n0); ugg[rr] = *(const GAS v4u*)(Gt + (size_t)m * 512 + c0); scv[rr] = *(const GAS f32x4*)(SC + rt); }
#pragma unroll
        for (int rr = 0; rr < 2; ++rr) { const int m = m0 + rr * NGW; const float bonus = scv[rr].z;
            float v[8], g[8]; unpack8(uvv[rr], v); unpack8(ugg[rr], g);
            float s1 = 0.f;
#pragma unroll
            for (int j = 0; j < 8; ++j) s1 += yv[rr][j];
            const float mean = sum8(s1) * (1.0f / 64.0f); float s2 = 0.f;
#pragma unroll
            for (int j = 0; j < 8; ++j) { yv[rr][j] -= mean; s2 += yv[rr][j] * yv[rr][j]; }
            const float rstd = __builtin_amdgcn_rsqf(sum8(s2) * (1.0f / 64.0f) + GN_EPS);
            float o[8];
#pragma unroll
            for (int j = 0; j < 8; ++j) o[j] = (yv[rr][j] * rstd * lw[j] + lb[j] + bonus * v[j]) * g[j];
            *(GAS v4u*)(YR + (size_t)m * 512 + c0) = pack8u(o); }
    }
}
__device__ __forceinline__ void p13_final(Frame& F) {
    const float* part = (const float*)(F.ws + WS_PART + 3 * 2 * MiB); const float* gn = F.in28;
    const int gw = F.vcu * NWAVES + F.wave, NGW = F.G * NWAVES, lane = fresh_tid() & 63;
    f32x4 g4[4];
#pragma unroll
    for (int j = 0; j < 4; ++j) g4[j] = ((const GAS f32x4*)gn)[lane + 64 * j];
    for (int m0 = gw; m0 < M; m0 += 4 * NGW) { f32x4 v[4][4]; float ps[4];
#pragma unroll
        for (int r = 0; r < 4; ++r) { const int m = m0 + r * NGW; ps[r] = 0.f; if (m < M) { GAS f32x4* xr = (GAS f32x4*)(F.out + (size_t)m * D) + lane; ps[r] = lane < 16 ? part[(size_t)m * 16 + lane] : 0.f;
#pragma unroll
            for (int j = 0; j < 4; ++j) v[r][j] = xr[64 * j]; } }
#pragma unroll
        for (int r = 0; r < 4; ++r) { const int m = m0 + r * NGW; if (m < M) { const float rs = 1.0f / sqrtf(wave_sum(ps[r]) * (1.0f / 1024.0f) + RMS_EPS);
            GAS f32x4* xr = (GAS f32x4*)(F.out + (size_t)m * D) + lane;
#pragma unroll
            for (int j = 0; j < 4; ++j) xr[64 * j] = v[r][j] * rs * g4[j]; } }
    }
}
struct Args { const float* in[29]; float* out; unsigned char* ws; };
__global__ void __launch_bounds__(NWAVES * 64, 2) fwd_megakernel(Args args) {
    extern __shared__ __attribute__((aligned(16))) unsigned char lds[];
    cg::grid_group grid = cg::this_grid();
    Frame F;
    F.lds = (LAS unsigned char*)lds;
    F.tid = threadIdx.x; F.lane = F.tid & 63; F.wave = __builtin_amdgcn_readfirstlane(F.tid >> 6);
    F.G = gridDim.x; { const int bx = blockIdx.x; F.vcu = (F.G % 8 == 0) ? (bx % 8) * (F.G / 8) + bx / 8 : bx; }
F.in0 = args.in[0]; F.in1 = args.in[1]; F.in2 = args.in[2]; F.in3 = args.in[3]; F.in4 = args.in[4]; F.in5 = args.in[5]; F.in6 = args.in[6]; F.in7 = args.in[7]; F.in8 = args.in[8]; F.in9 = args.in[9]; F.in10 = args.in[10]; F.in11 = args.in[11]; F.in12 = args.in[12]; F.in13 = args.in[13]; F.in14 = args.in[14]; F.in15 = args.in[15]; F.in16 = args.in[16]; F.in17 = args.in[17]; F.in18 = args.in[18]; F.in19 = args.in[19]; F.in20 = args.in[20]; F.in21 = args.in[21]; F.in22 = args.in[22]; F.in23 = args.in[23]; F.in24 = args.in[24]; F.in25 = args.in[25]; F.in26 = args.in[26]; F.in27 = args.in[27]; F.in28 = args.in[28];
    F.out = args.out; F.ws = args.ws;
    unsigned char* ws = args.ws;
    bf16* XB = (bf16*)(ws + WS_XB); bf16* HB = (bf16*)(ws + WS_H);
    float* PA = (float*)(ws + WS_PART); float* PB = PA + (size_t)M * 16; float* PC = PB + (size_t)M * 16; float* PD = PC + (size_t)M * 16;
    using pg8::gemm_phase; using pg8::StaticOrder; using pg8::Gemm;
    volatile LAS unsigned* bst = (volatile LAS unsigned*)(F.lds + RING_BYTES);
    if (F.tid == 0) { bst[0] = 0u; bst[1] = 0u; }
    __syncthreads();
    XcdBarrier bar = xcd_barrier_post((unsigned*)ws, bst);
#define SYNC() xcd_barrier(bar)
#define RUN_GEMM(EPI, Aptr, Bptr, NN, KK, ...) do { Gemm g_{(const pg8::bf16_t*)(Aptr), (const pg8::bf16_t*)(Bptr), M, (NN), (KK)}; StaticOrder S_; S_.init(M, (NN), F.G, (int)blockIdx.x); \
        pg8::EPI E_{__VA_ARGS__}; gemm_phase<pg8::EPI, StaticOrder, true, true>(F.lds, g_, S_, E_); } while (0)

    p0_prologue(F); SYNC();
    { const pg8::RsTab tb = fill_rstd(F, PA, 2 * FF); RUN_GEMM(EpiGU, XB, ws + WS_WGU1, 2 * FF, D, tb, F.lds, HB, PA); } grid.sync();
    RUN_GEMM(EpiRes, HB, ws + WS_WDN1, D, FF, F.in0, F.out, XB, PB, 0.5f); SYNC();
    { const pg8::RsTab tb = fill_rstd(F, PB, 2560); RUN_GEMM(EpiProj, XB, ws + WS_WIN, 2560, D, tb, F.lds, (bf16*)(ws + WS_RKVL), (bf16*)(ws + WS_ATTQ), (bf16*)(ws + WS_ATTKV), PB); } SYNC();
    p4_lora_in(F); p6_attention(F); SYNC();
    RUN_GEMM(EpiLora, ws + WS_LA, ws + WS_WLO, 1024, 128, (bf16*)(ws + WS_REC), (bf16*)(ws + WS_REC + 4 * REC_SLOT), (bf16*)(ws + WS_G), F.in8, F.in10, 0);
    RUN_GEMM(EpiLora, ws + WS_LA + (size_t)M * 128 * 2, ws + WS_WLO + 1024 * 128 * 2, 512, 128, (bf16*)(ws + WS_REC), (bf16*)(ws + WS_REC + 4 * REC_SLOT), (bf16*)(ws + WS_G), F.in8, F.in10, 2); SYNC();
    p7_scan(F); SYNC();
    p8_post(F);
    { const pg8::RsTab tb = fill_rstd(F, PB, 2048); RUN_GEMM(EpiGate, XB, ws + WS_WGT, 2048, D, tb, F.lds, (bf16*)(ws + WS_GATES), PB); } SYNC();
    RUN_GEMM(EpiBranch, ws + WS_YR, ws + WS_WBR, D, 512, (const bf16*)(ws + WS_GATES), (bf16*)(ws + WS_MERGED), 0, 0);
    RUN_GEMM(EpiBranch, ws + WS_ATTQ, ws + WS_WBA, D, 512, (const bf16*)(ws + WS_GATES), (bf16*)(ws + WS_MERGED), 1024, 1); SYNC();
    RUN_GEMM(EpiRes, ws + WS_MERGED, ws + WS_WOUT, D, D, F.out, F.out, XB, PC, 1.0f); SYNC();
    { const pg8::RsTab tb = fill_rstd(F, PC, 2 * FF); RUN_GEMM(EpiGU, XB, ws + WS_WGU2, 2 * FF, D, tb, F.lds, HB, PC); } SYNC();
    RUN_GEMM(EpiResNorm, HB, ws + WS_WDN2, D, FF, F.out, F.out, F.in28, (float*)(ws + WS_SC), (unsigned*)(ws + 32768), F.lds, 0.5f);
}

extern "C" void kernel_launch(void* const* d_in, const int* in_sizes, int n_in, void* d_out, int out_size, void* d_ws, size_t ws_size, hipStream_t stream) {
    static int grid = 0;
    if (grid == 0) {
        if (n_in != 29 || in_sizes[0] != M * D || out_size != M * D || ws_size < WS_END) { fprintf(stderr, "kernel_launch: unexpected shapes (n_in %d, ws %zu)\n", n_in, ws_size); grid = -1; return; }
        int dev = 0, cus = 0, per_cu = 0;
        hipGetDevice(&dev); hipDeviceGetAttribute(&cus, hipDeviceAttributeMultiprocessorCount, dev);
        if (hipFuncSetAttribute((const void*)fwd_megakernel, hipFuncAttributeMaxDynamicSharedMemorySize, LDS_BYTES) != hipSuccess) { fprintf(stderr, "kernel_launch: hipFuncSetAttribute failed\n"); grid = -1; return; }
        hipOccupancyMaxActiveBlocksPerMultiprocessor(&per_cu, (const void*)fwd_megakernel, NWAVES * 64, LDS_BYTES);
        (void)hipGetLastError();
        if (per_cu < 1) fprintf(stderr, "kernel_launch: occupancy query says %d blocks/CU\n", per_cu);
        grid = cus;
    }
    if (grid < 0) return;
    if (hipMemsetAsync(d_ws, 0, 65536, stream) != hipSuccess) { fprintf(stderr, "kernel_launch: memset failed\n"); return; }
    Args a{};
    for (int i = 0; i < 29; ++i) a.in[i] = (const float*)d_in[i];
    a.out = (float*)d_out; a.ws = (unsigned char*)d_ws;
    void* kargs[] = {&a};
    hipError_t e = hipLaunchCooperativeKernel((const void*)fwd_megakernel, dim3(grid), dim3(NWAVES * 64), kargs, LDS_BYTES, stream);
    if (e != hipSuccess) fprintf(stderr, "kernel_launch: cooperative launch failed: %s (grid %d)\n", hipGetErrorString(e), grid);
}
```

```cpp
#include <hip/hip_runtime.h>
#include <hip/hip_cooperative_groups.h>
#include <cstdio>
#include <cstdint>
namespace cg = cooperative_groups;
namespace pg8 {
#define PG8_LAS __attribute__((address_space(3)))
typedef unsigned short bf16_t;
typedef short bf16x8 __attribute__((ext_vector_type(8)));
typedef float f32x4 __attribute__((ext_vector_type(4)));
typedef unsigned u32x4 __attribute__((ext_vector_type(4)));
constexpr int BM = 256, BK = 64, HALF = 128, HTB = HALF * BK * 2  , STAGE_BYTES = 8 * HTB, NXCD = 8, WGM = 8;

__host__ __device__ __forceinline__ int lds_byte(int r, int c) { const int st = (r >> 4) * 2 + (c >> 5), rr = r & 15, cc = c & 31, ob = rr * 64 + cc * 2; return st * 1024 + (ob ^ (((ob >> 9) & 1) << 5)); }
__host__ __device__ __forceinline__ void stage_rc(int b, int& R, int& C) { const int st = b / 1024, sb = b % 1024, swz = sb ^ (((sb >> 9) & 1) << 5); R = (st >> 1) * 16 + swz / 64; C = (st & 1) * 32 + (swz % 64) / 2; }
__host__ __device__ __forceinline__ int perm32(int rho) { const int n = rho >> 4, i = rho & 15; return 8 * (i >> 2) + 4 * n + (i & 3); }

struct Unit { int pm, pn; };
struct Gemm { const bf16_t* A; const bf16_t* Bt; int M, N, K; };

struct StaticOrder {
    int nM, nN, nwg, G, c;
    __host__ __device__ void init(int M, int N, int G_, int c_) { nM = M / BM; nN = N / BM; nwg = nM * nN; G = G_; c = c_; }
    __host__ __device__ bool next(int i, Unit& u) const {
        const long L = (long)i * G + c; if (L >= nwg) return false;
        int wgid = (int)L; { const int q = nwg / NXCD, r = nwg % NXCD, xcd = wgid % NXCD, off = wgid / NXCD; wgid = (xcd < r ? xcd * (q + 1) : r * (q + 1) + (xcd - r) * q) + off; }
        const int nig = WGM * nN, gid = wgid / nig, fm = gid * WGM, gsz = (nM - fm) < WGM ? (nM - fm) : WGM;
        u.pm = fm + ((wgid % nig) % gsz); u.pn = (wgid % nig) / gsz; return true;
    }
    __device__ __forceinline__ void a_ready(const Unit&) const {}
    __device__ __forceinline__ void done(const Unit&) const {}
};

__device__ __forceinline__ unsigned cvt_pk_bf16(float lo, float hi) { unsigned r; asm volatile("v_cvt_pk_bf16_f32 %0, %1, %2" : "=v"(r) : "v"(lo), "v"(hi)); return r; }
__device__ __forceinline__ u32x4 pack8(f32x4 v0, f32x4 v1) {
    u32x4 w;
    asm volatile("s_nop 1\n\tv_cvt_pk_bf16_f32 %0, %4, %5\n\tv_cvt_pk_bf16_f32 %1, %6, %7\n\tv_cvt_pk_bf16_f32 %2, %8, %9\n\tv_cvt_pk_bf16_f32 %3, %10, %11"
                 : "=&v"(w.x), "=&v"(w.y), "=&v"(w.z), "=&v"(w.w)
                 : "v"(v0[0]), "v"(v0[1]), "v"(v0[2]), "v"(v0[3]), "v"(v1[0]), "v"(v1[1]), "v"(v1[2]), "v"(v1[3]));
    return w;
}
__device__ __forceinline__ float bf_lo(unsigned u) { return __uint_as_float(u << 16); }
__device__ __forceinline__ float bf_hi(unsigned u) { return __uint_as_float(u & 0xffff0000u); }
constexpr int RS_TAB_OFF = 131072 + 64;
struct RsTab { int pm[4]; };
__device__ __forceinline__ void rows_rstd(const RsTab& tb, PG8_LAS unsigned char* lds, const Unit& u, int wr, int fr, float (&rs)[2][4]) {
    const int slot = u.pm == tb.pm[0] ? 0 : (u.pm == tb.pm[1] ? 1 : (u.pm == tb.pm[2] ? 2 : 3));
    const PG8_LAS float* t = (const PG8_LAS float*)(lds + RS_TAB_OFF) + slot * 256 + wr * 64 + fr;
#pragma unroll
    for (int ai = 0; ai < 2; ++ai)
#pragma unroll
        for (int m = 0; m < 4; ++m) rs[ai][m] = t[ai * HALF + m * 16];
}
__device__ __forceinline__ float fexp_(float x) { return __builtin_amdgcn_exp2f(x * 1.44269504089f); }
__device__ __forceinline__ float sigmoidf_(float x) { return __builtin_amdgcn_rcpf(1.0f + fexp_(-x)); }

struct EpiGU {
    static constexpr bool PERM = true, AFTER_DRAIN = false;
    RsTab tb; PG8_LAS unsigned char* lds;
    bf16_t* H; const float* part;
    __device__ __forceinline__ void operator()(const f32x4 (&acc)[2][2][4][2], const Unit& u, int wr, int wc, int fr, int fq) const {
        const int row0 = u.pm * BM + wr * 64 + fr, col0 = u.pn * 128 + wc * 32 + 8 * fq;
        float rsv[2][4]; rows_rstd(tb, lds, u, wr, fr, rsv);
#pragma unroll
        for (int ai = 0; ai < 2; ++ai)
#pragma unroll
            for (int m = 0; m < 4; ++m) { const int row = row0 + ai * HALF + m * 16; const float rs = rsv[ai][m];
                f32x4 h0, h1;
#pragma unroll
                for (int j = 0; j < 4; ++j) { const float g0 = acc[ai][0][m][0][j] * rs, u0 = acc[ai][1][m][0][j] * rs, g1 = acc[ai][0][m][1][j] * rs, u1 = acc[ai][1][m][1][j] * rs;
                    h0[j] = g0 * u0 * __builtin_amdgcn_rcpf(1.0f + fexp_(-g0)); h1[j] = g1 * u1 * __builtin_amdgcn_rcpf(1.0f + fexp_(-g1)); }
                *(u32x4*)(H + (size_t)row * 2816 + col0) = pack8(h0, h1); asm volatile("" ::: "memory"); }
    }
};
struct EpiRes {
    static constexpr bool PERM = true, AFTER_DRAIN = false;
    const float* xin; float* xout; bf16_t* xb; float* part; float alpha;
    __device__ __forceinline__ void operator()(const f32x4 (&acc)[2][2][4][2], const Unit& u, int wr, int wc, int fr, int fq) const {
        const int row0 = u.pm * BM + wr * 64 + fr, col0 = u.pn * BM + wc * 32 + 8 * fq;
#pragma unroll
        for (int ai = 0; ai < 2; ++ai) {
            f32x4 rv[4][2][2];
#pragma unroll
            for (int m = 0; m < 4; ++m)
#pragma unroll
                for (int bj = 0; bj < 2; ++bj) { const size_t off = (size_t)(row0 + ai * HALF + m * 16) * 1024 + col0 + bj * HALF; rv[m][bj][0] = *(const f32x4*)(xin + off); rv[m][bj][1] = *(const f32x4*)(xin + off + 4); }
            asm volatile("" ::: "memory");
#pragma unroll
            for (int m = 0; m < 4; ++m) { const int row = row0 + ai * HALF + m * 16; float ss = 0.f;
#pragma unroll
                for (int bj = 0; bj < 2; ++bj) { const size_t off = (size_t)row * 1024 + col0 + bj * HALF;
                    const f32x4 v0 = rv[m][bj][0] + acc[ai][bj][m][0] * alpha, v1 = rv[m][bj][1] + acc[ai][bj][m][1] * alpha;
                    *(f32x4*)(xout + off) = v0; *(f32x4*)(xout + off + 4) = v1;
                    if (xb) *(u32x4*)(xb + off) = pack8(v0, v1);
                    ss += (v0[0] * v0[0] + v0[1] * v0[1]) + (v0[2] * v0[2] + v0[3] * v0[3]) + (v1[0] * v1[0] + v1[1] * v1[1]) + (v1[2] * v1[2] + v1[3] * v1[3]); }
                ss += __shfl_xor(ss, 16); ss += __shfl_xor(ss, 32);
                if (fq == 0) part[(size_t)row * 16 + u.pn * 4 + wc] = ss; }
            asm volatile("" ::: "memory"); }
    }
};
constexpr int XT_OFF = 131072 + 64 + 4096;
struct EpiResNorm {
    static constexpr bool PERM = true, AFTER_DRAIN = false;
    const float* xin; float* xout; const float* gain; float* xslot; unsigned* cnt; PG8_LAS unsigned char* lds; float alpha;
    __device__ __forceinline__ void operator()(const f32x4 (&acc_)[2][2][4][2], const Unit& u, int wr, int wc, int fr, int fq) const {
        f32x4 (&acc)[2][2][4][2] = const_cast<f32x4 (&)[2][2][4][2]>(acc_);
        PG8_LAS float* Pt = (PG8_LAS float*)(lds + XT_OFF); PG8_LAS float* St = Pt + 1024;
        const int tid = threadIdx.x, lane = tid & 63, wid = tid >> 6;
        const int row0 = u.pm * BM + wr * 64 + fr, col0 = u.pn * BM + wc * 32 + 8 * fq;
#pragma unroll
        for (int ai = 0; ai < 2; ++ai) {
            f32x4 rv[4][2][2];
#pragma unroll
            for (int m = 0; m < 4; ++m)
#pragma unroll
                for (int bj = 0; bj < 2; ++bj) { const size_t off = (size_t)(row0 + ai * HALF + m * 16) * 1024 + col0 + bj * HALF; rv[m][bj][0] = *(const f32x4*)(xin + off); rv[m][bj][1] = *(const f32x4*)(xin + off + 4); }
            asm volatile("" ::: "memory");
#pragma unroll
            for (int m = 0; m < 4; ++m) { float ss = 0.f;
#pragma unroll
                for (int bj = 0; bj < 2; ++bj) {
                    const f32x4 v0 = rv[m][bj][0] + acc[ai][bj][m][0] * alpha, v1 = rv[m][bj][1] + acc[ai][bj][m][1] * alpha;
                    acc[ai][bj][m][0] = v0; acc[ai][bj][m][1] = v1;
                    ss += (v0[0] * v0[0] + v0[1] * v0[1]) + (v0[2] * v0[2] + v0[3] * v0[3]) + (v1[0] * v1[0] + v1[1] * v1[1]) + (v1[2] * v1[2] + v1[3] * v1[3]); }
                ss += __shfl_xor(ss, 16); ss += __shfl_xor(ss, 32);
                if (fq == 0) Pt[(ai * HALF + wr * 64 + m * 16 + fr) * 4 + wc] = ss; }
            asm volatile("" ::: "memory"); }
        asm volatile("s_waitcnt lgkmcnt(0)" ::: "memory"); __builtin_amdgcn_s_barrier(); asm volatile("" ::: "memory");
        if (tid < 256) { const float ts = (Pt[tid * 4 + 0] + Pt[tid * 4 + 1]) + (Pt[tid * 4 + 2] + Pt[tid * 4 + 3]);
            __hip_atomic_store(xslot + ((size_t)(u.pm * BM + tid) * 4 + u.pn), ts, __ATOMIC_RELAXED, __HIP_MEMORY_SCOPE_AGENT); }
        asm volatile("s_waitcnt vmcnt(0)" ::: "memory");
        if (lane == 0) __hip_atomic_fetch_add(cnt + 64 * u.pm, 1u, __ATOMIC_RELAXED, __HIP_MEMORY_SCOPE_AGENT);
        if (wid == 0) { unsigned sp = 0;
            while ((unsigned)__builtin_amdgcn_readfirstlane(__hip_atomic_load(cnt + 64 * u.pm, __ATOMIC_RELAXED, __HIP_MEMORY_SCOPE_AGENT)) < 32u) { __builtin_amdgcn_s_sleep(2); if (++sp > (1u << 18)) break; }
            __builtin_amdgcn_fence(__ATOMIC_ACQUIRE, "agent"); }
        asm volatile("s_waitcnt vmcnt(0) lgkmcnt(0)" ::: "memory"); __builtin_amdgcn_s_barrier(); asm volatile("" ::: "memory");
        if (tid < 256) { const float* sl = xslot + (size_t)(u.pm * BM + tid) * 4; float tot = 0.f;
#pragma unroll
            for (int t = 0; t < 4; ++t) tot += __hip_atomic_load(sl + t, __ATOMIC_RELAXED, __HIP_MEMORY_SCOPE_AGENT);
            St[tid] = __builtin_amdgcn_rsqf(tot * (1.0f / 1024.0f) + 1e-6f); }
        asm volatile("s_waitcnt vmcnt(0) lgkmcnt(0)" ::: "memory"); __builtin_amdgcn_s_barrier(); asm volatile("" ::: "memory");
        f32x4 g[2][2];
#pragma unroll
        for (int bj = 0; bj < 2; ++bj) { g[bj][0] = *(const f32x4*)(gain + col0 + bj * HALF); g[bj][1] = *(const f32x4*)(gain + col0 + bj * HALF + 4); }
#pragma unroll
        for (int ai = 0; ai < 2; ++ai)
#pragma unroll
            for (int m = 0; m < 4; ++m) { const int rl = ai * HALF + wr * 64 + m * 16 + fr; const float rs = St[rl];
#pragma unroll
                for (int bj = 0; bj < 2; ++bj) { const size_t off = (size_t)(u.pm * BM + rl) * 1024 + col0 + bj * HALF;
                    *(f32x4*)(xout + off) = acc[ai][bj][m][0] * rs * g[bj][0]; *(f32x4*)(xout + off + 4) = acc[ai][bj][m][1] * rs * g[bj][1]; } }
    }
};
struct EpiProj {
    static constexpr bool PERM = true, AFTER_DRAIN = false;
    RsTab tb; PG8_LAS unsigned char* lds;
    bf16_t* rkvl; bf16_t* attq; bf16_t* attkv; const float* part;
    __device__ __forceinline__ void operator()(const f32x4 (&acc)[2][2][4][2], const Unit& u, int wr, int wc, int fr, int fq) const {
        bf16_t* base; int ldc, colt;
        if (u.pn < 7) { base = rkvl; ldc = 1792; colt = u.pn * BM; } else if (u.pn < 9) { base = attq; ldc = 512; colt = (u.pn - 7) * BM; } else { base = attkv; ldc = 256; colt = 0; }
        const int row0 = u.pm * BM + wr * 64 + fr, col0 = colt + wc * 32 + 8 * fq;
        float rsv[2][4]; rows_rstd(tb, lds, u, wr, fr, rsv);
#pragma unroll
        for (int ai = 0; ai < 2; ++ai)
#pragma unroll
            for (int m = 0; m < 4; ++m) { const int row = row0 + ai * HALF + m * 16; const float rs = rsv[ai][m];
#pragma unroll
                for (int bj = 0; bj < 2; ++bj) *(u32x4*)(base + (size_t)row * ldc + col0 + bj * HALF) = pack8(acc[ai][bj][m][0] * rs, acc[ai][bj][m][1] * rs); }
    }
};
struct EpiGate {
    static constexpr bool PERM = true, AFTER_DRAIN = false;
    RsTab tb; PG8_LAS unsigned char* lds;
    bf16_t* gates; const float* part;
    __device__ __forceinline__ void operator()(const f32x4 (&acc)[2][2][4][2], const Unit& u, int wr, int wc, int fr, int fq) const {
        const int row0 = u.pm * BM + wr * 64 + fr, col0 = u.pn * BM + wc * 32 + 8 * fq;
        float rsv[2][4]; rows_rstd(tb, lds, u, wr, fr, rsv);
#pragma unroll
        for (int ai = 0; ai < 2; ++ai)
#pragma unroll
            for (int m = 0; m < 4; ++m) { const int row = row0 + ai * HALF + m * 16; const float rs = rsv[ai][m];
#pragma unroll
                for (int bj = 0; bj < 2; ++bj) { f32x4 v0, v1;
#pragma unroll
                    for (int j = 0; j < 4; ++j) { v0[j] = sigmoidf_(acc[ai][bj][m][0][j] * rs); v1[j] = sigmoidf_(acc[ai][bj][m][1][j] * rs); }
                    *(u32x4*)(gates + (size_t)row * 2048 + col0 + bj * HALF) = pack8(v0, v1); } }
    }
};
struct EpiLora {
    static constexpr bool PERM = true, AFTER_DRAIN = false;
    bf16_t* rec_lw; bf16_t* rec_a; bf16_t* g; const float* w0; const float* a0; int kind_base;
    template <int KIND> __device__ __forceinline__ void body(const f32x4 (&acc)[2][2][4][2], const Unit& u, int wr, int wc, int fr, int fq) const {
        const int row0 = u.pm * BM + wr * 64 + fr, col0 = (u.pn & 1) * BM + wc * 32 + 8 * fq;
#pragma unroll
        for (int ai = 0; ai < 2; ++ai)
#pragma unroll
            for (int m = 0; m < 4; ++m) { const int row = row0 + ai * HALF + m * 16; const int b = row >> 12, t = row & 4095;
#pragma unroll
                for (int bj = 0; bj < 2; ++bj) { const int c = col0 + bj * HALF; f32x4 v0 = acc[ai][bj][m][0], v1 = acc[ai][bj][m][1];
                    if (KIND != 2) { const float* bias = (KIND == 0 ? w0 : a0) + c; v0 = v0 + *(const f32x4*)bias; v1 = v1 + *(const f32x4*)(bias + 4); }
                    if (KIND == 2) { *(u32x4*)(g + (size_t)row * 512 + c) = pack8(v0, v1); }
                    else {
#pragma unroll
                        for (int j = 0; j < 4; ++j) {
                            if (KIND == 0) { v0[j] = -0.60653065971263342f * sigmoidf_(v0[j]); v1[j] = -0.60653065971263342f * sigmoidf_(v1[j]); }
                            else { v0[j] = sigmoidf_(v0[j]); v1[j] = sigmoidf_(v1[j]); } }
                        bf16_t* dst = (KIND == 0 ? rec_lw : rec_a) + ((size_t)((b * 8 + (c >> 6)) * 4096 + t)) * 64 + (c & 63);
                        *(u32x4*)dst = pack8(v0, v1); } }
                asm volatile("" ::: "memory"); }
    }
    __device__ __forceinline__ void operator()(const f32x4 (&acc)[2][2][4][2], const Unit& u, int wr, int wc, int fr, int fq) const {
        const int kind = kind_base + (u.pn >> 1);
        if (kind == 0) body<0>(acc, u, wr, wc, fr, fq); else if (kind == 1) body<1>(acc, u, wr, wc, fr, fq); else body<2>(acc, u, wr, wc, fr, fq);
    }
};
struct EpiBranch {
    static constexpr bool PERM = true, AFTER_DRAIN = false;
    const bf16_t* gates; bf16_t* merged; int goff; int accum;
    __device__ __forceinline__ void operator()(const f32x4 (&acc)[2][2][4][2], const Unit& u, int wr, int wc, int fr, int fq) const {
        const int row0 = u.pm * BM + wr * 64 + fr, col0 = u.pn * BM + wc * 32 + 8 * fq;
#pragma unroll
        for (int ai = 0; ai < 2; ++ai) {
            u32x4 gq[4][2], pq[4][2];
#pragma unroll
            for (int m = 0; m < 4; ++m)
#pragma unroll
                for (int bj = 0; bj < 2; ++bj) { const int row = row0 + ai * HALF + m * 16, c = col0 + bj * HALF;
                    gq[m][bj] = *(const u32x4*)(gates + (size_t)row * 2048 + goff + c);
                    pq[m][bj] = accum ? *(const u32x4*)(merged + (size_t)row * 1024 + c) : (u32x4){0u, 0u, 0u, 0u}; }
            asm volatile("" ::: "memory");
#pragma unroll
            for (int m = 0; m < 4; ++m)
#pragma unroll
                for (int bj = 0; bj < 2; ++bj) { const int row = row0 + ai * HALF + m * 16, c = col0 + bj * HALF; const u32x4 g4 = gq[m][bj], p4 = pq[m][bj];
                    f32x4 v0 = acc[ai][bj][m][0], v1 = acc[ai][bj][m][1];
                    v0[0] = v0[0] * bf_lo(g4.x) + bf_lo(p4.x); v0[1] = v0[1] * bf_hi(g4.x) + bf_hi(p4.x); v0[2] = v0[2] * bf_lo(g4.y) + bf_lo(p4.y); v0[3] = v0[3] * bf_hi(g4.y) + bf_hi(p4.y);
                    v1[0] = v1[0] * bf_lo(g4.z) + bf_lo(p4.z); v1[1] = v1[1] * bf_hi(g4.z) + bf_hi(p4.z); v1[2] = v1[2] * bf_lo(g4.w) + bf_lo(p4.w); v1[3] = v1[3] * bf_hi(g4.w) + bf_hi(p4.w);
                    *(u32x4*)(merged + (size_t)row * 1024 + c) = pack8(v0, v1); }
            asm volatile("" ::: "memory"); }
    }
};

template <class Epi, class Sched, bool ALIGN_EPI = false, bool SP2 = false>
__device__ __forceinline__ void gemm_phase(PG8_LAS unsigned char* lds, const Gemm g, const Sched& S, const Epi& E) {
    int tid_ = threadIdx.x; asm volatile("" : "+v"(tid_));
    const int tid = tid_, wid = __builtin_amdgcn_readfirstlane(tid >> 6), lane = tid & 63, wr = wid >> 2, wc = wid & 3, fr = lane & 15, fq = lane >> 4;
    const int K = g.K, nt = K / BK;
    unsigned voffA[2], voffB[2];
#pragma unroll
    for (int i = 0; i < 2; ++i) { int R, C; stage_rc(tid * 16 + i * 8192, R, C); const int Rb = Epi::PERM ? ((R & ~31) + perm32(R & 31)) : R;
        voffA[i] = (unsigned)(R * K + C) * 2u; voffB[i] = (unsigned)(Rb * K + C) * 2u; }
    const size_t kstep = (size_t)(BK * 2);
    const size_t hstep = (size_t)HALF * K * 2;
    const size_t tstep = 2 * hstep;
    const unsigned ldsw = (unsigned)wid * 1024u;
    const int aoff = lds_byte(wr * 64 + fr, fq * 8), boff = lds_byte(wc * 32 + fr, fq * 8);
#define PG8_SA(b, h) (((b) * 2 + (h)) * HTB)
#define PG8_SB(b, h) ((4 + (b) * 2 + (h)) * HTB)
#define PG8_STAGE(bufoff, gbase, voff) do { _Pragma("unroll") for (int _i = 0; _i < 2; ++_i) \
        __builtin_amdgcn_global_load_lds((const unsigned*)((const char*)(gbase) + (voff)[_i]), (PG8_LAS unsigned*)(lds + (bufoff) + ldsw + _i * 8192), 16, 0, 0); } while (0)
#define PG8_LDA(dst, b, h) do { _Pragma("unroll") for (int m = 0; m < 4; ++m) _Pragma("unroll") for (int k = 0; k < 2; ++k) dst[m][k] = *(const PG8_LAS bf16x8*)(lds + PG8_SA(b, h) + aoff + m * 2048 + k * 1024); } while (0)
#define PG8_LDB(dst, b, h) do { _Pragma("unroll") for (int n = 0; n < 2; ++n) _Pragma("unroll") for (int k = 0; k < 2; ++k) dst[n][k] = *(const PG8_LAS bf16x8*)(lds + PG8_SB(b, h) + boff + n * 2048 + k * 1024); } while (0)
#define PG8_MMA(ai, bj, At, Bt) do { __builtin_amdgcn_s_setprio(1); _Pragma("unroll") for (int m = 0; m < 4; ++m) _Pragma("unroll") for (int n = 0; n < 2; ++n) _Pragma("unroll") for (int k = 0; k < 2; ++k) \
        acc[ai][bj][m][n] = __builtin_amdgcn_mfma_f32_16x16x32_bf16(Bt[n][k], At[m][k], acc[ai][bj][m][n], 0, 0, 0); __builtin_amdgcn_s_setprio(0); } while (0)
#define PG8_WAIT_V(n) asm volatile("s_waitcnt vmcnt(" #n ")" ::: "memory")
#define PG8_WAIT_L(n) asm volatile("s_waitcnt lgkmcnt(" #n ")" ::: "memory")
#define PG8_BAR __builtin_amdgcn_s_barrier()
#define PG8_SCHED __builtin_amdgcn_sched_barrier(0)
    Unit cur, nxt; int ui = 0;
    if (!S.next(0, cur)) return;
    f32x4 acc[2][2][4][2];
#pragma unroll
    for (int a = 0; a < 2; ++a)
#pragma unroll
        for (int b = 0; b < 2; ++b)
#pragma unroll
            for (int m = 0; m < 4; ++m)
#pragma unroll
                for (int n = 0; n < 2; ++n) acc[a][b][m][n] = (f32x4){0.f, 0.f, 0.f, 0.f};
    bf16x8 At[4][2], B0[2][2], B1[2][2];
    const char* cA = (const char*)g.A + (size_t)cur.pm * tstep; const char* cB = (const char*)g.Bt + (size_t)cur.pn * tstep;
    S.a_ready(cur);
    if constexpr (SP2) {
        PG8_STAGE(PG8_SB(0, 0), cB, voffB); PG8_STAGE(PG8_SB(0, 1), cB + hstep, voffB); PG8_STAGE(PG8_SA(0, 0), cA, voffA); PG8_STAGE(PG8_SA(0, 1), cA + hstep, voffA);
        if (wr == 1) PG8_BAR;
        PG8_WAIT_V(2); PG8_BAR;
        PG8_STAGE(PG8_SB(1, 0), cB + kstep, voffB); PG8_STAGE(PG8_SA(1, 0), cA + kstep, voffA); PG8_STAGE(PG8_SB(1, 1), cB + hstep + kstep, voffB);
        PG8_WAIT_V(6); PG8_BAR;
    } else {
        PG8_STAGE(PG8_SB(0, 0), cB, voffB); PG8_STAGE(PG8_SA(0, 0), cA, voffA); PG8_STAGE(PG8_SB(0, 1), cB + hstep, voffB); PG8_STAGE(PG8_SA(0, 1), cA + hstep, voffA);
        if (wr == 1) PG8_BAR;
        PG8_WAIT_V(4); PG8_BAR;
        PG8_STAGE(PG8_SB(1, 0), cB + kstep, voffB); PG8_STAGE(PG8_SA(1, 0), cA + kstep, voffA); PG8_STAGE(PG8_SB(1, 1), cB + hstep + kstep, voffB);
        PG8_WAIT_V(6); PG8_BAR;
    }
    for (;;) {
        const bool has_next = S.next(ui + 1, nxt);
        const char* nA = has_next ? (const char*)g.A + (size_t)nxt.pm * tstep : cA; const char* nB = has_next ? (const char*)g.Bt + (size_t)nxt.pn * tstep : cB;
        for (int t = 0; t < nt; t += 2) {
            const bool last = (t == nt - 2);
            const char* a1 = cA + (size_t)(t + 1) * kstep;
            const char* a2 = last ? nA : cA + (size_t)(t + 2) * kstep; const char* b2 = last ? nB : cB + (size_t)(t + 2) * kstep;
            const char* a3 = a2 + kstep; const char* b3 = b2 + kstep;
            if (last && has_next) S.a_ready(nxt);
            if constexpr (SP2) {
            PG8_LDB(B0, 0, 0); PG8_LDB(B1, 0, 1); PG8_SCHED; PG8_LDA(At, 0, 0); PG8_STAGE(PG8_SA(1, 1), a1 + hstep, voffA);
            PG8_WAIT_V(8); PG8_WAIT_L(0); PG8_BAR; PG8_MMA(0, 0, At, B0); PG8_MMA(0, 1, At, B1); PG8_BAR; PG8_SCHED;
            PG8_LDA(At, 0, 1); PG8_STAGE(PG8_SB(0, 0), b2, voffB); PG8_STAGE(PG8_SB(0, 1), b2 + hstep, voffB); PG8_STAGE(PG8_SA(0, 0), a2, voffA);
            PG8_WAIT_V(8); PG8_WAIT_L(0); PG8_BAR; PG8_MMA(1, 0, At, B0); PG8_MMA(1, 1, At, B1); PG8_BAR; PG8_SCHED;
            PG8_LDB(B0, 1, 0); PG8_LDB(B1, 1, 1); PG8_SCHED; PG8_LDA(At, 1, 0); PG8_STAGE(PG8_SA(0, 1), a2 + hstep, voffA);
            PG8_WAIT_V(8); PG8_WAIT_L(0); PG8_BAR; PG8_MMA(0, 0, At, B0); PG8_MMA(0, 1, At, B1); PG8_BAR; PG8_SCHED;
            PG8_LDA(At, 1, 1); PG8_STAGE(PG8_SB(1, 0), b3, voffB); PG8_STAGE(PG8_SB(1, 1), b3 + hstep, voffB); PG8_STAGE(PG8_SA(1, 0), a3, voffA);
            PG8_WAIT_V(8); PG8_WAIT_L(0); PG8_BAR; PG8_MMA(1, 0, At, B0); PG8_MMA(1, 1, At, B1); PG8_BAR; PG8_SCHED;
            } else {
            PG8_LDB(B0, 0, 0); PG8_SCHED; PG8_LDA(At, 0, 0); PG8_STAGE(PG8_SA(1, 1), a1 + hstep, voffA);
            PG8_WAIT_L(8); PG8_BAR; PG8_WAIT_L(0); PG8_MMA(0, 0, At, B0); PG8_BAR; PG8_SCHED;
            PG8_LDB(B1, 0, 1); PG8_STAGE(PG8_SB(0, 0), b2, voffB);
            PG8_BAR; PG8_WAIT_L(0); PG8_MMA(0, 1, At, B1); PG8_BAR;
            PG8_LDA(At, 0, 1); PG8_STAGE(PG8_SA(0, 0), a2, voffA);
            PG8_BAR; PG8_WAIT_L(0); PG8_MMA(1, 0, At, B0); PG8_BAR; PG8_SCHED;
            PG8_STAGE(PG8_SB(0, 1), b2 + hstep, voffB);
            PG8_WAIT_V(6); PG8_BAR; PG8_MMA(1, 1, At, B1); PG8_BAR;
            PG8_LDB(B0, 1, 0); PG8_SCHED; PG8_LDA(At, 1, 0); PG8_STAGE(PG8_SA(0, 1), a2 + hstep, voffA);
            PG8_WAIT_L(8); PG8_BAR; PG8_WAIT_L(0); PG8_MMA(0, 0, At, B0); PG8_BAR; PG8_SCHED;
            PG8_LDB(B1, 1, 1); PG8_STAGE(PG8_SB(1, 0), b3, voffB);
            PG8_BAR; PG8_WAIT_L(0); PG8_MMA(0, 1, At, B1); PG8_BAR;
            PG8_LDA(At, 1, 1); PG8_STAGE(PG8_SA(1, 0), a3, voffA);
            PG8_BAR; PG8_WAIT_L(0); PG8_MMA(1, 0, At, B0); PG8_BAR; PG8_SCHED;
            PG8_STAGE(PG8_SB(1, 1), b3 + hstep, voffB);
            PG8_WAIT_V(6); PG8_BAR; PG8_MMA(1, 1, At, B1); PG8_BAR;
            }
        }
        if constexpr (ALIGN_EPI) { if (wr == 0) PG8_BAR; }
        if constexpr (!Epi::AFTER_DRAIN) { E(acc, cur, wr, wc, fr, fq); S.done(cur); }
        if (!has_next) break;
#pragma unroll
        for (int a = 0; a < 2; ++a)
#pragma unroll
            for (int b = 0; b < 2; ++b)
#pragma unroll
                for (int m = 0; m < 4; ++m)
#pragma unroll
                    for (int n = 0; n < 2; ++n) acc[a][b][m][n] = (f32x4){0.f, 0.f, 0.f, 0.f};
        cur = nxt; cA = nA; cB = nB; ++ui;
        if constexpr (ALIGN_EPI) { if (wr == 1) PG8_BAR; }
    }
    PG8_WAIT_V(0);
    if constexpr (!ALIGN_EPI) { if (wr == 0) PG8_BAR; }
    PG8_BAR;
    if constexpr (Epi::AFTER_DRAIN) { E.fused(acc, cur, wr, wc, fr, fq, lds, wid, lane); S.done(cur); }
#undef PG8_SA
#undef PG8_SB
#undef PG8_STAGE
#undef PG8_LDA
#undef PG8_LDB
#undef PG8_MMA
#undef PG8_WAIT_V
#undef PG8_WAIT_L
#undef PG8_BAR
#undef PG8_SCHED
}
}
constexpr int NWAVES = 8;
constexpr int BATCH = 8, T = 4096, D = 1024, M = BATCH * T, FF = 2816, NH = 8, HD = 64, INC = 4512;
constexpr float RMS_EPS = 1e-6f, GN_EPS = 64e-5f;
constexpr size_t MiB = 1u << 20;
constexpr size_t WS_PART = 1 * MiB;
constexpr size_t WS_SC = 9 * MiB;
constexpr size_t WS_WGU1 = 13 * MiB, WS_WDN1 = WS_WGU1 + 11 * MiB, WS_WGU2 = WS_WDN1 + 5632 * 1024, WS_WDN2 = WS_WGU2 + 11 * MiB;
constexpr size_t WS_WIN = WS_WDN2 + 5632 * 1024, WS_WGT = WS_WIN + 5 * MiB, WS_WLO = WS_WGT + 4 * MiB, WS_WBR = WS_WLO + 768 * 1024, WS_WBA = WS_WBR + 1 * MiB, WS_WOUT = WS_WBA + 1 * MiB;
constexpr size_t WS_XB = 62 * MiB;
constexpr size_t WS_ATTQ = 126 * MiB;
constexpr size_t WS_ATTKV = 158 * MiB;
constexpr size_t WS_RKVL = 174 * MiB;
constexpr size_t WS_G = 286 * MiB;
constexpr size_t WS_REC = 318 * MiB, REC_SLOT = 32 * MiB;
constexpr size_t WS_H = 126 * MiB;
constexpr size_t WS_YRAW = WS_REC + 1 * REC_SLOT;
constexpr size_t WS_MERGED = WS_REC + 1 * REC_SLOT;
constexpr size_t WS_VB = WS_REC + 3 * REC_SLOT;
constexpr size_t WS_GATES = WS_ATTKV;
constexpr size_t WS_YR = WS_REC + 4 * REC_SLOT;
constexpr size_t WS_LA = WS_REC + 5 * REC_SLOT;
constexpr size_t WS_END = WS_REC + 6 * REC_SLOT;
static_assert(WS_WOUT + 4 * MiB <= WS_XB && WS_H + (size_t)M * FF * 2 <= WS_REC && WS_GATES + (size_t)M * 2048 * 2 <= WS_G, "ws map");
constexpr int RING_BYTES = 131072, LDS_BYTES = 147456;

#define GAS __attribute__((address_space(1)))
#define LAS __attribute__((address_space(3)))
typedef unsigned short bf16;
typedef unsigned v4u __attribute__((ext_vector_type(4)));
typedef unsigned v2u __attribute__((ext_vector_type(2)));
typedef float f32x4 __attribute__((ext_vector_type(4)));
typedef float f32x2 __attribute__((ext_vector_type(2)));
typedef short bf16x8 __attribute__((ext_vector_type(8)));
#define LDS_WAIT() asm volatile("s_waitcnt lgkmcnt(0)" ::: "memory")
__device__ __forceinline__ unsigned f2bf(float f) { unsigned u = __builtin_bit_cast(unsigned, f); return (u + 0x7fffu + ((u >> 16) & 1u)) >> 16; }
__device__ __forceinline__ unsigned pk2(float lo, float hi) { unsigned r; asm("s_nop 1\n\tv_cvt_pk_bf16_f32 %0, %1, %2\n\ts_nop 1" : "=v"(r) : "v"(lo), "v"(hi)); return r; }
__device__ __forceinline__ float bflo(unsigned u) { return __uint_as_float(u << 16); }
__device__ __forceinline__ float bfhi(unsigned u) { return __uint_as_float(u & 0xffff0000u); }
__device__ __forceinline__ float bf1(bf16 h) { return __uint_as_float((unsigned)h << 16); }
__device__ __forceinline__ float wave_sum(float v) {
#pragma unroll
    for (int o = 1; o < 64; o <<= 1) v += __shfl_xor(v, o);
    return v;
}
template <int CTRL> __device__ __forceinline__ float dppf(float x) { return __builtin_bit_cast(float, __builtin_amdgcn_update_dpp(0, __builtin_bit_cast(int, x), CTRL, 0xf, 0xf, false)); }
__device__ __forceinline__ float row16_sum(float x) { x += dppf<0xB1>(x); x += dppf<0x4E>(x); x += dppf<0x141>(x); x += dppf<0x140>(x); return x; }

#define RLX_AGENT __ATOMIC_RELAXED, __HIP_MEMORY_SCOPE_AGENT
#define XB_TMO      128
#define XB_XCNT(j)  (256  + 64 * (j))
#define XB_XSUB(j)  (1280 + 64 * (j))
#define XB_XGEN(j)  (2304 + 64 * (j))
#define XB_TOP      3328
#define XB_TOPGEN   3392
#define XCD_BAR_WORDS 3456
#define XB_SPIN_CAP (1u << 18)

__device__ __forceinline__ unsigned xb_ld(unsigned* p)              { return __hip_atomic_load(p, __ATOMIC_RELAXED, __HIP_MEMORY_SCOPE_AGENT); }
__device__ __forceinline__ unsigned xb_add(unsigned* p, unsigned v) { return __hip_atomic_fetch_add(p, v, __ATOMIC_RELAXED, __HIP_MEMORY_SCOPE_AGENT); }
__device__ __forceinline__ unsigned xb_xcc_id() { return (unsigned)__builtin_amdgcn_s_getreg((3 << 11) | 20) & 0xFu; }
#define XB_SPIN(cond, bar) do { unsigned _sp = 0; while (cond) { __builtin_amdgcn_s_sleep(1); \
    if ((++_sp & 255u) == 0u) { if (xb_ld(&(bar)[XB_TMO])) break; if (_sp > XB_SPIN_CAP) { atomicAdd(&(bar)[XB_TMO], 1u); break; } } } } while (0)

struct XcdBarrier {
    unsigned* bar; unsigned x;
    volatile LAS unsigned* st;
};

__device__ __forceinline__ XcdBarrier xcd_barrier_post(unsigned* bar, volatile LAS unsigned* st) {
    XcdBarrier b; b.bar = bar; b.x = xb_xcc_id(); b.st = st;
    if (threadIdx.x == 0) (void)xb_add(&bar[XB_XCNT(b.x)], 1u);
    return b;
}
__device__ __forceinline__ void xcd_barrier_complete(unsigned* bar, unsigned x, unsigned& nloc, unsigned& nx) {
    const unsigned G = gridDim.x * gridDim.y * gridDim.z;
    unsigned sum, cnt, mine, sp = 0u;
    for (;;) {
        sum = 0u; cnt = 0u; mine = 0u;
#pragma unroll
        for (unsigned j = 0; j < 16; ++j) { const unsigned c = xb_ld(&bar[XB_XCNT(j)]); sum += c; cnt += (c > 0u) ? 1u : 0u; mine = (j == x) ? c : mine; }
        if (sum == G) break;
        __builtin_amdgcn_s_sleep(1);
        if ((++sp & 255u) == 0u) { if (xb_ld(&bar[XB_TMO])) break; if (sp > XB_SPIN_CAP) { atomicAdd(&bar[XB_TMO], 1u); break; } }
    }
    nloc = mine > 0u ? mine : 1u; nx = cnt > 0u ? cnt : 1u;
}

__device__ __forceinline__ void xcd_barrier(const XcdBarrier& b) {
    asm volatile("s_waitcnt vmcnt(0)" ::: "memory");
    __syncthreads();
    if (threadIdx.x == 0) {
        unsigned* bar = b.bar;
        __builtin_amdgcn_s_waitcnt(0);
        unsigned nloc = b.st[0], nx = b.st[1];
        if (nloc == 0u) { xcd_barrier_complete(bar, b.x, nloc, nx); b.st[0] = nloc; b.st[1] = nx; }
        const unsigned old = xb_add(&bar[XB_XSUB(b.x)], 1u);
        const unsigned gen = old / nloc;
        if (old + 1u == (gen + 1u) * nloc) {
            __builtin_amdgcn_fence(__ATOMIC_RELEASE, "agent");
            asm volatile("s_waitcnt vmcnt(0)" ::: "memory");
            const unsigned og = xb_add(&bar[XB_TOP], 1u);
            const unsigned tg = og / nx;
            if (og + 1u == (tg + 1u) * nx) xb_add(&bar[XB_TOPGEN], 1u);
            else XB_SPIN(xb_ld(&bar[XB_TOPGEN]) == tg, bar);
            __builtin_amdgcn_fence(__ATOMIC_ACQUIRE, "agent");
            xb_add(&bar[XB_XGEN(b.x)], 1u);
            asm volatile("s_waitcnt vmcnt(0)" ::: "memory");
        } else {
            XB_SPIN(xb_ld(&bar[XB_XGEN(b.x)]) == gen, bar);
            __builtin_amdgcn_fence(__ATOMIC_ACQUIRE, "agent");
            asm volatile("s_waitcnt vmcnt(0)" ::: "memory");
        }
    }
    __syncthreads();
}

__device__ __forceinline__ int fresh_tid() { int t = threadIdx.x; asm volatile("" : "+v"(t)); return t; }
struct Frame {
    LAS unsigned char* lds;
    int tid, lane, wave, vcu, G;
    const float *in0, *in1, *in2, *in3, *in4, *in5, *in6, *in7, *in8, *in9, *in10, *in11, *in12, *in13, *in14, *in15, *in16, *in17, *in18, *in19, *in20, *in21, *in22, *in23, *in24, *in25, *in26, *in27, *in28; float* out; unsigned char* ws;
};

__device__ __forceinline__ pg8::RsTab fill_rstd(Frame& F, const float* part, int N) {
    pg8::StaticOrder S; S.init(M, N, F.G, (int)blockIdx.x); pg8::Unit u; pg8::RsTab tb; tb.pm[0] = tb.pm[1] = tb.pm[2] = tb.pm[3] = -1;
    for (int i = 0; S.next(i, u); ++i) { if (u.pm == tb.pm[0] || u.pm == tb.pm[1] || u.pm == tb.pm[2] || u.pm == tb.pm[3]) continue;
        if (tb.pm[0] < 0) tb.pm[0] = u.pm; else if (tb.pm[1] < 0) tb.pm[1] = u.pm; else if (tb.pm[2] < 0) tb.pm[2] = u.pm; else tb.pm[3] = u.pm; }
    const int tid = fresh_tid(); LAS float* t = (LAS float*)(F.lds + pg8::RS_TAB_OFF);
#pragma unroll
    for (int h = 0; h < 2; ++h) { const int e = tid + 512 * h, slot = e >> 8, r = e & 255; const int pm = slot == 0 ? tb.pm[0] : slot == 1 ? tb.pm[1] : slot == 2 ? tb.pm[2] : tb.pm[3];
        if (pm >= 0) { const GAS f32x4* p = (const GAS f32x4*)(part + ((size_t)pm * 256 + r) * 16); const f32x4 a = p[0], b = p[1], c = p[2], d = p[3];
            const float sm = ((a[0] + a[1]) + (a[2] + a[3])) + ((b[0] + b[1]) + (b[2] + b[3])) + ((c[0] + c[1]) + (c[2] + c[3])) + ((d[0] + d[1]) + (d[2] + d[3]));
            t[e] = __builtin_amdgcn_rsqf(sm * (1.0f / 1024.0f) + RMS_EPS); } }
    __syncthreads();
    return tb;
}
__device__ __forceinline__ void tr_item(const float* W, int ldn, int k0, int n0, bf16* WT, int ldk, int drow0, int dk0, const float* scale, int dup, LAS float* scr, int lane) {
    float tv[32], ts[32];
#pragma unroll
    for (int i = 0; i < 32; ++i) { const int kk = 2 * i + (lane >> 5); tv[i] = W[(size_t)(k0 + kk) * ldn + n0 + (lane & 31)]; ts[i] = scale ? scale[k0 + kk] : 1.0f; }
#pragma unroll
    for (int i = 0; i < 32; ++i) { const int kk = 2 * i + (lane >> 5); scr[kk * 33 + (lane & 31)] = tv[i] * ts[i]; }
    LDS_WAIT(); asm volatile("" ::: "memory");
    const int c = lane & 7;
#pragma unroll
    for (int j = 0; j < 4; ++j) { const int n = (lane >> 3) + 8 * j; const LAS float* s = scr + (8 * c) * 33 + n;
        v4u o; o.x = pk2(s[0 * 33], s[1 * 33]); o.y = pk2(s[2 * 33], s[3 * 33]); o.z = pk2(s[4 * 33], s[5 * 33]); o.w = pk2(s[6 * 33], s[7 * 33]);
        bf16* dp = WT + (size_t)(drow0 + n0 + n) * ldk + dk0 + k0 + 8 * c;
        *(GAS v4u*)dp = o; if (dup) *(GAS v4u*)(dp + dup) = o; }
    LDS_WAIT(); asm volatile("" ::: "memory");
}
__device__ __forceinline__ void p0_prologue(Frame& F) {
    LAS float* scr = (LAS float*)(F.lds + F.wave * 16384);
    unsigned char* ws = F.ws;
    const int gw = F.vcu * NWAVES + F.wave, NGW = F.G * NWAVES, lane = fresh_tid() & 63;
    constexpr int I_GU = 16 * 88, I_DN = 44 * 32, I_IN = 16 * 77, I_GT = 16 * 64, I_BR = 8 * 32, I_OUT = 16 * 32;
    constexpr int NITEMS = 4 * I_GU + 2 * I_DN + I_IN + I_GT + 2 * I_BR + I_OUT;
    for (int it = gw; it < NITEMS; it += NGW) {
        int r = it;
        if (r < 4 * I_GU) {
            const int which = r / I_GU; r -= which * I_GU; const int kb = r / 88, nb = r % 88, n0 = nb * 32;
            const float* W = which == 0 ? F.in2 : which == 1 ? F.in3 : which == 2 ? F.in25 : F.in26;
            tr_item(W, FF, kb * 64, n0, (bf16*)(ws + (which < 2 ? WS_WGU1 : WS_WGU2)), D, (n0 >> 7) * 256 + (which & 1) * 128 + (n0 & 127) - n0, 0, which < 2 ? F.in1 : F.in24, 0, scr, lane);
            continue; }
        r -= 4 * I_GU;
        if (r < 2 * I_DN) { const int which = r / I_DN; r -= which * I_DN; const int kb = r / 32, nb = r % 32;
            tr_item(which ? F.in27 : F.in4, D, kb * 64, nb * 32, (bf16*)(ws + (which ? WS_WDN2 : WS_WDN1)), FF, 0, 0, nullptr, 0, scr, lane); continue; }
        r -= 2 * I_DN;
        if (r < I_IN) { const int kb = r / 77, nb = r % 77, n0 = nb * 32;
            tr_item(F.in6, INC, kb * 64, n0, (bf16*)(ws + WS_WIN), D, n0 < 1696 ? 0 : 96, 0, F.in5, 0, scr, lane); continue; }
        r -= I_IN;
        if (r < I_GT) { const int kb = r / 64, nb = r % 64;
            tr_item(F.in6, INC, kb * 64, 2464 + nb * 32, (bf16*)(ws + WS_WGT), D, -2464, 0, F.in5, 0, scr, lane); continue; }
        r -= I_GT;
        if (r < 2 * I_BR) { const int which = r / I_BR; r -= which * I_BR; const int kb = r / 32, nb = r % 32;
            tr_item(which ? F.in22 : F.in21, D, kb * 64, nb * 32, (bf16*)(ws + (which ? WS_WBA : WS_WBR)), 512, 0, 0, nullptr, 0, scr, lane); continue; }
        r -= 2 * I_BR;
        { const int kb = r / 32, nb = r % 32; tr_item(F.in23, D, kb * 64, nb * 32, (bf16*)(ws + WS_WOUT), D, 0, 0, nullptr, 0, scr, lane); }
    }
    { GAS v4u* z = (GAS v4u*)(ws + WS_WIN + (size_t)1696 * D * 2); for (int i = gw * 64 + lane; i < 12288; i += NGW * 64) z[i] = (v4u){0u, 0u, 0u, 0u}; }
    { bf16* WL = (bf16*)(ws + WS_WLO);
      for (int i = gw * 64 + lane; i < 1536 * 128; i += NGW * 64) { const int n = i >> 7, k = i & 127, grp = n >> 9, nn = n & 511; float v = 0.f;
          if (grp == 0) { if (k < 32) v = F.in9[k * 512 + nn]; } else if (grp == 1) { if (k >= 32 && k < 64) v = F.in11[(k - 32) * 512 + nn]; } else { if (k < 96) v = F.in12[k * 512 + nn]; }
          WL[i] = (bf16)f2bf(v); } }
    { const float* x = F.in0; bf16* XB = (bf16*)(ws + WS_XB); float* part = (float*)(ws + WS_PART);
      for (int m0 = gw; m0 < M; m0 += 4 * NGW) { f32x4 v[4][4];
#pragma unroll
          for (int r = 0; r < 4; ++r) { const int m = m0 + r * NGW; if (m < M) { const GAS f32x4* xr = (const GAS f32x4*)(x + (size_t)m * D) + lane;
#pragma unroll
              for (int j = 0; j < 4; ++j) v[r][j] = xr[64 * j]; } }
#pragma unroll
          for (int r = 0; r < 4; ++r) { const int m = m0 + r * NGW; if (m < M) { float s = 0.f;
#pragma unroll
              for (int j = 0; j < 4; ++j) s += (v[r][j].x * v[r][j].x + v[r][j].y * v[r][j].y) + (v[r][j].z * v[r][j].z + v[r][j].w * v[r][j].w);
              s = wave_sum(s);
              GAS unsigned long long* o8 = (GAS unsigned long long*)(XB + (size_t)m * D) + lane;
#pragma unroll
              for (int j = 0; j < 4; ++j) o8[64 * j] = (unsigned long long)pk2(v[r][j].x, v[r][j].y) | ((unsigned long long)pk2(v[r][j].z, v[r][j].w) << 32);
              if (lane < 16) part[(size_t)m * 16 + lane] = lane == 0 ? s : 0.f; } } } }
}
__device__ __forceinline__ void p4_lora_in(Frame& F) {
    const bf16* RKVL = (const bf16*)(F.ws + WS_RKVL); const float* mu = F.in7 + 1536;
    const int gw = F.vcu * NWAVES + F.wave, NGW = F.G * NWAVES, lane = fresh_tid() & 63, second = lane >> 5, c0 = 4 * (lane & 31);
    bf16* LA = (bf16*)(F.ws + WS_LA) + (second ? (size_t)M * 128 : 0);
    const int sc0 = second ? 64 + c0 : c0;
    const bool act = second ? c0 < 96 : c0 < 64; f32x4 mv = (f32x4){0.f, 0.f, 0.f, 0.f}; if (act) mv = *(const GAS f32x4*)(mu + sc0);
    for (int m0 = gw; m0 < M; m0 += 4 * NGW) {
        v2u cu[4], pu[4];
#pragma unroll
        for (int rr = 0; rr < 4; ++rr) { const int m = m0 + rr * NGW; cu[rr] = (v2u){0u, 0u}; pu[rr] = (v2u){0u, 0u};
            if (act) { cu[rr] = *(const GAS v2u*)(RKVL + (size_t)m * 1792 + 1536 + sc0); if ((m & (T - 1)) != 0) pu[rr] = *(const GAS v2u*)(RKVL + (size_t)(m - 1) * 1792 + 1536 + sc0); } }
#pragma unroll
        for (int rr = 0; rr < 4; ++rr) { const int m = m0 + rr * NGW; float o[4] = {0.f, 0.f, 0.f, 0.f};
            if (act) { const float cur[4] = {bflo(cu[rr].x), bfhi(cu[rr].x), bflo(cu[rr].y), bfhi(cu[rr].y)}, prv[4] = {bflo(pu[rr].x), bfhi(pu[rr].x), bflo(pu[rr].y), bfhi(pu[rr].y)};
#pragma unroll
                for (int j = 0; j < 4; ++j) { const float p = cur[j] + (prv[j] - cur[j]) * mv[j]; const int c = sc0 + j;
                    const float e = __builtin_amdgcn_exp2f((c < 32 ? 2.0f : -1.0f) * 1.44269504089f * p), rc = __builtin_amdgcn_rcpf(1.0f + e);
                    o[j] = c < 32 ? 1.0f - 2.0f * rc : (c < 64 ? p : rc); } }
            *(GAS v2u*)(LA + (size_t)m * 128 + c0) = (v2u){pk2(o[0], o[1]), pk2(o[2], o[3])}; }
    }
}
__device__ __forceinline__ float sum8(float v) { v += __shfl_xor(v, 1); v += __shfl_xor(v, 2); v += __shfl_xor(v, 4); return v; }
__device__ __forceinline__ void unpack8(const v4u u, float (&f)[8]) { f[0] = bflo(u.x); f[1] = bfhi(u.x); f[2] = bflo(u.y); f[3] = bfhi(u.y); f[4] = bflo(u.z); f[5] = bfhi(u.z); f[6] = bflo(u.w); f[7] = bfhi(u.w); }
__device__ __forceinline__ v4u pack8u(const float (&f)[8]) { return (v4u){pk2(f[0], f[1]), pk2(f[2], f[3]), pk2(f[4], f[5]), pk2(f[6], f[7])}; }
__device__ __forceinline__ void ld8f(const float* p, float (&f)[8]) { const f32x4 a = *(const GAS f32x4*)p, b = *(const GAS f32x4*)(p + 4); f[0] = a.x; f[1] = a.y; f[2] = a.z; f[3] = a.w; f[4] = b.x; f[5] = b.y; f[6] = b.z; f[7] = b.w; }
constexpr int KS_STRIDE = 144, VT_STRIDE = 528, ATT_KS_OFF = 0, ATT_VT_OFF = 256 * KS_STRIDE;
__device__ __forceinline__ void p6_attention(Frame& F) {
    bf16* ATTQ = (bf16*)(F.ws + WS_ATTQ); const bf16* ATTKV = (const bf16*)(F.ws + WS_ATTKV);
    const float* qn = F.in18; const float* kn = F.in19; const float* sinks = F.in20;
    LAS unsigned char* Ks = F.lds + ATT_KS_OFF; LAS unsigned char* Vt = F.lds + ATT_VT_OFF;
    const int tid = fresh_tid(), lane = tid & 63, w = F.wave, g = lane >> 4, n16 = lane & 15;
    for (int unit = F.vcu; unit < BATCH * 2 * 32; unit += F.G) {
        const int nb = unit & 31, kvh = (unit >> 5) & 1, b = unit >> 6; const int m0 = b * T + nb * 128;
#pragma unroll
        for (int i = 0; i < 4; ++i) { const int e = tid + 512 * i, key = e >> 3, dg = e & 7; const bool valid = nb > 0 || key >= 128;
            v4u ku = (v4u){0u, 0u, 0u, 0u}, vu = (v4u){0u, 0u, 0u, 0u};
            if (valid) { const bf16* src = ATTKV + (size_t)(m0 - 128 + key) * 256 + kvh * 64 + dg * 8; ku = *(const GAS v4u*)src; vu = *(const GAS v4u*)(src + 128); }
            float kf[8] = {bflo(ku.x), bfhi(ku.x), bflo(ku.y), bfhi(ku.y), bflo(ku.z), bfhi(ku.z), bflo(ku.w), bfhi(ku.w)};
            float ss = 0.f;
#pragma unroll
            for (int j = 0; j < 8; ++j) ss += kf[j] * kf[j];
            ss += __shfl_xor(ss, 1); ss += __shfl_xor(ss, 2); ss += __shfl_xor(ss, 4);
            const float rs = __builtin_amdgcn_rsqf(ss * (1.0f / 64.0f) + RMS_EPS);
#pragma unroll
            for (int j = 0; j < 8; ++j) kf[j] *= rs * kn[dg * 8 + j];
            *(LAS v4u*)(Ks + key * KS_STRIDE + dg * 16) = (v4u){pk2(kf[0], kf[1]), pk2(kf[2], kf[3]), pk2(kf[4], kf[5]), pk2(kf[6], kf[7])};
            const unsigned vv[4] = {vu.x, vu.y, vu.z, vu.w};
#pragma unroll
            for (int j = 0; j < 8; ++j) *(LAS bf16*)(Vt + (dg * 8 + j) * VT_STRIDE + key * 2) = (bf16)((vv[j >> 1] >> ((j & 1) * 16)) & 0xffffu);
        }
        __syncthreads();
        const int hq = kvh * 4 + (w >> 1), qbase = (w & 1) * 64; const float sink = sinks[hq] * 1.44269504089f;
        float qg[16];
#pragma unroll
        for (int j = 0; j < 16; ++j) qg[j] = qn[(j >> 3) * 32 + 8 * g + (j & 7)];
        bf16* qrow = ATTQ + (size_t)(m0 + qbase + n16) * 512 + hq * 64 + 8 * g;
        v4u qa_n = *(const GAS v4u*)qrow, qb_n = *(const GAS v4u*)(qrow + 32);
        for (int qt = 0; qt < 4; ++qt) {
            const int q0 = qbase + 16 * qt, qi = q0 + n16, kt0 = q0 >> 4;
            const v4u qa = qa_n, qb = qb_n;
            if (qt < 3) { const bf16* qp = qrow + (size_t)(qt + 1) * 16 * 512; qa_n = *(const GAS v4u*)qp; qb_n = *(const GAS v4u*)(qp + 32); }
            bf16x8 ka[9][2];
#pragma unroll
            for (int i = 0; i < 9; ++i) { const int kt = kt0 + i, ktc = kt < 16 ? kt : 15; const LAS unsigned char* kp = Ks + (16 * ktc + n16) * KS_STRIDE + 16 * g;
                ka[i][0] = *(const LAS bf16x8*)kp; ka[i][1] = *(const LAS bf16x8*)(kp + 64); }
            float q[16] = {bflo(qa.x), bfhi(qa.x), bflo(qa.y), bfhi(qa.y), bflo(qa.z), bfhi(qa.z), bflo(qa.w), bfhi(qa.w),
                           bflo(qb.x), bfhi(qb.x), bflo(qb.y), bfhi(qb.y), bflo(qb.z), bfhi(qb.z), bflo(qb.w), bfhi(qb.w)};
            float ss = 0.f;
#pragma unroll
            for (int j = 0; j < 16; ++j) ss += q[j] * q[j];
            ss += __shfl_xor(ss, 16); ss += __shfl_xor(ss, 32);
            const float rs = (0.125f * 1.44269504089f) * __builtin_amdgcn_rsqf(ss * (1.0f / 64.0f) + RMS_EPS);
#pragma unroll
            for (int j = 0; j < 16; ++j) q[j] *= rs * qg[j];
            const v4u qf0 = (v4u){pk2(q[0], q[1]), pk2(q[2], q[3]), pk2(q[4], q[5]), pk2(q[6], q[7])}, qf1 = (v4u){pk2(q[8], q[9]), pk2(q[10], q[11]), pk2(q[12], q[13]), pk2(q[14], q[15])};
            const bf16x8 bq0 = __builtin_bit_cast(bf16x8, qf0), bq1 = __builtin_bit_cast(bf16x8, qf1);
            __builtin_amdgcn_sched_barrier(0);
            f32x4 st[10]; st[9] = (f32x4){0.f, 0.f, 0.f, 0.f};
#pragma unroll
            for (int i = 0; i < 9; ++i) { f32x4 acc = (f32x4){0.f, 0.f, 0.f, 0.f};
                acc = __builtin_amdgcn_mfma_f32_16x16x32_bf16(ka[i][0], bq0, acc, 0, 0, 0);
                st[i] = __builtin_amdgcn_mfma_f32_16x16x32_bf16(ka[i][1], bq1, acc, 0, 0, 0); }
            v2u vf[5][4][2];
#pragma unroll
            for (int j = 0; j < 5; ++j) { const int ka_ = kt0 + 2 * j, kb_ = ka_ + 1, kac = ka_ < 16 ? ka_ : 15, kbc = kb_ < 16 ? kb_ : 15;
#pragma unroll
                for (int dt = 0; dt < 4; ++dt) { const LAS unsigned char* vp = Vt + (16 * dt + n16) * VT_STRIDE;
                    vf[j][dt][0] = *(const LAS v2u*)(vp + (16 * kac + 4 * g) * 2); vf[j][dt][1] = *(const LAS v2u*)(vp + (16 * kbc + 4 * g) * 2); } }
            float mx = -INFINITY;
#pragma unroll
            for (int i = 0; i < 9; ++i)
#pragma unroll
                for (int r = 0; r < 4; ++r) { const int kj = 16 * (kt0 + i) + 4 * g + r; const bool ok = (i != 0 || kj > qi) && (i != 8 || kj <= qi + 128) && (nb > 0 || kj >= 128);
                    st[i][r] = ok ? st[i][r] : -INFINITY; mx = fmaxf(mx, st[i][r]); }
            mx = fmaxf(mx, __shfl_xor(mx, 16)); mx = fmaxf(mx, __shfl_xor(mx, 32)); mx = fmaxf(mx, sink);
            float den = 0.f;
#pragma unroll
            for (int i = 0; i < 9; ++i)
#pragma unroll
                for (int r = 0; r < 4; ++r) { const float p = __builtin_amdgcn_exp2f(st[i][r] - mx); st[i][r] = p; den += p; }
            den += __shfl_xor(den, 16); den += __shfl_xor(den, 32); den += __builtin_amdgcn_exp2f(sink - mx);
            const float inv = __builtin_amdgcn_rcpf(den);
            f32x4 o[4];
#pragma unroll
            for (int dt = 0; dt < 4; ++dt) o[dt] = (f32x4){0.f, 0.f, 0.f, 0.f};
#pragma unroll
            for (int j = 0; j < 5; ++j) {
                const v4u pu = (v4u){pk2(st[2 * j][0], st[2 * j][1]), pk2(st[2 * j][2], st[2 * j][3]), pk2(st[2 * j + 1][0], st[2 * j + 1][1]), pk2(st[2 * j + 1][2], st[2 * j + 1][3])};
                const bf16x8 pf = __builtin_bit_cast(bf16x8, pu);
#pragma unroll
                for (int dt = 0; dt < 4; ++dt) { const bf16x8 af = __builtin_bit_cast(bf16x8, (v4u){vf[j][dt][0].x, vf[j][dt][0].y, vf[j][dt][1].x, vf[j][dt][1].y});
                    o[dt] = __builtin_amdgcn_mfma_f32_16x16x32_bf16(af, pf, o[dt], 0, 0, 0); } }
            bf16* op = ATTQ + (size_t)(m0 + qi) * 512 + hq * 64 + 4 * g;
#pragma unroll
            for (int dt = 0; dt < 4; ++dt) *(GAS v2u*)(op + 16 * dt) = (v2u){pk2(o[dt][0] * inv, o[dt][1] * inv), pk2(o[dt][2] * inv, o[dt][3] * inv)};
        }
        __syncthreads();
    }
}
constexpr int SC_NS = 32, SC_NP = 16, SC_ARR = 4096, SC_SCL = 9 * SC_ARR, SC_VS = SC_SCL + 512, SC_YB = SC_VS + 4096, SC_BUF = SC_YB + 2048;
struct ScanPre { v2u r0, r1, r2, k0, k1, k2, lw1, lw2, a1, a2; unsigned short vr0, vr1, vr2; };
struct ScanPar { f32x4 mur, muk, kkw, kaw, rkw; float muvr; };
__device__ __forceinline__ ScanPre scan_issue(Frame& F, int bh, int quarter, int t0, int lt) {
    const unsigned char* REC = F.ws + WS_REC; const bf16* RKVL = (const bf16*)(F.ws + WS_RKVL);
    const int pr = lt >> 4, q = lt & 15, b = bh >> 3, h = bh & 7, t1 = t0 + 2 * pr;
    const bf16* row1 = RKVL + (size_t)(b * T + t1) * 1792 + h * 64; const bf16* rowp = row1 - (t1 > 0 ? 1792 : 0); const bf16* row2 = row1 + 1792;
    ScanPre p;
    p.r0 = *(const GAS v2u*)(rowp + 4 * q); p.r1 = *(const GAS v2u*)(row1 + 4 * q); p.r2 = *(const GAS v2u*)(row2 + 4 * q);
    p.k0 = *(const GAS v2u*)(rowp + 512 + 4 * q); p.k1 = *(const GAS v2u*)(row1 + 512 + 4 * q); p.k2 = *(const GAS v2u*)(row2 + 512 + 4 * q);
    const size_t e1 = ((size_t)bh * T + t1) * 128 + (size_t)q * 8;
    p.lw1 = *(const GAS v2u*)(REC + 0 * REC_SLOT + e1); p.lw2 = *(const GAS v2u*)(REC + 0 * REC_SLOT + e1 + 128);
    p.a1 = *(const GAS v2u*)(REC + 4 * REC_SLOT + e1); p.a2 = *(const GAS v2u*)(REC + 4 * REC_SLOT + e1 + 128);
    const int vc = 1024 + 16 * quarter + q; p.vr0 = rowp[vc]; p.vr1 = row1[vc]; p.vr2 = row2[vc];
    if (t1 == 0) { p.r0 = (v2u){0u, 0u}; p.k0 = (v2u){0u, 0u}; p.vr0 = 0; }
    return p;
}
__device__ __forceinline__ void un4(const v2u u, float (&f)[4]) { f[0] = bflo(u.x); f[1] = bfhi(u.x); f[2] = bflo(u.y); f[3] = bfhi(u.y); }
__device__ __forceinline__ void scan_commit(Frame& F, const ScanPre& p, const ScanPar& c, int bh, int quarter, int t0, LAS unsigned char* buf, int lt) {
    const int pr = lt >> 4, q = lt & 15, idx = pr * 16 + q, t1 = t0 + 2 * pr;
    float rA[4], rB[4], rC[4], kA[4], kB[4], kC[4], lw1[4], lw2[4], s1[4], s2[4];
    un4(p.r0, rA); un4(p.r1, rB); un4(p.r2, rC); un4(p.k0, kA); un4(p.k1, kB); un4(p.k2, kC); un4(p.lw1, lw1); un4(p.lw2, lw2); un4(p.a1, s1); un4(p.a2, s2);
    float r1[4], r2[4], k1[4], k2[4], kk1[4], kk2[4]; float n1 = 0.f, n2 = 0.f;
#pragma unroll
    for (int j = 0; j < 4; ++j) { r1[j] = rB[j] + (rA[j] - rB[j]) * c.mur[j]; r2[j] = rC[j] + (rB[j] - rC[j]) * c.mur[j]; k1[j] = kB[j] + (kA[j] - kB[j]) * c.muk[j]; k2[j] = kC[j] + (kB[j] - kC[j]) * c.muk[j];
        kk1[j] = k1[j] * c.kkw[j]; kk2[j] = k2[j] * c.kkw[j]; n1 += kk1[j] * kk1[j]; n2 += kk2[j] * kk2[j]; }
    n1 = row16_sum(n1); n2 = row16_sum(n2);
    const float i1 = __builtin_amdgcn_rsqf(fmaxf(n1, 1e-24f)), i2 = __builtin_amdgcn_rsqf(fmaxf(n2, 1e-24f));
    float a1[4], a2[4], b1[4], b2[4], w1[4], w2[4], z1[4], wa2[4], wz2[4], ww[4], bw[4], kw[4];
    float be1 = 0.f, ka1 = 0.f, bo1 = 0.f, be2 = 0.f, ka2 = 0.f, bo2 = 0.f, ba = 0.f, ka = 0.f, bz = 0.f, kz = 0.f;
#pragma unroll
    for (int j = 0; j < 4; ++j) { kk1[j] *= i1; kk2[j] *= i2; a1[j] = -kk1[j]; a2[j] = -kk2[j]; b1[j] = kk1[j] * s1[j]; b2[j] = kk2[j] * s2[j];
        k1[j] *= 1.0f + (s1[j] - 1.0f) * c.kaw[j]; k2[j] *= 1.0f + (s2[j] - 1.0f) * c.kaw[j];
        w1[j] = __expf(lw1[j]); w2[j] = __expf(lw2[j]); z1[j] = w1[j] * r1[j]; const float z2 = w2[j] * r2[j];
        be1 += b1[j] * r1[j]; ka1 += k1[j] * r1[j]; bo1 += r1[j] * k1[j] * c.rkw[j]; be2 += b2[j] * r2[j]; ka2 += k2[j] * r2[j]; bo2 += r2[j] * k2[j] * c.rkw[j];
        wa2[j] = w1[j] * a2[j]; wz2[j] = w1[j] * z2; ww[j] = w1[j] * w2[j]; bw[j] = b1[j] * w2[j]; kw[j] = k1[j] * w2[j];
        ba += b1[j] * a2[j]; ka += k1[j] * a2[j]; bz += b1[j] * z2; kz += k1[j] * z2; }
    be1 = row16_sum(be1); ka1 = row16_sum(ka1); bo1 = row16_sum(bo1); be2 = row16_sum(be2); ka2 = row16_sum(ka2); bo2 = row16_sum(bo2);
    ba = row16_sum(ba); ka = row16_sum(ka); bz = row16_sum(bz); kz = row16_sum(kz);
    LAS f32x4* A = (LAS f32x4*)buf;
    A[0 * 256 + idx] = (f32x4){a1[0], z1[0], a1[1], z1[1]}; A[1 * 256 + idx] = (f32x4){a1[2], z1[2], a1[3], z1[3]};
    A[2 * 256 + idx] = (f32x4){wa2[0], wz2[0], wa2[1], wz2[1]}; A[3 * 256 + idx] = (f32x4){wa2[2], wz2[2], wa2[3], wz2[3]};
    A[4 * 256 + idx] = (f32x4){ww[0], ww[1], ww[2], ww[3]}; A[5 * 256 + idx] = (f32x4){bw[0], bw[1], bw[2], bw[3]}; A[6 * 256 + idx] = (f32x4){kw[0], kw[1], kw[2], kw[3]};
    A[7 * 256 + idx] = (f32x4){b2[0], b2[1], b2[2], b2[3]}; A[8 * 256 + idx] = (f32x4){k2[0], k2[1], k2[2], k2[3]};
    if (q == 0) { LAS f32x4* S4 = (LAS f32x4*)(buf + SC_SCL); S4[pr * 2] = (f32x4){ba, bz, ka, kz}; S4[pr * 2 + 1] = (f32x4){be1, be2, 0.f, 0.f};
        if (quarter == 0) { f32x4* SC = (f32x4*)(F.ws + WS_SC) + (size_t)bh * T + t1; SC[0] = (f32x4){be1, ka1, bo1, 0.f}; SC[1] = (f32x4){be2, ka2, bo2, 0.f}; } }
    const float vA = bf1(p.vr0), vB = bf1(p.vr1), vC = bf1(p.vr2); const float v1 = vB + (vA - vB) * c.muvr, v2 = vC + (vB - vC) * c.muvr;
    ((LAS f32x4*)(buf + SC_VS))[idx] = (f32x4){v1, v2, v1 * ka1, v2 * ka2};
    bf16* VB = (bf16*)(F.ws + WS_VB) + ((size_t)bh * T + t1) * 64 + 16 * quarter + q; VB[0] = (bf16)f2bf(v1); VB[64] = (bf16)f2bf(v2);
}
__device__ __forceinline__ void scan_flush(Frame& F, int bh, int quarter, int t0, const LAS unsigned char* buf, int lt) {
    if (lt < 128) { const int s = lt >> 2, c4 = lt & 3; const int b = bh >> 3, h = bh & 7;
        float* yraw = (float*)(F.ws + WS_YRAW);
        const LAS float* yb = (const LAS float*)(buf + SC_YB) + ((s >> 1) * 16 + 4 * c4) * 2 + (s & 1);
        const f32x4 y = (f32x4){yb[0], yb[2], yb[4], yb[6]};
        *(GAS f32x4*)(yraw + (size_t)(b * T + t0 + s) * 512 + h * 64 + 16 * quarter + 4 * c4) = y; }
}
__device__ __forceinline__ void p7_scan(Frame& F) {
    const int w = F.wave, tid = fresh_tid(), lane = tid & 63, rl = lane >> 4, q = lane & 15, lt = tid - 256;
    constexpr int NBLK = T / SC_NS;
#define SCAN_BAR() do { asm volatile("s_waitcnt lgkmcnt(0)" ::: "memory"); __builtin_amdgcn_s_barrier(); asm volatile("" ::: "memory"); } while (0)
    for (int unit = F.vcu; unit < 256; unit += F.G) {
        const int bh = unit >> 2, quarter = unit & 3;
        ScanPre pre; ScanPar par;
        if (w >= 4) { const int h = bh & 7, q4 = h * 64 + 4 * (lt & 15);
            par.mur = *(const GAS f32x4*)(F.in7 + q4); par.muk = *(const GAS f32x4*)(F.in7 + 512 + q4); par.kkw = *(const GAS f32x4*)(F.in13 + q4); par.kaw = *(const GAS f32x4*)(F.in14 + q4); par.rkw = *(const GAS f32x4*)(F.in15 + q4);
            par.muvr = F.in7[1024 + h * 64 + 16 * quarter + (lt & 15)];
            pre = scan_issue(F, bh, quarter, 0, lt); scan_commit(F, pre, par, bh, quarter, 0, F.lds, lt); pre = scan_issue(F, bh, quarter, SC_NS, lt); }
        SCAN_BAR();
        f32x2 S01 = (f32x2){0.f, 0.f}, S23 = (f32x2){0.f, 0.f};
        for (int nb = 0; nb < NBLK; ++nb) {
            LAS unsigned char* cur = F.lds + (nb & 1) * SC_BUF; LAS unsigned char* oth = F.lds + ((nb + 1) & 1) * SC_BUF;
            if (w >= 4) {
                if (nb > 0) scan_flush(F, bh, quarter, (nb - 1) * SC_NS, oth, lt);
                if (nb + 1 < NBLK) scan_commit(F, pre, par, bh, quarter, (nb + 1) * SC_NS, oth, lt);
                if (nb + 2 < NBLK) pre = scan_issue(F, bh, quarter, (nb + 2) * SC_NS, lt);
            } else {
                const LAS f32x4* A = (const LAS f32x4*)cur + q; const LAS f32x4* SCL = (const LAS f32x4*)(cur + SC_SCL);
                const int rowl = 4 * w + rl; const LAS f32x4* VS = (const LAS f32x4*)(cur + SC_VS) + rowl; LAS f32x2* YB = (LAS f32x2*)(cur + SC_YB) + rowl;
                f32x4 az1a = A[0], az1b = A[256], az2a = A[512], az2b = A[768], ww = A[1024], b1 = A[1280], k1 = A[1536], b2 = A[1792], k2 = A[2048], c0 = SCL[0], vs = VS[0]; f32x2 c1 = *(const LAS f32x2*)(SCL + 1);
#pragma unroll 4
                for (int pr = 0; pr < SC_NP; ++pr) {
                    const int pn = (pr + 1) * 16;
                    const f32x4 n_az1a = A[pn], n_az1b = A[256 + pn], n_az2a = A[512 + pn], n_az2b = A[768 + pn], n_ww = A[1024 + pn], n_b1 = A[1280 + pn], n_k1 = A[1536 + pn], n_b2 = A[1792 + pn], n_k2 = A[2048 + pn],
                                n_c0 = SCL[2 * pr + 2], n_vs = VS[pn]; const f32x2 n_c1 = *(const LAS f32x2*)(SCL + 2 * pr + 3);
                    __builtin_amdgcn_sched_barrier(0);
                    f32x2 d1 = S01.xx * az1a.xy; d1 = S01.yy * az1a.zw + d1; d1 = S23.xx * az1b.xy + d1; d1 = S23.yy * az1b.zw + d1;
                    f32x2 d2 = S01.xx * az2a.xy; d2 = S01.yy * az2a.zw + d2; d2 = S23.xx * az2b.xy + d2; d2 = S23.yy * az2b.zw + d2;
                    f32x2 t01 = S01 * ww.xy; t01 = vs.xx * k1.xy + t01; t01 = vs.yy * k2.xy + t01;
                    f32x2 t23 = S23 * ww.zw; t23 = vs.xx * k1.zw + t23; t23 = vs.yy * k2.zw + t23;
                    float e0 = d1.x, e1 = d1.y, e2 = d2.x, e3 = d2.y;
#define SCAN_DPP4(ctrl) "v_add_f32_dpp %0, %0, %0 " ctrl " row_mask:0xf bank_mask:0xf\n\tv_add_f32_dpp %1, %1, %1 " ctrl " row_mask:0xf bank_mask:0xf\n\tv_add_f32_dpp %2, %2, %2 " ctrl " row_mask:0xf bank_mask:0xf\n\tv_add_f32_dpp %3, %3, %3 " ctrl " row_mask:0xf bank_mask:0xf\n\t"
                    asm volatile("s_nop 1\n\t" SCAN_DPP4("quad_perm:[1,0,3,2]") SCAN_DPP4("quad_perm:[2,3,0,1]") SCAN_DPP4("row_half_mirror") SCAN_DPP4("row_mirror") : "+v"(e0), "+v"(e1), "+v"(e2), "+v"(e3));
#undef SCAN_DPP4
                    const float sa1 = e0, z1 = e1, p2 = e2, q2 = e3;
                    f32x2 r2 = (f32x2){p2, q2}; r2 = (f32x2){sa1, sa1} * c0.xy + r2; r2 = vs.xx * c0.zw + r2;
                    const f32x2 sa12 = (f32x2){sa1, r2.x};
                    S01 = sa12.xx * b1.xy + t01; S01 = sa12.yy * b2.xy + S01;
                    S23 = sa12.xx * b1.zw + t23; S23 = sa12.yy * b2.zw + S23;
                    YB[pr * 16] = sa12 * c1 + ((f32x2){z1, r2.y} + vs.zw);
                    az1a = n_az1a; az1b = n_az1b; az2a = n_az2a; az2b = n_az2b; ww = n_ww; b1 = n_b1; k1 = n_k1; b2 = n_b2; k2 = n_k2; c0 = n_c0; c1 = n_c1; vs = n_vs;
                }
            }
            SCAN_BAR();
        }
        if (w >= 4) scan_flush(F, bh, quarter, T - SC_NS, F.lds + ((NBLK - 1) & 1) * SC_BUF, lt);
        asm volatile("s_waitcnt vmcnt(0)" ::: "memory"); SCAN_BAR();
    }
#undef SCAN_BAR
}
__device__ __forceinline__ void p8_post(Frame& F) {
    const float* yraw = (const float*)(F.ws + WS_YRAW); const bf16* RV = (const bf16*)(F.ws + WS_VB); const f32x4* SC = (const f32x4*)(F.ws + WS_SC);
    const bf16* Gt = (const bf16*)(F.ws + WS_G); bf16* YR = (bf16*)(F.ws + WS_YR);
    const int gw = F.vcu * NWAVES + F.wave, NGW = F.G * NWAVES, lane = fresh_tid() & 63, h = lane >> 3, c0 = 8 * lane, n0 = 8 * (lane & 7);
    float lw[8], lb[8]; ld8f(F.in16 + c0, lw); ld8f(F.in17 + c0, lb);
    for (int m0 = gw; m0 < M; m0 += 2 * NGW) {
        float yv[2][8]; v4u uvv[2], ugg[2]; f32x4 scv[2];
#pragma unroll
        for (int rr = 0; rr < 2; ++rr) { const int m = m0 + rr * NGW, b = m >> 12, t = m & (T - 1); const size_t rt = (size_t)(b * 8 + h) * T + t;
            ld8f(yraw + (size_t)m * 512 + c0, yv[rr]); uvv[rr] = *(const GAS v4u*)(RV + rt * 64 + n0); ugg[rr] = *(const GAS v4u*)(Gt + (size_t)m * 512 + c0); scv[rr] = *(const GAS f32x4*)(SC + rt); }
#pragma unroll
        for (int rr = 0; rr < 2; ++rr) { const int m = m0 + rr * NGW; const float bonus = scv[rr].z;
            float v[8], g[8]; unpack8(uvv[rr], v); unpack8(ugg[rr], g);
            float s1 = 0.f;
#pragma unroll
            for (int j = 0; j < 8; ++j) s1 += yv[rr][j];
            const float mean = sum8(s1) * (1.0f / 64.0f); float s2 = 0.f;
#pragma unroll
            for (int j = 0; j < 8; ++j) { yv[rr][j] -= mean; s2 += yv[rr][j] * yv[rr][j]; }
            const float rstd = __builtin_amdgcn_rsqf(sum8(s2) * (1.0f / 64.0f) + GN_EPS);
            float o[8];
#pragma unroll
            for (int j = 0; j < 8; ++j) o[j] = (yv[rr][j] * rstd * lw[j] + lb[j] + bonus * v[j]) * g[j];
            *(GAS v4u*)(YR + (size_t)m * 512 + c0) = pack8u(o); }
    }
}
__device__ __forceinline__ void p13_final(Frame& F) {
    const float* part = (const float*)(F.ws + WS_PART + 3 * 2 * MiB); const float* gn = F.in28;
    const int gw = F.vcu * NWAVES + F.wave, NGW = F.G * NWAVES, lane = fresh_tid() & 63;
    f32x4 g4[4];
#pragma unroll
    for (int j = 0; j < 4; ++j) g4[j] = ((const GAS f32x4*)gn)[lane + 64 * j];
    for (int m0 = gw; m0 < M; m0 += 4 * NGW) { f32x4 v[4][4]; float ps[4];
#pragma unroll
        for (int r = 0; r < 4; ++r) { const int m = m0 + r * NGW; ps[r] = 0.f; if (m < M) { GAS f32x4* xr = (GAS f32x4*)(F.out + (size_t)m * D) + lane; ps[r] = lane < 16 ? part[(size_t)m * 16 + lane] : 0.f;
#pragma unroll
            for (int j = 0; j < 4; ++j) v[r][j] = xr[64 * j]; } }
#pragma unroll
        for (int r = 0; r < 4; ++r) { const int m = m0 + r * NGW; if (m < M) { const float rs = 1.0f / sqrtf(wave_sum(ps[r]) * (1.0f / 1024.0f) + RMS_EPS);
            GAS f32x4* xr = (GAS f32x4*)(F.out + (size_t)m * D) + lane;
#pragma unroll
            for (int j = 0; j < 4; ++j) xr[64 * j] = v[r][j] * rs * g4[j]; } }
    }
}
struct Args { const float* in[29]; float* out; unsigned char* ws; };
__global__ void __launch_bounds__(NWAVES * 64, 2) fwd_megakernel(Args args) {
    extern __shared__ __attribute__((aligned(16))) unsigned char lds[];
    cg::grid_group grid = cg::this_grid();
    Frame F;
    F.lds = (LAS unsigned char*)lds;
    F.tid = threadIdx.x; F.lane = F.tid & 63; F.wave = __builtin_amdgcn_readfirstlane(F.tid >> 6);
    F.G = gridDim.x; { const int bx = blockIdx.x; F.vcu = (F.G % 8 == 0) ? (bx % 8) * (F.G / 8) + bx / 8 : bx; }
F.in0 = args.in[0]; F.in1 = args.in[1]; F.in2 = args.in[2]; F.in3 = args.in[3]; F.in4 = args.in[4]; F.in5 = args.in[5]; F.in6 = args.in[6]; F.in7 = args.in[7]; F.in8 = args.in[8]; F.in9 = args.in[9]; F.in10 = args.in[10]; F.in11 = args.in[11]; F.in12 = args.in[12]; F.in13 = args.in[13]; F.in14 = args.in[14]; F.in15 = args.in[15]; F.in16 = args.in[16]; F.in17 = args.in[17]; F.in18 = args.in[18]; F.in19 = args.in[19]; F.in20 = args.in[20]; F.in21 = args.in[21]; F.in22 = args.in[22]; F.in23 = args.in[23]; F.in24 = args.in[24]; F.in25 = args.in[25]; F.in26 = args.in[26]; F.in27 = args.in[27]; F.in28 = args.in[28];
    F.out = args.out; F.ws = args.ws;
    unsigned char* ws = args.ws;
    bf16* XB = (bf16*)(ws + WS_XB); bf16* HB = (bf16*)(ws + WS_H);
    float* PA = (float*)(ws + WS_PART); float* PB = PA + (size_t)M * 16; float* PC = PB + (size_t)M * 16; float* PD = PC + (size_t)M * 16;
    using pg8::gemm_phase; using pg8::StaticOrder; using pg8::Gemm;
    volatile LAS unsigned* bst = (volatile LAS unsigned*)(F.lds + RING_BYTES);
    if (F.tid == 0) { bst[0] = 0u; bst[1] = 0u; }
    __syncthreads();
    XcdBarrier bar = xcd_barrier_post((unsigned*)ws, bst);
#define SYNC() xcd_barrier(bar)
#define RUN_GEMM(EPI, Aptr, Bptr, NN, KK, ...) do { Gemm g_{(const pg8::bf16_t*)(Aptr), (const pg8::bf16_t*)(Bptr), M, (NN), (KK)}; StaticOrder S_; S_.init(M, (NN), F.G, (int)blockIdx.x); \
        pg8::EPI E_{__VA_ARGS__}; gemm_phase<pg8::EPI, StaticOrder, true, true>(F.lds, g_, S_, E_); } while (0)

    p0_prologue(F); SYNC();
    { const pg8::RsTab tb = fill_rstd(F, PA, 2 * FF); RUN_GEMM(EpiGU, XB, ws + WS_WGU1, 2 * FF, D, tb, F.lds, HB, PA); } grid.sync();
    RUN_GEMM(EpiRes, HB, ws + WS_WDN1, D, FF, F.in0, F.out, XB, PB, 0.5f); SYNC();
    { const pg8::RsTab tb = fill_rstd(F, PB, 2560); RUN_GEMM(EpiProj, XB, ws + WS_WIN, 2560, D, tb, F.lds, (bf16*)(ws + WS_RKVL), (bf16*)(ws + WS_ATTQ), (bf16*)(ws + WS_ATTKV), PB); } SYNC();
    p4_lora_in(F); p6_attention(F); SYNC();
    RUN_GEMM(EpiLora, ws + WS_LA, ws + WS_WLO, 1024, 128, (bf16*)(ws + WS_REC), (bf16*)(ws + WS_REC + 4 * REC_SLOT), (bf16*)(ws + WS_G), F.in8, F.in10, 0);
    RUN_GEMM(EpiLora, ws + WS_LA + (size_t)M * 128 * 2, ws + WS_WLO + 1024 * 128 * 2, 512, 128, (bf16*)(ws + WS_REC), (bf16*)(ws + WS_REC + 4 * REC_SLOT), (bf16*)(ws + WS_G), F.in8, F.in10, 2); SYNC();
    p7_scan(F); SYNC();
    p8_post(F);
    { const pg8::RsTab tb = fill_rstd(F, PB, 2048); RUN_GEMM(EpiGate, XB, ws + WS_WGT, 2048, D, tb, F.lds, (bf16*)(ws + WS_GATES), PB); } SYNC();
    RUN_GEMM(EpiBranch, ws + WS_YR, ws + WS_WBR, D, 512, (const bf16*)(ws + WS_GATES), (bf16*)(ws + WS_MERGED), 0, 0);
    RUN_GEMM(EpiBranch, ws + WS_ATTQ, ws + WS_WBA, D, 512, (const bf16*)(ws + WS_GATES), (bf16*)(ws + WS_MERGED), 1024, 1); SYNC();
    RUN_GEMM(EpiRes, ws + WS_MERGED, ws + WS_WOUT, D, D, F.out, F.out, XB, PC, 1.0f); SYNC();
    { const pg8::RsTab tb = fill_rstd(F, PC, 2 * FF); RUN_GEMM(EpiGU, XB, ws + WS_WGU2, 2 * FF, D, tb, F.lds, HB, PC); } SYNC();
    RUN_GEMM(EpiResNorm, HB, ws + WS_WDN2, D, FF, F.out, F.out, F.in28, (float*)(ws + WS_SC), (unsigned*)(ws + 32768), F.lds, 0.5f);
}

extern "C" void kernel_launch(void* const* d_in, const int* in_sizes, int n_in, void* d_out, int out_size, void* d_ws, size_t ws_size, hipStream_t stream) {
    static int grid = 0;
    if (grid == 0) {
        if (n_in != 29 || in_sizes[0] != M * D || out_size != M * D || ws_size < WS_END) { fprintf(stderr, "kernel_launch: unexpected shapes (n_in %d, ws %zu)\n", n_in, ws_size); grid = -1; return; }
        int dev = 0, cus = 0, per_cu = 0;
        hipGetDevice(&dev); hipDeviceGetAttribute(&cus, hipDeviceAttributeMultiprocessorCount, dev);
        if (hipFuncSetAttribute((const void*)fwd_megakernel, hipFuncAttributeMaxDynamicSharedMemorySize, LDS_BYTES) != hipSuccess) { fprintf(stderr, "kernel_launch: hipFuncSetAttribute failed\n"); grid = -1; return; }
        hipOccupancyMaxActiveBlocksPerMultiprocessor(&per_cu, (const void*)fwd_megakernel, NWAVES * 64, LDS_BYTES);
        (void)hipGetLastError();
        if (per_cu < 1) fprintf(stderr, "kernel_launch: occupancy query says %d blocks/CU\n", per_cu);
        grid = cus;
    }
    if (grid < 0) return;
    if (hipMemsetAsync(d_ws, 0, 65536, stream) != hipSuccess) { fprintf(stderr, "kernel_launch: memset failed\n"); return; }
    Args a{};
    for (int i = 0; i < 29; ++i) a.in[i] = (const float*)d_in[i];
    a.out = (float*)d_out; a.ws = (unsigned char*)d_ws;
    void* kargs[] = {&a};
    hipError_t e = hipLaunchCooperativeKernel((const void*)fwd_megakernel, dim3(grid), dim3(NWAVES * 64), kargs, LDS_BYTES, stream);
    if (e != hipSuccess) fprintf(stderr, "kernel_launch: cooperative launch failed: %s (grid %d)\n", hipGetErrorString(e), grid);
}
```
